# Optimizing an MI355X kernel written in HIP

```python
import math
import jax, jax.numpy as jnp
from jax import lax
import numpy as np

D_MODEL = 1024
BATCH = 8
SEQ = 4096
DEPTH = 1

GDN_HEADS = 4
GDN_DK = 128
GDN_DV = 128
CONV_K = 4
CHUNK = 64
ATTN_HEADS = 8
ATTN_DH = 64
DILATED_PAIRS = ((128, 1), (512, 4), (2048, 16))
QBLK = 128
NUM_BUCKETS = 32
REL_MAX_DIST = 2048
N_GROUPS = 4
EXPERTS_PER_GROUP = 8
N_EXPERTS = N_GROUPS * EXPERTS_PER_GROUP
TOP_K = 2
D_EXPERT = 256
MOE_BLK = 128

EPS = 1e-6
NEG_INF = -1e30

GDN_QK_W = GDN_HEADS * GDN_DK
GDN_V_W = GDN_HEADS * GDN_DV
ATTN_W = ATTN_HEADS * ATTN_DH
MIX_W = GDN_V_W + ATTN_W
GDN_CONV_W = 2 * GDN_QK_W + GDN_V_W
IN_COLS = GDN_CONV_W + GDN_V_W + 2 * GDN_HEADS + 3 * ATTN_W

kernel_name = "hybrid_gdn_dilated_attn_hmoe_block"


def rmsnorm(x, g):
    xf = x.astype(jnp.float32)
    y = xf * lax.rsqrt(jnp.mean(xf * xf, axis=-1, keepdims=True) + EPS)
    return (y * g.astype(jnp.float32)).astype(x.dtype)


def l2norm(x):
    return x * lax.rsqrt(jnp.sum(x * x, axis=-1, keepdims=True) + EPS)


def causal_dwconv(x, w):
    k = w.shape[0]
    return lax.conv_general_dilated(
        x, w.astype(x.dtype)[:, None, :], window_strides=(1,), padding=[(k - 1, 0)],
        dimension_numbers=("NWC", "WIO", "NWC"), feature_group_count=x.shape[-1])


def t5_bucket(dist):
    max_exact = NUM_BUCKETS // 2
    d_f = jnp.maximum(dist, 1).astype(jnp.float32)
    large = max_exact + (jnp.log(d_f / max_exact) / math.log(REL_MAX_DIST / max_exact)
                         * (NUM_BUCKETS - max_exact)).astype(jnp.int32)
    large = jnp.minimum(large, NUM_BUCKETS - 1)
    return jnp.where(dist < max_exact, dist, large)


def gated_delta_rule(q, k, v, beta, g):
    bsz, seq, nh, dk = q.shape
    dv = v.shape[-1]
    n = seq // CHUNK

    def chunks(t):
        return t.reshape(bsz, n, CHUNK, nh, -1).transpose(0, 3, 1, 2, 4)

    q, k, v = chunks(q), chunks(k), chunks(v)
    beta = beta.reshape(bsz, n, CHUNK, nh).transpose(0, 3, 1, 2)
    G = jnp.cumsum(g.reshape(bsz, n, CHUNK, nh).transpose(0, 3, 1, 2), axis=-1)
    idx = jnp.arange(CHUNK)
    diff = G[..., :, None] - G[..., None, :]
    dec_incl = jnp.exp(jnp.where(idx[:, None] >= idx[None, :], diff, -jnp.inf))
    dec_strict = jnp.where(idx[:, None] > idx[None, :], dec_incl, 0.0)
    kb = k * beta[..., None]
    a_mat = jnp.einsum("bhnik,bhnjk->bhnij", kb, k) * dec_strict + jnp.eye(CHUNK, dtype=q.dtype)
    rhs = jnp.concatenate([v * beta[..., None], kb * jnp.exp(G)[..., None]], axis=-1)
    sol = lax.linalg.triangular_solve(a_mat, rhs, left_side=True, lower=True, unit_diagonal=True)
    u0, w = sol[..., :dv], sol[..., dv:]
    a_qk = jnp.einsum("bhnik,bhnjk->bhnij", q, k) * dec_incl
    qg = q * jnp.exp(G)[..., None]
    kg = k * jnp.exp(G[..., -1:] - G)[..., None]
    gl = jnp.exp(G[..., -1])

    def step(state, inp):
        u0_c, w_c, qg_c, kg_c, aqk_c, gl_c = inp
        u = u0_c - jnp.einsum("bhck,bhkv->bhcv", w_c, state)
        o = jnp.einsum("bhck,bhkv->bhcv", qg_c, state) + jnp.einsum("bhij,bhjv->bhiv", aqk_c, u)
        state = gl_c[..., None, None] * state + jnp.einsum("bhck,bhcv->bhkv", kg_c, u)
        return state, o

    xs = tuple(jnp.moveaxis(t, 2, 0) for t in (u0, w, qg, kg, a_qk, gl))
    s0 = jnp.zeros((bsz, nh, dk, dv), jnp.float32)
    _, o = lax.scan(step, s0, xs)
    return o.transpose(1, 0, 3, 2, 4).reshape(bsz, seq, nh, dv)


def dilated_branch(q, k, v, rel_bias, window, dil):
    bsz, seq, nh, dh = q.shape
    steps = window // dil
    L = seq // dil
    Lp = -(-L // QBLK) * QBLK
    nb = Lp // QBLK

    def to_sub(t):
        t = t.reshape(bsz, L, dil, nh, dh).transpose(0, 2, 1, 3, 4)
        t = jnp.pad(t, ((0, 0), (0, 0), (0, Lp - L), (0, 0), (0, 0)))
        return t.reshape(bsz, dil, nb, QBLK, nh, dh)

    def band(t):
        prev = jnp.pad(t, ((0, 0), (0, 0), (1, 0), (0, 0), (0, 0), (0, 0)))[:, :, :-1]
        return jnp.concatenate([prev, t], axis=3)

    qb = to_sub(q)
    kk, vv = band(to_sub(k)), band(to_sub(v))
    s = jnp.einsum("brnqhd,brnkhd->brnhqk", qb, kk) * (dh ** -0.5)
    qi = jnp.arange(QBLK)[:, None]
    kj = jnp.arange(2 * QBLK)[None, :]
    delta = qi + QBLK - kj
    in_win = (delta >= 0) & (delta <= steps)
    bias = rel_bias.astype(jnp.float32)[t5_bucket(jnp.maximum(delta, 0) * dil)]
    s = s + bias.transpose(2, 0, 1)
    key_pos = jnp.arange(nb)[:, None] * QBLK - QBLK + kj
    valid = in_win[None] & (key_pos >= 0)[:, None, :]
    s = jnp.where(valid[:, None], s, NEG_INF)
    m = jnp.max(s, axis=-1, keepdims=True)
    p = jnp.exp(s - m)
    den = jnp.sum(p, axis=-1)
    o = jnp.einsum("brnhqk,brnkhd->brnqhd", p, vv) / den.transpose(0, 1, 2, 4, 3)[..., None]
    lse = (m[..., 0] + jnp.log(den)).transpose(0, 1, 2, 4, 3)
    o = o.reshape(bsz, dil, Lp, nh, dh)[:, :, :L].transpose(0, 2, 1, 3, 4).reshape(bsz, seq, nh, dh)
    lse = lse.reshape(bsz, dil, Lp, nh)[:, :, :L].transpose(0, 2, 1, 3).reshape(bsz, seq, nh)
    return o, lse


def hybrid_mixer(h, w_in, w_conv, a_log, dt_bias, gdn_norm, attn_norm, w_out, rel_bias):
    bsz, seq, _ = h.shape
    f32 = jnp.float32
    p = h @ w_in
    s1 = GDN_CONV_W
    s2 = s1 + GDN_V_W
    s3 = s2 + GDN_HEADS
    s4 = s3 + GDN_HEADS
    qkv_a, z, b_raw, a_raw, qkv_b = p[..., :s1], p[..., s1:s2], p[..., s2:s3], p[..., s3:s4], p[..., s4:]

    qkv_a = jax.nn.silu(causal_dwconv(qkv_a, w_conv)).astype(f32)
    qa = l2norm(qkv_a[..., :GDN_QK_W].reshape(bsz, seq, GDN_HEADS, GDN_DK)) * (GDN_DK ** -0.5)
    ka = l2norm(qkv_a[..., GDN_QK_W:2 * GDN_QK_W].reshape(bsz, seq, GDN_HEADS, GDN_DK))
    va = qkv_a[..., 2 * GDN_QK_W:].reshape(bsz, seq, GDN_HEADS, GDN_DV)
    beta = jax.nn.sigmoid(b_raw.astype(f32))
    g = -jnp.exp(a_log.astype(f32)) * jax.nn.softplus(a_raw.astype(f32) + dt_bias.astype(f32))
    oa = gated_delta_rule(qa, ka, va, beta, g)
    oa = rmsnorm(oa, gdn_norm) * jax.nn.silu(z.astype(f32).reshape(bsz, seq, GDN_HEADS, GDN_DV))
    oa = oa.reshape(bsz, seq, GDN_V_W)

    qkv_b = qkv_b.astype(f32)
    qb = qkv_b[..., :ATTN_W].reshape(bsz, seq, ATTN_HEADS, ATTN_DH)
    kb = qkv_b[..., ATTN_W:2 * ATTN_W].reshape(bsz, seq, ATTN_HEADS, ATTN_DH)
    vb = qkv_b[..., 2 * ATTN_W:].reshape(bsz, seq, ATTN_HEADS, ATTN_DH)
    outs, lses = [], []
    for window, dil in DILATED_PAIRS:
        o_i, lse_i = dilated_branch(qb, kb, vb, rel_bias, window, dil)
        outs.append(o_i)
        lses.append(lse_i)
    wts = jax.nn.softmax(jnp.stack(lses, axis=-1), axis=-1)
    ob = jnp.sum(jnp.stack(outs, axis=-1) * wts[:, :, :, None, :], axis=-1)
    ob = rmsnorm(ob.reshape(bsz, seq, ATTN_W), attn_norm)

    y = jnp.concatenate([oa, ob], axis=-1).astype(h.dtype)
    return y @ w_out


def hierarchical_moe(h, w_rg, w_re, w_gate, w_up, w_down):
    bsz, seq, d = h.shape
    f32 = jnp.float32
    T = bsz * seq
    xt = h.reshape(T, d)
    xf = xt.astype(f32)
    gp = jax.nn.softmax(xf @ w_rg.astype(f32), axis=-1)
    gprob, gidx = lax.top_k(gp, 1)
    el = (xf @ w_re.astype(f32)).reshape(T, N_GROUPS, EXPERTS_PER_GROUP)
    el = jnp.take_along_axis(el, gidx[:, :, None], axis=1)[:, 0]
    eprob, eidx = lax.top_k(jax.nn.softmax(el, axis=-1), TOP_K)
    eprob = eprob / jnp.sum(eprob, axis=-1, keepdims=True)
    gates = gprob * eprob
    expert = gidx * EXPERTS_PER_GROUP + eidx

    A = T * TOP_K
    flat_e = expert.reshape(A).astype(jnp.int32)
    flat_tok = jnp.repeat(jnp.arange(T, dtype=jnp.int32), TOP_K)
    flat_w = gates.reshape(A)
    order = jnp.argsort(flat_e)
    se, stok, sw = flat_e[order], flat_tok[order], flat_w[order]
    counts = jax.ops.segment_sum(jnp.ones((A,), jnp.int32), flat_e, num_segments=N_EXPERTS)
    starts = jnp.cumsum(counts) - counts
    padded = (counts + MOE_BLK - 1) // MOE_BLK * MOE_BLK
    pends = jnp.cumsum(padded)
    pstarts = pends - padded
    dest = pstarts[se] + jnp.arange(A, dtype=jnp.int32) - starts[se]
    P = -(-A // MOE_BLK) * MOE_BLK + N_EXPERTS * MOE_BLK
    nblk = P // MOE_BLK
    buf_tok = jnp.zeros((P,), jnp.int32).at[dest].set(stok)
    buf_w = jnp.zeros((P,), f32).at[dest].set(sw)
    blk_start = jnp.arange(nblk, dtype=jnp.int32) * MOE_BLK
    blk_e = jnp.minimum(jnp.searchsorted(pends, blk_start, side="right"), N_EXPERTS - 1)
    xs = xt[buf_tok].reshape(nblk, MOE_BLK, d)

    def expert_block(args):
        xb, e = args
        hid = jax.nn.silu(xb @ w_gate[e]) * (xb @ w_up[e])
        return hid @ w_down[e]

    ys = lax.map(expert_block, (xs, blk_e)).reshape(P, d)
    out = jnp.zeros((T, d), ys.dtype).at[buf_tok].add(ys * buf_w[:, None].astype(ys.dtype))
    return out.reshape(bsz, seq, d)


def setup_inputs(seed: int = 0) -> dict:
    key = jax.random.key(seed)
    ks = jax.random.split(key, 22)
    f32 = jnp.float32
    D = D_MODEL

    def nrm(k, shape, scale):
        return jax.random.normal(k, shape, f32) * scale

    dt = jnp.exp(jax.random.uniform(ks[8], (DEPTH, GDN_HEADS), f32, math.log(1e-3), math.log(1e-1)))
    return {
        "x": nrm(ks[0], (BATCH, SEQ, D), 1.0),
        "c": nrm(ks[1], (BATCH, D), 1.0),
        "w_ada": nrm(ks[2], (DEPTH, D, 6 * D), 0.5 * D ** -0.5),
        "b_ada": nrm(ks[3], (DEPTH, 6 * D), 0.02),
        "norm_mix": 1.0 + nrm(ks[4], (DEPTH, D), 0.02),
        "w_in": nrm(ks[5], (DEPTH, D, IN_COLS), D ** -0.5),
        "w_conv": nrm(ks[6], (DEPTH, CONV_K, GDN_CONV_W), CONV_K ** -0.5),
        "a_log": jnp.log(jax.random.uniform(ks[7], (DEPTH, GDN_HEADS), f32, 1.0, 16.0)),
        "dt_bias": dt + jnp.log(-jnp.expm1(-dt)),
        "gdn_norm": 1.0 + nrm(ks[9], (DEPTH, GDN_DV), 0.02),
        "attn_norm": 1.0 + nrm(ks[10], (DEPTH, ATTN_W), 0.02),
        "w_out": nrm(ks[11], (DEPTH, MIX_W, D), MIX_W ** -0.5),
        "rel_bias": nrm(ks[12], (NUM_BUCKETS, ATTN_HEADS), 0.5),
        "norm_ffn": 1.0 + nrm(ks[13], (DEPTH, D), 0.02),
        "w_router_group": nrm(ks[14], (DEPTH, D, N_GROUPS), D ** -0.5),
        "w_router_expert": nrm(ks[15], (DEPTH, D, N_EXPERTS), D ** -0.5),
        "w_gate": nrm(ks[16], (DEPTH, N_EXPERTS, D, D_EXPERT), D ** -0.5),
        "w_up": nrm(ks[17], (DEPTH, N_EXPERTS, D, D_EXPERT), D ** -0.5),
        "w_down": nrm(ks[18], (DEPTH, N_EXPERTS, D_EXPERT, D), D_EXPERT ** -0.5),
        "norm_final": 1.0 + nrm(ks[19], (D,), 0.02),
    }


def reference(x, c, w_ada, b_ada, norm_mix, w_in, w_conv, a_log, dt_bias, gdn_norm, attn_norm,
              w_out, rel_bias, norm_ffn, w_router_group, w_router_expert, w_gate, w_up, w_down,
              norm_final):
    for l in range(DEPTH):
        mod = c @ w_ada[l] + b_ada[l]
        sh_a, sc_a, gt_a, sh_f, sc_f, gt_f = jnp.split(mod[:, None, :], 6, axis=-1)
        h = rmsnorm(x, norm_mix[l]) * (1.0 + sc_a) + sh_a
        x = x + gt_a * hybrid_mixer(h, w_in[l], w_conv[l], a_log[l], dt_bias[l], gdn_norm[l],
                                    attn_norm[l], w_out[l], rel_bias)
        h = rmsnorm(x, norm_ffn[l]) * (1.0 + sc_f) + sh_f
        x = x + gt_f * hierarchical_moe(h, w_router_group[l], w_router_expert[l], w_gate[l],
                                        w_up[l], w_down[l])
    return rmsnorm(x, norm_final)
```

```cpp
#include <hip/hip_runtime.h>
#include <cstdio>
#include <cstdint>
#include <cmath>

constexpr int D = 1024, BATCH = 8, SEQ = 4096, T = BATCH * SEQ;
constexpr int IN_COLS = 3592, NEXP = 32, DEXP = 256, CAP = 65536;
constexpr float EPS = 1e-6f;
constexpr size_t MiB = 1u << 20;
constexpr size_t WS_MOD = 0;
constexpr size_t WS_BA = 1 * MiB;
constexpr size_t WS_LOGIT = 2 * MiB;
constexpr size_t WS_CNT = 8 * MiB;
constexpr size_t WS_QKVA = 16 * MiB;
constexpr size_t WS_Z = 208 * MiB;
constexpr size_t WS_QKVB = 272 * MiB;
constexpr size_t WS_XMID = 16 * MiB;
constexpr size_t WS_ACC = 144 * MiB;
constexpr size_t WS_HID = 272 * MiB;
constexpr size_t WS_LTOK = 464 * MiB;
constexpr size_t WS_LW = 472 * MiB;
constexpr size_t WS_NEED = 480 * MiB;

__device__ __forceinline__ float siluf(float x) { return x / (1.f + expf(-x)); }
__device__ __forceinline__ float sigmoidf(float x) { return 1.f / (1.f + expf(-x)); }

__global__ void k_mod(const float* c, const float* w, const float* b, float* mod) {
    int i = blockIdx.x * blockDim.x + threadIdx.x;
    if (i >= BATCH * 6144) return;
    int bb = i / 6144, n = i % 6144;
    float acc = 0.f;
    for (int k = 0; k < D; ++k) acc += c[bb * D + k] * w[(size_t)k * 6144 + n];
    mod[i] = acc + b[n];
}

__global__ void k_hnorm(const float* x, const float* g, const float* mod, int sh_off, int sc_off, float* out) {
    __shared__ float red[4];
    const int m = blockIdx.x, tid = threadIdx.x, bb = m / SEQ;
    const float4 v = ((const float4*)(x + (size_t)m * D))[tid];
    float s = v.x * v.x + v.y * v.y + v.z * v.z + v.w * v.w;
    for (int o = 32; o > 0; o >>= 1) s += __shfl_xor(s, o);
    if ((tid & 63) == 0) red[tid >> 6] = s;
    __syncthreads();
    s = red[0] + red[1] + red[2] + red[3];
    const float rs = rsqrtf(s * (1.f / D) + EPS);
    const float4 gg = ((const float4*)g)[tid];
    const float4 sc = ((const float4*)(mod + bb * 6144 + sc_off))[tid];
    const float4 sh = ((const float4*)(mod + bb * 6144 + sh_off))[tid];
    float4 o;
    o.x = v.x * rs * gg.x * (1.f + sc.x) + sh.x; o.y = v.y * rs * gg.y * (1.f + sc.y) + sh.y;
    o.z = v.z * rs * gg.z * (1.f + sc.z) + sh.z; o.w = v.w * rs * gg.w * (1.f + sc.w) + sh.w;
    ((float4*)(out + (size_t)m * D))[tid] = o;
}

struct GArgs {
    const float* A; int lda;
    const int* gather; const int* cnt; int cap;
    int M, N, K;
    const float* B; int ldb; long bstride;
    const float* B2;
    float* C; int ldc;
    const float* X; const float* gate; int gate_off;
    const float* wl;
};
template <int EPI> __global__ void __launch_bounds__(256) k_gemm(GArgs a) {
    __shared__ float As[8][128 + 4];
    __shared__ float Bs[8][128 + 4];
    const int tid = threadIdx.x, tx = tid & 15, ty = tid >> 4;
    const int e = blockIdx.z;
    const int m0 = blockIdx.y * 128, n0 = blockIdx.x * 128;
    const int Mv = a.cnt ? a.cnt[e] : a.M;
    if (m0 >= Mv) return;
    const float* Bp = a.B + (size_t)e * a.bstride;
    const float* B2p = (EPI == 2) ? a.B2 + (size_t)e * a.bstride : nullptr;
    const int lr = tid >> 1, lk = (tid & 1) * 4;
    int arow = m0 + lr; if (arow >= Mv) arow = Mv - 1;
    size_t aoff;
    if (EPI == 2) aoff = (size_t)a.gather[(size_t)e * a.cap + arow] * a.lda;
    else if (EPI == 3) aoff = ((size_t)e * a.cap + arow) * a.lda;
    else aoff = (size_t)arow * a.lda;
    const int bk = tid >> 5, bc = (tid & 31) * 4;
    float acc[8][8], acc2[8][8];
#pragma unroll
    for (int i = 0; i < 8; ++i)
#pragma unroll
        for (int j = 0; j < 8; ++j) { acc[i][j] = 0.f; acc2[i][j] = 0.f; }
    for (int pass = 0; pass < (EPI == 2 ? 2 : 1); ++pass) {
        const float* Bq = pass ? B2p : Bp;
        for (int k0 = 0; k0 < a.K; k0 += 8) {
            const float4 av = *(const float4*)(a.A + aoff + k0 + lk);
            float4 bv = make_float4(0.f, 0.f, 0.f, 0.f);
            if (n0 + bc < a.N) bv = *(const float4*)(Bq + (size_t)(k0 + bk) * a.ldb + n0 + bc);
            __syncthreads();
            As[lk + 0][lr] = av.x; As[lk + 1][lr] = av.y; As[lk + 2][lr] = av.z; As[lk + 3][lr] = av.w;
            *(float4*)&Bs[bk][bc] = bv;
            __syncthreads();
#pragma unroll
            for (int kk = 0; kk < 8; ++kk) {
                float ar[8], br[8];
#pragma unroll
                for (int i = 0; i < 8; ++i) ar[i] = As[kk][ty * 8 + i];
#pragma unroll
                for (int j = 0; j < 8; ++j) br[j] = Bs[kk][tx * 8 + j];
#pragma unroll
                for (int i = 0; i < 8; ++i)
#pragma unroll
                    for (int j = 0; j < 8; ++j) { if (pass == 0) acc[i][j] += ar[i] * br[j]; else acc2[i][j] += ar[i] * br[j]; }
            }
        }
    }
#pragma unroll
    for (int i = 0; i < 8; ++i) {
        const int r = m0 + ty * 8 + i;
        if (r >= Mv) continue;
#pragma unroll
        for (int j = 0; j < 8; ++j) {
            const int cidx = n0 + tx * 8 + j;
            if (cidx >= a.N) continue;
            if (EPI == 0) a.C[(size_t)r * a.ldc + cidx] = acc[i][j];
            else if (EPI == 1) a.C[(size_t)r * a.ldc + cidx] = a.X[(size_t)r * a.ldc + cidx] + a.gate[(r / SEQ) * 6144 + a.gate_off + cidx] * acc[i][j];
            else if (EPI == 2) a.C[((size_t)e * a.cap + r) * a.ldc + cidx] = siluf(acc[i][j]) * acc2[i][j];
            else { const int tok = a.gather[(size_t)e * a.cap + r]; const float w = a.wl[(size_t)e * a.cap + r];
                   atomicAdd(&a.C[(size_t)tok * a.ldc + cidx], w * acc[i][j]); }
        }
    }
}

__global__ void __launch_bounds__(128) k_gdn(const float* qkva, const float* ba, const float* wconv, const float* a_log, const float* dt_bias, float* Y) {
    __shared__ float sq[128], sk[128], red[4];
    const int b = blockIdx.x >> 2, h = blockIdx.x & 3, v = threadIdx.x;
    const int cq = h * 128 + v, ck = 512 + cq, cv = 1024 + cq;
    float wq[4], wk[4], wv[4];
#pragma unroll
    for (int i = 0; i < 4; ++i) { wq[i] = wconv[i * 1536 + cq]; wk[i] = wconv[i * 1536 + ck]; wv[i] = wconv[i * 1536 + cv]; }
    float xq[4] = {0, 0, 0, 0}, xk[4] = {0, 0, 0, 0}, xv[4] = {0, 0, 0, 0};
    float S[128];
#pragma unroll
    for (int k = 0; k < 128; ++k) S[k] = 0.f;
    const float Aexp = expf(a_log[h]), dtb = dt_bias[h];
    for (int t = 0; t < SEQ; ++t) {
        const size_t m = (size_t)b * SEQ + t;
#pragma unroll
        for (int i = 0; i < 3; ++i) { xq[i] = xq[i + 1]; xk[i] = xk[i + 1]; xv[i] = xv[i + 1]; }
        xq[3] = qkva[m * 1536 + cq]; xk[3] = qkva[m * 1536 + ck]; xv[3] = qkva[m * 1536 + cv];
        float qc = 0.f, kc = 0.f, vc = 0.f;
#pragma unroll
        for (int i = 0; i < 4; ++i) { qc += wq[i] * xq[i]; kc += wk[i] * xk[i]; vc += wv[i] * xv[i]; }
        qc = siluf(qc); kc = siluf(kc); vc = siluf(vc);
        float s1 = qc * qc, s2 = kc * kc;
        for (int o = 32; o > 0; o >>= 1) { s1 += __shfl_xor(s1, o); s2 += __shfl_xor(s2, o); }
        __syncthreads();
        if ((v & 63) == 0) { red[(v >> 6) * 2] = s1; red[(v >> 6) * 2 + 1] = s2; }
        __syncthreads();
        s1 = red[0] + red[2]; s2 = red[1] + red[3];
        const float qn = qc * rsqrtf(s1 + EPS) * 0.08838834764831845f;
        const float kn = kc * rsqrtf(s2 + EPS);
        sq[v] = qn; sk[v] = kn;
        __syncthreads();
        const float beta = sigmoidf(ba[m * 8 + h]);
        const float xr = ba[m * 8 + 4 + h] + dtb;
        const float sp = xr > 20.f ? xr : log1pf(expf(xr));
        const float ad = expf(-Aexp * sp);
        float kS = 0.f;
#pragma unroll
        for (int k = 0; k < 128; ++k) kS += S[k] * sk[k];
        const float dd = beta * (vc - ad * kS);
        float o = 0.f;
#pragma unroll
        for (int k = 0; k < 128; ++k) { S[k] = ad * S[k] + sk[k] * dd; o += S[k] * sq[k]; }
        Y[m * 1024 + cq] = o;
    }
}

__global__ void __launch_bounds__(256) k_attn(const float* qkvb, const float* rel_bias, float* Y) {
    __shared__ float tbl[3 * 129][8];
    const int tid = threadIdx.x;
    for (int i = tid; i < 3 * 129; i += 256) {
        const int br = i / 129, j = i % 129, dil = br == 0 ? 1 : (br == 1 ? 4 : 16), dist = j * dil;
        int bucket;
        if (dist < 16) bucket = dist;
        else { const double vv = log((double)dist / 16.0) / log(128.0) * 16.0; int l = 16 + (int)vv; bucket = l < 31 ? l : 31; }
        for (int hh = 0; hh < 8; ++hh) tbl[i][hh] = rel_bias[bucket * 8 + hh];
    }
    __syncthreads();
    const int gid = blockIdx.x * 256 + tid;
    const int m = gid >> 3, hd = gid & 7, t = m % SEQ;
    float q[64], acc[64];
    const float* qp = qkvb + (size_t)m * 1536 + hd * 64;
#pragma unroll
    for (int d = 0; d < 64; ++d) { q[d] = qp[d] * 0.125f; acc[d] = 0.f; }
    float mrun = -1e30f, l = 0.f;
    for (int br = 0; br < 3; ++br) {
        const int dil = br == 0 ? 1 : (br == 1 ? 4 : 16);
        for (int j = 0; j <= 128; ++j) {
            const int kt = t - j * dil;
            if (kt < 0) break;
            const float* kp = qkvb + (size_t)(m - j * dil) * 1536 + 512 + hd * 64;
            const float* vp = kp + 512;
            float s = 0.f;
#pragma unroll
            for (int d = 0; d < 64; d += 4) { const float4 kk = *(const float4*)(kp + d); s += q[d] * kk.x + q[d + 1] * kk.y + q[d + 2] * kk.z + q[d + 3] * kk.w; }
            s += tbl[br * 129 + j][hd];
            const float mn = fmaxf(mrun, s);
            const float f = expf(mrun - mn), p = expf(s - mn);
            l = l * f + p;
#pragma unroll
            for (int d = 0; d < 64; d += 4) { const float4 vv = *(const float4*)(vp + d);
                acc[d] = acc[d] * f + p * vv.x; acc[d + 1] = acc[d + 1] * f + p * vv.y; acc[d + 2] = acc[d + 2] * f + p * vv.z; acc[d + 3] = acc[d + 3] * f + p * vv.w; }
            mrun = mn;
        }
    }
    const float il = 1.f / l;
    float* yp = Y + (size_t)m * 1024 + 512 + hd * 64;
#pragma unroll
    for (int d = 0; d < 64; ++d) yp[d] = acc[d] * il;
}

__global__ void k_yfin(float* Y, const float* Z, const float* gdn_norm, const float* attn_norm) {
    __shared__ float red[8];
    const int m = blockIdx.x, tid = threadIdx.x;
    float* y = Y + (size_t)m * 1024;
    const float g0 = y[tid * 2], g1 = y[tid * 2 + 1], a0 = y[512 + tid * 2], a1 = y[512 + tid * 2 + 1];
    float sg = g0 * g0 + g1 * g1, sa = a0 * a0 + a1 * a1;
    for (int o = 32; o > 0; o >>= 1) { sg += __shfl_xor(sg, o); sa += __shfl_xor(sa, o); }
    if ((tid & 63) == 0) { red[tid >> 6] = sa; }
    __syncthreads();
    sa = red[0] + red[1] + red[2] + red[3];
    const float rg = rsqrtf(sg * (1.f / 128.f) + EPS), ra = rsqrtf(sa * (1.f / 512.f) + EPS);
    const int vv = (tid * 2) & 127;
    const float z0 = Z[(size_t)m * 512 + tid * 2], z1 = Z[(size_t)m * 512 + tid * 2 + 1];
    y[tid * 2] = g0 * rg * gdn_norm[vv] * siluf(z0);
    y[tid * 2 + 1] = g1 * rg * gdn_norm[vv + 1] * siluf(z1);
    y[512 + tid * 2] = a0 * ra * attn_norm[tid * 2];
    y[512 + tid * 2 + 1] = a1 * ra * attn_norm[tid * 2 + 1];
}

__global__ void k_route(const float* logit, int* cnt, int* ltok, float* lw) {
    const int m = blockIdx.x * blockDim.x + threadIdx.x;
    if (m >= T) return;
    const float* lg = logit + (size_t)m * 36;
    float gmax = lg[0]; int gi = 0;
    for (int i = 1; i < 4; ++i) if (lg[i] > gmax) { gmax = lg[i]; gi = i; }
    float gs = 0.f;
    for (int i = 0; i < 4; ++i) gs += expf(lg[i] - gmax);
    const float gprob = 1.f / gs;
    const float* el = lg + 4 + gi * 8;
    float e1 = -1e30f, e2 = -1e30f; int i1 = 0, i2 = 0;
    for (int i = 0; i < 8; ++i) { const float v = el[i]; if (v > e1) { e2 = e1; i2 = i1; e1 = v; i1 = i; } else if (v > e2) { e2 = v; i2 = i; } }
    const float p2 = expf(e2 - e1);
    const float w1 = gprob / (1.f + p2), w2 = gprob * p2 / (1.f + p2);
    const int ex1 = gi * 8 + i1, ex2 = gi * 8 + i2;
    int s1 = atomicAdd(&cnt[ex1], 1); ltok[(size_t)ex1 * CAP + s1] = m; lw[(size_t)ex1 * CAP + s1] = w1;
    int s2 = atomicAdd(&cnt[ex2], 1); ltok[(size_t)ex2 * CAP + s2] = m; lw[(size_t)ex2 * CAP + s2] = w2;
}

__global__ void k_final(const float* xmid, const float* accb, const float* mod, const float* g, float* out) {
    __shared__ float red[4];
    const int m = blockIdx.x, tid = threadIdx.x, bb = m / SEQ;
    const float4 xv = ((const float4*)(xmid + (size_t)m * D))[tid];
    const float4 av = ((const float4*)(accb + (size_t)m * D))[tid];
    const float4 gt = ((const float4*)(mod + bb * 6144 + 5 * 1024))[tid];
    float4 v; v.x = xv.x + gt.x * av.x; v.y = xv.y + gt.y * av.y; v.z = xv.z + gt.z * av.z; v.w = xv.w + gt.w * av.w;
    float s = v.x * v.x + v.y * v.y + v.z * v.z + v.w * v.w;
    for (int o = 32; o > 0; o >>= 1) s += __shfl_xor(s, o);
    if ((tid & 63) == 0) red[tid >> 6] = s;
    __syncthreads();
    s = red[0] + red[1] + red[2] + red[3];
    const float rs = rsqrtf(s * (1.f / D) + EPS);
    const float4 gg = ((const float4*)g)[tid];
    float4 o; o.x = v.x * rs * gg.x; o.y = v.y * rs * gg.y; o.z = v.z * rs * gg.z; o.w = v.w * rs * gg.w;
    ((float4*)(out + (size_t)m * D))[tid] = o;
}

extern "C" void kernel_launch(void* const* d_in, const int* in_sizes, int n_in, void* d_out, int out_size, void* d_ws, size_t ws_size, hipStream_t stream) {
    if (ws_size < WS_NEED) { fprintf(stderr, "kernel_launch: workspace too small: %zu < %zu\n", ws_size, (size_t)WS_NEED); return; }
    const float* x = (const float*)d_in[0]; const float* c = (const float*)d_in[1]; const float* w_ada = (const float*)d_in[2]; const float* b_ada = (const float*)d_in[3];
    const float* norm_mix = (const float*)d_in[4]; const float* w_in = (const float*)d_in[5]; const float* w_conv = (const float*)d_in[6]; const float* a_log = (const float*)d_in[7];
    const float* dt_bias = (const float*)d_in[8]; const float* gdn_norm = (const float*)d_in[9]; const float* attn_norm = (const float*)d_in[10]; const float* w_out = (const float*)d_in[11];
    const float* rel_bias = (const float*)d_in[12]; const float* norm_ffn = (const float*)d_in[13]; const float* w_rg = (const float*)d_in[14]; const float* w_re = (const float*)d_in[15];
    const float* w_gate = (const float*)d_in[16]; const float* w_up = (const float*)d_in[17]; const float* w_down = (const float*)d_in[18]; const float* norm_final = (const float*)d_in[19];
    char* ws = (char*)d_ws; float* out = (float*)d_out;
    float* mod = (float*)(ws + WS_MOD); float* ba = (float*)(ws + WS_BA); float* logit = (float*)(ws + WS_LOGIT); int* cnt = (int*)(ws + WS_CNT);
    float* qkva = (float*)(ws + WS_QKVA); float* zb = (float*)(ws + WS_Z); float* qkvb = (float*)(ws + WS_QKVB);
    float* xmid = (float*)(ws + WS_XMID); float* accb = (float*)(ws + WS_ACC); float* hid = (float*)(ws + WS_HID);
    int* ltok = (int*)(ws + WS_LTOK); float* lw = (float*)(ws + WS_LW);
    float* hbuf = out;

    k_mod<<<(BATCH * 6144 + 255) / 256, 256, 0, stream>>>(c, w_ada, b_ada, mod);
    k_hnorm<<<T, 256, 0, stream>>>(x, norm_mix, mod, 0, 1024, hbuf);
    {
        GArgs g{}; g.A = hbuf; g.lda = D; g.M = T; g.K = D; g.ldb = IN_COLS;
        g.B = w_in; g.N = 1536; g.C = qkva; g.ldc = 1536; k_gemm<0><<<dim3(12, T / 128, 1), 256, 0, stream>>>(g);
        g.B = w_in + 1536; g.N = 512; g.C = zb; g.ldc = 512; k_gemm<0><<<dim3(4, T / 128, 1), 256, 0, stream>>>(g);
        g.B = w_in + 2048; g.N = 8; g.C = ba; g.ldc = 8; k_gemm<0><<<dim3(1, T / 128, 1), 256, 0, stream>>>(g);
        g.B = w_in + 2056; g.N = 1536; g.C = qkvb; g.ldc = 1536; k_gemm<0><<<dim3(12, T / 128, 1), 256, 0, stream>>>(g);
    }
    float* Y = out;
    k_gdn<<<32, 128, 0, stream>>>(qkva, ba, w_conv, a_log, dt_bias, Y);
    k_attn<<<T * 8 / 256, 256, 0, stream>>>(qkvb, rel_bias, Y);
    k_yfin<<<T, 256, 0, stream>>>(Y, zb, gdn_norm, attn_norm);
    {
        GArgs g{}; g.A = Y; g.lda = D; g.M = T; g.K = D; g.B = w_out; g.ldb = D; g.N = D; g.C = xmid; g.ldc = D; g.X = x; g.gate = mod; g.gate_off = 2048;
        k_gemm<1><<<dim3(8, T / 128, 1), 256, 0, stream>>>(g);
    }
    float* h2 = out;
    k_hnorm<<<T, 256, 0, stream>>>(xmid, norm_ffn, mod, 3072, 4096, h2);
    {
        GArgs g{}; g.A = h2; g.lda = D; g.M = T; g.K = D;
        g.B = w_rg; g.ldb = 4; g.N = 4; g.C = logit; g.ldc = 36; k_gemm<0><<<dim3(1, T / 128, 1), 256, 0, stream>>>(g);
        g.B = w_re; g.ldb = 32; g.N = 32; g.C = logit + 4; g.ldc = 36; k_gemm<0><<<dim3(1, T / 128, 1), 256, 0, stream>>>(g);
    }
    hipMemsetAsync(cnt, 0, 32 * sizeof(int), stream);
    hipMemsetAsync(accb, 0, (size_t)T * D * 4, stream);
    k_route<<<T / 256, 256, 0, stream>>>(logit, cnt, ltok, lw);
    {
        for (int e = 0; e < NEXP; ++e) {
            GArgs g{}; g.A = h2; g.lda = D; g.gather = ltok + (size_t)e * CAP; g.cnt = cnt + e; g.cap = 0; g.M = CAP; g.K = D;
            g.B = w_gate + (size_t)e * D * DEXP; g.B2 = w_up + (size_t)e * D * DEXP; g.ldb = DEXP; g.bstride = 0; g.N = DEXP; g.C = hid; g.ldc = DEXP;
            k_gemm<2><<<dim3(2, 512, 1), 256, 0, stream>>>(g);
            GArgs d{}; d.A = hid; d.lda = DEXP; d.gather = ltok + (size_t)e * CAP; d.cnt = cnt + e; d.cap = 0; d.M = CAP; d.K = DEXP;
            d.B = w_down + (size_t)e * DEXP * D; d.ldb = D; d.bstride = 0; d.N = D; d.C = accb; d.ldc = D; d.wl = lw + (size_t)e * CAP;
            k_gemm<3><<<dim3(8, 512, 1), 256, 0, stream>>>(d);
        }
    }
    k_final<<<T, 256, 0, stream>>>(xmid, accb, mod, norm_final, out);
}
```

```cpp
#define MK_DEV 0
#define MK_SPLIT 0
#define MK_MODE 0
#define MK_A1 0
#define MK_REP -1
#define MK_REPSCAN 0
#define MK_REPATT 0
#define MK_PROF_A -1
#define MK_PROF_B -1
#define MK_ATT_PF 0
#define MK_SERIAL_SCAN 0
#define MK_PROF_SA 25
#define MK_PROF_SB 250
#include <hip/hip_runtime.h>
#include <hip/hip_cooperative_groups.h>
#include <cstdio>
#include <cstdint>
#include <cmath>

namespace pg8 {
#define PG8_LAS __attribute__((address_space(3)))
typedef unsigned short bf16_t;
typedef short bf16x8 __attribute__((ext_vector_type(8)));
typedef float f32x4 __attribute__((ext_vector_type(4)));
typedef unsigned u32x4 __attribute__((ext_vector_type(4)));
constexpr int BM = 256, BK = 64, HALF = 128, HTB = HALF * BK * 2  , STAGE_BYTES = 8 * HTB, NXCD = 8, WGM = 8;

__host__ __device__ __forceinline__ int lds_byte(int r, int c) { const int st = (r >> 4) * 2 + (c >> 5), rr = r & 15, cc = c & 31, ob = rr * 64 + cc * 2; return st * 1024 + (ob ^ (((ob >> 9) & 1) << 5)); }
__host__ __device__ __forceinline__ void stage_rc(int b, int& R, int& C) { const int st = b / 1024, sb = b % 1024, swz = sb ^ (((sb >> 9) & 1) << 5); R = (st >> 1) * 16 + swz / 64; C = (st & 1) * 32 + (swz % 64) / 2; }
__host__ __device__ __forceinline__ int perm32(int rho) { const int n = rho >> 4, i = rho & 15; return 8 * (i >> 2) + 4 * n + (i & 3); }

__device__ __forceinline__ int lane_now() { int l; asm volatile("v_mbcnt_lo_u32_b32 %0, -1, 0\n\tv_mbcnt_hi_u32_b32 %0, -1, %0" : "=v"(l)); return l; }
constexpr int GATH_LDS_OFF = 148480;
struct Unit { int pm, pn, pb, e, mt; };
struct Gemm { const bf16_t* A; const bf16_t* Bt; int M, N, K; };

struct StaticOrder {
    int nM, nN, nwg, G, c;
    __host__ __device__ void init(int M, int N, int G_, int c_) { nM = M / BM; nN = N / BM; nwg = nM * nN; G = G_; c = c_; }
    __host__ __device__ bool next(int i, Unit& u) const {
        const long L = (long)i * G + c; if (L >= nwg) return false;
        int wgid = (int)L; { const int q = nwg / NXCD, r = nwg % NXCD, xcd = wgid % NXCD, off = wgid / NXCD; wgid = (xcd < r ? xcd * (q + 1) : r * (q + 1) + (xcd - r) * q) + off; }
        const int nig = WGM * nN, gid = wgid / nig, fm = gid * WGM, gsz = (nM - fm) < WGM ? (nM - fm) : WGM;
        u.pm = fm + ((wgid % nig) % gsz); u.pn = (wgid % nig) / gsz; u.pb = u.pn; u.e = 0; u.mt = 0; return true;
    }
    static constexpr bool GATHER = false;
    __device__ __forceinline__ void a_ready(const Unit&) const {}
    __device__ __forceinline__ void done(const Unit&) const {}
};

__device__ __forceinline__ unsigned cvt_pk_bf16(float lo, float hi) { typedef float f32x2_t_ __attribute__((ext_vector_type(2))); typedef __bf16 bf16x2_t_ __attribute__((ext_vector_type(2))); const f32x2_t_ v_ = {lo, hi}; return __builtin_bit_cast(unsigned, __builtin_convertvector(v_, bf16x2_t_)); }
struct EpiProj {
    static constexpr bool PERM = true, AFTER_DRAIN = false;
    unsigned char* ws; float qscale;
    __device__ __forceinline__ void operator()(const f32x4 (&acc)[2][2][4][2], const Unit& u, int wr, int wc, int fr, int fq) const {
        { const int ln_ = lane_now(); fr = ln_ & 15; fq = ln_ >> 4; }
        const int pn = u.pn;
        const int t = (pn - 6) >> 1;
        const bool a = pn < 6;
        const size_t off = a ? ((size_t)160 << 20) : (((size_t)256 + 32 * (size_t)t) << 20);
        const bool hm = !a && t >= 1;
        const int ldc = a ? 1536 : (hm ? 64 : 512), colt = a ? pn * 256 : ((pn - 6) & 1) * 256;
        const float sc = (t == 1 && !a) ? qscale : 1.f;
        const int row0 = u.pm * BM + wr * 64 + fr, col0 = colt + wc * 32 + 8 * fq;
        const int rowe = hm ? (row0 & 4095) : row0;
        const size_t cole = hm ? (((size_t)(col0 >> 6) << 18) + (size_t)(col0 & 63) + ((size_t)(row0 >> 12) << 21)) : (size_t)col0;
        const size_t bjstep = hm ? ((size_t)2 << 18) : (size_t)HALF;
        bf16_t* base = (bf16_t*)(ws + off);
#pragma unroll
        for (int ai = 0; ai < 2; ++ai)
#pragma unroll
            for (int m = 0; m < 4; ++m) { bf16_t* rowp = base + (size_t)(rowe + ai * HALF + m * 16) * ldc + cole;
#pragma unroll
                for (int bj = 0; bj < 2; ++bj) { const f32x4 v0 = acc[ai][bj][m][0] * sc, v1 = acc[ai][bj][m][1] * sc;
                    u32x4 w; w.x = cvt_pk_bf16(v0[0], v0[1]); w.y = cvt_pk_bf16(v0[2], v0[3]); w.z = cvt_pk_bf16(v1[0], v1[1]); w.w = cvt_pk_bf16(v1[2], v1[3]);
                    *(u32x4*)(rowp + bj * bjstep) = w; } }
    }
};

struct EpiRes {
    static constexpr bool PERM = true, AFTER_DRAIN = false;
    const float* x; const float* mod; bf16_t* out; int gate_off;
    __device__ __forceinline__ void operator()(const f32x4 (&acc)[2][2][4][2], const Unit& u, int wr, int wc, int fr, int fq) const {
        { const int ln_ = lane_now(); fr = ln_ & 15; fq = ln_ >> 4; }
        const int col0 = u.pn * BM + wc * 32 + 8 * fq, b = (u.pm * BM) >> 12;
#pragma unroll
        for (int bj = 0; bj < 2; ++bj) {
            const f32x4 g0 = *(const f32x4*)(mod + b * 6144 + gate_off + col0 + bj * HALF), g1 = *(const f32x4*)(mod + b * 6144 + gate_off + col0 + bj * HALF + 4);
#pragma unroll
            for (int ai = 0; ai < 2; ++ai) {
                f32x4 xv[4][2];
#pragma unroll
                for (int m = 0; m < 4; ++m) { const size_t off = (size_t)(u.pm * BM + ai * HALF + wr * 64 + m * 16 + fr) * 1024 + col0 + bj * HALF;
                    xv[m][0] = *(const f32x4*)(x + off); xv[m][1] = *(const f32x4*)(x + off + 4); }
#pragma unroll
                for (int m = 0; m < 4; ++m) { const size_t off = (size_t)(u.pm * BM + ai * HALF + wr * 64 + m * 16 + fr) * 1024 + col0 + bj * HALF;
                    const f32x4 v0 = xv[m][0] + g0 * acc[ai][bj][m][0], v1 = xv[m][1] + g1 * acc[ai][bj][m][1];
                    u32x4 w; w.x = cvt_pk_bf16(v0[0], v0[1]); w.y = cvt_pk_bf16(v0[2], v0[3]); w.z = cvt_pk_bf16(v1[0], v1[1]); w.w = cvt_pk_bf16(v1[2], v1[3]);
                    *(u32x4*)(out + off) = w; }
            }
            asm volatile("" ::: "memory"); }
    }
};
__device__ __forceinline__ float silu_f(float v) { return v * __builtin_amdgcn_rcpf(1.f + __builtin_amdgcn_exp2f(-1.4426950408889634f * v)); }
struct EpiHid {
    static constexpr bool PERM = true, AFTER_DRAIN = false;
    bf16_t* hid; int hid_bytes;
    __device__ __forceinline__ void operator()(const f32x4 (&acc)[2][2][4][2], const Unit& u, int wr, int wc, int fr, int fq) const {
        { const int ln_ = lane_now(); fr = ln_ & 15; fq = ln_ >> 4; }
        const __amdgpu_buffer_rsrc_t rs = __builtin_amdgcn_make_buffer_rsrc((void*)hid, 0, hid_bytes, 0x00020000);
        const int col0 = u.pn * HALF + wc * 32 + 8 * fq;
#pragma unroll
        for (int ai = 0; ai < 2; ++ai)
#pragma unroll
            for (int m = 0; m < 4; ++m) { const size_t row = (size_t)u.pm * BM + ai * HALF + wr * 64 + m * 16 + fr;
                const f32x4 g0 = acc[ai][0][m][0], g1 = acc[ai][0][m][1], u0 = acc[ai][1][m][0], u1 = acc[ai][1][m][1];
                u32x4 w; w.x = cvt_pk_bf16(silu_f(g0[0]) * u0[0], silu_f(g0[1]) * u0[1]); w.y = cvt_pk_bf16(silu_f(g0[2]) * u0[2], silu_f(g0[3]) * u0[3]);
                w.z = cvt_pk_bf16(silu_f(g1[0]) * u1[0], silu_f(g1[1]) * u1[1]); w.w = cvt_pk_bf16(silu_f(g1[2]) * u1[2], silu_f(g1[3]) * u1[3]);
                __builtin_amdgcn_raw_buffer_store_b128(w, rs, (unsigned)((row * 256 + col0) * 2), 0,   16); }
    }
};
struct EpiYs {
    static constexpr bool PERM = true, AFTER_DRAIN = false;
    bf16_t* ys; const float* lw; const PG8_LAS int* cnt; int cap;
    __device__ __forceinline__ void operator()(const f32x4 (&acc)[2][2][4][2], const Unit& u, int wr, int wc, int fr, int fq) const {
        { const int ln_ = lane_now(); fr = ln_ & 15; fq = ln_ >> 4; }
        const int col0 = u.pn * BM + wc * 32 + 8 * fq, n_e = cnt[u.e];
#pragma unroll
        for (int ai = 0; ai < 2; ++ai)
#pragma unroll
            for (int m = 0; m < 4; ++m) { const int rl = u.mt * BM + ai * HALF + wr * 64 + m * 16 + fr;
                const float wv = rl < n_e ? lw[(size_t)u.e * cap + rl] : 0.f;
                bf16_t* rowp = ys + ((size_t)u.pm * BM + ai * HALF + wr * 64 + m * 16 + fr) * 1024 + col0;
#pragma unroll
                for (int bj = 0; bj < 2; ++bj) { const f32x4 v0 = acc[ai][bj][m][0] * wv, v1 = acc[ai][bj][m][1] * wv;
                    u32x4 w; w.x = cvt_pk_bf16(v0[0], v0[1]); w.y = cvt_pk_bf16(v0[2], v0[3]); w.z = cvt_pk_bf16(v1[0], v1[1]); w.w = cvt_pk_bf16(v1[2], v1[3]);
                    *(u32x4*)(rowp + bj * HALF) = w; } }
    }
};
template <bool GATHER_, int NPN> struct MoeOrder {
    static constexpr bool GATHER = GATHER_;
    const PG8_LAS int* tpre; const PG8_LAS int* cnt; const int* ltok; int cap, G, c; unsigned* tcnt; int wave;
    __device__ __forceinline__ bool next(int i, Unit& u) const {
        const int NT = __builtin_amdgcn_readfirstlane(tpre[32]); int L;
        if constexpr (GATHER) { L = i * G + c; }
        else { const int x = (2 * NT) % G, F = G - x;
            if (c >= x) L = i < 2 ? (c - x) + i * F : 2 * F + (i - 2) * G + (c - x);
            else L = 2 * F + i * G + F + c; }
        if (L >= NT * NPN) return false;
        const int tt = L / NPN, pn = L % NPN; int e = 0;
#pragma unroll
        for (int k = 1; k < 32; ++k) e += (tt >= tpre[k]) ? 1 : 0;
        e = __builtin_amdgcn_readfirstlane(e);
        u.pm = tt; u.pn = pn; u.e = e; u.mt = tt - __builtin_amdgcn_readfirstlane(tpre[e]); u.pb = e * NPN + pn; return true;
    }
    __device__ __forceinline__ void avoff(const Unit& u, int tid, int K, unsigned (&v0)[2], unsigned (&v1)[2]) const {
        const int n_e = cnt[u.e];
#pragma unroll
        for (int i = 0; i < 2; ++i) { int R, C; stage_rc(tid * 16 + i * 8192, R, C); const int r0 = u.mt * BM + R, r1 = r0 + HALF;
            const int t0 = ltok[(size_t)u.e * cap + (r0 < n_e ? r0 : 0)], t1 = ltok[(size_t)u.e * cap + (r1 < n_e ? r1 : 0)];
            v0[i] = (unsigned)(t0 * K + C) * 2u; v1[i] = (unsigned)(t1 * K + C) * 2u; }
    }
    __device__ __forceinline__ void a_ready(const Unit& u) const {
        if constexpr (!GATHER) {
            if (wave == 0 && lane_now() == 0) {
                unsigned sp = 0u;
                while (__hip_atomic_load(tcnt + u.pm, __ATOMIC_RELAXED, __HIP_MEMORY_SCOPE_AGENT) < 2u && ++sp < (1u << 22)) __builtin_amdgcn_s_sleep(1);
                __builtin_amdgcn_fence(__ATOMIC_ACQUIRE, "agent"); asm volatile("s_waitcnt vmcnt(0)" ::: "memory"); }
            __builtin_amdgcn_s_barrier();
        }
    }
    __device__ __forceinline__ void done(const Unit& u) const {
        if constexpr (GATHER) {
            asm volatile("s_waitcnt vmcnt(0)" ::: "memory");
            __builtin_amdgcn_s_barrier();
            if (wave == 0 && lane_now() == 0) (void)__hip_atomic_fetch_add(tcnt + u.pm, 1u, __ATOMIC_RELAXED, __HIP_MEMORY_SCOPE_AGENT);
        }
    }
};
template <class Epi, class Sched, bool ALIGN_EPI = false, bool SP2 = false>
__device__ __forceinline__ void gemm_phase(PG8_LAS unsigned char* lds, const Gemm g, const Sched& S, const Epi& E, int wave_sgpr) {
    const int wid = __builtin_amdgcn_readfirstlane(wave_sgpr), lane = lane_now(), tid = wid * 64 + lane, wr = wid >> 2, wc = wid & 3, fr = lane & 15, fq = lane >> 4;
    const int K = g.K, nt = K / BK;
    unsigned voffA[2], voffB[2];
#pragma unroll
    for (int i = 0; i < 2; ++i) { int R, C; stage_rc(tid * 16 + i * 8192, R, C); const int Rb = Epi::PERM ? ((R & ~31) + perm32(R & 31)) : R;
        voffA[i] = (unsigned)(R * K + C) * 2u; voffB[i] = (unsigned)(Rb * K + C) * 2u; }
    const size_t kstep = (size_t)(BK * 2);
    const size_t hstep = (size_t)HALF * K * 2;
    const size_t tstep = 2 * hstep;
    const unsigned ldsw = (unsigned)wid * 1024u;
    const int aoff = lds_byte(wr * 64 + fr, fq * 8), boff = lds_byte(wc * 32 + fr, fq * 8);
#define PG8_SA(b, h) (((b) * 2 + (h)) * HTB)
#define PG8_SB(b, h) ((4 + (b) * 2 + (h)) * HTB)
#define PG8_STAGE(bufoff, gbase, voff) do { _Pragma("unroll") for (int _i = 0; _i < 2; ++_i) \
        __builtin_amdgcn_global_load_lds((const unsigned*)((const char*)(gbase) + (voff)[_i]), (PG8_LAS unsigned*)(lds + (bufoff) + ldsw + _i * 8192), 16, 0, 0); } while (0)
#define PG8_STAGE_A(bufoff, kptr, h, nxtsel) do { if constexpr (Sched::GATHER) { unsigned _v[2]; _v[0] = cv##h[0]; _v[1] = cv##h[1]; \
            if (nxtsel) { const u32x4 _p = *(const PG8_LAS u32x4*)(lds + GATH_LDS_OFF + tid * 16); _v[0] = (h) ? _p.z : _p.x; _v[1] = (h) ? _p.w : _p.y; } PG8_STAGE(bufoff, kptr, _v); } \
        else { PG8_STAGE(bufoff, (kptr) + (h) * hstep, voffA); } } while (0)
#define PG8_LDA(dst, b, h) do { _Pragma("unroll") for (int m = 0; m < 4; ++m) _Pragma("unroll") for (int k = 0; k < 2; ++k) dst[m][k] = *(const PG8_LAS bf16x8*)(lds + PG8_SA(b, h) + aoff + m * 2048 + k * 1024); } while (0)
#define PG8_LDB(dst, b, h) do { _Pragma("unroll") for (int n = 0; n < 2; ++n) _Pragma("unroll") for (int k = 0; k < 2; ++k) dst[n][k] = *(const PG8_LAS bf16x8*)(lds + PG8_SB(b, h) + boff + n * 2048 + k * 1024); } while (0)
#define PG8_MMA(ai, bj, At, Bt) do { __builtin_amdgcn_s_setprio(1); _Pragma("unroll") for (int m = 0; m < 4; ++m) _Pragma("unroll") for (int n = 0; n < 2; ++n) _Pragma("unroll") for (int k = 0; k < 2; ++k) \
        acc[ai][bj][m][n] = __builtin_amdgcn_mfma_f32_16x16x32_bf16(Bt[n][k], At[m][k], acc[ai][bj][m][n], 0, 0, 0); __builtin_amdgcn_s_setprio(0); } while (0)
#define PG8_WAIT_V(n) asm volatile("s_waitcnt vmcnt(" #n ")" ::: "memory")
#define PG8_WAIT_L(n) asm volatile("s_waitcnt lgkmcnt(" #n ")" ::: "memory")
#define PG8_BAR __builtin_amdgcn_s_barrier()
#define PG8_SCHED __builtin_amdgcn_sched_barrier(0)
    Unit cur, nxt; int ui = 0;
    if (!S.next(0, cur)) return;
    f32x4 acc[2][2][4][2];
#pragma unroll
    for (int a = 0; a < 2; ++a)
#pragma unroll
        for (int b = 0; b < 2; ++b)
#pragma unroll
            for (int m = 0; m < 4; ++m)
#pragma unroll
                for (int n = 0; n < 2; ++n) acc[a][b][m][n] = (f32x4){0.f, 0.f, 0.f, 0.f};
    bf16x8 At[4][2], B0[2][2], B1[2][2];
    const char* cA = (const char*)g.A + (Sched::GATHER ? (size_t)0 : (size_t)cur.pm * tstep); const char* cB = (const char*)g.Bt + (size_t)cur.pb * tstep;
    unsigned cv0[2] = {0u, 0u}, cv1[2] = {0u, 0u};
    if constexpr (Sched::GATHER) S.avoff(cur, tid, K, cv0, cv1);
    S.a_ready(cur);
    if constexpr (SP2) {
        PG8_STAGE(PG8_SB(0, 0), cB, voffB); PG8_STAGE(PG8_SB(0, 1), cB + hstep, voffB); PG8_STAGE_A(PG8_SA(0, 0), cA, 0, false); PG8_STAGE_A(PG8_SA(0, 1), cA, 1, false);
        if (wr == 1) PG8_BAR;
        PG8_WAIT_V(2); PG8_BAR;
        PG8_STAGE(PG8_SB(1, 0), cB + kstep, voffB); PG8_STAGE_A(PG8_SA(1, 0), cA + kstep, 0, false); PG8_STAGE(PG8_SB(1, 1), cB + hstep + kstep, voffB);
        PG8_WAIT_V(6); PG8_BAR;
    } else {
        PG8_STAGE(PG8_SB(0, 0), cB, voffB); PG8_STAGE_A(PG8_SA(0, 0), cA, 0, false); PG8_STAGE(PG8_SB(0, 1), cB + hstep, voffB); PG8_STAGE_A(PG8_SA(0, 1), cA, 1, false);
        if (wr == 1) PG8_BAR;
        PG8_WAIT_V(4); PG8_BAR;
        PG8_STAGE(PG8_SB(1, 0), cB + kstep, voffB); PG8_STAGE_A(PG8_SA(1, 0), cA + kstep, 0, false); PG8_STAGE(PG8_SB(1, 1), cB + hstep + kstep, voffB);
        PG8_WAIT_V(6); PG8_BAR;
    }
    for (;;) {
        const bool has_next = S.next(ui + 1, nxt);
        if (has_next) S.a_ready(nxt);
        const char* nA = has_next ? (const char*)g.A + (Sched::GATHER ? (size_t)0 : (size_t)nxt.pm * tstep) : cA; const char* nB = has_next ? (const char*)g.Bt + (size_t)nxt.pb * tstep : cB;
        if constexpr (Sched::GATHER) { unsigned nv0[2], nv1[2];
            if (has_next) S.avoff(nxt, tid, K, nv0, nv1); else { nv0[0] = cv0[0]; nv0[1] = cv0[1]; nv1[0] = cv1[0]; nv1[1] = cv1[1]; }
            *(PG8_LAS u32x4*)(lds + GATH_LDS_OFF + tid * 16) = (u32x4){nv0[0], nv0[1], nv1[0], nv1[1]}; }
        for (int t = 0; t < nt; t += 2) {
            const bool last = (t == nt - 2);
            const char* a1 = cA + (size_t)(t + 1) * kstep;
            const char* a2 = last ? nA : cA + (size_t)(t + 2) * kstep; const char* b2 = last ? nB : cB + (size_t)(t + 2) * kstep;
            const char* a3 = a2 + kstep; const char* b3 = b2 + kstep;
            if constexpr (SP2) {
            PG8_LDB(B0, 0, 0); PG8_LDB(B1, 0, 1); PG8_SCHED; PG8_LDA(At, 0, 0); PG8_STAGE_A(PG8_SA(1, 1), a1, 1, false);
            PG8_WAIT_V(8); PG8_WAIT_L(0); PG8_BAR; PG8_MMA(0, 0, At, B0); PG8_MMA(0, 1, At, B1); PG8_BAR; PG8_SCHED;
            PG8_LDA(At, 0, 1); PG8_STAGE(PG8_SB(0, 0), b2, voffB); PG8_STAGE(PG8_SB(0, 1), b2 + hstep, voffB); PG8_STAGE_A(PG8_SA(0, 0), a2, 0, last);
            PG8_WAIT_V(8); PG8_WAIT_L(0); PG8_BAR; PG8_MMA(1, 0, At, B0); PG8_MMA(1, 1, At, B1); PG8_BAR; PG8_SCHED;
            PG8_LDB(B0, 1, 0); PG8_LDB(B1, 1, 1); PG8_SCHED; PG8_LDA(At, 1, 0); PG8_STAGE_A(PG8_SA(0, 1), a2, 1, last);
            PG8_WAIT_V(8); PG8_WAIT_L(0); PG8_BAR; PG8_MMA(0, 0, At, B0); PG8_MMA(0, 1, At, B1); PG8_BAR; PG8_SCHED;
            PG8_LDA(At, 1, 1); PG8_STAGE(PG8_SB(1, 0), b3, voffB); PG8_STAGE(PG8_SB(1, 1), b3 + hstep, voffB); PG8_STAGE_A(PG8_SA(1, 0), a3, 0, last);
            PG8_WAIT_V(8); PG8_WAIT_L(0); PG8_BAR; PG8_MMA(1, 0, At, B0); PG8_MMA(1, 1, At, B1); PG8_BAR; PG8_SCHED;
            } else {
            PG8_LDB(B0, 0, 0); PG8_SCHED; PG8_LDA(At, 0, 0); PG8_STAGE_A(PG8_SA(1, 1), a1, 1, false);
            PG8_WAIT_L(8); PG8_BAR; PG8_WAIT_L(0); PG8_MMA(0, 0, At, B0); PG8_BAR; PG8_SCHED;
            PG8_LDB(B1, 0, 1); PG8_STAGE(PG8_SB(0, 0), b2, voffB);
            PG8_BAR; PG8_WAIT_L(0); PG8_MMA(0, 1, At, B1); PG8_BAR;
            PG8_LDA(At, 0, 1); PG8_STAGE_A(PG8_SA(0, 0), a2, 0, last);
            PG8_BAR; PG8_WAIT_L(0); PG8_MMA(1, 0, At, B0); PG8_BAR; PG8_SCHED;
            PG8_STAGE(PG8_SB(0, 1), b2 + hstep, voffB);
            PG8_WAIT_V(6); PG8_BAR; PG8_MMA(1, 1, At, B1); PG8_BAR;
            PG8_LDB(B0, 1, 0); PG8_SCHED; PG8_LDA(At, 1, 0); PG8_STAGE_A(PG8_SA(0, 1), a2, 1, last);
            PG8_WAIT_L(8); PG8_BAR; PG8_WAIT_L(0); PG8_MMA(0, 0, At, B0); PG8_BAR; PG8_SCHED;
            PG8_LDB(B1, 1, 1); PG8_STAGE(PG8_SB(1, 0), b3, voffB);
            PG8_BAR; PG8_WAIT_L(0); PG8_MMA(0, 1, At, B1); PG8_BAR;
            PG8_LDA(At, 1, 1); PG8_STAGE_A(PG8_SA(1, 0), a3, 0, last);
            PG8_BAR; PG8_WAIT_L(0); PG8_MMA(1, 0, At, B0); PG8_BAR; PG8_SCHED;
            PG8_STAGE(PG8_SB(1, 1), b3 + hstep, voffB);
            PG8_WAIT_V(6); PG8_BAR; PG8_MMA(1, 1, At, B1); PG8_BAR;
            }
        }
        if constexpr (ALIGN_EPI) { if (wr == 0) PG8_BAR; }
        if constexpr (!Epi::AFTER_DRAIN) { E(acc, cur, wr, wc, fr, fq); S.done(cur); }
        if (!has_next) break;
#pragma unroll
        for (int a = 0; a < 2; ++a)
#pragma unroll
            for (int b = 0; b < 2; ++b)
#pragma unroll
                for (int m = 0; m < 4; ++m)
#pragma unroll
                    for (int n = 0; n < 2; ++n) acc[a][b][m][n] = (f32x4){0.f, 0.f, 0.f, 0.f};
        cur = nxt; cA = nA; cB = nB; ++ui; if constexpr (Sched::GATHER) { const u32x4 _p = *(const PG8_LAS u32x4*)(lds + GATH_LDS_OFF + tid * 16); cv0[0] = _p.x; cv0[1] = _p.y; cv1[0] = _p.z; cv1[1] = _p.w; }
        if constexpr (ALIGN_EPI) { if (wr == 1) PG8_BAR; }
    }
    PG8_WAIT_V(0);
    if constexpr (!ALIGN_EPI) { if (wr == 0) PG8_BAR; }
    PG8_BAR;
    if constexpr (Epi::AFTER_DRAIN) { E.fused(acc, cur, wr, wc, fr, fq, lds, wid, lane); S.done(cur); }
#undef PG8_SA
#undef PG8_SB
#undef PG8_STAGE
#undef PG8_STAGE_A
#undef PG8_LDA
#undef PG8_LDB
#undef PG8_MMA
#undef PG8_WAIT_V
#undef PG8_WAIT_L
#undef PG8_BAR
#undef PG8_SCHED
}
}

constexpr int NWAVES = 8;
constexpr int D = 1024, BATCH = 8, SEQ = 4096, T = BATCH * SEQ;
constexpr int IN_COLS = 3592, NPROJ = 3584, NEXP = 32, DEXP = 256, CAP = 65536;
constexpr float EPS = 1e-6f;
constexpr size_t MiB = 1u << 20;
constexpr size_t WS_CTL = 0, CTL_ZERO_BYTES = 1 * MiB;
constexpr size_t WS_MOD = 1 * MiB;
constexpr size_t WS_BG = 2 * MiB;
constexpr size_t WS_TOKSLOT = 3 * MiB;
constexpr size_t WS_WRT = 6 * MiB;
constexpr size_t WS_WIN = 8 * MiB;
constexpr size_t WS_WOUT = 15 * MiB;
constexpr size_t WS_WGU = 32 * MiB;
constexpr size_t WS_WDN = 64 * MiB;
constexpr size_t WS_LTOK = 80 * MiB;
constexpr size_t WS_LW = 88 * MiB;
constexpr size_t WS_H = 96 * MiB;
constexpr size_t WS_QKVA = 160 * MiB;
constexpr size_t WS_Z = 256 * MiB;
constexpr size_t WS_QB = 288 * MiB, WS_KB = 320 * MiB, WS_VB = 352 * MiB;
constexpr size_t WS_Y = 384 * MiB;
constexpr int PROWS = 65536 + 32 * 256;
constexpr size_t WS_HID = 448 * MiB;
constexpr size_t WS_YS = 160 * MiB;
constexpr size_t WS_PART0 = 96 * MiB, WS_PART1 = 128 * MiB, WS_PART2 = 448 * MiB;
constexpr size_t WS_LSE = 480 * MiB;
constexpr size_t WS_GAQK = 484 * MiB;
constexpr size_t WS_GGL = 500 * MiB;
constexpr size_t WS_XM = 320 * MiB;
constexpr size_t WS_NEED = 512 * MiB;
static_assert(WS_QKVA == (size_t)160 << 20 && WS_Z == (size_t)256 << 20 && WS_QB == (size_t)288 << 20 && WS_KB == (size_t)320 << 20 && WS_VB == (size_t)352 << 20, "EpiProj offsets");
constexpr int CW_MODF = 992;
constexpr int CW_ATTQ = 2048;
constexpr int CW_TCNT = 2560;
constexpr int CW_CNT = 1024;
constexpr int CW_BAR = 4096;

constexpr int RING_OFF = 0, RING_BYTES = 131072;
constexpr int PHASE_LDS = 147456;
constexpr int LDSCTL_OFF = PHASE_LDS, MISC_OFF = LDSCTL_OFF + 320, MOE_OFF = MISC_OFF + 128;
constexpr int LDS_BYTES = 163840;
static_assert(RING_OFF == 0 && MOE_OFF + 512 <= pg8::GATH_LDS_OFF && pg8::GATH_LDS_OFF + 8192 <= LDS_BYTES, "LDS map");

#define GAS __attribute__((address_space(1)))
#define LAS __attribute__((address_space(3)))
typedef unsigned short bf16;
typedef unsigned v4u __attribute__((ext_vector_type(4)));
typedef float f32x4 __attribute__((ext_vector_type(4)));
typedef short bf16x8 __attribute__((ext_vector_type(8)));
typedef GAS unsigned gu32;
typedef GAS unsigned long long gu64;
#define RLX_AGENT __ATOMIC_RELAXED, __HIP_MEMORY_SCOPE_AGENT
#define LDS_WAIT() asm volatile("s_waitcnt lgkmcnt(0)" ::: "memory")
#define VM_WAIT() asm volatile("s_waitcnt vmcnt(0)" ::: "memory")
__device__ __forceinline__ unsigned long long rt() { return __builtin_amdgcn_s_memrealtime(); }
__device__ __forceinline__ unsigned f2bf(float f) { unsigned u = __builtin_bit_cast(unsigned, f); return (u + 0x7fffu + ((u >> 16) & 1u)) >> 16; }
__device__ __forceinline__ unsigned pk2(float lo, float hi) { return f2bf(lo) | (f2bf(hi) << 16); }

#define XB_TMO      128
#define XB_XCNT(j)  (256  + 64 * (j))
#define XB_XSUB(j)  (1280 + 64 * (j))
#define XB_XGEN(j)  (2304 + 64 * (j))
#define XB_TOP      3328
#define XB_TOPGEN   3392
#define XCD_BAR_WORDS 3456
#define XB_SPIN_CAP (1u << 18)

__device__ __forceinline__ unsigned xb_ld(unsigned* p)              { return __hip_atomic_load(p, __ATOMIC_RELAXED, __HIP_MEMORY_SCOPE_AGENT); }
__device__ __forceinline__ unsigned xb_add(unsigned* p, unsigned v) { return __hip_atomic_fetch_add(p, v, __ATOMIC_RELAXED, __HIP_MEMORY_SCOPE_AGENT); }
__device__ __forceinline__ unsigned xb_xcc_id() { return (unsigned)__builtin_amdgcn_s_getreg((3 << 11) | 20) & 0xFu; }
#define XB_SPIN(cond, bar) do { unsigned _sp = 0; while (cond) { __builtin_amdgcn_s_sleep(1); \
    if ((++_sp & 255u) == 0u) { if (xb_ld(&(bar)[XB_TMO])) break; if (_sp > XB_SPIN_CAP) { atomicAdd(&(bar)[XB_TMO], 1u); break; } } } } while (0)

struct XcdBarrier {
    unsigned* bar; unsigned x; int wave;
    volatile LAS unsigned* st;
};

__device__ __forceinline__ XcdBarrier xcd_barrier_post(unsigned* bar, volatile LAS unsigned* st, int wave) {
    XcdBarrier b; b.bar = bar; b.x = xb_xcc_id(); b.st = st; b.wave = wave;
    if (wave == 0 && pg8::lane_now() == 0) (void)xb_add(&bar[XB_XCNT(b.x)], 1u);
    return b;
}
__device__ __forceinline__ void xcd_barrier_complete(unsigned* bar, unsigned x, unsigned& nloc, unsigned& nx) {
    const unsigned G = gridDim.x * gridDim.y * gridDim.z;
    unsigned sum, cnt, mine, sp = 0u;
    for (;;) {
        sum = 0u; cnt = 0u; mine = 0u;
#pragma unroll
        for (unsigned j = 0; j < 16; ++j) { const unsigned c = xb_ld(&bar[XB_XCNT(j)]); sum += c; cnt += (c > 0u) ? 1u : 0u; mine = (j == x) ? c : mine; }
        if (sum == G) break;
        __builtin_amdgcn_s_sleep(1);
        if ((++sp & 255u) == 0u) { if (xb_ld(&bar[XB_TMO])) break; if (sp > XB_SPIN_CAP) { atomicAdd(&bar[XB_TMO], 1u); break; } }
    }
    nloc = mine > 0u ? mine : 1u; nx = cnt > 0u ? cnt : 1u;
}

__device__ __forceinline__ void xcd_barrier(const XcdBarrier& b) {
    asm volatile("s_waitcnt vmcnt(0)" ::: "memory");
    __syncthreads();
    if (b.wave == 0 && pg8::lane_now() == 0) {
        unsigned* bar = b.bar;
        __builtin_amdgcn_s_waitcnt(0);
        unsigned nloc = b.st[0], nx = b.st[1];
        if (nloc == 0u) { xcd_barrier_complete(bar, b.x, nloc, nx); b.st[0] = nloc; b.st[1] = nx; }
        const unsigned old = xb_add(&bar[XB_XSUB(b.x)], 1u);
        const unsigned gen = old / nloc;
        if (old + 1u == (gen + 1u) * nloc) {
            __builtin_amdgcn_fence(__ATOMIC_RELEASE, "agent");
            asm volatile("s_waitcnt vmcnt(0)" ::: "memory");
            const unsigned og = xb_add(&bar[XB_TOP], 1u);
            const unsigned tg = og / nx;
            if (og + 1u == (tg + 1u) * nx) xb_add(&bar[XB_TOPGEN], 1u);
            else XB_SPIN(xb_ld(&bar[XB_TOPGEN]) == tg, bar);
            __builtin_amdgcn_fence(__ATOMIC_ACQUIRE, "agent");
            xb_add(&bar[XB_XGEN(b.x)], 1u);
            asm volatile("s_waitcnt vmcnt(0)" ::: "memory");
        } else {
            XB_SPIN(xb_ld(&bar[XB_XGEN(b.x)]) == gen, bar);
            __builtin_amdgcn_fence(__ATOMIC_ACQUIRE, "agent");
            asm volatile("s_waitcnt vmcnt(0)" ::: "memory");
        }
    }
    __syncthreads();
}

__device__ __forceinline__ float dpp_add(float v, const int ctrl_sel) {
    int r;
    if (ctrl_sel == 0) r = __builtin_amdgcn_mov_dpp(__builtin_bit_cast(int, v), 0xB1, 0xF, 0xF, false);
    else if (ctrl_sel == 1) r = __builtin_amdgcn_mov_dpp(__builtin_bit_cast(int, v), 0x4E, 0xF, 0xF, false);
    else if (ctrl_sel == 2) r = __builtin_amdgcn_mov_dpp(__builtin_bit_cast(int, v), 0x124, 0xF, 0xF, false);
    else r = __builtin_amdgcn_mov_dpp(__builtin_bit_cast(int, v), 0x128, 0xF, 0xF, false);
    return v + __builtin_bit_cast(float, r);
}
__device__ __forceinline__ float row16_sum(float v) { v = dpp_add(v, 0); v = dpp_add(v, 1); v = dpp_add(v, 2); v = dpp_add(v, 3); return v; }
__device__ __forceinline__ float wave_sum(float v) {
    v = row16_sum(v);
    v += __shfl_xor(v, 16);
    v += __shfl_xor(v, 32);
    return v;
}
__device__ __forceinline__ void p0_transpose_item(const float* W, int K, int N, bf16* WT, int row_off, LAS float* scr, int item, int lane) {
    const int nblk = N / 32, kb = item / nblk, nb = item % nblk, k0 = 64 * kb, n0 = 32 * nb;
#pragma unroll 8
    for (int i = 0; i < 32; ++i) { const int kk = 2 * i + (lane >> 5); scr[kk * 33 + (lane & 31)] = W[(size_t)(k0 + kk) * N + n0 + (lane & 31)]; }
    LDS_WAIT(); asm volatile("" ::: "memory");
    const int c = lane & 7;
#pragma unroll
    for (int j = 0; j < 4; ++j) { const int n = (lane >> 3) + 8 * j; const LAS float* s = scr + (8 * c) * 33 + n;
        v4u o; o.x = pk2(s[0 * 33], s[1 * 33]); o.y = pk2(s[2 * 33], s[3 * 33]); o.z = pk2(s[4 * 33], s[5 * 33]); o.w = pk2(s[6 * 33], s[7 * 33]);
        *(GAS v4u*)(WT + (size_t)(row_off + n0 + n) * K + k0 + 8 * c) = o; }
    LDS_WAIT(); asm volatile("" ::: "memory");
}

__device__ __forceinline__ float bf2f(bf16 v) { return __uint_as_float((unsigned)v << 16); }
__device__ __forceinline__ float siluf(float x) { return x / (1.f + __expf(-x)); }
__device__ __forceinline__ float sigmoidf(float x) { return 1.f / (1.f + __expf(-x)); }

struct Args { const float* in[20]; float* out; unsigned char* ws; int ph_lo, ph_hi, li, pad; };

struct Frame {
    LAS unsigned char* lds; volatile LAS unsigned* MISC; gu32* ctl;
    int wave, vcu, G;
};

__device__ __forceinline__ void transpose_item(const float* W, int K, int pitch, int ncols, bf16* WT, int row_off, LAS float* scr, int item, int lane) {
    const int nblk = ncols / 32, kb = item / nblk, nb = item % nblk, k0 = 64 * kb, n0 = 32 * nb;
#pragma unroll 8
    for (int i = 0; i < 32; ++i) { const int kk = 2 * i + (lane >> 5); scr[kk * 33 + (lane & 31)] = W[(size_t)(k0 + kk) * pitch + n0 + (lane & 31)]; }
    LDS_WAIT(); asm volatile("" ::: "memory");
    const int c = lane & 7;
#pragma unroll
    for (int j = 0; j < 4; ++j) { const int n = (lane >> 3) + 8 * j; const LAS float* s = scr + (8 * c) * 33 + n;
        v4u o; o.x = pk2(s[0 * 33], s[1 * 33]); o.y = pk2(s[2 * 33], s[3 * 33]); o.z = pk2(s[4 * 33], s[5 * 33]); o.w = pk2(s[6 * 33], s[7 * 33]);
        *(GAS v4u*)(WT + (size_t)(row_off + n0 + n) * K + k0 + 8 * c) = o; }
    LDS_WAIT(); asm volatile("" ::: "memory");
}

__device__ __forceinline__ void p0_phase(Frame& F, unsigned char* ws, const float* c, const float* w_ada, const float* b_ada, const float* w_in, const float* w_out, const float* w_gate, const float* w_up, const float* w_down, const float* w_rg, const float* w_re) {
    const int lane_ = pg8::lane_now(), tid_ = F.wave * 64 + lane_;
    float* mod = (float*)(ws + WS_MOD);
    if ((int)blockIdx.x < 192) {
        LAS float* cs = (LAS float*)(F.lds + RING_OFF);
        LAS float* red = cs + 8192;
        for (int i = tid_; i < 8192; i += NWAVES * 64) cs[i] = c[i];
        __syncthreads();
        for (int item = blockIdx.x; item < 192; item += F.G) {
            const int col = tid_ & 31, kq = tid_ >> 5, n = item * 32 + col;
            float acc[8];
#pragma unroll
            for (int b = 0; b < 8; ++b) acc[b] = 0.f;
            float wa[32], wb[32];
#pragma unroll
            for (int k = 0; k < 32; ++k) wa[k] = w_ada[(size_t)(kq * 64 + k) * 6144 + n];
#pragma unroll
            for (int k = 0; k < 32; ++k) wb[k] = w_ada[(size_t)(kq * 64 + 32 + k) * 6144 + n];
#pragma unroll
            for (int k = 0; k < 32; ++k) {
#pragma unroll
                for (int b = 0; b < 8; ++b) acc[b] += cs[b * D + kq * 64 + k] * wa[k]; }
#pragma unroll
            for (int k = 0; k < 32; ++k) {
#pragma unroll
                for (int b = 0; b < 8; ++b) acc[b] += cs[b * D + kq * 64 + 32 + k] * wb[k]; }
#pragma unroll
            for (int b = 0; b < 8; ++b) red[(kq * 8 + b) * 32 + col] = acc[b];
            __syncthreads();
            if (tid_ < 256) { const int b = tid_ >> 5; float s = 0.f;
#pragma unroll
              for (int q = 0; q < 16; ++q) s += red[(q * 8 + b) * 32 + col];
              mod[b * 6144 + n] = s + b_ada[n]; }
            __syncthreads();
        }
    }
    { bf16* wrt = (bf16*)(ws + WS_WRT);
      for (int i = blockIdx.x * (NWAVES * 64) + tid_; i < 48 * 1024; i += F.G * NWAVES * 64) { const int e = i >> 10, k = i & 1023;
          const float v = e < 4 ? w_rg[k * 4 + e] : (e < 36 ? w_re[k * 32 + e - 4] : 0.f); wrt[i] = (bf16)f2bf(v); } }
}
__device__ __forceinline__ void p0b_phase(Frame& F, unsigned char* ws, const float* w_in, const float* w_out, const float* w_gate, const float* w_up, const float* w_down) {
    const int lane_ = pg8::lane_now();
    LAS float* scr = (LAS float*)(F.lds + RING_OFF + F.wave * 16384);
    const int gw = F.vcu * NWAVES + F.wave, NGW = F.G * NWAVES;
    bf16* win_t = (bf16*)(ws + WS_WIN); bf16* wout_t = (bf16*)(ws + WS_WOUT); bf16* wgu_t = (bf16*)(ws + WS_WGU); bf16* wdn_t = (bf16*)(ws + WS_WDN);
    constexpr int I_A = 16 * 64, I_B = 16 * 48, I_C = 16 * 32, I_D = 32 * 256, I_E = 32 * 128, I_ALL = I_A + I_B + I_C + I_D + I_E;
#define P0_DECODE(it_, W_, K_, pitch_, ncols_, WT_, roff_, li_) do { int r = (it_); \
        if (r < I_A) { W_ = w_in; K_ = D; pitch_ = IN_COLS; ncols_ = 2048; WT_ = win_t; roff_ = 0; li_ = r; } \
        else if ((r -= I_A) < I_B) { W_ = w_in + 2056; K_ = D; pitch_ = IN_COLS; ncols_ = 1536; WT_ = win_t; roff_ = 2048; li_ = r; } \
        else if ((r -= I_B) < I_C) { W_ = w_out; K_ = D; pitch_ = D; ncols_ = D; WT_ = wout_t; roff_ = 0; li_ = r; } \
        else if ((r -= I_C) < I_D) { const int e = r >> 8, q = r & 255, piece = q >> 6; \
            W_ = (piece < 2 ? w_gate : w_up) + (size_t)e * D * DEXP + (piece & 1) * 128; K_ = D; pitch_ = DEXP; ncols_ = 128; WT_ = wgu_t + (size_t)e * 512 * D; roff_ = (piece & 1) * 256 + (piece >> 1) * 128; li_ = q & 63; } \
        else { r -= I_D; const int e = r >> 7; W_ = w_down + (size_t)e * DEXP * D; K_ = DEXP; pitch_ = D; ncols_ = D; WT_ = wdn_t + (size_t)e * D * DEXP; roff_ = 0; li_ = r & 127; } } while (0)
#define P0_LOAD(dst, W_, pitch_, ncols_, li_) do { const int nblk_ = (ncols_) / 32, k0_ = 64 * ((li_) / nblk_), n0_ = 32 * ((li_) % nblk_); \
        _Pragma("unroll") for (int i = 0; i < 32; ++i) dst[i] = (W_)[(size_t)(k0_ + 2 * i + (lane_ >> 5)) * (pitch_) + n0_ + (lane_ & 31)]; } while (0)
    float tv[32];
    const float* cW = nullptr; int cK = 0, cP = 0, cN = 32, cR = 0, cL = 0; bf16* cT = nullptr;
    if (gw < I_ALL) { P0_DECODE(gw, cW, cK, cP, cN, cT, cR, cL); P0_LOAD(tv, cW, cP, cN, cL); }
    for (int it = gw; it < I_ALL; it += NGW) {
#pragma unroll
        for (int i = 0; i < 32; ++i) scr[(2 * i + (lane_ >> 5)) * 33 + (lane_ & 31)] = tv[i];
        const int K = cK, roff = cR; bf16* WT = cT; const int nblk = cN / 32, k0 = 64 * (cL / nblk), n0 = 32 * (cL % nblk);
        if (it + NGW < I_ALL) { P0_DECODE(it + NGW, cW, cK, cP, cN, cT, cR, cL); P0_LOAD(tv, cW, cP, cN, cL); }
        LDS_WAIT(); asm volatile("" ::: "memory");
        const int c = lane_ & 7;
#pragma unroll
        for (int j = 0; j < 4; ++j) { const int n = (lane_ >> 3) + 8 * j; const LAS float* s = scr + (8 * c) * 33 + n;
            v4u o; o.x = pk2(s[0 * 33], s[1 * 33]); o.y = pk2(s[2 * 33], s[3 * 33]); o.z = pk2(s[4 * 33], s[5 * 33]); o.w = pk2(s[6 * 33], s[7 * 33]);
            *(GAS v4u*)(WT + (size_t)(roff + n0 + n) * K + k0 + 8 * c) = o; }
        LDS_WAIT(); asm volatile("" ::: "memory");
    }
#undef P0_DECODE
#undef P0_LOAD
}

__device__ __forceinline__ void p1_rows(f32x4 (&v)[2][4], int mb, int lane_, const f32x4 (&gm)[4], const f32x4 (&sh)[4], bf16* H, const LAS float* w8, float* bg, const float* a_log, const float* dt_bias) {
            float ss[2];
#pragma unroll
            for (int r = 0; r < 2; ++r) { float s = 0.f;
#pragma unroll
                for (int j = 0; j < 4; ++j) s += (v[r][j].x * v[r][j].x + v[r][j].y * v[r][j].y) + (v[r][j].z * v[r][j].z + v[r][j].w * v[r][j].w);
                ss[r] = s; }
#pragma unroll
    for (int r = 0; r < 2; ++r) ss[r] = wave_sum(ss[r]);
            float dots[2][8];
#pragma unroll
            for (int r = 0; r < 2; ++r)
#pragma unroll
                for (int q = 0; q < 8; ++q) dots[r][q] = 0.f;
#pragma unroll
            for (int r = 0; r < 2; ++r) { const float rs = rsqrtf(ss[r] * (1.f / D) + EPS);
                GAS unsigned long long* o8 = (GAS unsigned long long*)(H + (size_t)(mb + r) * D) + lane_;
#pragma unroll
                for (int j = 0; j < 4; ++j) { v[r][j] = v[r][j] * rs * gm[j] + sh[j];
                    o8[64 * j] = (unsigned long long)pk2(v[r][j].x, v[r][j].y) | ((unsigned long long)pk2(v[r][j].z, v[r][j].w) << 32); } }
            asm volatile("" ::: "memory");
#pragma unroll
            for (int j = 0; j < 4; ++j)
#pragma unroll
                for (int q = 0; q < 8; ++q) { const f32x4 w = *(const LAS f32x4*)(w8 + q * 1024 + 4 * lane_ + 256 * j);
#pragma unroll
                    for (int r = 0; r < 2; ++r) dots[r][q] += (v[r][j].x * w.x + v[r][j].y * w.y) + (v[r][j].z * w.z + v[r][j].w * w.w); }
#pragma unroll
            for (int r = 0; r < 2; ++r)
#pragma unroll
                for (int q = 0; q < 8; ++q) dots[r][q] = wave_sum(dots[r][q]);
            if (lane_ < 16) {
                const int r = lane_ >> 3, q = lane_ & 7;
                float raw = 0.f;
#pragma unroll
                for (int rr = 0; rr < 2; ++rr)
#pragma unroll
                    for (int qq = 0; qq < 8; ++qq) raw = (r == rr && q == qq) ? dots[rr][qq] : raw;
                float o;
                if (q < 4) o = sigmoidf(raw);
                else { const int hh = q - 4; const float xr2 = raw + dt_bias[hh]; const float sp = xr2 > 20.f ? xr2 : log1pf(expf(xr2)); o = -expf(a_log[hh]) * sp; }
                bg[(size_t)(mb + r) * 8 + q] = o;
            }
}
__device__ __forceinline__ void p1_phase(Frame& F, unsigned char* ws, const float* x, const float* norm_mix, const float* w_in, const float* a_log, const float* dt_bias) {
    const int lane_ = pg8::lane_now(), tid_ = F.wave * 64 + lane_;
    const float* mod = (const float*)(ws + WS_MOD); float* bg = (float*)(ws + WS_BG); bf16* H = (bf16*)(ws + WS_H);
    LAS float* w8 = (LAS float*)(F.lds + RING_OFF);
    for (int i = tid_; i < 8 * 1024; i += NWAVES * 64) { const int j = i >> 10, k = i & 1023; w8[i] = w_in[(size_t)k * IN_COLS + 2048 + j]; }
    __syncthreads();
    for (int tl = F.vcu * NWAVES + F.wave; tl < T / 16; tl += F.G * NWAVES) {
        const int m0 = tl * 16, bb = m0 >> 12;
        f32x4 gm[4], sh[4];
#pragma unroll
        for (int j = 0; j < 4; ++j) { const f32x4 g = ((const GAS f32x4*)norm_mix)[lane_ + 64 * j]; const f32x4 sc = ((const GAS f32x4*)(mod + bb * 6144 + 1024))[lane_ + 64 * j];
            sh[j] = ((const GAS f32x4*)(mod + bb * 6144))[lane_ + 64 * j]; gm[j] = g * (sc + 1.f); }
        f32x4 vA[2][4], vB[2][4], vC[2][4];
#define P1_LOAD(dst, mb_) do { _Pragma("unroll") for (int r = 0; r < 2; ++r) { const GAS f32x4* xr = (const GAS f32x4*)(x + (size_t)((mb_) + r) * D) + lane_; \
            _Pragma("unroll") for (int j = 0; j < 4; ++j) dst[r][j] = xr[64 * j]; } } while (0)
        P1_LOAD(vA, m0); P1_LOAD(vB, m0 + 2);
        P1_LOAD(vC, m0 + 4);  p1_rows(vA, m0, lane_, gm, sh, H, w8, bg, a_log, dt_bias);
        P1_LOAD(vA, m0 + 6);  p1_rows(vB, m0 + 2, lane_, gm, sh, H, w8, bg, a_log, dt_bias);
        P1_LOAD(vB, m0 + 8);  p1_rows(vC, m0 + 4, lane_, gm, sh, H, w8, bg, a_log, dt_bias);
        P1_LOAD(vC, m0 + 10); p1_rows(vA, m0 + 6, lane_, gm, sh, H, w8, bg, a_log, dt_bias);
        P1_LOAD(vA, m0 + 12); p1_rows(vB, m0 + 8, lane_, gm, sh, H, w8, bg, a_log, dt_bias);
        P1_LOAD(vB, m0 + 14); p1_rows(vC, m0 + 10, lane_, gm, sh, H, w8, bg, a_log, dt_bias);
        p1_rows(vA, m0 + 12, lane_, gm, sh, H, w8, bg, a_log, dt_bias);
        p1_rows(vB, m0 + 14, lane_, gm, sh, H, w8, bg, a_log, dt_bias);
#undef P1_LOAD
    }
}


__device__ __forceinline__ f32x4 bf4_to_f32(unsigned long long a) { f32x4 y; y.x = __uint_as_float((unsigned)(a & 0xFFFFu) << 16); y.y = __uint_as_float((unsigned)(a >> 16) << 16); y.z = __uint_as_float((unsigned)((a >> 32) & 0xFFFFu) << 16); y.w = __uint_as_float((unsigned)(a >> 48) << 16); return y; }
__device__ __forceinline__ void p7_rows(const unsigned long long (&raw)[2][4], int mb, int lane_, const f32x4 (&gm)[4], const f32x4 (&sh)[4], bf16* H) {
    float ss[2]; f32x4 v[2][4];
#pragma unroll
    for (int r = 0; r < 2; ++r)
#pragma unroll
        for (int j = 0; j < 4; ++j) v[r][j] = bf4_to_f32(raw[r][j]);
#pragma unroll
    for (int r = 0; r < 2; ++r) { float s = 0.f;
#pragma unroll
        for (int j = 0; j < 4; ++j) s += (v[r][j].x * v[r][j].x + v[r][j].y * v[r][j].y) + (v[r][j].z * v[r][j].z + v[r][j].w * v[r][j].w);
        ss[r] = s; }
#pragma unroll
    for (int r = 0; r < 2; ++r) ss[r] = wave_sum(ss[r]);
#pragma unroll
    for (int r = 0; r < 2; ++r) { const float rs = rsqrtf(ss[r] * (1.f / D) + EPS);
        GAS unsigned long long* o8 = (GAS unsigned long long*)(H + (size_t)(mb + r) * D) + lane_;
#pragma unroll
        for (int j = 0; j < 4; ++j) { const f32x4 h = v[r][j] * rs * gm[j] + sh[j];
            o8[64 * j] = (unsigned long long)pk2(h.x, h.y) | ((unsigned long long)pk2(h.z, h.w) << 32); } }
}
#if MK_PROF_A >= 110 && MK_PROF_A < 120
#define PROF7(idx) do { if (blockIdx.x == 0 && F.wave == 0 && pg8::lane_now() == 0) { const unsigned long long t_ = __builtin_amdgcn_s_memrealtime(); \
        const unsigned long long p_ = ((unsigned long long)F.MISC[23] << 32) | F.MISC[22]; if ((idx) >= 0) F.MISC[24 + (idx)] = __float_as_uint(__uint_as_float(F.MISC[24 + (idx)]) + (float)(t_ - p_) * 0.01f); \
        F.MISC[22] = (unsigned)t_; F.MISC[23] = (unsigned)(t_ >> 32); } } while (0)
#else
#define PROF7(idx) do {} while (0)
#endif
__device__ __forceinline__ void p5_phase(Frame& F, unsigned char* ws, const bf16* xmid, const float* norm_ffn) {
    const int lane_ = pg8::lane_now(), tid_ = F.wave * 64 + lane_;
    const float* mod = (const float*)(ws + WS_MOD); bf16* H = (bf16*)(ws + WS_H); const bf16* wrt = (const bf16*)(ws + WS_WRT);
    int* ltok = (int*)(ws + WS_LTOK); float* lw = (float*)(ws + WS_LW); int* tokslot = (int*)(ws + WS_TOKSLOT);
    gu32* gcnt = F.ctl + CW_CNT;
    LAS float* lg = (LAS float*)(F.lds + RING_OFF) + F.wave * (16 * 48);
    LAS unsigned* lcnt = (LAS unsigned*)(F.lds + RING_OFF + 32768);
    LAS unsigned* gbase = lcnt + 32;
    constexpr int NT = T / 16;
    LAS unsigned char* wrtL = F.lds + RING_OFF + 40960;
    for (int i = tid_; i < 48 * 128; i += NWAVES * 64) { const int row = i >> 7, p = i & 127;
        *(LAS v4u*)(wrtL + row * 2048 + ((p ^ (row & 7)) << 4)) = *(const GAS v4u*)(wrt + (size_t)row * D + 8 * p); }
    for (int tl0 = F.vcu * NWAVES; tl0 < NT; tl0 += F.G * NWAVES) {
        const int tl = tl0 + F.wave; const bool active = tl < NT; const int m0 = tl * 16;
        if (tid_ < 32) lcnt[tid_] = 0u;
        __syncthreads(); PROF7(-1);
        int e1 = 0, e2 = 0, ls1 = 0, ls2 = 0; float w1 = 0.f, w2 = 0.f;
        if (active) {
            {
                const int bb = m0 >> 12;
                f32x4 gm[4], sh[4];
#pragma unroll
                for (int j = 0; j < 4; ++j) { const f32x4 g = ((const GAS f32x4*)norm_ffn)[lane_ + 64 * j]; const f32x4 sc = ((const GAS f32x4*)(mod + bb * 6144 + 4096))[lane_ + 64 * j];
                    sh[j] = ((const GAS f32x4*)(mod + bb * 6144 + 3072))[lane_ + 64 * j]; gm[j] = g * (sc + 1.f); }
                unsigned long long vA[2][4], vB[2][4], vC[2][4], vD[2][4];
#define P7_LOAD(dst, mb_) do { _Pragma("unroll") for (int r = 0; r < 2; ++r) { const GAS unsigned long long* xr = (const GAS unsigned long long*)(xmid + (size_t)((mb_) + r) * D) + lane_; \
                    _Pragma("unroll") for (int j = 0; j < 4; ++j) dst[r][j] = xr[64 * j]; } } while (0)
                P7_LOAD(vA, m0); P7_LOAD(vB, m0 + 2); P7_LOAD(vC, m0 + 4);
#pragma unroll 1
                for (int gp = 0; gp < 2; ++gp) {
                    P7_LOAD(vD, m0 + 8 * gp + 6);
                    p7_rows(vA, m0 + 8 * gp, lane_, gm, sh, H);
                    if (gp < 1) P7_LOAD(vA, m0 + 8);
                    p7_rows(vB, m0 + 8 * gp + 2, lane_, gm, sh, H);
                    if (gp < 1) P7_LOAD(vB, m0 + 10);
                    p7_rows(vC, m0 + 8 * gp + 4, lane_, gm, sh, H);
                    if (gp < 1) P7_LOAD(vC, m0 + 12);
                    p7_rows(vD, m0 + 8 * gp + 6, lane_, gm, sh, H);
                }
#undef P7_LOAD
            }
            PROF7(0);
            __threadfence_block();
            asm volatile("s_waitcnt vmcnt(0)" ::: "memory");
            f32x4 acc0 = {0.f, 0.f, 0.f, 0.f}, acc1 = acc0, acc2 = acc0;
            const bf16* ap = H + (size_t)(m0 + (lane_ & 15)) * D + 8 * (lane_ >> 4);
            const LAS unsigned char* bp = wrtL + (lane_ & 15) * 2048; const int bg_ = lane_ >> 4, bx_ = lane_ & 7;
#pragma unroll 16
            for (int sI = 0; sI < 32; ++sI) {
                const bf16x8 av = *(const GAS bf16x8*)(ap + 32 * sI);
                const int po = ((4 * sI + bg_) ^ bx_) << 4;
                const bf16x8 b0 = *(const LAS bf16x8*)(bp + po), b1 = *(const LAS bf16x8*)(bp + 16 * 2048 + po), b2 = *(const LAS bf16x8*)(bp + 32 * 2048 + po);
                acc0 = __builtin_amdgcn_mfma_f32_16x16x32_bf16(av, b0, acc0, 0, 0, 0);
                acc1 = __builtin_amdgcn_mfma_f32_16x16x32_bf16(av, b1, acc1, 0, 0, 0);
                acc2 = __builtin_amdgcn_mfma_f32_16x16x32_bf16(av, b2, acc2, 0, 0, 0);
            }
            PROF7(1);
#pragma unroll
            for (int rg = 0; rg < 4; ++rg) { const int row = 4 * (lane_ >> 4) + rg;
                lg[row * 48 + (lane_ & 15)] = acc0[rg]; lg[row * 48 + 16 + (lane_ & 15)] = acc1[rg]; lg[row * 48 + 32 + (lane_ & 15)] = acc2[rg]; }
            LDS_WAIT(); asm volatile("" ::: "memory");
            if (lane_ < 16) {
                const LAS float* l = lg + lane_ * 48;
                float gmax = l[0]; int gi = 0;
#pragma unroll
                for (int i = 1; i < 4; ++i) { const float v = l[i]; if (v > gmax) { gmax = v; gi = i; } }
                float gs = 0.f;
#pragma unroll
                for (int i = 0; i < 4; ++i) gs += __expf(l[i] - gmax);
                const float gprob = 1.f / gs;
                float a1 = -1e30f, a2 = -1e30f; int i1 = 0, i2 = 0;
#pragma unroll
                for (int i = 0; i < 8; ++i) { const float v = l[4 + gi * 8 + i]; if (v > a1) { a2 = a1; i2 = i1; a1 = v; i1 = i; } else if (v > a2) { a2 = v; i2 = i; } }
                const float p2 = __expf(a2 - a1);
                w1 = gprob / (1.f + p2); w2 = gprob * p2 / (1.f + p2);
                e1 = gi * 8 + i1; e2 = gi * 8 + i2;
                ls1 = (int)atomicAdd((unsigned*)&lcnt[e1], 1u); ls2 = (int)atomicAdd((unsigned*)&lcnt[e2], 1u);
            }
        }
        __syncthreads(); PROF7(2);
        if (tid_ < 32) gbase[tid_] = __hip_atomic_fetch_add(gcnt + tid_, lcnt[tid_], __ATOMIC_RELAXED, __HIP_MEMORY_SCOPE_AGENT);
        __syncthreads(); PROF7(3);
        if (active && lane_ < 16) {
            const int m = m0 + lane_; const int s1 = (int)gbase[e1] + ls1, s2 = (int)gbase[e2] + ls2;
            ltok[(size_t)e1 * CAP + s1] = m; lw[(size_t)e1 * CAP + s1] = w1;
            ltok[(size_t)e2 * CAP + s2] = m; lw[(size_t)e2 * CAP + s2] = w2;
            tokslot[2 * m] = (e1 << 20) | s1; tokslot[2 * m + 1] = (e2 << 20) | s2;
        }
        PROF7(4);
    }
}

__device__ __forceinline__ void moe_setup(Frame& F) {
    const int lane_ = pg8::lane_now(), tid_ = F.wave * 64 + lane_;
    LAS int* tpre = (LAS int*)(F.lds + MOE_OFF); LAS int* cn = tpre + 33;
    if (tid_ == 0) { int acc = 0;
        for (int e = 0; e < 32; ++e) { const int c = (int)__hip_atomic_load(F.ctl + CW_CNT + e, RLX_AGENT); cn[e] = c; tpre[e] = acc; acc += (c + 255) >> 8; }
        tpre[32] = acc; }
    __syncthreads();
}

__device__ __forceinline__ void p10_rows(const unsigned long long (&xraw)[2][4], const unsigned long long (&ya)[2][4], const unsigned long long (&yb)[2][4], int mb, int lane_, const f32x4 (&gt)[4], const f32x4 (&nf)[4], float* xo) {
    float ss[2]; f32x4 v[2][4];
#pragma unroll
    for (int r = 0; r < 2; ++r)
#pragma unroll
        for (int j = 0; j < 4; ++j) v[r][j] = bf4_to_f32(xraw[r][j]);
#pragma unroll
    for (int r = 0; r < 2; ++r) { float s = 0.f;
#pragma unroll
        for (int j = 0; j < 4; ++j) { const unsigned long long a = ya[r][j], b = yb[r][j]; f32x4 y;
            y.x = __uint_as_float((unsigned)(a & 0xFFFFu) << 16) + __uint_as_float((unsigned)(b & 0xFFFFu) << 16);
            y.y = __uint_as_float((unsigned)(a >> 16) << 16) + __uint_as_float((unsigned)(b >> 16) << 16);
            y.z = __uint_as_float((unsigned)((a >> 32) & 0xFFFFu) << 16) + __uint_as_float((unsigned)((b >> 32) & 0xFFFFu) << 16);
            y.w = __uint_as_float((unsigned)(a >> 48) << 16) + __uint_as_float((unsigned)(b >> 48) << 16);
            v[r][j] = v[r][j] + gt[j] * y;
            s += (v[r][j].x * v[r][j].x + v[r][j].y * v[r][j].y) + (v[r][j].z * v[r][j].z + v[r][j].w * v[r][j].w); }
        ss[r] = s; }
#pragma unroll
    for (int r = 0; r < 2; ++r) ss[r] = wave_sum(ss[r]);
#pragma unroll
    for (int r = 0; r < 2; ++r) { const float rs = rsqrtf(ss[r] * (1.f / D) + EPS);
        GAS f32x4* xr = (GAS f32x4*)(xo + (size_t)(mb + r) * D) + lane_;
#pragma unroll
        for (int j = 0; j < 4; ++j) xr[64 * j] = v[r][j] * rs * nf[j]; }
}
__device__ __forceinline__ void p8_phase(Frame& F, unsigned char* ws, float* xo, const float* norm_final) {
    const bf16* xm = (const bf16*)(ws + WS_XM);
    const int lane_ = pg8::lane_now();
    const float* mod = (const float*)(ws + WS_MOD); const int* tokslot = (const int*)(ws + WS_TOKSLOT); const bf16* ys = (const bf16*)(ws + WS_YS);
    const LAS int* tpre = (const LAS int*)(F.lds + MOE_OFF);
    f32x4 nf[4];
#pragma unroll
    for (int j = 0; j < 4; ++j) nf[j] = ((const GAS f32x4*)norm_final)[lane_ + 64 * j];
    for (int tl = F.vcu * NWAVES + F.wave; tl < T / 16; tl += F.G * NWAVES) {
        const int m0 = tl * 16, bb = m0 >> 12;
        int myrow = 0;
        if (lane_ < 32) { const int t = tokslot[2 * m0 + lane_]; myrow = tpre[t >> 20] * 256 + (t & 0xFFFFF); }
        f32x4 gt[4];
#pragma unroll
        for (int j = 0; j < 4; ++j) gt[j] = ((const GAS f32x4*)(mod + bb * 6144 + 5120))[lane_ + 64 * j];
        unsigned long long vA[2][4], vB[2][4], yaA[2][4], ybA[2][4], yaB[2][4], ybB[2][4];
#define P10_LOAD(dv, da, db, g_) do { _Pragma("unroll") for (int r = 0; r < 2; ++r) { \
            const size_t r0 = (size_t)__shfl(myrow, 2 * (2 * (g_) + r)), r1 = (size_t)__shfl(myrow, 2 * (2 * (g_) + r) + 1); \
            const GAS unsigned long long* xr = (const GAS unsigned long long*)(xm + (size_t)(m0 + 2 * (g_) + r) * D) + lane_; \
            const GAS unsigned long long* y0 = (const GAS unsigned long long*)(ys + r0 * D) + lane_; const GAS unsigned long long* y1 = (const GAS unsigned long long*)(ys + r1 * D) + lane_; \
            _Pragma("unroll") for (int j = 0; j < 4; ++j) { dv[r][j] = xr[64 * j]; da[r][j] = y0[64 * j]; db[r][j] = y1[64 * j]; } } } while (0)
        P10_LOAD(vA, yaA, ybA, 0);
#pragma unroll 1
        for (int gp = 0; gp < 4; ++gp) {
            P10_LOAD(vB, yaB, ybB, 2 * gp + 1);
            p10_rows(vA, yaA, ybA, m0 + 4 * gp, lane_, gt, nf, xo);
            if (gp < 3) P10_LOAD(vA, yaA, ybA, 2 * gp + 2);
            p10_rows(vB, yaB, ybB, m0 + 4 * gp + 2, lane_, gt, nf, xo);
        }
#undef P10_LOAD
    }
}

#if MK_PROF_A >= 200
#define PROFA(idx) do { if (blockIdx.x == 32 && wid_ == 0 && lane == 0) { const unsigned long long t_ = __builtin_amdgcn_s_memrealtime(); \
        const unsigned long long p_ = ((unsigned long long)misc_[23] << 32) | misc_[22]; if ((idx) >= 0) misc_[24 + (idx)] = __float_as_uint(__uint_as_float(misc_[24 + (idx)]) + (float)(t_ - p_) * 0.01f); \
        misc_[22] = (unsigned)t_; misc_[23] = (unsigned)(t_ >> 32); } } while (0)
#else
#define PROFA(idx) do {} while (0)
#endif
#ifndef ATT_NPF
#define ATT_NPF 2
#endif
namespace att {
typedef short bf16x8 __attribute__((ext_vector_type(8)));
typedef short s16x4 __attribute__((ext_vector_type(4)));
typedef float f32x16 __attribute__((ext_vector_type(16)));
typedef unsigned u32x4 __attribute__((ext_vector_type(4)));
constexpr int TBL_N = 192;
constexpr int LDS_TBL = 0;
constexpr int LDS_WAVE = 18432;
constexpr int WAVE_BYTES = 8448;
constexpr float LOG2E = 1.4426950408889634f;
__device__ __forceinline__ int crow(int r, int hi) { return (r & 3) + 8 * (r >> 2) + 4 * hi; }
__device__ __forceinline__ unsigned cvtpk(float lo, float hi) { typedef float f32x2_t_ __attribute__((ext_vector_type(2))); typedef __bf16 bf16x2_t_ __attribute__((ext_vector_type(2))); const f32x2_t_ v_ = {lo, hi}; return __builtin_bit_cast(unsigned, __builtin_convertvector(v_, bf16x2_t_)); }
__device__ __forceinline__ s16x4 vtr(const LAS unsigned char* p) { typedef short v4i16_t __attribute__((ext_vector_type(4)));
    return __builtin_bit_cast(s16x4, __builtin_amdgcn_ds_read_tr16_b64_v4i16((LAS v4i16_t*)p)); }

__device__ __forceinline__ void build_tables(LAS float* tbl, const float* rel_bias, int tid) {
    for (int i = tid; i < 24 * TBL_N; i += NWAVES * 64) {
        const int bh = i / TBL_N, u = i % TBL_N, br = bh >> 3, h = bh & 7, delta = 159 - u, dil = br == 0 ? 1 : (br == 1 ? 4 : 16);
        float v = -1e30f;
        if (delta >= 0 && delta <= 128) { const int dist = delta * dil; int bucket;
            if (dist < 16) bucket = dist; else { const double vv = log((double)dist / 16.0) / log(128.0) * 16.0; const int l = 16 + (int)vv; bucket = l < 31 ? l : 31; }
            v = rel_bias[bucket * 8 + h] * LOG2E; }
        tbl[i] = v;
    }
}
__device__ __forceinline__ void build_tables_max(LAS float* tbl, int tid) {
    if (tid < 24) { float mx = -1e30f; for (int u = 31; u <= 159; ++u) mx = fmaxf(mx, tbl[tid * TBL_N + u]); tbl[tid * TBL_N + TBL_N - 1] = mx; }
}

struct TileP { int rowbase, h, dil, r, I0; };
__device__ __forceinline__ unsigned lane_kofs(int dil, int lane) { return (unsigned)((lane & 31) * dil * 128 + (lane >> 5) * 16); }
__device__ __forceinline__ unsigned lane_vofs(int dil, int lane) { return (unsigned)((lane >> 3) * dil * 128 + (lane & 7) * 16); }
__device__ __forceinline__ const GAS unsigned char* tile_row(const void* B, const TileP& t, int J) {
    const long tok = (long)(t.rowbase * 8 + t.h * 4096) + t.r + (long)t.dil * J; return (const GAS unsigned char*)B + tok * 128; }
__device__ __forceinline__ unsigned lane_pofs(int dil, int lane) { return (unsigned)((lane >> 3) * dil * 1024 + (lane & 7) * 16); }
__device__ __forceinline__ void load_q(const bf16* QB, const TileP& t, unsigned kofs, bf16x8 (&qf)[4]) {
    const GAS unsigned char* b = tile_row(QB, t, t.I0);
#pragma unroll
    for (int s = 0; s < 4; ++s) qf[s] = *(const GAS bf16x8*)(b + kofs + 32 * s);
}
__device__ __forceinline__ void load_k(const bf16* KB, const TileP& t, unsigned kofs, int kt, bf16x8 (&kfk)[4]) {
    const GAS unsigned char* b = tile_row(KB, t, t.I0 - 128 + 32 * kt);
#pragma unroll
    for (int s = 0; s < 4; ++s) kfk[s] = *(const GAS bf16x8*)(b + kofs + 32 * s);
}
__device__ __forceinline__ void load_v(const bf16* VB, const TileP& t, unsigned vofs, int kt, u32x4 (&vv)[4]) {
#pragma unroll
    for (int ii = 0; ii < 4; ++ii) vv[ii] = *(const GAS u32x4*)(tile_row(VB, t, t.I0 - 128 + 32 * kt + 8 * ii) + vofs);
}
__device__ __forceinline__ void wave_tile(const bf16* QB, const bf16* KB, const bf16* VB, bf16* part, float* lse, const LAS float* tb, LAS unsigned char* wl,
                                          const TileP& tc, bool has_next, const TileP& tn, int lane, volatile LAS unsigned* misc_, int wid_,
                                          bf16x8 (&qf)[4], bf16x8 (&qn)[4], bf16x8 (&ks0)[4], u32x4 (&vx)[4], u32x4 (&vy)[4]) {
    const int h = tc.h, I0 = tc.I0;
    const int i = lane & 31, h2 = lane >> 5;
    PROFA(-1);
    LAS unsigned char* vt = wl; LAS unsigned char* ost = wl + 4096;
    const bool needmask = I0 < 128;
    const LAS float* tbase = tb + (31 - i + 4 * h2);
    const int vrow_l = lane >> 3, vch = lane & 7;
    const LAS unsigned char* vrd = vt + ((lane >> 4) & 1) * 32 + (lane & 3) * 8 + (4 * h2 + ((lane & 15) >> 2)) * 64;
    const unsigned kofs = lane_kofs(tc.dil, lane), vofs = lane_vofs(tc.dil, lane);
    bf16x8 ks1[4], ks2[4], ks3[4], ks4[4];
    load_k(KB, tc, kofs, 3, ks1);
    float m = 0.f, l = 0.f;
    f32x16 o0 = {0.f, 0.f, 0.f, 0.f, 0.f, 0.f, 0.f, 0.f, 0.f, 0.f, 0.f, 0.f, 0.f, 0.f, 0.f, 0.f}, o1 = o0;
#define ATT_STEP(j_, KF_, VV_, PRE_) do { constexpr int kt = 4 - (j_); \
        _Pragma("unroll") for (int ii = 0; ii < 4; ++ii) *(LAS u32x4*)(vt + (vch >> 2) * 2048 + (vrow_l + 8 * ii) * 64 + (vch & 3) * 16) = VV_[ii]; \
        if ((j_) < 3) load_v(VB, tc, vofs, kt - 2, VV_); else if (has_next) load_v(VB, tn, lane_vofs(tn.dil, lane), 7 - (j_), VV_);     \
        f32x16 acc; \
        if ((j_) == 0) { _Pragma("unroll") for (int rr = 0; rr < 16; ++rr) acc[rr] = 0.f; } else { _Pragma("unroll") for (int rr = 0; rr < 16; ++rr) acc[rr] = -m; } \
        _Pragma("unroll") for (int s = 0; s < 4; ++s) acc = __builtin_amdgcn_mfma_f32_32x32x16_bf16(KF_[s], qf[s], acc, 0, 0, 0); \
        PRE_; \
        if ((j_) == 0) { float mx = acc[0]; _Pragma("unroll") for (int rr = 1; rr < 16; ++rr) mx = fmaxf(mx, acc[rr]); \
            { float w_ = mx; asm volatile("" : "+v"(w_)); auto rx = __builtin_amdgcn_permlane32_swap(__float_as_uint(mx), __float_as_uint(w_), false, false); mx = fmaxf(__uint_as_float(rx[0]), __uint_as_float(rx[1])); } \
            m = mx + tb[att::TBL_N - 1]; _Pragma("unroll") for (int rr = 0; rr < 16; ++rr) acc[rr] -= m; } \
        if (needmask) {                                       \
            const int jlim = 128 - 32 * kt - I0 - 4 * h2; asm volatile("" ::: "memory"); \
            _Pragma("unroll") for (int rr = 0; rr < 16; ++rr) { const int kk = (rr & 3) + 8 * (rr >> 2); if (kk < jlim) acc[rr] = -1e30f; } } \
        float p[16]; \
        _Pragma("unroll") for (int rr = 0; rr < 16; ++rr) { const int kk = (rr & 3) + 8 * (rr >> 2); \
            p[rr] = __builtin_amdgcn_exp2f(acc[rr] + tbase[32 * kt + kk]); l += p[rr]; } \
        u32x4 pw0, pw1; \
        pw0.x = cvtpk(p[0], p[1]); pw0.y = cvtpk(p[2], p[3]); pw0.z = cvtpk(p[4], p[5]); pw0.w = cvtpk(p[6], p[7]); \
        pw1.x = cvtpk(p[8], p[9]); pw1.y = cvtpk(p[10], p[11]); pw1.z = cvtpk(p[12], p[13]); pw1.w = cvtpk(p[14], p[15]); \
        const bf16x8 pa0 = __builtin_bit_cast(bf16x8, pw0), pa1 = __builtin_bit_cast(bf16x8, pw1); \
        asm volatile("s_waitcnt lgkmcnt(0)" ::: "memory"); \
        _Pragma("unroll") for (int db = 0; db < 2; ++db) { \
            const s16x4 a0 = vtr(vrd + db * 2048), a1 = vtr(vrd + db * 2048 + 512), b0 = vtr(vrd + db * 2048 + 1024), b1 = vtr(vrd + db * 2048 + 1536); \
            const bf16x8 v0 = (bf16x8){a0[0], a0[1], a0[2], a0[3], a1[0], a1[1], a1[2], a1[3]}, v1 = (bf16x8){b0[0], b0[1], b0[2], b0[3], b1[0], b1[1], b1[2], b1[3]}; \
            if (db == 0) { o0 = __builtin_amdgcn_mfma_f32_32x32x16_bf16(v0, pa0, o0, 0, 0, 0); o0 = __builtin_amdgcn_mfma_f32_32x32x16_bf16(v1, pa1, o0, 0, 0, 0); } \
            else         { o1 = __builtin_amdgcn_mfma_f32_32x32x16_bf16(v0, pa0, o1, 0, 0, 0); o1 = __builtin_amdgcn_mfma_f32_32x32x16_bf16(v1, pa1, o1, 0, 0, 0); } } \
        asm volatile("s_waitcnt lgkmcnt(0)" ::: "memory"); } while (0)
    ATT_STEP(0, ks0, vx, load_k(KB, tc, kofs, 2, ks2));
    PROFA(0);
    ATT_STEP(1, ks1, vy, load_k(KB, tc, kofs, 1, ks3));
    ATT_STEP(2, ks2, vx, { load_k(KB, tc, kofs, 0, ks4); if (has_next) load_q(QB, tn, lane_kofs(tn.dil, lane), qn); });
    ATT_STEP(3, ks3, vy, if (has_next) load_k(KB, tn, lane_kofs(tn.dil, lane), 4, ks0));
    ATT_STEP(4, ks4, vx, (void)0);
#undef ATT_STEP
    PROFA(1);
    { float w_ = l; asm volatile("" : "+v"(w_)); auto rr = __builtin_amdgcn_permlane32_swap(__float_as_uint(l), __float_as_uint(w_), false, false); l = __uint_as_float(rr[0]) + __uint_as_float(rr[1]); }
    const float il = 1.f / l;
    if (h2 == 0) *(GAS float*)((GAS unsigned char*)lse + ((long)tc.rowbase + tc.r + (long)tc.dil * I0) * 32 + h * 4 + (size_t)(i * tc.dil * 32)) = m + __log2f(l);
#pragma unroll
    for (int qd = 0; qd < 4; ++qd) { typedef unsigned u32x2_ __attribute__((ext_vector_type(2)));
        LAS unsigned char* wp = ost + i * 128 + h2 * 8;
        *(LAS u32x2_*)(wp + ((qd ^ (i & 7)) << 4)) = (u32x2_){cvtpk(o0[4 * qd] * il, o0[4 * qd + 1] * il), cvtpk(o0[4 * qd + 2] * il, o0[4 * qd + 3] * il)};
        *(LAS u32x2_*)(wp + (((qd + 4) ^ (i & 7)) << 4)) = (u32x2_){cvtpk(o1[4 * qd] * il, o1[4 * qd + 1] * il), cvtpk(o1[4 * qd + 2] * il, o1[4 * qd + 3] * il)}; }
    asm volatile("s_waitcnt lgkmcnt(0)" ::: "memory");
    { GAS unsigned char* pb = (GAS unsigned char*)part + ((long)(tc.rowbase * 8 + h * 4096) + tc.r + (long)tc.dil * I0) * 128;
#pragma unroll
      for (int ii = 0; ii < 4; ++ii) { const int row = ii * 8 + vrow_l;
        const u32x4 v = *(const LAS u32x4*)(ost + row * 128 + ((vch ^ (row & 7)) << 4));
        *(GAS u32x4*)(pb + (size_t)(ii * 8 * tc.dil) * 128 + vofs) = v; } }
    asm volatile("s_waitcnt lgkmcnt(0)" ::: "memory");
    PROFA(2);
}
}

struct AttTile { int br, h, b, dil, r, I0; };
__device__ __forceinline__ AttTile att_tile(int u, int wt) {
    AttTile t; t.h = u / 192; const int nu = u % 192; t.br = nu % 3; const int bb = nu / 3; t.b = bb >> 3; const int blk = bb & 7;
    t.dil = t.br == 0 ? 1 : (t.br == 1 ? 4 : 16);
    if (t.br == 0) { t.r = 0; t.I0 = blk * 512 + 32 * wt; } else if (t.br == 1) { t.r = wt & 3; t.I0 = blk * 128 + 32 * (wt >> 2); } else { t.r = wt; t.I0 = blk * 32; }
    return t;
}
__device__ __forceinline__ unsigned att_draw_unit(gu32* qctr, volatile LAS unsigned* Q, unsigned x) {
    unsigned k = Q[1];
    while (k < 8u) { const unsigned y = (x + k) & 7u; const unsigned nu = __hip_atomic_fetch_add(qctr + 32 * y, 1u, __ATOMIC_RELAXED, __HIP_MEMORY_SCOPE_AGENT);
        if (nu < 192u) return y * 192u + nu;
        ++k; Q[1] = k; }
    return 1536u;
}
__device__ __forceinline__ void att_prefetch(const bf16* QB, const bf16* KB, const bf16* VB, const AttTile& t, int lane, unsigned (&pf)[6]) {
#pragma unroll
    for (int q = 0; q < 6; ++q) { const int xidx = lane + 64 * q; const bf16* base; int J;
        if (xidx < 32) { base = QB; J = t.I0 + xidx; } else if (xidx < 192) { base = KB; J = t.I0 - 128 + (xidx - 32); } else { base = VB; J = t.I0 - 128 + (xidx - 192); }
        if (J < 0) J = 0; if (xidx >= 352) J = t.I0;
        pf[q] = *(const GAS unsigned*)(base + ((size_t)t.b * SEQ + t.r + (size_t)t.dil * J) * 512 + 64 * t.h); }
}
__device__ __forceinline__ void attn_phase(Frame& F, unsigned char* ws, const float* rel_bias) {
    const int lane_ = pg8::lane_now(), tid_ = F.wave * 64 + lane_;
    LAS float* tbl = (LAS float*)(F.lds + RING_OFF + att::LDS_TBL);
    volatile LAS unsigned* Q = (volatile LAS unsigned*)(F.lds + LDSCTL_OFF);
    gu32* qctr = F.ctl + CW_ATTQ; const unsigned xq_ = xb_xcc_id() & 7u;
    if (tid_ < 32) Q[tid_] = 0u;
    att::build_tables(tbl, rel_bias, tid_);
    __syncthreads();
    att::build_tables_max(tbl, tid_);
    if (tid_ == 0) { Q[8] = att_draw_unit(qctr, Q, xq_); Q[9] = att_draw_unit(qctr, Q, xq_); Q[16] = 1u; Q[17] = 2u; }
    __syncthreads();
    const bf16* QB = (const bf16*)(ws + WS_QB); const bf16* KB = (const bf16*)(ws + WS_KB); const bf16* VB = (const bf16*)(ws + WS_VB);
    LAS unsigned char* wl = F.lds + RING_OFF + att::LDS_WAVE + F.wave * att::WAVE_BYTES;
#define ATT_DRAW(u_, wt_) do { unsigned g_ = 0u; if (pg8::lane_now() == 0) g_ = atomicAdd((unsigned*)&Q[0], 1u); g_ = (unsigned)__builtin_amdgcn_readfirstlane((int)g_); \
        const unsigned s_ = g_ >> 4; wt_ = (int)(g_ & 15u); \
        if (wt_ == 0 && pg8::lane_now() == 0) { const unsigned nu_ = att_draw_unit(qctr, Q, xq_); Q[8 + ((s_ + 2u) & 7u)] = nu_; \
            asm volatile("s_waitcnt lgkmcnt(0)" ::: "memory"); Q[16 + ((s_ + 2u) & 7u)] = s_ + 3u; } \
        while (Q[16 + (s_ & 7u)] != s_ + 1u) __builtin_amdgcn_s_sleep(1); \
        u_ = __builtin_amdgcn_readfirstlane((int)Q[8 + (s_ & 7u)]); } while (0)
#if MK_PROF_A >= 200
    const unsigned long long tph0_ = __builtin_amdgcn_s_memrealtime(); unsigned long long tdraw_ = 0; int ntile_ = 0;
#endif
    int u_cur, wt_cur, u_nxt, wt_nxt;
    ATT_DRAW(u_cur, wt_cur);
    att::bf16x8 qA[4], qB[4], ks0[4]; att::u32x4 vA[4], vB[4];
    if (u_cur < 1536) { const AttTile t0 = att_tile(u_cur, wt_cur); const att::TileP p0{t0.b * SEQ, t0.h, t0.dil, t0.r, t0.I0}; const int ln = pg8::lane_now();
        const unsigned ko = att::lane_kofs(p0.dil, ln), vo = att::lane_vofs(p0.dil, ln);
        att::load_q(QB, p0, ko, qA); att::load_k(KB, p0, ko, 4, ks0); att::load_v(VB, p0, vo, 4, vA); att::load_v(VB, p0, vo, 3, vB); }
#if MK_PROF_A >= 200
#define ATT_PROF_DRAW0() const unsigned long long td0_ = __builtin_amdgcn_s_memrealtime()
#define ATT_PROF_DRAW1() do { tdraw_ += __builtin_amdgcn_s_memrealtime() - td0_; ++ntile_; } while (0)
#else
#define ATT_PROF_DRAW0() do {} while (0)
#define ATT_PROF_DRAW1() do {} while (0)
#endif
#define ATT_ONE_TILE(QC_, QN_, VX_, VY_) do { \
        ATT_PROF_DRAW0(); \
        ATT_DRAW(u_nxt, wt_nxt);                               \
        ATT_PROF_DRAW1(); \
        const int ln = pg8::lane_now();                        \
        const AttTile t = att_tile(u_cur, wt_cur); \
        const bool has_next = u_nxt < 1536; \
        const AttTile tn = att_tile(has_next ? u_nxt : u_cur, has_next ? wt_nxt : wt_cur); \
        const att::TileP pc{t.b * SEQ, t.h, t.dil, t.r, t.I0}, pn{tn.b * SEQ, tn.h, tn.dil, tn.r, tn.I0}; \
        bf16* part = (bf16*)(ws + (t.br == 0 ? WS_PART0 : (t.br == 1 ? WS_PART1 : WS_PART2))); \
        float* lse = (float*)(ws + WS_LSE) + (size_t)t.br * T * 8; \
        att::wave_tile(QB, KB, VB, part, lse, tbl + (t.br * 8 + t.h) * att::TBL_N, wl, pc, has_next, pn, ln, F.MISC, F.wave, QC_, QN_, ks0, VX_, VY_); \
        u_cur = u_nxt; wt_cur = wt_nxt; } while (0)
    while (u_cur < 1536) {
        ATT_ONE_TILE(qA, qB, vA, vB);
        if (u_cur >= 1536) break;
        ATT_ONE_TILE(qB, qA, vB, vA);
    }
#undef ATT_ONE_TILE
#undef ATT_DRAW
#if MK_PROF_A >= 200
    if (pg8::lane_now() == 0) atomicMax((unsigned*)(F.ctl + CW_CNT + 70), (unsigned)(__builtin_amdgcn_s_memrealtime() - tph0_));
    if (blockIdx.x == 32 && tid_ == 0) { F.MISC[27] = __float_as_uint((float)(__builtin_amdgcn_s_memrealtime() - tph0_) * 0.01f); F.MISC[26] = __float_as_uint((float)ntile_ * 5.f); F.MISC[25] = __float_as_uint((float)tdraw_ * 0.01f); }
#endif
    __syncthreads();
}

__device__ __forceinline__ void attn_combine_phase(Frame& F, unsigned char* ws, const float* attn_norm) {
    const int lane_ = pg8::lane_now();
    const int gw = F.vcu * NWAVES + F.wave, NGW = F.G * NWAVES;
    const float* lse = (const float*)(ws + WS_LSE); bf16* Y = (bf16*)(ws + WS_Y);
    const bf16* p0 = (const bf16*)(ws + WS_PART0); const bf16* p1 = (const bf16*)(ws + WS_PART1); const bf16* p2 = (const bf16*)(ws + WS_PART2);
    const int h = lane_ >> 3;
    f32x4 an0 = ((const GAS f32x4*)attn_norm)[2 * lane_], an1 = ((const GAS f32x4*)attn_norm)[2 * lane_ + 1];
    for (int tl = gw; tl < T / 16; tl += NGW) {
#pragma unroll 1
        for (int g4 = 0; g4 < 4; ++g4) {
            const int mb = tl * 16 + 4 * g4;
            float l0[4], l1[4], l2[4]; v4u pa[4], pb[4], pc[4];
#pragma unroll
            for (int r = 0; r < 4; ++r) { const size_t m = (size_t)(mb + r);
                l0[r] = lse[m * 8 + h]; l1[r] = lse[(size_t)T * 8 + m * 8 + h]; l2[r] = lse[(size_t)2 * T * 8 + m * 8 + h];
                const size_t po = ((((m >> 12) * 8 + h) << 12) + (m & 4095)) * 64 + 8 * (lane_ & 7);
                pa[r] = *(const GAS v4u*)(p0 + po); pb[r] = *(const GAS v4u*)(p1 + po); pc[r] = *(const GAS v4u*)(p2 + po); }
            float o[4][8], ss[4];
#pragma unroll
            for (int r = 0; r < 4; ++r) {
                const float mx = fmaxf(l0[r], fmaxf(l1[r], l2[r]));
                float w0 = __builtin_amdgcn_exp2f(l0[r] - mx), w1 = __builtin_amdgcn_exp2f(l1[r] - mx), w2 = __builtin_amdgcn_exp2f(l2[r] - mx);
                const float inv = 1.f / (w0 + w1 + w2); w0 *= inv; w1 *= inv; w2 *= inv;
                float s = 0.f;
#pragma unroll
                for (int q = 0; q < 4; ++q) { const unsigned ua = pa[r][q], ub = pb[r][q], uc = pc[r][q];
                    o[r][2 * q] = w0 * __uint_as_float(ua << 16) + w1 * __uint_as_float(ub << 16) + w2 * __uint_as_float(uc << 16);
                    o[r][2 * q + 1] = w0 * __uint_as_float(ua & 0xFFFF0000u) + w1 * __uint_as_float(ub & 0xFFFF0000u) + w2 * __uint_as_float(uc & 0xFFFF0000u);
                    s += o[r][2 * q] * o[r][2 * q] + o[r][2 * q + 1] * o[r][2 * q + 1]; }
                ss[r] = s; }
#pragma unroll
            for (int r = 0; r < 4; ++r) ss[r] = wave_sum(ss[r]);
#pragma unroll
            for (int r = 0; r < 4; ++r) { const float ra = rsqrtf(ss[r] * (1.f / 512.f) + EPS);
                v4u w;
                w.x = pk2(o[r][0] * ra * an0.x, o[r][1] * ra * an0.y); w.y = pk2(o[r][2] * ra * an0.z, o[r][3] * ra * an0.w);
                w.z = pk2(o[r][4] * ra * an1.x, o[r][5] * ra * an1.y); w.w = pk2(o[r][6] * ra * an1.z, o[r][7] * ra * an1.w);
                *(GAS v4u*)(Y + (size_t)(mb + r) * 1024 + 512 + 8 * lane_) = w; }
        }
    }
}
namespace gdn {
__device__ __forceinline__ float fsilu(float x) { return x * __builtin_amdgcn_rcpf(1.f + __builtin_amdgcn_exp2f(-1.4426950408889634f * x)); }
typedef short bf16x8 __attribute__((ext_vector_type(8)));
typedef short s16x4 __attribute__((ext_vector_type(4)));
typedef float f32x4 __attribute__((ext_vector_type(4)));
typedef float f32x16 __attribute__((ext_vector_type(16)));
typedef unsigned u32x4 __attribute__((ext_vector_type(4)));
typedef __bf16 bf16x2_t __attribute__((ext_vector_type(2)));
constexpr int NCH = 2048;
constexpr int SCAN_BYTES = 49152;
__device__ __forceinline__ int sigma_inv(int x) { return (x & ~31) | (((x >> 2) & 3) << 3) | (((x >> 4) & 1) << 2) | (x & 3); }
__device__ __forceinline__ int crow(int r, int hi) { return (r & 3) + 8 * (r >> 2) + 4 * hi; }
__device__ __forceinline__ unsigned cvtpk(float lo, float hi) { typedef float f32x2_t_ __attribute__((ext_vector_type(2))); typedef __bf16 bf16x2_t_ __attribute__((ext_vector_type(2))); const f32x2_t_ v_ = {lo, hi}; return __builtin_bit_cast(unsigned, __builtin_convertvector(v_, bf16x2_t_)); }
__device__ __forceinline__ float bflo(unsigned w) { return __uint_as_float(w << 16); }
__device__ __forceinline__ float bfhi(unsigned w) { return __uint_as_float(w & 0xFFFF0000u); }
__device__ __forceinline__ s16x4 vtr(const LAS unsigned char* p) { typedef short v4i16_t __attribute__((ext_vector_type(4)));
    return __builtin_bit_cast(s16x4, __builtin_amdgcn_ds_read_tr16_b64_v4i16((LAS v4i16_t*)p)); }
__device__ __forceinline__ int sw256(int row, int col) { return row * 256 + ((((col >> 3) ^ (row & 15)) << 4) | ((col & 7) << 1)); }
__device__ __forceinline__ int sw128(int row, int col) { return row * 128 + ((((col >> 3) ^ ((row >> 1) & 7)) << 4) | ((col & 7) << 1)); }

constexpr int L_QN = 0, L_KN = 16384, L_KGT = 32768, L_AQK = 49152, L_G = 57344  , L_A = 59392  , L_G8 = 124928  ;

#if MK_PROF_A >= 100 && MK_PROF_A < 110
#define PROFX(idx) do { if (blockIdx.x == 0 && F.wave == 0 && pg8::lane_now() == 0) { const unsigned long long t_ = __builtin_amdgcn_s_memrealtime(); \
        const unsigned long long p_ = ((unsigned long long)F.MISC[23] << 32) | F.MISC[22]; if ((idx) >= 0) F.MISC[24 + (idx)] = __float_as_uint(__uint_as_float(F.MISC[24 + (idx)]) + (float)(t_ - p_) * 0.01f); \
        F.MISC[22] = (unsigned)t_; F.MISC[23] = (unsigned)(t_ >> 32); } } while (0)
#else
#define PROFX(idx) do {} while (0)
#endif
__device__ __forceinline__ void a1_phase(Frame& F, unsigned char* ws, unsigned char* dout, const float* wconv) {
    const int w = F.wave;
    PROFX(-1);
    const bf16* qkva = (const bf16*)(ws + WS_QKVA); const float* bg = (const float*)(ws + WS_BG);
    unsigned char* scanops = dout; bf16* QGb = (bf16*)(dout + 96 * MiB); bf16* AQKb = (bf16*)(ws + WS_GAQK); float* GLb = (float*)(ws + WS_GGL);
    bf16* RS = (bf16*)(ws + WS_H);
    LAS unsigned char* L = F.lds + RING_OFF;
    for (int grp = F.vcu; grp < NCH / 8; grp += F.G) {
        {
            const int lane = pg8::lane_now(), ch = grp * 8 + w, n = ch & 63, bh = ch >> 6, h = bh & 3, b = bh >> 2;
            const size_t m0 = (size_t)b * SEQ + n * 64;
            LAS float* Gs = (LAS float*)(L + L_G8 + w * 1024);
            float gq = bg[(m0 + lane) * 8 + 4 + h]; const float be = bg[(m0 + lane) * 8 + h];
#pragma unroll
            for (int o = 1; o < 64; o <<= 1) { const float t = __shfl_up(gq, o); if (lane >= o) gq += t; }
            const float glast = __shfl(gq, 63);
            Gs[lane] = gq; Gs[64 + lane] = __expf(gq); Gs[128 + lane] = be; Gs[192 + lane] = __expf(glast - gq);
            if (lane == 0) GLb[ch] = __expf(glast);
        }
        unsigned rq[11], rk[11], rv[11];
#define A1_LOADRAW(ci_) do { const int ch_ = grp * 8 + (ci_), n_ = ch_ & 63, bh_ = ch_ >> 6, h_ = bh_ & 3, b_ = bh_ >> 2; const int ln_ = pg8::lane_now(); \
            const int cq_ = h_ * 128 + 2 * ln_; \
            _Pragma("unroll") for (int t = 0; t < 11; ++t) { const int tt = n_ * 64 + 8 * w - 3 + t; \
                if (tt >= 0) { const size_t m = (size_t)b_ * SEQ + tt; rq[t] = *(const GAS unsigned*)(qkva + m * 1536 + cq_); rk[t] = *(const GAS unsigned*)(qkva + m * 1536 + 512 + cq_); rv[t] = *(const GAS unsigned*)(qkva + m * 1536 + 1024 + cq_); } \
                else { rq[t] = 0u; rk[t] = 0u; rv[t] = 0u; } } } while (0)
        A1_LOADRAW(0);
        float wq[4][2], wk[4][2], wv[4][2];
        { const int ln_ = pg8::lane_now(), cq = ((grp >> 3) & 3) * 128 + 2 * ln_, ck = 512 + cq, cv = 1024 + cq;
#pragma unroll
          for (int t = 0; t < 4; ++t) { wq[t][0] = wconv[t * 1536 + cq]; wq[t][1] = wconv[t * 1536 + cq + 1]; wk[t][0] = wconv[t * 1536 + ck]; wk[t][1] = wconv[t * 1536 + ck + 1];
              wv[t][0] = wconv[t * 1536 + cv]; wv[t][1] = wconv[t * 1536 + cv + 1]; } }
        for (int ci = 0; ci < 8; ++ci) {
            const int ch = grp * 8 + ci, n = ch & 63, bh = ch >> 6, h = bh & 3, b = bh >> 2;
            const int t0 = n * 64; const size_t m0 = (size_t)b * SEQ + t0;
            const int lane = pg8::lane_now(), tid = w * 64 + lane, i32 = lane & 31, h2 = lane >> 5;
            __syncthreads(); PROFX(0);
            LAS float* Gs = (LAS float*)(L + L_G8 + ci * 1024); LAS float* eG = Gs + 64; LAS float* bet = Gs + 128; LAS float* eGl = Gs + 192;
            {
                float kg0[8], kg1[8];
#pragma unroll
                for (int rr = 0; rr < 8; ++rr) {
                    const int c = 8 * w + rr;
                    unsigned xq[4], xk[4], xv[4];
#pragma unroll
                    for (int t = 0; t < 4; ++t) { xq[t] = rq[rr + t]; xk[t] = rk[rr + t]; xv[t] = rv[rr + t]; }
                    float q0 = 0.f, q1 = 0.f, k0 = 0.f, k1 = 0.f, v0 = 0.f, v1 = 0.f;
#pragma unroll
                    for (int t = 0; t < 4; ++t) { q0 += wq[t][0] * bflo(xq[t]); q1 += wq[t][1] * bfhi(xq[t]); k0 += wk[t][0] * bflo(xk[t]); k1 += wk[t][1] * bfhi(xk[t]);
                        v0 += wv[t][0] * bflo(xv[t]); v1 += wv[t][1] * bfhi(xv[t]); }
                    q0 = fsilu(q0); q1 = fsilu(q1); k0 = fsilu(k0); k1 = fsilu(k1); v0 = fsilu(v0); v1 = fsilu(v1);
                    const float sq = wave_sum(q0 * q0 + q1 * q1), sk = wave_sum(k0 * k0 + k1 * k1);
                    const float rq = rsqrtf(sq + EPS) * 0.08838834764831845f, rk = rsqrtf(sk + EPS);
                    q0 *= rq; q1 *= rq; k0 *= rk; k1 *= rk;
                    const float be = bet[c], eg = eG[c], egl = eGl[c];
                    const int kc = 2 * lane;
                    *(LAS unsigned*)(L + L_QN + sw256(c, kc)) = cvtpk(q0, q1);
                    *(LAS unsigned*)(L + L_KN + sw256(c, kc)) = cvtpk(k0, k1);
                    kg0[rr] = k0 * egl; kg1[rr] = k1 * egl;
                    *(GAS unsigned*)(QGb + (size_t)ch * 8192 + c * 128 + sigma_inv(kc)) = cvtpk(q0 * eg, q1 * eg);
                    *(GAS unsigned*)(RS + (size_t)ch * 16384 + c * 256 + kc) = cvtpk(k0 * be * eg, k1 * be * eg);
                    *(GAS unsigned*)(RS + (size_t)ch * 16384 + c * 256 + 128 + kc) = cvtpk(v0 * be, v1 * be);
                }
                { const int kc = 2 * lane, c0 = 8 * w, p0 = (c0 & ~31) | (((c0 >> 2) & 3) << 3) | (((c0 >> 4) & 1) << 2);
                  typedef unsigned u32x2 __attribute__((ext_vector_type(2)));
                  *(LAS u32x2*)(L + L_KGT + sw128(kc, p0)) = (u32x2){cvtpk(kg0[0], kg0[1]), cvtpk(kg0[2], kg0[3])};
                  *(LAS u32x2*)(L + L_KGT + sw128(kc, p0 + 8)) = (u32x2){cvtpk(kg0[4], kg0[5]), cvtpk(kg0[6], kg0[7])};
                  *(LAS u32x2*)(L + L_KGT + sw128(kc + 1, p0)) = (u32x2){cvtpk(kg1[0], kg1[1]), cvtpk(kg1[2], kg1[3])};
                  *(LAS u32x2*)(L + L_KGT + sw128(kc + 1, p0 + 8)) = (u32x2){cvtpk(kg1[4], kg1[5]), cvtpk(kg1[6], kg1[7])}; }
            }
            if (ci < 7) A1_LOADRAW(ci + 1);
            __syncthreads(); PROFX(1);
            {
                const int pw = w >> 2, ti = (w >> 1) & 1, tj = w & 1;
                f32x16 acc = {0.f, 0.f, 0.f, 0.f, 0.f, 0.f, 0.f, 0.f, 0.f, 0.f, 0.f, 0.f, 0.f, 0.f, 0.f, 0.f};
                const LAS unsigned char* Ab = L + (pw ? L_QN : L_KN);
#pragma unroll
                for (int s = 0; s < 8; ++s) {
                    const bf16x8 af = *(const LAS bf16x8*)(Ab + sw256(32 * ti + i32, 16 * s + 8 * h2));
                    const bf16x8 bf = *(const LAS bf16x8*)(L + L_KN + sw256(32 * tj + i32, 16 * s + 8 * h2));
                    acc = __builtin_amdgcn_mfma_f32_32x32x16_bf16(af, bf, acc, 0, 0, 0);
                }
                const int j = 32 * tj + i32; const float Gj = Gs[j];
                if (pw == 0) {
                    LAS unsigned char* As = L + L_A + ci * 8192;
#pragma unroll
                    for (int rg = 0; rg < 16; ++rg) { const int i = 32 * ti + crow(rg, h2);
                        const float v = (j < i) ? bet[i] * acc[rg] * __expf(Gs[i] - Gj) : 0.f;
                        *(LAS bf16*)(As + i * 128 + j * 2) = (bf16)f2bf(v); }
                } else {
                    const int pj = sigma_inv(j);
#pragma unroll
                    for (int rg = 0; rg < 16; ++rg) { const int i = 32 * ti + crow(rg, h2);
                        const float v = (j <= i) ? acc[rg] * __expf(Gs[i] - Gj) : 0.f;
                        *(LAS bf16*)(L + L_AQK + i * 128 + pj * 2) = (bf16)f2bf(v); }
                }
            }
            __syncthreads(); PROFX(2);
            {
#pragma unroll
                for (int q = 0; q < 2; ++q) { const int off = (tid + 512 * q) * 16; *(GAS u32x4*)(scanops + (size_t)ch * SCAN_BYTES + 16384 + off) = *(const LAS u32x4*)(L + L_KGT + off); }
                { const int off = tid * 16; *(GAS u32x4*)((unsigned char*)AQKb + (size_t)ch * 8192 + off) = *(const LAS u32x4*)(L + L_AQK + off); }
            }
        }
        __syncthreads(); PROFX(3);
#if MK_A1 == 1
        {
            const int lane = pg8::lane_now(), tid = w * 64 + lane;
#pragma unroll
            for (int q = 0; q < 8; ++q) { const int off = (tid + 512 * q) * 16; *(GAS u32x4*)(ws + WS_PART2 + (size_t)grp * 65536 + off) = *(const LAS u32x4*)(L + L_A + off); }
        }
#else
        {
            const int lane = pg8::lane_now();
            LAS unsigned char* As = L + L_A + w * 8192;
            unsigned tp[32];
            float tprev = 0.f;
#pragma unroll
            for (int i = 0; i < 64; ++i) {
                float acc = 0.f;
#pragma unroll
                for (int p = 0; p < i / 2; ++p) { const unsigned lwp = *(const LAS unsigned*)(As + i * 128 + p * 4);
                    acc = __builtin_amdgcn_fdot2_f32_bf16(__builtin_bit_cast(bf16x2_t, lwp), __builtin_bit_cast(bf16x2_t, tp[p]), acc, false); }
                if (i & 1) { const unsigned lw1 = *(const LAS unsigned*)(As + i * 128 + (i - 1) * 2); acc += bflo(lw1) * tprev; }
                const float ti = ((lane == i) ? 1.f : 0.f) - acc;
                if (i & 1) tp[i >> 1] = cvtpk(tprev, ti);
                tprev = ti;
            }
#pragma unroll
            for (int p = 0; p < 32; ++p) { *(LAS bf16*)(As + (2 * p) * 128 + lane * 2) = (bf16)(tp[p] & 0xFFFFu); *(LAS bf16*)(As + (2 * p + 1) * 128 + lane * 2) = (bf16)(tp[p] >> 16); }
        }
        __syncthreads(); PROFX(4);
        u32x4 rpre[4];
        for (int ci = 0; ci < 8; ++ci) {
            const int ch = grp * 8 + ci;
            const int lane = pg8::lane_now(), tid = w * 64 + lane, i32 = lane & 31, h2 = lane >> 5;
            __syncthreads();
            if (ci == 0) {
#pragma unroll
                for (int q = 0; q < 4; ++q) rpre[q] = *(const GAS u32x4*)((const unsigned char*)RS + (size_t)ch * 32768 + (tid + 512 * q) * 16); }
#pragma unroll
            for (int q = 0; q < 4; ++q) *(LAS u32x4*)(L + (tid + 512 * q) * 16) = rpre[q];
            if (ci < 7) {
#pragma unroll
                for (int q = 0; q < 4; ++q) rpre[q] = *(const GAS u32x4*)((const unsigned char*)RS + (size_t)(ch + 1) * 32768 + (tid + 512 * q) * 16); }
            __syncthreads();
            const LAS unsigned char* Ts = L + L_A + ci * 8192;
            f32x16 x0 = {0.f, 0.f, 0.f, 0.f, 0.f, 0.f, 0.f, 0.f, 0.f, 0.f, 0.f, 0.f, 0.f, 0.f, 0.f, 0.f}, x1 = x0;
            const LAS unsigned char* rb = L + (8 * h2 + ((lane & 15) >> 2)) * 512 + (32 * w + 16 * ((lane >> 4) & 1) + 4 * (lane & 3)) * 2;
#pragma unroll
            for (int s = 0; s < 4; ++s) {
                const s16x4 lo = vtr(rb + (16 * s) * 512), hi = vtr(rb + (16 * s + 4) * 512);
                const bf16x8 bf = (bf16x8){lo[0], lo[1], lo[2], lo[3], hi[0], hi[1], hi[2], hi[3]};
                const bf16x8 a0 = *(const LAS bf16x8*)(Ts + i32 * 128 + (16 * s + 8 * h2) * 2), a1 = *(const LAS bf16x8*)(Ts + (32 + i32) * 128 + (16 * s + 8 * h2) * 2);
                x0 = __builtin_amdgcn_mfma_f32_32x32x16_bf16(a0, bf, x0, 0, 0, 0);
                x1 = __builtin_amdgcn_mfma_f32_32x32x16_bf16(a1, bf, x1, 0, 0, 0);
            }
            __syncthreads();
            {
                const int x = 32 * w + i32;
#pragma unroll
                for (int rg = 0; rg < 16; ++rg) {
#pragma unroll
                    for (int mt = 0; mt < 2; ++mt) { const int c = 32 * mt + crow(rg, h2); const float v = mt ? x1[rg] : x0[rg];
                        if (x < 128) *(LAS bf16*)(L + sw256(c, sigma_inv(x))) = (bf16)f2bf(-v);
                        else { const int vv = x - 128; const int idx = (((vv >> 4) * 64 + (vv & 15) + 16 * ((c >> 2) & 3)) * 16 + (c >> 4) * 4 + (c & 3));
                               *(LAS bf16*)(L + 16384 + idx * 2) = (bf16)f2bf(v); } }
                }
            }
            __syncthreads();
#pragma unroll
            for (int q = 0; q < 2; ++q) { const int off = (tid + 512 * q) * 16;
                *(GAS u32x4*)(scanops + (size_t)ch * SCAN_BYTES + off) = *(const LAS u32x4*)(L + off);
                *(GAS u32x4*)(scanops + (size_t)ch * SCAN_BYTES + 32768 + off) = *(const LAS u32x4*)(L + 16384 + off); }
        }
#endif
        __syncthreads(); PROFX(5);
    }
}

__device__ __forceinline__ void glds16(const void* gsrc, unsigned lds_dst) { unsigned keep;
    asm volatile("s_mov_b32 %0, m0\n\ts_mov_b32 m0, %2\n\ts_nop 0\n\tglobal_load_lds_dwordx4 %1, off\n\ts_mov_b32 m0, %0" : "=&s"(keep) : "v"(gsrc), "s"(lds_dst) : "memory"); }

__device__ __forceinline__ void scan_phase(Frame& F, unsigned char* ws, const unsigned char* dout, int bh) {
    const int lane = pg8::lane_now(), w = F.wave;
    const unsigned char* scanops = dout; const float* GLb = (const float*)(ws + WS_GGL);
    bf16* ST = (bf16*)(ws + WS_QKVA); bf16* UT = (bf16*)(ws + WS_QKVA + 64 * MiB);
    LAS unsigned char* L = F.lds + RING_OFF;
    const unsigned lds0 = (unsigned)(uintptr_t)(F.lds + RING_OFF);
    const int v16 = lane & 15, kg = lane >> 4;
    f32x4 Sf[8];
#pragma unroll
    for (int mt = 0; mt < 8; ++mt) Sf[mt] = (f32x4){0.f, 0.f, 0.f, 0.f};
    float glv = GLb[bh * 64 + lane];
    asm volatile("s_waitcnt vmcnt(0)" : "+v"(glv));
#define GDN_STAGE3(n, sl_) do { const unsigned char* src_ = scanops + (size_t)(bh * 64 + (n)) * SCAN_BYTES + lane * 16; \
        _Pragma("unroll") for (int q_ = 0; q_ < 6; ++q_) { const int piece_ = w * 6 + q_; \
            glds16(src_ + piece_ * 1024, (unsigned)__builtin_amdgcn_readfirstlane(lds0 + (sl_) * SCAN_BYTES + piece_ * 1024)); } } while (0)
#define GDN_STAGE(n) GDN_STAGE3(n, n)
    GDN_STAGE(0); GDN_STAGE(1);
    asm volatile("s_waitcnt vmcnt(6)" ::: "memory");
    int slot = 0, slot2 = 2;
    u32x4 Sb[4], Ub[2];
    for (int n = 0; n < 64; ++n) {
        __builtin_amdgcn_s_barrier();
        asm volatile("" ::: "memory");
        if (n + 2 < 64) GDN_STAGE3(n + 2, slot2);
        const LAS unsigned char* sl = L + slot * SCAN_BYTES;
        const float gl = __shfl(glv, n);
#pragma unroll
        for (int s = 0; s < 4; ++s) { Sb[s].x = cvtpk(Sf[2 * s][0], Sf[2 * s][1]); Sb[s].y = cvtpk(Sf[2 * s][2], Sf[2 * s][3]); Sb[s].z = cvtpk(Sf[2 * s + 1][0], Sf[2 * s + 1][1]); Sb[s].w = cvtpk(Sf[2 * s + 1][2], Sf[2 * s + 1][3]); }
        f32x4 Uf[4];
        { const u32x4 u0 = *(const LAS u32x4*)(sl + 32768 + (w * 64 + lane) * 32), u1 = *(const LAS u32x4*)(sl + 32768 + (w * 64 + lane) * 32 + 16);
          Uf[0] = (f32x4){bflo(u0.x), bfhi(u0.x), bflo(u0.y), bfhi(u0.y)}; Uf[1] = (f32x4){bflo(u0.z), bfhi(u0.z), bflo(u0.w), bfhi(u0.w)};
          Uf[2] = (f32x4){bflo(u1.x), bfhi(u1.x), bflo(u1.y), bfhi(u1.y)}; Uf[3] = (f32x4){bflo(u1.z), bfhi(u1.z), bflo(u1.w), bfhi(u1.w)}; }
        bf16x8 ak[16];
        {
            bf16x8 aw[16];
#pragma unroll
            for (int mt = 0; mt < 4; ++mt)
#pragma unroll
                for (int s = 0; s < 4; ++s) aw[mt * 4 + s] = *(const LAS bf16x8*)(sl + sw256(16 * mt + v16, 32 * s + 8 * kg));
#pragma unroll
            for (int s = 0; s < 4; ++s)
#pragma unroll
                for (int mt = 0; mt < 4; ++mt) Uf[mt] = __builtin_amdgcn_mfma_f32_16x16x32_bf16(aw[mt * 4 + s], __builtin_bit_cast(bf16x8, Sb[s]), Uf[mt], 0, 0, 0);
#pragma unroll
            for (int mt = 0; mt < 8; ++mt)
#pragma unroll
                for (int s = 0; s < 2; ++s) ak[mt * 2 + s] = *(const LAS bf16x8*)(sl + 16384 + sw128(16 * mt + v16, 32 * s + 8 * kg));
            __builtin_amdgcn_sched_group_barrier(0x100, 34, 0);
            __builtin_amdgcn_sched_group_barrier(0x008, 16, 0);
        }
#pragma unroll
        for (int s = 0; s < 2; ++s) { Ub[s].x = cvtpk(Uf[2 * s][0], Uf[2 * s][1]); Ub[s].y = cvtpk(Uf[2 * s][2], Uf[2 * s][3]); Ub[s].z = cvtpk(Uf[2 * s + 1][0], Uf[2 * s + 1][1]); Ub[s].w = cvtpk(Uf[2 * s + 1][2], Uf[2 * s + 1][3]); }
        {
#pragma unroll
            for (int mt = 0; mt < 8; ++mt) Sf[mt] = Sf[mt] * gl;
#pragma unroll
            for (int s = 0; s < 2; ++s)
#pragma unroll
                for (int mt = 0; mt < 8; ++mt) Sf[mt] = __builtin_amdgcn_mfma_f32_16x16x32_bf16(ak[mt * 2 + s], __builtin_bit_cast(bf16x8, Ub[s]), Sf[mt], 0, 0, 0);
        }
        if (n + 2 < 64) asm volatile("s_waitcnt vmcnt(6) lgkmcnt(0)" ::: "memory"); else asm volatile("s_waitcnt vmcnt(0) lgkmcnt(0)" ::: "memory");
        { bf16* dst = ST + (size_t)(bh * 64 + n) * 16384 + (w * 4 * 64 + lane) * 8;
#pragma unroll
          for (int s = 0; s < 4; ++s) *(GAS u32x4*)(dst + s * 512) = Sb[s]; }
        { bf16* dst = UT + (size_t)(bh * 64 + n) * 8192 + (w * 2 * 64 + lane) * 8;
#pragma unroll
          for (int s = 0; s < 2; ++s) *(GAS u32x4*)(dst + s * 512) = Ub[s]; }
        slot = (slot == 2) ? 0 : slot + 1; slot2 = (slot2 == 2) ? 0 : slot2 + 1;
    }
    asm volatile("s_waitcnt vmcnt(0) lgkmcnt(0)" ::: "memory");
    __builtin_amdgcn_s_barrier();
#undef GDN_STAGE
#undef GDN_STAGE3
}

__device__ __forceinline__ void a3_phase(Frame& F, unsigned char* ws, const unsigned char* dout, const float* gdn_norm) {
    const int lane = pg8::lane_now(), w = F.wave, tid = w * 64 + lane;
    const bf16* QGb = (const bf16*)(dout + 96 * MiB); const bf16* AQKb = (const bf16*)(ws + WS_GAQK);
    const bf16* ST = (const bf16*)(ws + WS_QKVA); const bf16* UT = (const bf16*)(ws + WS_QKVA + 64 * MiB);
    const bf16* Z = (const bf16*)(ws + WS_Z); bf16* Y = (bf16*)(ws + WS_Y);
    LAS float* Ot = (LAS float*)(F.lds + RING_OFF);
    const int v16 = lane & 15, kg = lane >> 4;
    const int c = tid >> 3, v0 = 16 * (tid & 7);
    f32x4 gn[4];
#pragma unroll
    for (int q = 0; q < 4; ++q) gn[q] = *(const GAS f32x4*)(gdn_norm + v0 + 4 * q);
    bf16x8 fa[24], fb[6];
#define A3_LOAD(ch_) do { const int ch__ = (ch_); \
        const bf16* sp_ = ST + (size_t)ch__ * 16384 + (w * 4 * 64 + lane) * 8; const bf16* up_ = UT + (size_t)ch__ * 8192 + (w * 2 * 64 + lane) * 8; \
        const bf16* qp_ = QGb + (size_t)ch__ * 8192 + v16 * 128 + 8 * kg; const bf16* ap_ = AQKb + (size_t)ch__ * 4096 + v16 * 64 + 8 * kg; \
        _Pragma("unroll") for (int s = 0; s < 4; ++s) { fb[s] = *(const GAS bf16x8*)(sp_ + 512 * s); \
            _Pragma("unroll") for (int mt = 0; mt < 4; ++mt) fa[4 * s + mt] = *(const GAS bf16x8*)(qp_ + (16 * mt) * 128 + 32 * s); } \
        _Pragma("unroll") for (int s = 0; s < 2; ++s) { fb[4 + s] = *(const GAS bf16x8*)(up_ + 512 * s); \
            _Pragma("unroll") for (int mt = 0; mt < 4; ++mt) fa[16 + 4 * s + mt] = *(const GAS bf16x8*)(ap_ + (16 * mt) * 64 + 32 * s); } } while (0)
    if (F.vcu < NCH) A3_LOAD(F.vcu);
    for (int ch = F.vcu; ch < NCH; ch += F.G) {
        const int n = ch & 63, bh = ch >> 6, h = bh & 3, b = bh >> 2;
        const size_t m = (size_t)b * SEQ + n * 64 + c;
        const u32x4 z0 = *(const GAS u32x4*)(Z + m * 512 + h * 128 + v0), z1 = *(const GAS u32x4*)(Z + m * 512 + h * 128 + v0 + 8);
        f32x4 acc[4];
#pragma unroll
        for (int mt = 0; mt < 4; ++mt) acc[mt] = (f32x4){0.f, 0.f, 0.f, 0.f};
#pragma unroll
        for (int s = 0; s < 6; ++s)
#pragma unroll
            for (int mt = 0; mt < 4; ++mt) acc[mt] = __builtin_amdgcn_mfma_f32_16x16x32_bf16(fa[4 * s + mt], fb[s], acc[mt], 0, 0, 0);
        if (ch + F.G < NCH) A3_LOAD(ch + F.G);
        __syncthreads();
#pragma unroll
        for (int mt = 0; mt < 4; ++mt)
#pragma unroll
            for (int rg = 0; rg < 4; ++rg) Ot[(16 * mt + 4 * kg + rg) * 132 + 16 * w + v16] = acc[mt][rg];
        __syncthreads();
        {
            f32x4 o[4]; float ss = 0.f;
#pragma unroll
            for (int q = 0; q < 4; ++q) { o[q] = *(const LAS f32x4*)(Ot + c * 132 + v0 + 4 * q); ss += (o[q].x * o[q].x + o[q].y * o[q].y) + (o[q].z * o[q].z + o[q].w * o[q].w); }
            ss = dpp_add(ss, 0); ss = dpp_add(ss, 1);
            ss += __builtin_bit_cast(float, __builtin_amdgcn_mov_dpp(__builtin_bit_cast(int, ss), 0x141, 0xF, 0xF, false));
            const float rg = rsqrtf(ss * (1.f / 128.f) + EPS);
            u32x4 y0, y1;
#pragma unroll
            for (int q = 0; q < 2; ++q) {
                const f32x4 a = o[q] * rg * gn[q], bq = o[2 + q] * rg * gn[2 + q];
                y0[2 * q] = cvtpk(a.x * fsilu(bflo(z0[2 * q])), a.y * fsilu(bfhi(z0[2 * q]))); y0[2 * q + 1] = cvtpk(a.z * fsilu(bflo(z0[2 * q + 1])), a.w * fsilu(bfhi(z0[2 * q + 1])));
                y1[2 * q] = cvtpk(bq.x * fsilu(bflo(z1[2 * q])), bq.y * fsilu(bfhi(z1[2 * q]))); y1[2 * q + 1] = cvtpk(bq.z * fsilu(bflo(z1[2 * q + 1])), bq.w * fsilu(bfhi(z1[2 * q + 1]))); }
            *(GAS u32x4*)(Y + m * 1024 + h * 128 + v0) = y0; *(GAS u32x4*)(Y + m * 1024 + h * 128 + v0 + 8) = y1;
        }
    }
#undef A3_LOAD
}
}

__global__ void __launch_bounds__(NWAVES * 64, 2) mega_fwd(Args args) {
    extern __shared__ __attribute__((aligned(16))) unsigned char lds[];
    Frame F;
    F.lds = (LAS unsigned char*)lds;
    F.MISC = (volatile LAS unsigned*)(F.lds + MISC_OFF);
    F.wave = __builtin_amdgcn_readfirstlane(threadIdx.x >> 6);
    F.G = gridDim.x; { const int bx = blockIdx.x; F.vcu = (F.G % 8 == 0) ? (bx % 8) * (F.G / 8) + bx / 8 : bx; }
    unsigned char* ws = args.ws;
    F.ctl = (gu32*)(ws + WS_CTL);
    for (int u = threadIdx.x; u < (LDS_BYTES - LDSCTL_OFF) / 4; u += NWAVES * 64) ((LAS unsigned*)(F.lds + LDSCTL_OFF))[u] = 0u;
    __syncthreads();
    const int lo = args.ph_lo, hi = args.ph_hi;
    const bool multi = (hi - lo) > 1;
    XcdBarrier bar; bar.bar = (unsigned*)(F.ctl + CW_BAR) + args.li * XCD_BAR_WORDS; bar.x = 0; bar.st = nullptr; bar.wave = F.wave;
    if (multi) bar = xcd_barrier_post((unsigned*)(F.ctl + CW_BAR) + args.li * XCD_BAR_WORDS, F.MISC + 8, F.wave);
#ifndef MK_REP
#define MK_REP -1
#endif
#define REPS(k) (((k) == MK_REP) ? 2 : 1)
#define IN(k) (lo <= (k) && (k) < hi)
#define BOTH(k) (IN(k) && IN((k) + 1))
#define GRID_BAR() do { xcd_barrier(bar); PROF_STAMP(); } while (0)
#if MK_PROF_A >= 0
    if (F.wave == 0 && pg8::lane_now() == 0) { const unsigned long long t_ = __builtin_amdgcn_s_memrealtime(); F.MISC[16] = (unsigned)t_; F.MISC[17] = (unsigned)(t_ >> 32); F.MISC[18] = (unsigned)lo; F.MISC[19] = 0u; F.MISC[20] = 0u; }
#define PROF_STAMP() do { if (F.wave == 0 && pg8::lane_now() == 0) { const unsigned long long t_ = __builtin_amdgcn_s_memrealtime(); \
        const unsigned long long p_ = ((unsigned long long)F.MISC[17] << 32) | F.MISC[16]; const float d_ = (float)(t_ - p_) * 0.01f; const int k_ = (int)F.MISC[18]; \
        if (k_ == MK_PROF_A) F.MISC[19] = __float_as_uint(d_); if (k_ == MK_PROF_B) F.MISC[20] = __float_as_uint(d_); F.MISC[16] = (unsigned)t_; F.MISC[17] = (unsigned)(t_ >> 32); F.MISC[18] = (unsigned)(k_ + 1); } } while (0)
#else
#define PROF_STAMP() do {} while (0)
#endif

#if MK_PROF_A >= 120 && MK_PROF_A < 130
#define PROFM(idx) do { if (blockIdx.x == 0 && F.wave == 0 && pg8::lane_now() == 0) { const unsigned long long t_ = __builtin_amdgcn_s_memrealtime(); \
        const unsigned long long p_ = ((unsigned long long)F.MISC[23] << 32) | F.MISC[22]; if ((idx) >= 0) F.MISC[24 + (idx)] = __float_as_uint(__uint_as_float(F.MISC[24 + (idx)]) + (float)(t_ - p_) * 0.01f); \
        F.MISC[22] = (unsigned)t_; F.MISC[23] = (unsigned)(t_ >> 32); } } while (0)
#else
#define PROFM(idx) do {} while (0)
#endif
    if (IN(0)) { p0_phase(F, ws, args.in[1], args.in[2], args.in[3], args.in[5], args.in[11], args.in[16], args.in[17], args.in[18], args.in[14], args.in[15]);
        asm volatile("s_waitcnt vmcnt(0)" ::: "memory"); __syncthreads();
        if ((int)blockIdx.x < 192 && F.wave == 0 && pg8::lane_now() == 0) { __builtin_amdgcn_fence(__ATOMIC_RELEASE, "agent"); asm volatile("s_waitcnt vmcnt(0)" ::: "memory"); (void)xb_add((unsigned*)(F.ctl + CW_MODF), 1u); }
        PROF_STAMP(); }
    if (IN(1)) { p0b_phase(F, ws, args.in[5], args.in[11], args.in[16], args.in[17], args.in[18]);
        if (F.wave == 0 && pg8::lane_now() == 0) { unsigned* bw_ = (unsigned*)(F.ctl + CW_BAR) + args.li * XCD_BAR_WORDS; const unsigned need_ = (unsigned)(F.G < 192 ? F.G : 192);
            XB_SPIN(xb_ld((unsigned*)(F.ctl + CW_MODF)) < need_, bw_);
            __builtin_amdgcn_fence(__ATOMIC_ACQUIRE, "agent"); asm volatile("s_waitcnt vmcnt(0)" ::: "memory"); }
        __syncthreads();
        p1_phase(F, ws, args.in[0], args.in[4], args.in[5], args.in[7], args.in[8]);
        if (BOTH(1)) GRID_BAR(); }
    if (IN(2)) { for (int rep_ = 0; rep_ < REPS(2); ++rep_) {
        pg8::Gemm g{(const pg8::bf16_t*)(ws + WS_H), (const pg8::bf16_t*)(ws + WS_WIN), T, NPROJ, D};
        pg8::StaticOrder S; S.init(T, NPROJ, F.G, (int)blockIdx.x);
        pg8::EpiProj E{ws, 0.125f * 1.4426950408889634f};
        pg8::gemm_phase<pg8::EpiProj, pg8::StaticOrder, true, true>(F.lds + RING_OFF, g, S, E, F.wave); }
        if (BOTH(2)) GRID_BAR();
    }
    if (IN(3)) { for (int rep_ = 0; rep_ < REPS(3); ++rep_) gdn::a1_phase(F, ws, (unsigned char*)args.out, args.in[6]); if (BOTH(3)) GRID_BAR(); }
    if (IN(4)) { for (int rep_ = 0; rep_ < REPS(4); ++rep_) {
        if ((int)blockIdx.x < 32) {
#if MK_PROF_A >= 200
            unsigned long long ts0_ = __builtin_amdgcn_s_memrealtime();
#endif
            for (int r2_ = 0; r2_ < 1 + MK_REPSCAN; ++r2_) gdn::scan_phase(F, ws, (const unsigned char*)args.out, (int)blockIdx.x);
#if MK_PROF_A >= 200
            if (pg8::lane_now() == 0) atomicMax((unsigned*)(F.ctl + CW_CNT + 71), (unsigned)(__builtin_amdgcn_s_memrealtime() - ts0_));
#endif
        }
#if MK_SERIAL_SCAN
        if ((int)blockIdx.x < 32) { __syncthreads(); if (F.wave == 0 && pg8::lane_now() == 0) (void)xb_add((unsigned*)(F.ctl + CW_MODF + 32), 1u); }
        else { if (F.wave == 0 && pg8::lane_now() == 0) { unsigned* bw_ = (unsigned*)(F.ctl + CW_BAR) + args.li * XCD_BAR_WORDS; XB_SPIN(xb_ld((unsigned*)(F.ctl + CW_MODF + 32)) < 32u, bw_); } __syncthreads(); }
#endif
        attn_phase(F, ws, args.in[12]);
        }
        if (BOTH(4)) GRID_BAR(); }
#if MK_PROF_A >= 200
    if (blockIdx.x == 32 && F.wave == 0 && pg8::lane_now() == 0) { for (int q_ = 0; q_ < 4; ++q_) F.ctl[CW_CNT + 64 + q_] = F.MISC[24 + q_]; }
#endif
    if (IN(5)) { for (int rep_ = 0; rep_ < REPS(5); ++rep_) {
        PROFM(-1);
#if MK_MODE != 2 && MK_MODE != 3
        gdn::a3_phase(F, ws, (const unsigned char*)args.out, args.in[9]);
#endif
        PROFM(0);
        attn_combine_phase(F, ws, args.in[10]); PROFM(1); }
        if (BOTH(5)) GRID_BAR(); }

    if (IN(6)) { for (int rep_ = 0; rep_ < REPS(6); ++rep_) {
        pg8::Gemm g{(const pg8::bf16_t*)(ws + WS_Y), (const pg8::bf16_t*)(ws + WS_WOUT), T, D, D};
        pg8::StaticOrder S; S.init(T, D, F.G, (int)blockIdx.x);
        pg8::EpiRes E{args.in[0], (const float*)(ws + WS_MOD), (pg8::bf16_t*)(ws + WS_XM), 2048};
        pg8::gemm_phase<pg8::EpiRes, pg8::StaticOrder, true, true>(F.lds + RING_OFF, g, S, E, F.wave); }
        if (BOTH(6)) GRID_BAR();
    }
    if (IN(7)) { p5_phase(F, ws, (const bf16*)(ws + WS_XM), args.in[13]); if (BOTH(7)) GRID_BAR(); }
    if (IN(8) || IN(9) || IN(10)) moe_setup(F);
    if (IN(8)) { for (int rep_ = 0; rep_ < REPS(8); ++rep_) {
        pg8::Gemm g{(const pg8::bf16_t*)(ws + WS_H), (const pg8::bf16_t*)(ws + WS_WGU), PROWS, 256, D};
        pg8::MoeOrder<true, 2> S{(const LAS int*)(F.lds + MOE_OFF), (const LAS int*)(F.lds + MOE_OFF) + 33, (const int*)(ws + WS_LTOK), CAP, F.G, F.vcu, (unsigned*)(F.ctl + CW_TCNT), F.wave};
        pg8::EpiHid E{(pg8::bf16_t*)(ws + WS_HID), PROWS * 256 * 2};
        pg8::gemm_phase<pg8::EpiHid, pg8::MoeOrder<true, 2>, true, true>(F.lds + RING_OFF, g, S, E, F.wave); }
        if (BOTH(8)) { __syncthreads(); PROF_STAMP(); }
    }
    if (IN(9)) { for (int rep_ = 0; rep_ < REPS(9); ++rep_) {
        pg8::Gemm g{(const pg8::bf16_t*)(ws + WS_HID), (const pg8::bf16_t*)(ws + WS_WDN), PROWS, D, DEXP};
        pg8::MoeOrder<false, 4> S{(const LAS int*)(F.lds + MOE_OFF), (const LAS int*)(F.lds + MOE_OFF) + 33, (const int*)(ws + WS_LTOK), CAP, F.G, F.vcu, (unsigned*)(F.ctl + CW_TCNT), F.wave};
        pg8::EpiYs E{(pg8::bf16_t*)(ws + WS_YS), (const float*)(ws + WS_LW), (const LAS int*)(F.lds + MOE_OFF) + 33, CAP};
        pg8::gemm_phase<pg8::EpiYs, pg8::MoeOrder<false, 4>, true, true>(F.lds + RING_OFF, g, S, E, F.wave); }
        if (BOTH(9)) GRID_BAR();
    }
    if (IN(10)) { p8_phase(F, ws, args.out, args.in[19]); }
#if MK_PROF_A >= 0
    GRID_BAR();
    if (blockIdx.x == 0) { const int t_ = F.wave * 64 + pg8::lane_now(); if (MK_PROF_A >= 200 && t_ == 0) { for (int q_ = 0; q_ < 4; ++q_) F.MISC[24 + q_] = F.ctl[CW_CNT + 64 + q_]; F.MISC[30] = __float_as_uint((float)F.ctl[CW_CNT + 70] * 0.01f); F.MISC[31] = __float_as_uint((float)F.ctl[CW_CNT + 71] * 0.01f); } __syncthreads();
        const float prof_a = (MK_PROF_A >= 100) ? __uint_as_float(F.MISC[24 + (MK_PROF_A % 10)]) : __uint_as_float(F.MISC[19]), prof_b = (MK_PROF_B >= 100) ? __uint_as_float(F.MISC[24 + (MK_PROF_B % 10)]) : __uint_as_float(F.MISC[20]);
        for (int r = t_; r < T; r += NWAVES * 64) args.out[(size_t)r * D + 1] += prof_b * (1.f / (float)MK_PROF_SB);
        if (t_ == 0) args.out[0] += 10.f + prof_a * (0.01f * (float)MK_PROF_SA); }
#endif
#undef IN
#undef BOTH
}


static int g_grid = 0;
static void launch_mega(Args a, int lo, int hi, int li, hipStream_t stream) {
    a.ph_lo = lo; a.ph_hi = hi; a.li = li;
    void* params[] = {&a};
    hipError_t e = hipLaunchCooperativeKernel((const void*)mega_fwd, dim3(g_grid), dim3(NWAVES * 64), params, LDS_BYTES, stream);
    if (e != hipSuccess) fprintf(stderr, "kernel_launch: cooperative launch [%d,%d) failed: %s (grid %d)\n", lo, hi, hipGetErrorString(e), g_grid);
}

extern "C" void kernel_launch(void* const* d_in, const int* in_sizes, int n_in, void* d_out, int out_size, void* d_ws, size_t ws_size, hipStream_t stream) {
    if (g_grid == 0) {
        if (n_in != 20 || ws_size < WS_NEED || out_size != T * D) { fprintf(stderr, "kernel_launch: unexpected shapes (n_in %d, ws %zu, out %d)\n", n_in, ws_size, out_size); g_grid = -1; return; }
        int dev = 0, cus = 0, per_cu = 0;
        (void)hipGetDevice(&dev); (void)hipDeviceGetAttribute(&cus, hipDeviceAttributeMultiprocessorCount, dev);
        if (hipFuncSetAttribute((const void*)mega_fwd, hipFuncAttributeMaxDynamicSharedMemorySize, LDS_BYTES) != hipSuccess) { fprintf(stderr, "kernel_launch: hipFuncSetAttribute failed\n"); g_grid = -1; return; }
        if (hipOccupancyMaxActiveBlocksPerMultiprocessor(&per_cu, (const void*)mega_fwd, NWAVES * 64, LDS_BYTES) != hipSuccess || per_cu < 1) { fprintf(stderr, "kernel_launch: occupancy query says %d\n", per_cu); per_cu = 1; }
        (void)hipGetLastError();
        g_grid = cus;
        fprintf(stderr, "kernel_launch: cus %d per_cu %d grid %d\n", cus, per_cu, g_grid);
    }
    if (g_grid < 0) return;
    (void)hipMemsetAsync((char*)d_ws + WS_CTL, 0, CTL_ZERO_BYTES, stream);
    Args a{};
    for (int i = 0; i < 20; ++i) a.in[i] = (const float*)d_in[i];
    a.out = (float*)d_out; a.ws = (unsigned char*)d_ws;
#if MK_DEV
#if MK_SPLIT
    launch_mega(a, 0, 1, 0, stream); launch_mega(a, 1, 2, 0, stream); launch_mega(a, 2, 3, 0, stream);
#else
    launch_mega(a, 0, 3, 0, stream);
#endif
#if MK_MODE == 2
    naive_gdn(a, stream); launch_mega(a, 4, 6, 1, stream); naive_yfin_gdn(a, stream); launch_mega(a, 6, 11, 2, stream);
#elif MK_MODE == 5
    launch_mega(a, 3, 4, 1, stream); naive_solve(a, stream); launch_mega(a, 4, 11, 2, stream);
#elif MK_MODE == 4
    launch_mega(a, 3, 4, 1, stream); naive_scan(a, stream); launch_mega(a, 4, 11, 2, stream);
#elif MK_MODE == 3
    launch_mega(a, 3, 6, 1, stream); naive_a3(a, stream); launch_mega(a, 6, 11, 2, stream);
#else
    launch_mega(a, 3, 11, 1, stream);
#endif
#else
    launch_mega(a, 0, 11, 0, stream);
#endif
}
```

```cpp
#define MK_DEV 0
#define MK_SPLIT 0
#define MK_MODE 0
#define MK_A1 0
#define MK_REP -1
#define MK_REPSCAN 0
#define MK_REPATT 0
#define MK_PROF_A -1
#define MK_PROF_B -1
#define MK_ATT_PF 0
#define MK_SERIAL_SCAN 0
#define MK_PROF_SA 25
#define MK_PROF_SB 250
#include <hip/hip_runtime.h>
#include <hip/hip_cooperative_groups.h>
#include <cstdio>
#include <cstdint>
#include <cmath>

namespace pg8 {
#define PG8_LAS __attribute__((address_space(3)))
typedef unsigned short bf16_t;
typedef short bf16x8 __attribute__((ext_vector_type(8)));
typedef float f32x4 __attribute__((ext_vector_type(4)));
typedef unsigned u32x4 __attribute__((ext_vector_type(4)));
constexpr int BM = 256, BK = 64, HALF = 128, HTB = HALF * BK * 2  , STAGE_BYTES = 8 * HTB, NXCD = 8, WGM = 8;

__host__ __device__ __forceinline__ int lds_byte(int r, int c) { const int st = (r >> 4) * 2 + (c >> 5), rr = r & 15, cc = c & 31, ob = rr * 64 + cc * 2; return st * 1024 + (ob ^ (((ob >> 9) & 1) << 5)); }
__host__ __device__ __forceinline__ void stage_rc(int b, int& R, int& C) { const int st = b / 1024, sb = b % 1024, swz = sb ^ (((sb >> 9) & 1) << 5); R = (st >> 1) * 16 + swz / 64; C = (st & 1) * 32 + (swz % 64) / 2; }
__host__ __device__ __forceinline__ int perm32(int rho) { const int n = rho >> 4, i = rho & 15; return 8 * (i >> 2) + 4 * n + (i & 3); }

__device__ __forceinline__ int lane_now() { int l; asm volatile("v_mbcnt_lo_u32_b32 %0, -1, 0\n\tv_mbcnt_hi_u32_b32 %0, -1, %0" : "=v"(l)); return l; }
constexpr int GATH_LDS_OFF = 148480;
struct Unit { int pm, pn, pb, e, mt; };
struct Gemm { const bf16_t* A; const bf16_t* Bt; int M, N, K; };

struct StaticOrder {
    int nM, nN, nwg, G, c;
    __host__ __device__ void init(int M, int N, int G_, int c_) { nM = M / BM; nN = N / BM; nwg = nM * nN; G = G_; c = c_; }
    __host__ __device__ bool next(int i, Unit& u) const {
        const long L = (long)i * G + c; if (L >= nwg) return false;
        int wgid = (int)L; { const int q = nwg / NXCD, r = nwg % NXCD, xcd = wgid % NXCD, off = wgid / NXCD; wgid = (xcd < r ? xcd * (q + 1) : r * (q + 1) + (xcd - r) * q) + off; }
        const int nig = WGM * nN, gid = wgid / nig, fm = gid * WGM, gsz = (nM - fm) < WGM ? (nM - fm) : WGM;
        u.pm = fm + ((wgid % nig) % gsz); u.pn = (wgid % nig) / gsz; u.pb = u.pn; u.e = 0; u.mt = 0; return true;
    }
    static constexpr bool GATHER = false;
    __device__ __forceinline__ void a_ready(const Unit&) const {}
    __device__ __forceinline__ void done(const Unit&) const {}
};

__device__ __forceinline__ unsigned cvt_pk_bf16(float lo, float hi) { typedef float f32x2_t_ __attribute__((ext_vector_type(2))); typedef __bf16 bf16x2_t_ __attribute__((ext_vector_type(2))); const f32x2_t_ v_ = {lo, hi}; return __builtin_bit_cast(unsigned, __builtin_convertvector(v_, bf16x2_t_)); }
struct EpiProj {
    static constexpr bool PERM = true, AFTER_DRAIN = false;
    unsigned char* ws; float qscale;
    __device__ __forceinline__ void operator()(const f32x4 (&acc)[2][2][4][2], const Unit& u, int wr, int wc, int fr, int fq) const {
        { const int ln_ = lane_now(); fr = ln_ & 15; fq = ln_ >> 4; }
        const int pn = u.pn;
        const int t = (pn - 6) >> 1;
        const bool a = pn < 6;
        const size_t off = a ? ((size_t)160 << 20) : (((size_t)256 + 32 * (size_t)t) << 20);
        const bool hm = !a && t >= 1;
        const int colt = a ? pn * 256 : ((pn - 6) & 1) * 256;
        const float sc = (t == 1 && !a) ? qscale : 1.f;
        const int row0 = u.pm * BM + wr * 64 + fr, col0 = colt + wc * 32 + 8 * fq;
        const int rowe = row0 & 4095, bq = row0 >> 12;
        const int ldc = a ? 384 : (hm ? 64 : 128);
        const int hh = hm ? (col0 >> 6) : ((col0 >> 7) & 3), nh = hm ? 8 : 4;
        const size_t cole = (size_t)(bq * nh + hh) * 4096 * ldc + (a ? (size_t)(col0 >> 9) * 128 : (size_t)0) + (size_t)(hm ? (col0 & 63) : (col0 & 127));
        const size_t bjstep = (size_t)(hm ? 2 : 1) * 4096 * ldc;
        bf16_t* base = (bf16_t*)(ws + off);
#pragma unroll
        for (int ai = 0; ai < 2; ++ai)
#pragma unroll
            for (int m = 0; m < 4; ++m) { bf16_t* rowp = base + (size_t)(rowe + ai * HALF + m * 16) * ldc + cole;
#pragma unroll
                for (int bj = 0; bj < 2; ++bj) { const f32x4 v0 = acc[ai][bj][m][0] * sc, v1 = acc[ai][bj][m][1] * sc;
                    u32x4 w; w.x = cvt_pk_bf16(v0[0], v0[1]); w.y = cvt_pk_bf16(v0[2], v0[3]); w.z = cvt_pk_bf16(v1[0], v1[1]); w.w = cvt_pk_bf16(v1[2], v1[3]);
                    *(u32x4*)(rowp + bj * bjstep) = w; } }
    }
};

struct EpiRes {
    static constexpr bool PERM = true, AFTER_DRAIN = false;
    const float* x; const float* mod; bf16_t* out; int gate_off;
    __device__ __forceinline__ void operator()(const f32x4 (&acc)[2][2][4][2], const Unit& u, int wr, int wc, int fr, int fq) const {
        { const int ln_ = lane_now(); fr = ln_ & 15; fq = ln_ >> 4; }
        const int col0 = u.pn * BM + wc * 32 + 8 * fq, b = (u.pm * BM) >> 12;
#pragma unroll
        for (int bj = 0; bj < 2; ++bj) {
            const f32x4 g0 = *(const f32x4*)(mod + b * 6144 + gate_off + col0 + bj * HALF), g1 = *(const f32x4*)(mod + b * 6144 + gate_off + col0 + bj * HALF + 4);
#pragma unroll
            for (int ai = 0; ai < 2; ++ai) {
                f32x4 xv[4][2];
#pragma unroll
                for (int m = 0; m < 4; ++m) { const size_t off = (size_t)(u.pm * BM + ai * HALF + wr * 64 + m * 16 + fr) * 1024 + col0 + bj * HALF;
                    xv[m][0] = *(const f32x4*)(x + off); xv[m][1] = *(const f32x4*)(x + off + 4); }
#pragma unroll
                for (int m = 0; m < 4; ++m) { const size_t off = (size_t)(u.pm * BM + ai * HALF + wr * 64 + m * 16 + fr) * 1024 + col0 + bj * HALF;
                    const f32x4 v0 = xv[m][0] + g0 * acc[ai][bj][m][0], v1 = xv[m][1] + g1 * acc[ai][bj][m][1];
                    u32x4 w; w.x = cvt_pk_bf16(v0[0], v0[1]); w.y = cvt_pk_bf16(v0[2], v0[3]); w.z = cvt_pk_bf16(v1[0], v1[1]); w.w = cvt_pk_bf16(v1[2], v1[3]);
                    *(u32x4*)(out + off) = w; }
            }
            asm volatile("" ::: "memory"); }
    }
};
__device__ __forceinline__ float silu_f(float v) { return v * __builtin_amdgcn_rcpf(1.f + __builtin_amdgcn_exp2f(-1.4426950408889634f * v)); }
struct EpiHid {
    static constexpr bool PERM = true, AFTER_DRAIN = false;
    bf16_t* hid; int hid_bytes;
    __device__ __forceinline__ void operator()(const f32x4 (&acc)[2][2][4][2], const Unit& u, int wr, int wc, int fr, int fq) const {
        { const int ln_ = lane_now(); fr = ln_ & 15; fq = ln_ >> 4; }
        const __amdgpu_buffer_rsrc_t rs = __builtin_amdgcn_make_buffer_rsrc((void*)hid, 0, hid_bytes, 0x00020000);
        const int col0 = u.pn * HALF + wc * 32 + 8 * fq;
#pragma unroll
        for (int ai = 0; ai < 2; ++ai)
#pragma unroll
            for (int m = 0; m < 4; ++m) { const size_t row = (size_t)u.pm * BM + ai * HALF + wr * 64 + m * 16 + fr;
                const f32x4 g0 = acc[ai][0][m][0], g1 = acc[ai][0][m][1], u0 = acc[ai][1][m][0], u1 = acc[ai][1][m][1];
                u32x4 w; w.x = cvt_pk_bf16(silu_f(g0[0]) * u0[0], silu_f(g0[1]) * u0[1]); w.y = cvt_pk_bf16(silu_f(g0[2]) * u0[2], silu_f(g0[3]) * u0[3]);
                w.z = cvt_pk_bf16(silu_f(g1[0]) * u1[0], silu_f(g1[1]) * u1[1]); w.w = cvt_pk_bf16(silu_f(g1[2]) * u1[2], silu_f(g1[3]) * u1[3]);
                __builtin_amdgcn_raw_buffer_store_b128(w, rs, (unsigned)((row * 256 + col0) * 2), 0,   16); }
    }
};
struct EpiYs {
    static constexpr bool PERM = true, AFTER_DRAIN = false;
    bf16_t* ys; const float* lw; const PG8_LAS int* cnt; int cap;
    __device__ __forceinline__ void operator()(const f32x4 (&acc)[2][2][4][2], const Unit& u, int wr, int wc, int fr, int fq) const {
        { const int ln_ = lane_now(); fr = ln_ & 15; fq = ln_ >> 4; }
        const int col0 = u.pn * BM + wc * 32 + 8 * fq, n_e = cnt[u.e];
#pragma unroll
        for (int ai = 0; ai < 2; ++ai)
#pragma unroll
            for (int m = 0; m < 4; ++m) { const int rl = u.mt * BM + ai * HALF + wr * 64 + m * 16 + fr;
                const float wv = rl < n_e ? lw[(size_t)u.e * cap + rl] : 0.f;
                bf16_t* rowp = ys + ((size_t)u.pm * BM + ai * HALF + wr * 64 + m * 16 + fr) * 1024 + col0;
#pragma unroll
                for (int bj = 0; bj < 2; ++bj) { const f32x4 v0 = acc[ai][bj][m][0] * wv, v1 = acc[ai][bj][m][1] * wv;
                    u32x4 w; w.x = cvt_pk_bf16(v0[0], v0[1]); w.y = cvt_pk_bf16(v0[2], v0[3]); w.z = cvt_pk_bf16(v1[0], v1[1]); w.w = cvt_pk_bf16(v1[2], v1[3]);
                    *(u32x4*)(rowp + bj * HALF) = w; } }
    }
};
template <bool GATHER_, int NPN> struct MoeOrder {
    static constexpr bool GATHER = GATHER_;
    const PG8_LAS int* tpre; const PG8_LAS int* cnt; const int* ltok; int cap, G, c; unsigned* tcnt; int wave;
    __device__ __forceinline__ bool next(int i, Unit& u) const {
        const int NT = __builtin_amdgcn_readfirstlane(tpre[32]); int L;
        if constexpr (GATHER) { L = i * G + c; }
        else { const int x = (2 * NT) % G, F = G - x;
            if (c >= x) L = i < 2 ? (c - x) + i * F : 2 * F + (i - 2) * G + (c - x);
            else L = 2 * F + i * G + F + c; }
        if (L >= NT * NPN) return false;
        const int tt = L / NPN, pn = L % NPN; int e = 0;
#pragma unroll
        for (int k = 1; k < 32; ++k) e += (tt >= tpre[k]) ? 1 : 0;
        e = __builtin_amdgcn_readfirstlane(e);
        u.pm = tt; u.pn = pn; u.e = e; u.mt = tt - __builtin_amdgcn_readfirstlane(tpre[e]); u.pb = e * NPN + pn; return true;
    }
    __device__ __forceinline__ void avoff(const Unit& u, int tid, int K, unsigned (&v0)[2], unsigned (&v1)[2]) const {
        const int n_e = cnt[u.e];
#pragma unroll
        for (int i = 0; i < 2; ++i) { int R, C; stage_rc(tid * 16 + i * 8192, R, C); const int r0 = u.mt * BM + R, r1 = r0 + HALF;
            const int t0 = ltok[(size_t)u.e * cap + (r0 < n_e ? r0 : 0)], t1 = ltok[(size_t)u.e * cap + (r1 < n_e ? r1 : 0)];
            v0[i] = (unsigned)(t0 * K + C) * 2u; v1[i] = (unsigned)(t1 * K + C) * 2u; }
    }
    __device__ __forceinline__ void a_ready(const Unit& u) const {
        if constexpr (!GATHER) {
            if (wave == 0 && lane_now() == 0) {
                unsigned sp = 0u;
                while (__hip_atomic_load(tcnt + u.pm, __ATOMIC_RELAXED, __HIP_MEMORY_SCOPE_AGENT) < 2u && ++sp < (1u << 22)) __builtin_amdgcn_s_sleep(1);
                __builtin_amdgcn_fence(__ATOMIC_ACQUIRE, "agent"); asm volatile("s_waitcnt vmcnt(0)" ::: "memory"); }
            __builtin_amdgcn_s_barrier();
        }
    }
    __device__ __forceinline__ void done(const Unit& u) const {
        if constexpr (GATHER) {
            asm volatile("s_waitcnt vmcnt(0)" ::: "memory");
            __builtin_amdgcn_s_barrier();
            if (wave == 0 && lane_now() == 0) (void)__hip_atomic_fetch_add(tcnt + u.pm, 1u, __ATOMIC_RELAXED, __HIP_MEMORY_SCOPE_AGENT);
        }
    }
};
template <class Epi, class Sched, bool ALIGN_EPI = false, bool SP2 = false>
__device__ __forceinline__ void gemm_phase(PG8_LAS unsigned char* lds, const Gemm g, const Sched& S, const Epi& E, int wave_sgpr) {
    const int wid = __builtin_amdgcn_readfirstlane(wave_sgpr), lane = lane_now(), tid = wid * 64 + lane, wr = wid >> 2, wc = wid & 3, fr = lane & 15, fq = lane >> 4;
    const int K = g.K, nt = K / BK;
    unsigned voffA[2], voffB[2];
#pragma unroll
    for (int i = 0; i < 2; ++i) { int R, C; stage_rc(tid * 16 + i * 8192, R, C); const int Rb = Epi::PERM ? ((R & ~31) + perm32(R & 31)) : R;
        voffA[i] = (unsigned)(R * K + C) * 2u; voffB[i] = (unsigned)(Rb * K + C) * 2u; }
    const size_t kstep = (size_t)(BK * 2);
    const size_t hstep = (size_t)HALF * K * 2;
    const size_t tstep = 2 * hstep;
    const unsigned ldsw = (unsigned)wid * 1024u;
    const int aoff = lds_byte(wr * 64 + fr, fq * 8), boff = lds_byte(wc * 32 + fr, fq * 8);
#define PG8_SA(b, h) (((b) * 2 + (h)) * HTB)
#define PG8_SB(b, h) ((4 + (b) * 2 + (h)) * HTB)
#define PG8_STAGE(bufoff, gbase, voff) do { _Pragma("unroll") for (int _i = 0; _i < 2; ++_i) \
        __builtin_amdgcn_global_load_lds((const unsigned*)((const char*)(gbase) + (voff)[_i]), (PG8_LAS unsigned*)(lds + (bufoff) + ldsw + _i * 8192), 16, 0, 0); } while (0)
#define PG8_STAGE_A(bufoff, kptr, h, nxtsel) do { if constexpr (Sched::GATHER) { unsigned _v[2]; _v[0] = cv##h[0]; _v[1] = cv##h[1]; \
            if (nxtsel) { const u32x4 _p = *(const PG8_LAS u32x4*)(lds + GATH_LDS_OFF + tid * 16); _v[0] = (h) ? _p.z : _p.x; _v[1] = (h) ? _p.w : _p.y; } PG8_STAGE(bufoff, kptr, _v); } \
        else { PG8_STAGE(bufoff, (kptr) + (h) * hstep, voffA); } } while (0)
#define PG8_LDA(dst, b, h) do { _Pragma("unroll") for (int m = 0; m < 4; ++m) _Pragma("unroll") for (int k = 0; k < 2; ++k) dst[m][k] = *(const PG8_LAS bf16x8*)(lds + PG8_SA(b, h) + aoff + m * 2048 + k * 1024); } while (0)
#define PG8_LDB(dst, b, h) do { _Pragma("unroll") for (int n = 0; n < 2; ++n) _Pragma("unroll") for (int k = 0; k < 2; ++k) dst[n][k] = *(const PG8_LAS bf16x8*)(lds + PG8_SB(b, h) + boff + n * 2048 + k * 1024); } while (0)
#define PG8_MMA(ai, bj, At, Bt) do { __builtin_amdgcn_s_setprio(1); _Pragma("unroll") for (int m = 0; m < 4; ++m) _Pragma("unroll") for (int n = 0; n < 2; ++n) _Pragma("unroll") for (int k = 0; k < 2; ++k) \
        acc[ai][bj][m][n] = __builtin_amdgcn_mfma_f32_16x16x32_bf16(Bt[n][k], At[m][k], acc[ai][bj][m][n], 0, 0, 0); __builtin_amdgcn_s_setprio(0); } while (0)
#define PG8_WAIT_V(n) asm volatile("s_waitcnt vmcnt(" #n ")" ::: "memory")
#define PG8_WAIT_L(n) asm volatile("s_waitcnt lgkmcnt(" #n ")" ::: "memory")
#define PG8_BAR __builtin_amdgcn_s_barrier()
#define PG8_SCHED __builtin_amdgcn_sched_barrier(0)
    Unit cur, nxt; int ui = 0;
    if (!S.next(0, cur)) return;
    f32x4 acc[2][2][4][2];
#pragma unroll
    for (int a = 0; a < 2; ++a)
#pragma unroll
        for (int b = 0; b < 2; ++b)
#pragma unroll
            for (int m = 0; m < 4; ++m)
#pragma unroll
                for (int n = 0; n < 2; ++n) acc[a][b][m][n] = (f32x4){0.f, 0.f, 0.f, 0.f};
    bf16x8 At[4][2], B0[2][2], B1[2][2];
    const char* cA = (const char*)g.A + (Sched::GATHER ? (size_t)0 : (size_t)cur.pm * tstep); const char* cB = (const char*)g.Bt + (size_t)cur.pb * tstep;
    unsigned cv0[2] = {0u, 0u}, cv1[2] = {0u, 0u};
    if constexpr (Sched::GATHER) S.avoff(cur, tid, K, cv0, cv1);
    S.a_ready(cur);
    if constexpr (SP2) {
        PG8_STAGE(PG8_SB(0, 0), cB, voffB); PG8_STAGE(PG8_SB(0, 1), cB + hstep, voffB); PG8_STAGE_A(PG8_SA(0, 0), cA, 0, false); PG8_STAGE_A(PG8_SA(0, 1), cA, 1, false);
        if (wr == 1) PG8_BAR;
        PG8_WAIT_V(2); PG8_BAR;
        PG8_STAGE(PG8_SB(1, 0), cB + kstep, voffB); PG8_STAGE_A(PG8_SA(1, 0), cA + kstep, 0, false); PG8_STAGE(PG8_SB(1, 1), cB + hstep + kstep, voffB);
        PG8_WAIT_V(6); PG8_BAR;
    } else {
        PG8_STAGE(PG8_SB(0, 0), cB, voffB); PG8_STAGE_A(PG8_SA(0, 0), cA, 0, false); PG8_STAGE(PG8_SB(0, 1), cB + hstep, voffB); PG8_STAGE_A(PG8_SA(0, 1), cA, 1, false);
        if (wr == 1) PG8_BAR;
        PG8_WAIT_V(4); PG8_BAR;
        PG8_STAGE(PG8_SB(1, 0), cB + kstep, voffB); PG8_STAGE_A(PG8_SA(1, 0), cA + kstep, 0, false); PG8_STAGE(PG8_SB(1, 1), cB + hstep + kstep, voffB);
        PG8_WAIT_V(6); PG8_BAR;
    }
    for (;;) {
        const bool has_next = S.next(ui + 1, nxt);
        if (has_next) S.a_ready(nxt);
        const char* nA = has_next ? (const char*)g.A + (Sched::GATHER ? (size_t)0 : (size_t)nxt.pm * tstep) : cA; const char* nB = has_next ? (const char*)g.Bt + (size_t)nxt.pb * tstep : cB;
        if constexpr (Sched::GATHER) { unsigned nv0[2], nv1[2];
            if (has_next) S.avoff(nxt, tid, K, nv0, nv1); else { nv0[0] = cv0[0]; nv0[1] = cv0[1]; nv1[0] = cv1[0]; nv1[1] = cv1[1]; }
            *(PG8_LAS u32x4*)(lds + GATH_LDS_OFF + tid * 16) = (u32x4){nv0[0], nv0[1], nv1[0], nv1[1]}; }
        for (int t = 0; t < nt; t += 2) {
            const bool last = (t == nt - 2);
            const char* a1 = cA + (size_t)(t + 1) * kstep;
            const char* a2 = last ? nA : cA + (size_t)(t + 2) * kstep; const char* b2 = last ? nB : cB + (size_t)(t + 2) * kstep;
            const char* a3 = a2 + kstep; const char* b3 = b2 + kstep;
            if constexpr (SP2) {
            PG8_LDB(B0, 0, 0); PG8_LDB(B1, 0, 1); PG8_SCHED; PG8_LDA(At, 0, 0); PG8_STAGE_A(PG8_SA(1, 1), a1, 1, false);
            PG8_WAIT_V(8); PG8_WAIT_L(0); PG8_BAR; PG8_MMA(0, 0, At, B0); PG8_MMA(0, 1, At, B1); PG8_BAR; PG8_SCHED;
            PG8_LDA(At, 0, 1); PG8_STAGE(PG8_SB(0, 0), b2, voffB); PG8_STAGE(PG8_SB(0, 1), b2 + hstep, voffB); PG8_STAGE_A(PG8_SA(0, 0), a2, 0, last);
            PG8_WAIT_V(8); PG8_WAIT_L(0); PG8_BAR; PG8_MMA(1, 0, At, B0); PG8_MMA(1, 1, At, B1); PG8_BAR; PG8_SCHED;
            PG8_LDB(B0, 1, 0); PG8_LDB(B1, 1, 1); PG8_SCHED; PG8_LDA(At, 1, 0); PG8_STAGE_A(PG8_SA(0, 1), a2, 1, last);
            PG8_WAIT_V(8); PG8_WAIT_L(0); PG8_BAR; PG8_MMA(0, 0, At, B0); PG8_MMA(0, 1, At, B1); PG8_BAR; PG8_SCHED;
            PG8_LDA(At, 1, 1); PG8_STAGE(PG8_SB(1, 0), b3, voffB); PG8_STAGE(PG8_SB(1, 1), b3 + hstep, voffB); PG8_STAGE_A(PG8_SA(1, 0), a3, 0, last);
            PG8_WAIT_V(8); PG8_WAIT_L(0); PG8_BAR; PG8_MMA(1, 0, At, B0); PG8_MMA(1, 1, At, B1); PG8_BAR; PG8_SCHED;
            } else {
            PG8_LDB(B0, 0, 0); PG8_SCHED; PG8_LDA(At, 0, 0); PG8_STAGE_A(PG8_SA(1, 1), a1, 1, false);
            PG8_WAIT_L(8); PG8_BAR; PG8_WAIT_L(0); PG8_MMA(0, 0, At, B0); PG8_BAR; PG8_SCHED;
            PG8_LDB(B1, 0, 1); PG8_STAGE(PG8_SB(0, 0), b2, voffB);
            PG8_BAR; PG8_WAIT_L(0); PG8_MMA(0, 1, At, B1); PG8_BAR;
            PG8_LDA(At, 0, 1); PG8_STAGE_A(PG8_SA(0, 0), a2, 0, last);
            PG8_BAR; PG8_WAIT_L(0); PG8_MMA(1, 0, At, B0); PG8_BAR; PG8_SCHED;
            PG8_STAGE(PG8_SB(0, 1), b2 + hstep, voffB);
            PG8_WAIT_V(6); PG8_BAR; PG8_MMA(1, 1, At, B1); PG8_BAR;
            PG8_LDB(B0, 1, 0); PG8_SCHED; PG8_LDA(At, 1, 0); PG8_STAGE_A(PG8_SA(0, 1), a2, 1, last);
            PG8_WAIT_L(8); PG8_BAR; PG8_WAIT_L(0); PG8_MMA(0, 0, At, B0); PG8_BAR; PG8_SCHED;
            PG8_LDB(B1, 1, 1); PG8_STAGE(PG8_SB(1, 0), b3, voffB);
            PG8_BAR; PG8_WAIT_L(0); PG8_MMA(0, 1, At, B1); PG8_BAR;
            PG8_LDA(At, 1, 1); PG8_STAGE_A(PG8_SA(1, 0), a3, 0, last);
            PG8_BAR; PG8_WAIT_L(0); PG8_MMA(1, 0, At, B0); PG8_BAR; PG8_SCHED;
            PG8_STAGE(PG8_SB(1, 1), b3 + hstep, voffB);
            PG8_WAIT_V(6); PG8_BAR; PG8_MMA(1, 1, At, B1); PG8_BAR;
            }
        }
        if constexpr (ALIGN_EPI) { if (wr == 0) PG8_BAR; }
        if constexpr (!Epi::AFTER_DRAIN) { E(acc, cur, wr, wc, fr, fq); S.done(cur); }
        if (!has_next) break;
#pragma unroll
        for (int a = 0; a < 2; ++a)
#pragma unroll
            for (int b = 0; b < 2; ++b)
#pragma unroll
                for (int m = 0; m < 4; ++m)
#pragma unroll
                    for (int n = 0; n < 2; ++n) acc[a][b][m][n] = (f32x4){0.f, 0.f, 0.f, 0.f};
        cur = nxt; cA = nA; cB = nB; ++ui; if constexpr (Sched::GATHER) { const u32x4 _p = *(const PG8_LAS u32x4*)(lds + GATH_LDS_OFF + tid * 16); cv0[0] = _p.x; cv0[1] = _p.y; cv1[0] = _p.z; cv1[1] = _p.w; }
        if constexpr (ALIGN_EPI) { if (wr == 1) PG8_BAR; }
    }
    PG8_WAIT_V(0);
    if constexpr (!ALIGN_EPI) { if (wr == 0) PG8_BAR; }
    PG8_BAR;
    if constexpr (Epi::AFTER_DRAIN) { E.fused(acc, cur, wr, wc, fr, fq, lds, wid, lane); S.done(cur); }
#undef PG8_SA
#undef PG8_SB
#undef PG8_STAGE
#undef PG8_STAGE_A
#undef PG8_LDA
#undef PG8_LDB
#undef PG8_MMA
#undef PG8_WAIT_V
#undef PG8_WAIT_L
#undef PG8_BAR
#undef PG8_SCHED
}
}

constexpr int NWAVES = 8;
constexpr int D = 1024, BATCH = 8, SEQ = 4096, T = BATCH * SEQ;
constexpr int IN_COLS = 3592, NPROJ = 3584, NEXP = 32, DEXP = 256, CAP = 65536;
constexpr float EPS = 1e-6f;
constexpr size_t MiB = 1u << 20;
constexpr size_t WS_CTL = 0, CTL_ZERO_BYTES = 1 * MiB;
constexpr size_t WS_MOD = 1 * MiB;
constexpr size_t WS_BG = 2 * MiB;
constexpr size_t WS_TOKSLOT = 3 * MiB;
constexpr size_t WS_WRT = 6 * MiB;
constexpr size_t WS_WIN = 8 * MiB;
constexpr size_t WS_WOUT = 15 * MiB;
constexpr size_t WS_WGU = 32 * MiB;
constexpr size_t WS_WDN = 64 * MiB;
constexpr size_t WS_LTOK = 80 * MiB;
constexpr size_t WS_LW = 88 * MiB;
constexpr size_t WS_H = 96 * MiB;
constexpr size_t WS_QKVA = 160 * MiB;
constexpr size_t WS_Z = 256 * MiB;
constexpr size_t WS_QB = 288 * MiB, WS_KB = 320 * MiB, WS_VB = 352 * MiB;
constexpr size_t WS_Y = 384 * MiB;
constexpr int PROWS = 65536 + 32 * 256;
constexpr size_t WS_HID = 448 * MiB;
constexpr size_t WS_YS = 160 * MiB;
constexpr size_t WS_PART0 = 96 * MiB, WS_PART1 = 128 * MiB, WS_PART2 = 448 * MiB;
constexpr size_t WS_LSE = 480 * MiB;
constexpr size_t WS_GAQK = 484 * MiB;
constexpr size_t WS_GGL = 500 * MiB;
constexpr size_t WS_XM = 320 * MiB;
constexpr size_t WS_NEED = 512 * MiB;
static_assert(WS_QKVA == (size_t)160 << 20 && WS_Z == (size_t)256 << 20 && WS_QB == (size_t)288 << 20 && WS_KB == (size_t)320 << 20 && WS_VB == (size_t)352 << 20, "EpiProj offsets");
constexpr int CW_MODF = 992;
constexpr int CW_ATTQ = 2048;
constexpr int CW_TCNT = 2560;
constexpr int CW_CNT = 1024;
constexpr int CW_BAR = 4096;

constexpr int RING_OFF = 0, RING_BYTES = 131072;
constexpr int PHASE_LDS = 147456;
constexpr int LDSCTL_OFF = PHASE_LDS, MISC_OFF = LDSCTL_OFF + 320, MOE_OFF = MISC_OFF + 128;
constexpr int LDS_BYTES = 163840;
static_assert(RING_OFF == 0 && MOE_OFF + 512 <= pg8::GATH_LDS_OFF && pg8::GATH_LDS_OFF + 8192 <= LDS_BYTES, "LDS map");

#define GAS __attribute__((address_space(1)))
#define LAS __attribute__((address_space(3)))
typedef unsigned short bf16;
typedef unsigned v4u __attribute__((ext_vector_type(4)));
typedef float f32x4 __attribute__((ext_vector_type(4)));
typedef short bf16x8 __attribute__((ext_vector_type(8)));
typedef GAS unsigned gu32;
typedef GAS unsigned long long gu64;
#define RLX_AGENT __ATOMIC_RELAXED, __HIP_MEMORY_SCOPE_AGENT
#define LDS_WAIT() asm volatile("s_waitcnt lgkmcnt(0)" ::: "memory")
#define VM_WAIT() asm volatile("s_waitcnt vmcnt(0)" ::: "memory")
__device__ __forceinline__ unsigned long long rt() { return __builtin_amdgcn_s_memrealtime(); }
__device__ __forceinline__ unsigned f2bf(float f) { unsigned u = __builtin_bit_cast(unsigned, f); return (u + 0x7fffu + ((u >> 16) & 1u)) >> 16; }
__device__ __forceinline__ unsigned pk2(float lo, float hi) { return f2bf(lo) | (f2bf(hi) << 16); }

#define XB_TMO      128
#define XB_XCNT(j)  (256  + 64 * (j))
#define XB_XSUB(j)  (1280 + 64 * (j))
#define XB_XGEN(j)  (2304 + 64 * (j))
#define XB_TOP      3328
#define XB_TOPGEN   3392
#define XCD_BAR_WORDS 3456
#define XB_SPIN_CAP (1u << 18)

__device__ __forceinline__ unsigned xb_ld(unsigned* p)              { return __hip_atomic_load(p, __ATOMIC_RELAXED, __HIP_MEMORY_SCOPE_AGENT); }
__device__ __forceinline__ unsigned xb_add(unsigned* p, unsigned v) { return __hip_atomic_fetch_add(p, v, __ATOMIC_RELAXED, __HIP_MEMORY_SCOPE_AGENT); }
__device__ __forceinline__ unsigned xb_xcc_id() { return (unsigned)__builtin_amdgcn_s_getreg((3 << 11) | 20) & 0xFu; }
#define XB_SPIN(cond, bar) do { unsigned _sp = 0; while (cond) { __builtin_amdgcn_s_sleep(1); \
    if ((++_sp & 255u) == 0u) { if (xb_ld(&(bar)[XB_TMO])) break; if (_sp > XB_SPIN_CAP) { atomicAdd(&(bar)[XB_TMO], 1u); break; } } } } while (0)

struct XcdBarrier {
    unsigned* bar; unsigned x; int wave;
    volatile LAS unsigned* st;
};

__device__ __forceinline__ XcdBarrier xcd_barrier_post(unsigned* bar, volatile LAS unsigned* st, int wave) {
    XcdBarrier b; b.bar = bar; b.x = xb_xcc_id(); b.st = st; b.wave = wave;
    if (wave == 0 && pg8::lane_now() == 0) (void)xb_add(&bar[XB_XCNT(b.x)], 1u);
    return b;
}
__device__ __forceinline__ void xcd_barrier_complete(unsigned* bar, unsigned x, unsigned& nloc, unsigned& nx) {
    const unsigned G = gridDim.x * gridDim.y * gridDim.z;
    unsigned sum, cnt, mine, sp = 0u;
    for (;;) {
        sum = 0u; cnt = 0u; mine = 0u;
#pragma unroll
        for (unsigned j = 0; j < 16; ++j) { const unsigned c = xb_ld(&bar[XB_XCNT(j)]); sum += c; cnt += (c > 0u) ? 1u : 0u; mine = (j == x) ? c : mine; }
        if (sum == G) break;
        __builtin_amdgcn_s_sleep(1);
        if ((++sp & 255u) == 0u) { if (xb_ld(&bar[XB_TMO])) break; if (sp > XB_SPIN_CAP) { atomicAdd(&bar[XB_TMO], 1u); break; } }
    }
    nloc = mine > 0u ? mine : 1u; nx = cnt > 0u ? cnt : 1u;
}

__device__ __forceinline__ void xcd_barrier(const XcdBarrier& b) {
    asm volatile("s_waitcnt vmcnt(0)" ::: "memory");
    __syncthreads();
    if (b.wave == 0 && pg8::lane_now() == 0) {
        unsigned* bar = b.bar;
        __builtin_amdgcn_s_waitcnt(0);
        unsigned nloc = b.st[0], nx = b.st[1];
        if (nloc == 0u) { xcd_barrier_complete(bar, b.x, nloc, nx); b.st[0] = nloc; b.st[1] = nx; }
        const unsigned old = xb_add(&bar[XB_XSUB(b.x)], 1u);
        const unsigned gen = old / nloc;
        if (old + 1u == (gen + 1u) * nloc) {
            __builtin_amdgcn_fence(__ATOMIC_RELEASE, "agent");
            asm volatile("s_waitcnt vmcnt(0)" ::: "memory");
            const unsigned og = xb_add(&bar[XB_TOP], 1u);
            const unsigned tg = og / nx;
            if (og + 1u == (tg + 1u) * nx) xb_add(&bar[XB_TOPGEN], 1u);
            else XB_SPIN(xb_ld(&bar[XB_TOPGEN]) == tg, bar);
            __builtin_amdgcn_fence(__ATOMIC_ACQUIRE, "agent");
            xb_add(&bar[XB_XGEN(b.x)], 1u);
            asm volatile("s_waitcnt vmcnt(0)" ::: "memory");
        } else {
            XB_SPIN(xb_ld(&bar[XB_XGEN(b.x)]) == gen, bar);
            __builtin_amdgcn_fence(__ATOMIC_ACQUIRE, "agent");
            asm volatile("s_waitcnt vmcnt(0)" ::: "memory");
        }
    }
    __syncthreads();
}

__device__ __forceinline__ float dpp_add(float v, const int ctrl_sel) {
    int r;
    if (ctrl_sel == 0) r = __builtin_amdgcn_mov_dpp(__builtin_bit_cast(int, v), 0xB1, 0xF, 0xF, false);
    else if (ctrl_sel == 1) r = __builtin_amdgcn_mov_dpp(__builtin_bit_cast(int, v), 0x4E, 0xF, 0xF, false);
    else if (ctrl_sel == 2) r = __builtin_amdgcn_mov_dpp(__builtin_bit_cast(int, v), 0x124, 0xF, 0xF, false);
    else r = __builtin_amdgcn_mov_dpp(__builtin_bit_cast(int, v), 0x128, 0xF, 0xF, false);
    return v + __builtin_bit_cast(float, r);
}
__device__ __forceinline__ float row16_sum(float v) { v = dpp_add(v, 0); v = dpp_add(v, 1); v = dpp_add(v, 2); v = dpp_add(v, 3); return v; }
__device__ __forceinline__ float wave_sum(float v) {
    v = row16_sum(v);
    v += __shfl_xor(v, 16);
    v += __shfl_xor(v, 32);
    return v;
}
__device__ __forceinline__ void p0_transpose_item(const float* W, int K, int N, bf16* WT, int row_off, LAS float* scr, int item, int lane) {
    const int nblk = N / 32, kb = item / nblk, nb = item % nblk, k0 = 64 * kb, n0 = 32 * nb;
#pragma unroll 8
    for (int i = 0; i < 32; ++i) { const int kk = 2 * i + (lane >> 5); scr[kk * 33 + (lane & 31)] = W[(size_t)(k0 + kk) * N + n0 + (lane & 31)]; }
    LDS_WAIT(); asm volatile("" ::: "memory");
    const int c = lane & 7;
#pragma unroll
    for (int j = 0; j < 4; ++j) { const int n = (lane >> 3) + 8 * j; const LAS float* s = scr + (8 * c) * 33 + n;
        v4u o; o.x = pk2(s[0 * 33], s[1 * 33]); o.y = pk2(s[2 * 33], s[3 * 33]); o.z = pk2(s[4 * 33], s[5 * 33]); o.w = pk2(s[6 * 33], s[7 * 33]);
        *(GAS v4u*)(WT + (size_t)(row_off + n0 + n) * K + k0 + 8 * c) = o; }
    LDS_WAIT(); asm volatile("" ::: "memory");
}

__device__ __forceinline__ float bf2f(bf16 v) { return __uint_as_float((unsigned)v << 16); }
__device__ __forceinline__ float siluf(float x) { return x / (1.f + __expf(-x)); }
__device__ __forceinline__ float sigmoidf(float x) { return 1.f / (1.f + __expf(-x)); }

struct Args { const float* in[20]; float* out; unsigned char* ws; int ph_lo, ph_hi, li, pad; };

struct Frame {
    LAS unsigned char* lds; volatile LAS unsigned* MISC; gu32* ctl;
    int wave, vcu, G;
};

__device__ __forceinline__ void transpose_item(const float* W, int K, int pitch, int ncols, bf16* WT, int row_off, LAS float* scr, int item, int lane) {
    const int nblk = ncols / 32, kb = item / nblk, nb = item % nblk, k0 = 64 * kb, n0 = 32 * nb;
#pragma unroll 8
    for (int i = 0; i < 32; ++i) { const int kk = 2 * i + (lane >> 5); scr[kk * 33 + (lane & 31)] = W[(size_t)(k0 + kk) * pitch + n0 + (lane & 31)]; }
    LDS_WAIT(); asm volatile("" ::: "memory");
    const int c = lane & 7;
#pragma unroll
    for (int j = 0; j < 4; ++j) { const int n = (lane >> 3) + 8 * j; const LAS float* s = scr + (8 * c) * 33 + n;
        v4u o; o.x = pk2(s[0 * 33], s[1 * 33]); o.y = pk2(s[2 * 33], s[3 * 33]); o.z = pk2(s[4 * 33], s[5 * 33]); o.w = pk2(s[6 * 33], s[7 * 33]);
        *(GAS v4u*)(WT + (size_t)(row_off + n0 + n) * K + k0 + 8 * c) = o; }
    LDS_WAIT(); asm volatile("" ::: "memory");
}

__device__ __forceinline__ void p0_phase(Frame& F, unsigned char* ws, const float* c, const float* w_ada, const float* b_ada, const float* w_in, const float* w_out, const float* w_gate, const float* w_up, const float* w_down, const float* w_rg, const float* w_re) {
    const int lane_ = pg8::lane_now(), tid_ = F.wave * 64 + lane_;
    float* mod = (float*)(ws + WS_MOD);
    if ((int)blockIdx.x < 192) {
        LAS float* cs = (LAS float*)(F.lds + RING_OFF);
        LAS float* red = cs + 8192;
        for (int i = tid_; i < 8192; i += NWAVES * 64) cs[i] = c[i];
        __syncthreads();
        for (int item = blockIdx.x; item < 192; item += F.G) {
            const int col = tid_ & 31, kq = tid_ >> 5, n = item * 32 + col;
            float acc[8];
#pragma unroll
            for (int b = 0; b < 8; ++b) acc[b] = 0.f;
            float wa[32], wb[32];
#pragma unroll
            for (int k = 0; k < 32; ++k) wa[k] = w_ada[(size_t)(kq * 64 + k) * 6144 + n];
#pragma unroll
            for (int k = 0; k < 32; ++k) wb[k] = w_ada[(size_t)(kq * 64 + 32 + k) * 6144 + n];
#pragma unroll
            for (int k = 0; k < 32; ++k) {
#pragma unroll
                for (int b = 0; b < 8; ++b) acc[b] += cs[b * D + kq * 64 + k] * wa[k]; }
#pragma unroll
            for (int k = 0; k < 32; ++k) {
#pragma unroll
                for (int b = 0; b < 8; ++b) acc[b] += cs[b * D + kq * 64 + 32 + k] * wb[k]; }
#pragma unroll
            for (int b = 0; b < 8; ++b) red[(kq * 8 + b) * 32 + col] = acc[b];
            __syncthreads();
            if (tid_ < 256) { const int b = tid_ >> 5; float s = 0.f;
#pragma unroll
              for (int q = 0; q < 16; ++q) s += red[(q * 8 + b) * 32 + col];
              mod[b * 6144 + n] = s + b_ada[n]; }
            __syncthreads();
        }
    }
    { bf16* wrt = (bf16*)(ws + WS_WRT);
      for (int i = blockIdx.x * (NWAVES * 64) + tid_; i < 48 * 1024; i += F.G * NWAVES * 64) { const int e = i >> 10, k = i & 1023;
          const float v = e < 4 ? w_rg[k * 4 + e] : (e < 36 ? w_re[k * 32 + e - 4] : 0.f); wrt[i] = (bf16)f2bf(v); } }
}
__device__ __forceinline__ void p0b_phase(Frame& F, unsigned char* ws, const float* w_in, const float* w_out, const float* w_gate, const float* w_up, const float* w_down) {
    const int lane_ = pg8::lane_now();
    LAS float* scr = (LAS float*)(F.lds + RING_OFF + F.wave * 16384);
    const int gw = F.vcu * NWAVES + F.wave, NGW = F.G * NWAVES;
    bf16* win_t = (bf16*)(ws + WS_WIN); bf16* wout_t = (bf16*)(ws + WS_WOUT); bf16* wgu_t = (bf16*)(ws + WS_WGU); bf16* wdn_t = (bf16*)(ws + WS_WDN);
    constexpr int I_A = 16 * 64, I_B = 16 * 48, I_C = 16 * 32, I_D = 32 * 256, I_E = 32 * 128, I_ALL = I_A + I_B + I_C + I_D + I_E;
#define P0_DECODE(it_, W_, K_, pitch_, ncols_, WT_, roff_, li_) do { int r = (it_); \
        if (r < I_A) { W_ = w_in; K_ = D; pitch_ = IN_COLS; ncols_ = 2048; WT_ = win_t; roff_ = 0; li_ = r; } \
        else if ((r -= I_A) < I_B) { W_ = w_in + 2056; K_ = D; pitch_ = IN_COLS; ncols_ = 1536; WT_ = win_t; roff_ = 2048; li_ = r; } \
        else if ((r -= I_B) < I_C) { W_ = w_out; K_ = D; pitch_ = D; ncols_ = D; WT_ = wout_t; roff_ = 0; li_ = r; } \
        else if ((r -= I_C) < I_D) { const int e = r >> 8, q = r & 255, piece = q >> 6; \
            W_ = (piece < 2 ? w_gate : w_up) + (size_t)e * D * DEXP + (piece & 1) * 128; K_ = D; pitch_ = DEXP; ncols_ = 128; WT_ = wgu_t + (size_t)e * 512 * D; roff_ = (piece & 1) * 256 + (piece >> 1) * 128; li_ = q & 63; } \
        else { r -= I_D; const int e = r >> 7; W_ = w_down + (size_t)e * DEXP * D; K_ = DEXP; pitch_ = D; ncols_ = D; WT_ = wdn_t + (size_t)e * D * DEXP; roff_ = 0; li_ = r & 127; } } while (0)
#define P0_LOAD(dst, W_, pitch_, ncols_, li_) do { const int nblk_ = (ncols_) / 32, k0_ = 64 * ((li_) / nblk_), n0_ = 32 * ((li_) % nblk_); \
        _Pragma("unroll") for (int i = 0; i < 32; ++i) dst[i] = (W_)[(size_t)(k0_ + 2 * i + (lane_ >> 5)) * (pitch_) + n0_ + (lane_ & 31)]; } while (0)
    float tv[32];
    const float* cW = nullptr; int cK = 0, cP = 0, cN = 32, cR = 0, cL = 0; bf16* cT = nullptr;
    if (gw < I_ALL) { P0_DECODE(gw, cW, cK, cP, cN, cT, cR, cL); P0_LOAD(tv, cW, cP, cN, cL); }
    for (int it = gw; it < I_ALL; it += NGW) {
#pragma unroll
        for (int i = 0; i < 32; ++i) scr[(2 * i + (lane_ >> 5)) * 33 + (lane_ & 31)] = tv[i];
        const int K = cK, roff = cR; bf16* WT = cT; const int nblk = cN / 32, k0 = 64 * (cL / nblk), n0 = 32 * (cL % nblk);
        if (it + NGW < I_ALL) { P0_DECODE(it + NGW, cW, cK, cP, cN, cT, cR, cL); P0_LOAD(tv, cW, cP, cN, cL); }
        LDS_WAIT(); asm volatile("" ::: "memory");
        const int c = lane_ & 7;
#pragma unroll
        for (int j = 0; j < 4; ++j) { const int n = (lane_ >> 3) + 8 * j; const LAS float* s = scr + (8 * c) * 33 + n;
            v4u o; o.x = pk2(s[0 * 33], s[1 * 33]); o.y = pk2(s[2 * 33], s[3 * 33]); o.z = pk2(s[4 * 33], s[5 * 33]); o.w = pk2(s[6 * 33], s[7 * 33]);
            *(GAS v4u*)(WT + (size_t)(roff + n0 + n) * K + k0 + 8 * c) = o; }
        LDS_WAIT(); asm volatile("" ::: "memory");
    }
#undef P0_DECODE
#undef P0_LOAD
}

__device__ __forceinline__ void p1_rows(f32x4 (&v)[2][4], int mb, int lane_, const f32x4 (&gm)[4], const f32x4 (&sh)[4], bf16* H, const LAS float* w8, float* bg, const float* a_log, const float* dt_bias) {
            float ss[2];
#pragma unroll
            for (int r = 0; r < 2; ++r) { float s = 0.f;
#pragma unroll
                for (int j = 0; j < 4; ++j) s += (v[r][j].x * v[r][j].x + v[r][j].y * v[r][j].y) + (v[r][j].z * v[r][j].z + v[r][j].w * v[r][j].w);
                ss[r] = s; }
#pragma unroll
    for (int r = 0; r < 2; ++r) ss[r] = wave_sum(ss[r]);
            float dots[2][8];
#pragma unroll
            for (int r = 0; r < 2; ++r)
#pragma unroll
                for (int q = 0; q < 8; ++q) dots[r][q] = 0.f;
#pragma unroll
            for (int r = 0; r < 2; ++r) { const float rs = rsqrtf(ss[r] * (1.f / D) + EPS);
                GAS unsigned long long* o8 = (GAS unsigned long long*)(H + (size_t)(mb + r) * D) + lane_;
#pragma unroll
                for (int j = 0; j < 4; ++j) { v[r][j] = v[r][j] * rs * gm[j] + sh[j];
                    o8[64 * j] = (unsigned long long)pk2(v[r][j].x, v[r][j].y) | ((unsigned long long)pk2(v[r][j].z, v[r][j].w) << 32); } }
            asm volatile("" ::: "memory");
#pragma unroll
            for (int j = 0; j < 4; ++j)
#pragma unroll
                for (int q = 0; q < 8; ++q) { const f32x4 w = *(const LAS f32x4*)(w8 + q * 1024 + 4 * lane_ + 256 * j);
#pragma unroll
                    for (int r = 0; r < 2; ++r) dots[r][q] += (v[r][j].x * w.x + v[r][j].y * w.y) + (v[r][j].z * w.z + v[r][j].w * w.w); }
#pragma unroll
            for (int r = 0; r < 2; ++r)
#pragma unroll
                for (int q = 0; q < 8; ++q) dots[r][q] = wave_sum(dots[r][q]);
            if (lane_ < 16) {
                const int r = lane_ >> 3, q = lane_ & 7;
                float raw = 0.f;
#pragma unroll
                for (int rr = 0; rr < 2; ++rr)
#pragma unroll
                    for (int qq = 0; qq < 8; ++qq) raw = (r == rr && q == qq) ? dots[rr][qq] : raw;
                float o;
                if (q < 4) o = sigmoidf(raw);
                else { const int hh = q - 4; const float xr2 = raw + dt_bias[hh]; const float sp = xr2 > 20.f ? xr2 : log1pf(expf(xr2)); o = -expf(a_log[hh]) * sp; }
                bg[(size_t)(mb + r) * 8 + q] = o;
            }
}
__device__ __forceinline__ void p1_phase(Frame& F, unsigned char* ws, const float* x, const float* norm_mix, const float* w_in, const float* a_log, const float* dt_bias) {
    const int lane_ = pg8::lane_now(), tid_ = F.wave * 64 + lane_;
    const float* mod = (const float*)(ws + WS_MOD); float* bg = (float*)(ws + WS_BG); bf16* H = (bf16*)(ws + WS_H);
    LAS float* w8 = (LAS float*)(F.lds + RING_OFF);
    for (int i = tid_; i < 8 * 1024; i += NWAVES * 64) { const int j = i >> 10, k = i & 1023; w8[i] = w_in[(size_t)k * IN_COLS + 2048 + j]; }
    __syncthreads();
    for (int tl = F.vcu * NWAVES + F.wave; tl < T / 16; tl += F.G * NWAVES) {
        const int m0 = tl * 16, bb = m0 >> 12;
        f32x4 gm[4], sh[4];
#pragma unroll
        for (int j = 0; j < 4; ++j) { const f32x4 g = ((const GAS f32x4*)norm_mix)[lane_ + 64 * j]; const f32x4 sc = ((const GAS f32x4*)(mod + bb * 6144 + 1024))[lane_ + 64 * j];
            sh[j] = ((const GAS f32x4*)(mod + bb * 6144))[lane_ + 64 * j]; gm[j] = g * (sc + 1.f); }
        f32x4 vA[2][4], vB[2][4], vC[2][4];
#define P1_LOAD(dst, mb_) do { _Pragma("unroll") for (int r = 0; r < 2; ++r) { const GAS f32x4* xr = (const GAS f32x4*)(x + (size_t)((mb_) + r) * D) + lane_; \
            _Pragma("unroll") for (int j = 0; j < 4; ++j) dst[r][j] = xr[64 * j]; } } while (0)
        P1_LOAD(vA, m0); P1_LOAD(vB, m0 + 2);
        P1_LOAD(vC, m0 + 4);  p1_rows(vA, m0, lane_, gm, sh, H, w8, bg, a_log, dt_bias);
        P1_LOAD(vA, m0 + 6);  p1_rows(vB, m0 + 2, lane_, gm, sh, H, w8, bg, a_log, dt_bias);
        P1_LOAD(vB, m0 + 8);  p1_rows(vC, m0 + 4, lane_, gm, sh, H, w8, bg, a_log, dt_bias);
        P1_LOAD(vC, m0 + 10); p1_rows(vA, m0 + 6, lane_, gm, sh, H, w8, bg, a_log, dt_bias);
        P1_LOAD(vA, m0 + 12); p1_rows(vB, m0 + 8, lane_, gm, sh, H, w8, bg, a_log, dt_bias);
        P1_LOAD(vB, m0 + 14); p1_rows(vC, m0 + 10, lane_, gm, sh, H, w8, bg, a_log, dt_bias);
        p1_rows(vA, m0 + 12, lane_, gm, sh, H, w8, bg, a_log, dt_bias);
        p1_rows(vB, m0 + 14, lane_, gm, sh, H, w8, bg, a_log, dt_bias);
#undef P1_LOAD
    }
}


__device__ __forceinline__ f32x4 bf4_to_f32(unsigned long long a) { f32x4 y; y.x = __uint_as_float((unsigned)(a & 0xFFFFu) << 16); y.y = __uint_as_float((unsigned)(a >> 16) << 16); y.z = __uint_as_float((unsigned)((a >> 32) & 0xFFFFu) << 16); y.w = __uint_as_float((unsigned)(a >> 48) << 16); return y; }
__device__ __forceinline__ void p7_rows(const unsigned long long (&raw)[2][4], int mb, int lane_, const f32x4 (&gm)[4], const f32x4 (&sh)[4], bf16* H) {
    float ss[2]; f32x4 v[2][4];
#pragma unroll
    for (int r = 0; r < 2; ++r)
#pragma unroll
        for (int j = 0; j < 4; ++j) v[r][j] = bf4_to_f32(raw[r][j]);
#pragma unroll
    for (int r = 0; r < 2; ++r) { float s = 0.f;
#pragma unroll
        for (int j = 0; j < 4; ++j) s += (v[r][j].x * v[r][j].x + v[r][j].y * v[r][j].y) + (v[r][j].z * v[r][j].z + v[r][j].w * v[r][j].w);
        ss[r] = s; }
#pragma unroll
    for (int r = 0; r < 2; ++r) ss[r] = wave_sum(ss[r]);
#pragma unroll
    for (int r = 0; r < 2; ++r) { const float rs = rsqrtf(ss[r] * (1.f / D) + EPS);
        GAS unsigned long long* o8 = (GAS unsigned long long*)(H + (size_t)(mb + r) * D) + lane_;
#pragma unroll
        for (int j = 0; j < 4; ++j) { const f32x4 h = v[r][j] * rs * gm[j] + sh[j];
            o8[64 * j] = (unsigned long long)pk2(h.x, h.y) | ((unsigned long long)pk2(h.z, h.w) << 32); } }
}
#if MK_PROF_A >= 110 && MK_PROF_A < 120
#define PROF7(idx) do { if (blockIdx.x == 0 && F.wave == 0 && pg8::lane_now() == 0) { const unsigned long long t_ = __builtin_amdgcn_s_memrealtime(); \
        const unsigned long long p_ = ((unsigned long long)F.MISC[23] << 32) | F.MISC[22]; if ((idx) >= 0) F.MISC[24 + (idx)] = __float_as_uint(__uint_as_float(F.MISC[24 + (idx)]) + (float)(t_ - p_) * 0.01f); \
        F.MISC[22] = (unsigned)t_; F.MISC[23] = (unsigned)(t_ >> 32); } } while (0)
#else
#define PROF7(idx) do {} while (0)
#endif
__device__ __forceinline__ void p5_phase(Frame& F, unsigned char* ws, const bf16* xmid, const float* norm_ffn) {
    const int lane_ = pg8::lane_now(), tid_ = F.wave * 64 + lane_;
    const float* mod = (const float*)(ws + WS_MOD); bf16* H = (bf16*)(ws + WS_H); const bf16* wrt = (const bf16*)(ws + WS_WRT);
    int* ltok = (int*)(ws + WS_LTOK); float* lw = (float*)(ws + WS_LW); int* tokslot = (int*)(ws + WS_TOKSLOT);
    gu32* gcnt = F.ctl + CW_CNT;
    LAS float* lg = (LAS float*)(F.lds + RING_OFF) + F.wave * (16 * 48);
    LAS unsigned* lcnt = (LAS unsigned*)(F.lds + RING_OFF + 32768);
    LAS unsigned* gbase = lcnt + 32;
    constexpr int NT = T / 16;
    LAS unsigned char* wrtL = F.lds + RING_OFF + 40960;
    for (int i = tid_; i < 48 * 128; i += NWAVES * 64) { const int row = i >> 7, p = i & 127;
        *(LAS v4u*)(wrtL + row * 2048 + ((p ^ (row & 7)) << 4)) = *(const GAS v4u*)(wrt + (size_t)row * D + 8 * p); }
    for (int tl0 = F.vcu * NWAVES; tl0 < NT; tl0 += F.G * NWAVES) {
        const int tl = tl0 + F.wave; const bool active = tl < NT; const int m0 = tl * 16;
        if (tid_ < 32) lcnt[tid_] = 0u;
        __syncthreads(); PROF7(-1);
        int e1 = 0, e2 = 0, ls1 = 0, ls2 = 0; float w1 = 0.f, w2 = 0.f;
        if (active) {
            {
                const int bb = m0 >> 12;
                f32x4 gm[4], sh[4];
#pragma unroll
                for (int j = 0; j < 4; ++j) { const f32x4 g = ((const GAS f32x4*)norm_ffn)[lane_ + 64 * j]; const f32x4 sc = ((const GAS f32x4*)(mod + bb * 6144 + 4096))[lane_ + 64 * j];
                    sh[j] = ((const GAS f32x4*)(mod + bb * 6144 + 3072))[lane_ + 64 * j]; gm[j] = g * (sc + 1.f); }
                unsigned long long vA[2][4], vB[2][4], vC[2][4], vD[2][4];
#define P7_LOAD(dst, mb_) do { _Pragma("unroll") for (int r = 0; r < 2; ++r) { const GAS unsigned long long* xr = (const GAS unsigned long long*)(xmid + (size_t)((mb_) + r) * D) + lane_; \
                    _Pragma("unroll") for (int j = 0; j < 4; ++j) dst[r][j] = xr[64 * j]; } } while (0)
                P7_LOAD(vA, m0); P7_LOAD(vB, m0 + 2); P7_LOAD(vC, m0 + 4);
#pragma unroll 1
                for (int gp = 0; gp < 2; ++gp) {
                    P7_LOAD(vD, m0 + 8 * gp + 6);
                    p7_rows(vA, m0 + 8 * gp, lane_, gm, sh, H);
                    if (gp < 1) P7_LOAD(vA, m0 + 8);
                    p7_rows(vB, m0 + 8 * gp + 2, lane_, gm, sh, H);
                    if (gp < 1) P7_LOAD(vB, m0 + 10);
                    p7_rows(vC, m0 + 8 * gp + 4, lane_, gm, sh, H);
                    if (gp < 1) P7_LOAD(vC, m0 + 12);
                    p7_rows(vD, m0 + 8 * gp + 6, lane_, gm, sh, H);
                }
#undef P7_LOAD
            }
            PROF7(0);
            __threadfence_block();
            asm volatile("s_waitcnt vmcnt(0)" ::: "memory");
            f32x4 acc0 = {0.f, 0.f, 0.f, 0.f}, acc1 = acc0, acc2 = acc0;
            const bf16* ap = H + (size_t)(m0 + (lane_ & 15)) * D + 8 * (lane_ >> 4);
            const LAS unsigned char* bp = wrtL + (lane_ & 15) * 2048; const int bg_ = lane_ >> 4, bx_ = lane_ & 7;
#pragma unroll 16
            for (int sI = 0; sI < 32; ++sI) {
                const bf16x8 av = *(const GAS bf16x8*)(ap + 32 * sI);
                const int po = ((4 * sI + bg_) ^ bx_) << 4;
                const bf16x8 b0 = *(const LAS bf16x8*)(bp + po), b1 = *(const LAS bf16x8*)(bp + 16 * 2048 + po), b2 = *(const LAS bf16x8*)(bp + 32 * 2048 + po);
                acc0 = __builtin_amdgcn_mfma_f32_16x16x32_bf16(av, b0, acc0, 0, 0, 0);
                acc1 = __builtin_amdgcn_mfma_f32_16x16x32_bf16(av, b1, acc1, 0, 0, 0);
                acc2 = __builtin_amdgcn_mfma_f32_16x16x32_bf16(av, b2, acc2, 0, 0, 0);
            }
            PROF7(1);
#pragma unroll
            for (int rg = 0; rg < 4; ++rg) { const int row = 4 * (lane_ >> 4) + rg;
                lg[row * 48 + (lane_ & 15)] = acc0[rg]; lg[row * 48 + 16 + (lane_ & 15)] = acc1[rg]; lg[row * 48 + 32 + (lane_ & 15)] = acc2[rg]; }
            LDS_WAIT(); asm volatile("" ::: "memory");
            if (lane_ < 16) {
                const LAS float* l = lg + lane_ * 48;
                float gmax = l[0]; int gi = 0;
#pragma unroll
                for (int i = 1; i < 4; ++i) { const float v = l[i]; if (v > gmax) { gmax = v; gi = i; } }
                float gs = 0.f;
#pragma unroll
                for (int i = 0; i < 4; ++i) gs += __expf(l[i] - gmax);
                const float gprob = 1.f / gs;
                float a1 = -1e30f, a2 = -1e30f; int i1 = 0, i2 = 0;
#pragma unroll
                for (int i = 0; i < 8; ++i) { const float v = l[4 + gi * 8 + i]; if (v > a1) { a2 = a1; i2 = i1; a1 = v; i1 = i; } else if (v > a2) { a2 = v; i2 = i; } }
                const float p2 = __expf(a2 - a1);
                w1 = gprob / (1.f + p2); w2 = gprob * p2 / (1.f + p2);
                e1 = gi * 8 + i1; e2 = gi * 8 + i2;
                ls1 = (int)atomicAdd((unsigned*)&lcnt[e1], 1u); ls2 = (int)atomicAdd((unsigned*)&lcnt[e2], 1u);
            }
        }
        __syncthreads(); PROF7(2);
        if (tid_ < 32) gbase[tid_] = __hip_atomic_fetch_add(gcnt + tid_, lcnt[tid_], __ATOMIC_RELAXED, __HIP_MEMORY_SCOPE_AGENT);
        __syncthreads(); PROF7(3);
        if (active && lane_ < 16) {
            const int m = m0 + lane_; const int s1 = (int)gbase[e1] + ls1, s2 = (int)gbase[e2] + ls2;
            ltok[(size_t)e1 * CAP + s1] = m; lw[(size_t)e1 * CAP + s1] = w1;
            ltok[(size_t)e2 * CAP + s2] = m; lw[(size_t)e2 * CAP + s2] = w2;
            tokslot[2 * m] = (e1 << 20) | s1; tokslot[2 * m + 1] = (e2 << 20) | s2;
        }
        PROF7(4);
    }
}

__device__ __forceinline__ void moe_setup(Frame& F) {
    const int lane_ = pg8::lane_now(), tid_ = F.wave * 64 + lane_;
    LAS int* tpre = (LAS int*)(F.lds + MOE_OFF); LAS int* cn = tpre + 33;
    if (tid_ == 0) { int acc = 0;
        for (int e = 0; e < 32; ++e) { const int c = (int)__hip_atomic_load(F.ctl + CW_CNT + e, RLX_AGENT); cn[e] = c; tpre[e] = acc; acc += (c + 255) >> 8; }
        tpre[32] = acc; }
    __syncthreads();
}

__device__ __forceinline__ void p10_rows(const unsigned long long (&xraw)[2][4], const unsigned long long (&ya)[2][4], const unsigned long long (&yb)[2][4], int mb, int lane_, const f32x4 (&gt)[4], const f32x4 (&nf)[4], float* xo) {
    float ss[2]; f32x4 v[2][4];
#pragma unroll
    for (int r = 0; r < 2; ++r)
#pragma unroll
        for (int j = 0; j < 4; ++j) v[r][j] = bf4_to_f32(xraw[r][j]);
#pragma unroll
    for (int r = 0; r < 2; ++r) { float s = 0.f;
#pragma unroll
        for (int j = 0; j < 4; ++j) { const unsigned long long a = ya[r][j], b = yb[r][j]; f32x4 y;
            y.x = __uint_as_float((unsigned)(a & 0xFFFFu) << 16) + __uint_as_float((unsigned)(b & 0xFFFFu) << 16);
            y.y = __uint_as_float((unsigned)(a >> 16) << 16) + __uint_as_float((unsigned)(b >> 16) << 16);
            y.z = __uint_as_float((unsigned)((a >> 32) & 0xFFFFu) << 16) + __uint_as_float((unsigned)((b >> 32) & 0xFFFFu) << 16);
            y.w = __uint_as_float((unsigned)(a >> 48) << 16) + __uint_as_float((unsigned)(b >> 48) << 16);
            v[r][j] = v[r][j] + gt[j] * y;
            s += (v[r][j].x * v[r][j].x + v[r][j].y * v[r][j].y) + (v[r][j].z * v[r][j].z + v[r][j].w * v[r][j].w); }
        ss[r] = s; }
#pragma unroll
    for (int r = 0; r < 2; ++r) ss[r] = wave_sum(ss[r]);
#pragma unroll
    for (int r = 0; r < 2; ++r) { const float rs = rsqrtf(ss[r] * (1.f / D) + EPS);
        GAS f32x4* xr = (GAS f32x4*)(xo + (size_t)(mb + r) * D) + lane_;
#pragma unroll
        for (int j = 0; j < 4; ++j) xr[64 * j] = v[r][j] * rs * nf[j]; }
}
__device__ __forceinline__ void p8_phase(Frame& F, unsigned char* ws, float* xo, const float* norm_final) {
    const bf16* xm = (const bf16*)(ws + WS_XM);
    const int lane_ = pg8::lane_now();
    const float* mod = (const float*)(ws + WS_MOD); const int* tokslot = (const int*)(ws + WS_TOKSLOT); const bf16* ys = (const bf16*)(ws + WS_YS);
    const LAS int* tpre = (const LAS int*)(F.lds + MOE_OFF);
    f32x4 nf[4];
#pragma unroll
    for (int j = 0; j < 4; ++j) nf[j] = ((const GAS f32x4*)norm_final)[lane_ + 64 * j];
    for (int tl = F.vcu * NWAVES + F.wave; tl < T / 16; tl += F.G * NWAVES) {
        const int m0 = tl * 16, bb = m0 >> 12;
        int myrow = 0;
        if (lane_ < 32) { const int t = tokslot[2 * m0 + lane_]; myrow = tpre[t >> 20] * 256 + (t & 0xFFFFF); }
        f32x4 gt[4];
#pragma unroll
        for (int j = 0; j < 4; ++j) gt[j] = ((const GAS f32x4*)(mod + bb * 6144 + 5120))[lane_ + 64 * j];
        unsigned long long vA[2][4], vB[2][4], yaA[2][4], ybA[2][4], yaB[2][4], ybB[2][4];
#define P10_LOAD(dv, da, db, g_) do { _Pragma("unroll") for (int r = 0; r < 2; ++r) { \
            const size_t r0 = (size_t)__shfl(myrow, 2 * (2 * (g_) + r)), r1 = (size_t)__shfl(myrow, 2 * (2 * (g_) + r) + 1); \
            const GAS unsigned long long* xr = (const GAS unsigned long long*)(xm + (size_t)(m0 + 2 * (g_) + r) * D) + lane_; \
            const GAS unsigned long long* y0 = (const GAS unsigned long long*)(ys + r0 * D) + lane_; const GAS unsigned long long* y1 = (const GAS unsigned long long*)(ys + r1 * D) + lane_; \
            _Pragma("unroll") for (int j = 0; j < 4; ++j) { dv[r][j] = xr[64 * j]; da[r][j] = y0[64 * j]; db[r][j] = y1[64 * j]; } } } while (0)
        P10_LOAD(vA, yaA, ybA, 0);
#pragma unroll 1
        for (int gp = 0; gp < 4; ++gp) {
            P10_LOAD(vB, yaB, ybB, 2 * gp + 1);
            p10_rows(vA, yaA, ybA, m0 + 4 * gp, lane_, gt, nf, xo);
            if (gp < 3) P10_LOAD(vA, yaA, ybA, 2 * gp + 2);
            p10_rows(vB, yaB, ybB, m0 + 4 * gp + 2, lane_, gt, nf, xo);
        }
#undef P10_LOAD
    }
}

#if MK_PROF_A >= 200
#define PROFA(idx) do { if (blockIdx.x == 32 && wid_ == 0 && lane == 0) { const unsigned long long t_ = __builtin_amdgcn_s_memrealtime(); \
        const unsigned long long p_ = ((unsigned long long)misc_[23] << 32) | misc_[22]; if ((idx) >= 0) misc_[24 + (idx)] = __float_as_uint(__uint_as_float(misc_[24 + (idx)]) + (float)(t_ - p_) * 0.01f); \
        misc_[22] = (unsigned)t_; misc_[23] = (unsigned)(t_ >> 32); } } while (0)
#else
#define PROFA(idx) do {} while (0)
#endif
#ifndef ATT_NPF
#define ATT_NPF 2
#endif
namespace att {
typedef short bf16x8 __attribute__((ext_vector_type(8)));
typedef short s16x4 __attribute__((ext_vector_type(4)));
typedef float f32x16 __attribute__((ext_vector_type(16)));
typedef unsigned u32x4 __attribute__((ext_vector_type(4)));
constexpr int TBL_N = 192;
constexpr int LDS_TBL = 0;
constexpr int LDS_WAVE = 18432;
constexpr int WAVE_BYTES = 8448;
constexpr float LOG2E = 1.4426950408889634f;
__device__ __forceinline__ int crow(int r, int hi) { return (r & 3) + 8 * (r >> 2) + 4 * hi; }
__device__ __forceinline__ unsigned cvtpk(float lo, float hi) { typedef float f32x2_t_ __attribute__((ext_vector_type(2))); typedef __bf16 bf16x2_t_ __attribute__((ext_vector_type(2))); const f32x2_t_ v_ = {lo, hi}; return __builtin_bit_cast(unsigned, __builtin_convertvector(v_, bf16x2_t_)); }
__device__ __forceinline__ s16x4 vtr(const LAS unsigned char* p) { typedef short v4i16_t __attribute__((ext_vector_type(4)));
    return __builtin_bit_cast(s16x4, __builtin_amdgcn_ds_read_tr16_b64_v4i16((LAS v4i16_t*)p)); }

__device__ __forceinline__ void build_tables(LAS float* tbl, const float* rel_bias, int tid) {
    for (int i = tid; i < 24 * TBL_N; i += NWAVES * 64) {
        const int bh = i / TBL_N, u = i % TBL_N, br = bh >> 3, h = bh & 7, delta = 159 - u, dil = br == 0 ? 1 : (br == 1 ? 4 : 16);
        float v = -1e30f;
        if (delta >= 0 && delta <= 128) { const int dist = delta * dil; int bucket;
            if (dist < 16) bucket = dist; else { const double vv = log((double)dist / 16.0) / log(128.0) * 16.0; const int l = 16 + (int)vv; bucket = l < 31 ? l : 31; }
            v = rel_bias[bucket * 8 + h] * LOG2E; }
        tbl[i] = v;
    }
}
__device__ __forceinline__ void build_tables_max(LAS float* tbl, int tid) {
    if (tid < 24) { float mx = -1e30f; for (int u = 31; u <= 159; ++u) mx = fmaxf(mx, tbl[tid * TBL_N + u]); tbl[tid * TBL_N + TBL_N - 1] = mx; }
}

struct TileP { int rowbase, h, dil, r, I0; };
__device__ __forceinline__ unsigned lane_kofs(int dil, int lane) { return (unsigned)((lane & 31) * dil * 128 + (lane >> 5) * 16); }
__device__ __forceinline__ unsigned lane_vofs(int dil, int lane) { return (unsigned)((lane >> 3) * dil * 128 + (lane & 7) * 16); }
__device__ __forceinline__ const GAS unsigned char* tile_row(const void* B, const TileP& t, int J) {
    const long tok = (long)(t.rowbase * 8 + t.h * 4096) + t.r + (long)t.dil * J; return (const GAS unsigned char*)B + tok * 128; }
__device__ __forceinline__ unsigned lane_pofs(int dil, int lane) { return (unsigned)((lane >> 3) * dil * 1024 + (lane & 7) * 16); }
__device__ __forceinline__ void load_q(const bf16* QB, const TileP& t, unsigned kofs, bf16x8 (&qf)[4]) {
    const GAS unsigned char* b = tile_row(QB, t, t.I0);
#pragma unroll
    for (int s = 0; s < 4; ++s) qf[s] = *(const GAS bf16x8*)(b + kofs + 32 * s);
}
__device__ __forceinline__ void load_k(const bf16* KB, const TileP& t, unsigned kofs, int kt, bf16x8 (&kfk)[4]) {
    const GAS unsigned char* b = tile_row(KB, t, t.I0 - 128 + 32 * kt);
#pragma unroll
    for (int s = 0; s < 4; ++s) kfk[s] = *(const GAS bf16x8*)(b + kofs + 32 * s);
}
__device__ __forceinline__ void load_v(const bf16* VB, const TileP& t, unsigned vofs, int kt, u32x4 (&vv)[4]) {
#pragma unroll
    for (int ii = 0; ii < 4; ++ii) vv[ii] = *(const GAS u32x4*)(tile_row(VB, t, t.I0 - 128 + 32 * kt + 8 * ii) + vofs);
}
__device__ __forceinline__ void wave_tile(const bf16* QB, const bf16* KB, const bf16* VB, bf16* part, float* lse, const LAS float* tb, LAS unsigned char* wl,
                                          const TileP& tc, bool has_next, const TileP& tn, int lane, volatile LAS unsigned* misc_, int wid_,
                                          bf16x8 (&qf)[4], bf16x8 (&qn)[4], bf16x8 (&ks0)[4], u32x4 (&vx)[4], u32x4 (&vy)[4]) {
    const int h = tc.h, I0 = tc.I0;
    const int i = lane & 31, h2 = lane >> 5;
    PROFA(-1);
    LAS unsigned char* vt = wl; LAS unsigned char* ost = wl + 4096;
    const bool needmask = I0 < 128;
    const LAS float* tbase = tb + (31 - i + 4 * h2);
    const int vrow_l = lane >> 3, vch = lane & 7;
    const LAS unsigned char* vrd = vt + ((lane >> 4) & 1) * 32 + (lane & 3) * 8 + (4 * h2 + ((lane & 15) >> 2)) * 64;
    const unsigned kofs = lane_kofs(tc.dil, lane), vofs = lane_vofs(tc.dil, lane);
    bf16x8 ks1[4], ks2[4], ks3[4], ks4[4];
    load_k(KB, tc, kofs, 3, ks1);
    float m = 0.f, l = 0.f;
    f32x16 o0 = {0.f, 0.f, 0.f, 0.f, 0.f, 0.f, 0.f, 0.f, 0.f, 0.f, 0.f, 0.f, 0.f, 0.f, 0.f, 0.f}, o1 = o0;
#define ATT_STEP(j_, KF_, VV_, PRE_) do { constexpr int kt = 4 - (j_); \
        _Pragma("unroll") for (int ii = 0; ii < 4; ++ii) *(LAS u32x4*)(vt + (vch >> 2) * 2048 + (vrow_l + 8 * ii) * 64 + (vch & 3) * 16) = VV_[ii]; \
        if ((j_) < 3) load_v(VB, tc, vofs, kt - 2, VV_); else if (has_next) load_v(VB, tn, lane_vofs(tn.dil, lane), 7 - (j_), VV_);     \
        f32x16 acc; \
        if ((j_) == 0) { _Pragma("unroll") for (int rr = 0; rr < 16; ++rr) acc[rr] = 0.f; } else { _Pragma("unroll") for (int rr = 0; rr < 16; ++rr) acc[rr] = -m; } \
        _Pragma("unroll") for (int s = 0; s < 4; ++s) acc = __builtin_amdgcn_mfma_f32_32x32x16_bf16(KF_[s], qf[s], acc, 0, 0, 0); \
        PRE_; \
        if ((j_) == 0) { float mx = acc[0]; _Pragma("unroll") for (int rr = 1; rr < 16; ++rr) mx = fmaxf(mx, acc[rr]); \
            { float w_ = mx; asm volatile("" : "+v"(w_)); auto rx = __builtin_amdgcn_permlane32_swap(__float_as_uint(mx), __float_as_uint(w_), false, false); mx = fmaxf(__uint_as_float(rx[0]), __uint_as_float(rx[1])); } \
            m = mx + tb[att::TBL_N - 1]; _Pragma("unroll") for (int rr = 0; rr < 16; ++rr) acc[rr] -= m; } \
        if (needmask) {                                       \
            const int jlim = 128 - 32 * kt - I0 - 4 * h2; asm volatile("" ::: "memory"); \
            _Pragma("unroll") for (int rr = 0; rr < 16; ++rr) { const int kk = (rr & 3) + 8 * (rr >> 2); if (kk < jlim) acc[rr] = -1e30f; } } \
        float p[16]; \
        _Pragma("unroll") for (int rr = 0; rr < 16; ++rr) { const int kk = (rr & 3) + 8 * (rr >> 2); \
            p[rr] = __builtin_amdgcn_exp2f(acc[rr] + tbase[32 * kt + kk]); l += p[rr]; } \
        u32x4 pw0, pw1; \
        pw0.x = cvtpk(p[0], p[1]); pw0.y = cvtpk(p[2], p[3]); pw0.z = cvtpk(p[4], p[5]); pw0.w = cvtpk(p[6], p[7]); \
        pw1.x = cvtpk(p[8], p[9]); pw1.y = cvtpk(p[10], p[11]); pw1.z = cvtpk(p[12], p[13]); pw1.w = cvtpk(p[14], p[15]); \
        const bf16x8 pa0 = __builtin_bit_cast(bf16x8, pw0), pa1 = __builtin_bit_cast(bf16x8, pw1); \
        asm volatile("s_waitcnt lgkmcnt(0)" ::: "memory"); \
        _Pragma("unroll") for (int db = 0; db < 2; ++db) { \
            const s16x4 a0 = vtr(vrd + db * 2048), a1 = vtr(vrd + db * 2048 + 512), b0 = vtr(vrd + db * 2048 + 1024), b1 = vtr(vrd + db * 2048 + 1536); \
            const bf16x8 v0 = (bf16x8){a0[0], a0[1], a0[2], a0[3], a1[0], a1[1], a1[2], a1[3]}, v1 = (bf16x8){b0[0], b0[1], b0[2], b0[3], b1[0], b1[1], b1[2], b1[3]}; \
            if (db == 0) { o0 = __builtin_amdgcn_mfma_f32_32x32x16_bf16(v0, pa0, o0, 0, 0, 0); o0 = __builtin_amdgcn_mfma_f32_32x32x16_bf16(v1, pa1, o0, 0, 0, 0); } \
            else         { o1 = __builtin_amdgcn_mfma_f32_32x32x16_bf16(v0, pa0, o1, 0, 0, 0); o1 = __builtin_amdgcn_mfma_f32_32x32x16_bf16(v1, pa1, o1, 0, 0, 0); } } \
        asm volatile("s_waitcnt lgkmcnt(0)" ::: "memory"); } while (0)
    ATT_STEP(0, ks0, vx, load_k(KB, tc, kofs, 2, ks2));
    PROFA(0);
    ATT_STEP(1, ks1, vy, load_k(KB, tc, kofs, 1, ks3));
    ATT_STEP(2, ks2, vx, { load_k(KB, tc, kofs, 0, ks4); if (has_next) load_q(QB, tn, lane_kofs(tn.dil, lane), qn); });
    ATT_STEP(3, ks3, vy, if (has_next) load_k(KB, tn, lane_kofs(tn.dil, lane), 4, ks0));
    ATT_STEP(4, ks4, vx, (void)0);
#undef ATT_STEP
    PROFA(1);
    { float w_ = l; asm volatile("" : "+v"(w_)); auto rr = __builtin_amdgcn_permlane32_swap(__float_as_uint(l), __float_as_uint(w_), false, false); l = __uint_as_float(rr[0]) + __uint_as_float(rr[1]); }
    const float il = 1.f / l;
    if (h2 == 0) *(GAS float*)((GAS unsigned char*)lse + ((long)tc.rowbase + tc.r + (long)tc.dil * I0) * 32 + h * 4 + (size_t)(i * tc.dil * 32)) = m + __log2f(l);
#pragma unroll
    for (int qd = 0; qd < 4; ++qd) { typedef unsigned u32x2_ __attribute__((ext_vector_type(2)));
        LAS unsigned char* wp = ost + i * 128 + h2 * 8;
        *(LAS u32x2_*)(wp + ((qd ^ (i & 7)) << 4)) = (u32x2_){cvtpk(o0[4 * qd] * il, o0[4 * qd + 1] * il), cvtpk(o0[4 * qd + 2] * il, o0[4 * qd + 3] * il)};
        *(LAS u32x2_*)(wp + (((qd + 4) ^ (i & 7)) << 4)) = (u32x2_){cvtpk(o1[4 * qd] * il, o1[4 * qd + 1] * il), cvtpk(o1[4 * qd + 2] * il, o1[4 * qd + 3] * il)}; }
    asm volatile("s_waitcnt lgkmcnt(0)" ::: "memory");
    { GAS unsigned char* pb = (GAS unsigned char*)part + ((long)tc.rowbase + tc.r + (long)tc.dil * I0) * 1024 + h * 128; const unsigned pofs = lane_pofs(tc.dil, lane);
#pragma unroll
      for (int ii = 0; ii < 4; ++ii) { const int row = ii * 8 + vrow_l;
        const u32x4 v = *(const LAS u32x4*)(ost + row * 128 + ((vch ^ (row & 7)) << 4));
        *(GAS u32x4*)(pb + (size_t)(ii * 8 * tc.dil) * 1024 + pofs) = v; } }
    asm volatile("s_waitcnt lgkmcnt(0)" ::: "memory");
    PROFA(2);
}
}

struct AttTile { int br, h, b, dil, r, I0; };
__device__ __forceinline__ AttTile att_tile(int u, int wt) {
    AttTile t; t.h = u / 192; const int nu = u % 192; t.br = nu % 3; const int bb = nu / 3; t.b = bb >> 3; const int blk = bb & 7;
    t.dil = t.br == 0 ? 1 : (t.br == 1 ? 4 : 16);
    if (t.br == 0) { t.r = 0; t.I0 = blk * 512 + 32 * wt; } else if (t.br == 1) { t.r = wt & 3; t.I0 = blk * 128 + 32 * (wt >> 2); } else { t.r = wt; t.I0 = blk * 32; }
    return t;
}
__device__ __forceinline__ unsigned att_draw_unit(gu32* qctr, volatile LAS unsigned* Q, unsigned x) {
    unsigned k = Q[1];
    while (k < 8u) { const unsigned y = (x + k) & 7u; const unsigned nu = __hip_atomic_fetch_add(qctr + 32 * y, 1u, __ATOMIC_RELAXED, __HIP_MEMORY_SCOPE_AGENT);
        if (nu < 192u) return y * 192u + nu;
        ++k; Q[1] = k; }
    return 1536u;
}
__device__ __forceinline__ void att_prefetch(const bf16* QB, const bf16* KB, const bf16* VB, const AttTile& t, int lane, unsigned (&pf)[6]) {
#pragma unroll
    for (int q = 0; q < 6; ++q) { const int xidx = lane + 64 * q; const bf16* base; int J;
        if (xidx < 32) { base = QB; J = t.I0 + xidx; } else if (xidx < 192) { base = KB; J = t.I0 - 128 + (xidx - 32); } else { base = VB; J = t.I0 - 128 + (xidx - 192); }
        if (J < 0) J = 0; if (xidx >= 352) J = t.I0;
        pf[q] = *(const GAS unsigned*)(base + ((size_t)t.b * SEQ + t.r + (size_t)t.dil * J) * 512 + 64 * t.h); }
}
__device__ __forceinline__ void attn_phase(Frame& F, unsigned char* ws, const float* rel_bias) {
    const int lane_ = pg8::lane_now(), tid_ = F.wave * 64 + lane_;
    LAS float* tbl = (LAS float*)(F.lds + RING_OFF + att::LDS_TBL);
    volatile LAS unsigned* Q = (volatile LAS unsigned*)(F.lds + LDSCTL_OFF);
    gu32* qctr = F.ctl + CW_ATTQ; const unsigned xq_ = xb_xcc_id() & 7u;
    if (tid_ < 32) Q[tid_] = 0u;
    att::build_tables(tbl, rel_bias, tid_);
    __syncthreads();
    att::build_tables_max(tbl, tid_);
    if (tid_ == 0) { Q[8] = att_draw_unit(qctr, Q, xq_); Q[9] = att_draw_unit(qctr, Q, xq_); Q[16] = 1u; Q[17] = 2u; }
    __syncthreads();
    const bf16* QB = (const bf16*)(ws + WS_QB); const bf16* KB = (const bf16*)(ws + WS_KB); const bf16* VB = (const bf16*)(ws + WS_VB);
    LAS unsigned char* wl = F.lds + RING_OFF + att::LDS_WAVE + F.wave * att::WAVE_BYTES;
#define ATT_DRAW(u_, wt_) do { unsigned g_ = 0u; if (pg8::lane_now() == 0) g_ = atomicAdd((unsigned*)&Q[0], 1u); g_ = (unsigned)__builtin_amdgcn_readfirstlane((int)g_); \
        const unsigned s_ = g_ >> 4; wt_ = (int)(g_ & 15u); \
        if (wt_ == 0 && pg8::lane_now() == 0) { const unsigned nu_ = att_draw_unit(qctr, Q, xq_); Q[8 + ((s_ + 2u) & 7u)] = nu_; \
            asm volatile("s_waitcnt lgkmcnt(0)" ::: "memory"); Q[16 + ((s_ + 2u) & 7u)] = s_ + 3u; } \
        while (Q[16 + (s_ & 7u)] != s_ + 1u) __builtin_amdgcn_s_sleep(1); \
        u_ = __builtin_amdgcn_readfirstlane((int)Q[8 + (s_ & 7u)]); } while (0)
#if MK_PROF_A >= 200
    const unsigned long long tph0_ = __builtin_amdgcn_s_memrealtime(); unsigned long long tdraw_ = 0; int ntile_ = 0;
#endif
    int u_cur, wt_cur, u_nxt, wt_nxt;
    ATT_DRAW(u_cur, wt_cur);
    att::bf16x8 qA[4], qB[4], ks0[4]; att::u32x4 vA[4], vB[4];
    if (u_cur < 1536) { const AttTile t0 = att_tile(u_cur, wt_cur); const att::TileP p0{t0.b * SEQ, t0.h, t0.dil, t0.r, t0.I0}; const int ln = pg8::lane_now();
        const unsigned ko = att::lane_kofs(p0.dil, ln), vo = att::lane_vofs(p0.dil, ln);
        att::load_q(QB, p0, ko, qA); att::load_k(KB, p0, ko, 4, ks0); att::load_v(VB, p0, vo, 4, vA); att::load_v(VB, p0, vo, 3, vB); }
#if MK_PROF_A >= 200
#define ATT_PROF_DRAW0() const unsigned long long td0_ = __builtin_amdgcn_s_memrealtime()
#define ATT_PROF_DRAW1() do { tdraw_ += __builtin_amdgcn_s_memrealtime() - td0_; ++ntile_; } while (0)
#else
#define ATT_PROF_DRAW0() do {} while (0)
#define ATT_PROF_DRAW1() do {} while (0)
#endif
#define ATT_ONE_TILE(QC_, QN_, VX_, VY_) do { \
        ATT_PROF_DRAW0(); \
        ATT_DRAW(u_nxt, wt_nxt);                               \
        ATT_PROF_DRAW1(); \
        const int ln = pg8::lane_now();                        \
        const AttTile t = att_tile(u_cur, wt_cur); \
        const bool has_next = u_nxt < 1536; \
        const AttTile tn = att_tile(has_next ? u_nxt : u_cur, has_next ? wt_nxt : wt_cur); \
        const att::TileP pc{t.b * SEQ, t.h, t.dil, t.r, t.I0}, pn{tn.b * SEQ, tn.h, tn.dil, tn.r, tn.I0}; \
        bf16* part = (bf16*)(ws + (t.br == 0 ? WS_PART0 : (t.br == 1 ? WS_PART1 : WS_PART2))); \
        float* lse = (float*)(ws + WS_LSE) + (size_t)t.br * T * 8; \
        att::wave_tile(QB, KB, VB, part, lse, tbl + (t.br * 8 + t.h) * att::TBL_N, wl, pc, has_next, pn, ln, F.MISC, F.wave, QC_, QN_, ks0, VX_, VY_); \
        u_cur = u_nxt; wt_cur = wt_nxt; } while (0)
    while (u_cur < 1536) {
        ATT_ONE_TILE(qA, qB, vA, vB);
        if (u_cur >= 1536) break;
        ATT_ONE_TILE(qB, qA, vB, vA);
    }
#undef ATT_ONE_TILE
#undef ATT_DRAW
#if MK_PROF_A >= 200
    if (pg8::lane_now() == 0) atomicMax((unsigned*)(F.ctl + CW_CNT + 70), (unsigned)(__builtin_amdgcn_s_memrealtime() - tph0_));
    if (blockIdx.x == 32 && tid_ == 0) { F.MISC[27] = __float_as_uint((float)(__builtin_amdgcn_s_memrealtime() - tph0_) * 0.01f); F.MISC[26] = __float_as_uint((float)ntile_ * 5.f); F.MISC[25] = __float_as_uint((float)tdraw_ * 0.01f); }
#endif
    __syncthreads();
}

__device__ __forceinline__ void attn_combine_phase(Frame& F, unsigned char* ws, const float* attn_norm) {
    const int lane_ = pg8::lane_now();
    const int gw = F.vcu * NWAVES + F.wave, NGW = F.G * NWAVES;
    const float* lse = (const float*)(ws + WS_LSE); bf16* Y = (bf16*)(ws + WS_Y);
    const bf16* p0 = (const bf16*)(ws + WS_PART0); const bf16* p1 = (const bf16*)(ws + WS_PART1); const bf16* p2 = (const bf16*)(ws + WS_PART2);
    const int h = lane_ >> 3;
    f32x4 an0 = ((const GAS f32x4*)attn_norm)[2 * lane_], an1 = ((const GAS f32x4*)attn_norm)[2 * lane_ + 1];
    for (int tl = gw; tl < T / 16; tl += NGW) {
#pragma unroll 1
        for (int g4 = 0; g4 < 4; ++g4) {
            const int mb = tl * 16 + 4 * g4;
            float l0[4], l1[4], l2[4]; v4u pa[4], pb[4], pc[4];
#pragma unroll
            for (int r = 0; r < 4; ++r) { const size_t m = (size_t)(mb + r);
                l0[r] = lse[m * 8 + h]; l1[r] = lse[(size_t)T * 8 + m * 8 + h]; l2[r] = lse[(size_t)2 * T * 8 + m * 8 + h];
                pa[r] = *(const GAS v4u*)(p0 + m * 512 + 8 * lane_); pb[r] = *(const GAS v4u*)(p1 + m * 512 + 8 * lane_); pc[r] = *(const GAS v4u*)(p2 + m * 512 + 8 * lane_); }
            float o[4][8], ss[4];
#pragma unroll
            for (int r = 0; r < 4; ++r) {
                const float mx = fmaxf(l0[r], fmaxf(l1[r], l2[r]));
                float w0 = __builtin_amdgcn_exp2f(l0[r] - mx), w1 = __builtin_amdgcn_exp2f(l1[r] - mx), w2 = __builtin_amdgcn_exp2f(l2[r] - mx);
                const float inv = 1.f / (w0 + w1 + w2); w0 *= inv; w1 *= inv; w2 *= inv;
                float s = 0.f;
#pragma unroll
                for (int q = 0; q < 4; ++q) { const unsigned ua = pa[r][q], ub = pb[r][q], uc = pc[r][q];
                    o[r][2 * q] = w0 * __uint_as_float(ua << 16) + w1 * __uint_as_float(ub << 16) + w2 * __uint_as_float(uc << 16);
                    o[r][2 * q + 1] = w0 * __uint_as_float(ua & 0xFFFF0000u) + w1 * __uint_as_float(ub & 0xFFFF0000u) + w2 * __uint_as_float(uc & 0xFFFF0000u);
                    s += o[r][2 * q] * o[r][2 * q] + o[r][2 * q + 1] * o[r][2 * q + 1]; }
                ss[r] = s; }
#pragma unroll
            for (int r = 0; r < 4; ++r) ss[r] = wave_sum(ss[r]);
#pragma unroll
            for (int r = 0; r < 4; ++r) { const float ra = rsqrtf(ss[r] * (1.f / 512.f) + EPS);
                v4u w;
                w.x = pk2(o[r][0] * ra * an0.x, o[r][1] * ra * an0.y); w.y = pk2(o[r][2] * ra * an0.z, o[r][3] * ra * an0.w);
                w.z = pk2(o[r][4] * ra * an1.x, o[r][5] * ra * an1.y); w.w = pk2(o[r][6] * ra * an1.z, o[r][7] * ra * an1.w);
                *(GAS v4u*)(Y + (size_t)(mb + r) * 1024 + 512 + 8 * lane_) = w; }
        }
    }
}
namespace gdn {
__device__ __forceinline__ float fsilu(float x) { return x * __builtin_amdgcn_rcpf(1.f + __builtin_amdgcn_exp2f(-1.4426950408889634f * x)); }
typedef short bf16x8 __attribute__((ext_vector_type(8)));
typedef short s16x4 __attribute__((ext_vector_type(4)));
typedef float f32x4 __attribute__((ext_vector_type(4)));
typedef float f32x16 __attribute__((ext_vector_type(16)));
typedef unsigned u32x4 __attribute__((ext_vector_type(4)));
typedef __bf16 bf16x2_t __attribute__((ext_vector_type(2)));
constexpr int NCH = 2048;
constexpr int SCAN_BYTES = 49152;
__device__ __forceinline__ int sigma_inv(int x) { return (x & ~31) | (((x >> 2) & 3) << 3) | (((x >> 4) & 1) << 2) | (x & 3); }
__device__ __forceinline__ int crow(int r, int hi) { return (r & 3) + 8 * (r >> 2) + 4 * hi; }
__device__ __forceinline__ unsigned cvtpk(float lo, float hi) { typedef float f32x2_t_ __attribute__((ext_vector_type(2))); typedef __bf16 bf16x2_t_ __attribute__((ext_vector_type(2))); const f32x2_t_ v_ = {lo, hi}; return __builtin_bit_cast(unsigned, __builtin_convertvector(v_, bf16x2_t_)); }
__device__ __forceinline__ float bflo(unsigned w) { return __uint_as_float(w << 16); }
__device__ __forceinline__ float bfhi(unsigned w) { return __uint_as_float(w & 0xFFFF0000u); }
__device__ __forceinline__ s16x4 vtr(const LAS unsigned char* p) { typedef short v4i16_t __attribute__((ext_vector_type(4)));
    return __builtin_bit_cast(s16x4, __builtin_amdgcn_ds_read_tr16_b64_v4i16((LAS v4i16_t*)p)); }
__device__ __forceinline__ int sw256(int row, int col) { return row * 256 + ((((col >> 3) ^ (row & 15)) << 4) | ((col & 7) << 1)); }
__device__ __forceinline__ int sw128(int row, int col) { return row * 128 + ((((col >> 3) ^ ((row >> 1) & 7)) << 4) | ((col & 7) << 1)); }

constexpr int L_QN = 0, L_KN = 16384, L_KGT = 32768, L_AQK = 49152, L_G = 57344  , L_A = 59392  , L_G8 = 124928  ;

#if MK_PROF_A >= 100 && MK_PROF_A < 110
#define PROFX(idx) do { if (blockIdx.x == 0 && F.wave == 0 && pg8::lane_now() == 0) { const unsigned long long t_ = __builtin_amdgcn_s_memrealtime(); \
        const unsigned long long p_ = ((unsigned long long)F.MISC[23] << 32) | F.MISC[22]; if ((idx) >= 0) F.MISC[24 + (idx)] = __float_as_uint(__uint_as_float(F.MISC[24 + (idx)]) + (float)(t_ - p_) * 0.01f); \
        F.MISC[22] = (unsigned)t_; F.MISC[23] = (unsigned)(t_ >> 32); } } while (0)
#else
#define PROFX(idx) do {} while (0)
#endif
__device__ __forceinline__ void a1_phase(Frame& F, unsigned char* ws, unsigned char* dout, const float* wconv) {
    const int w = F.wave;
    PROFX(-1);
    const bf16* qkva = (const bf16*)(ws + WS_QKVA); const float* bg = (const float*)(ws + WS_BG);
    unsigned char* scanops = dout; bf16* QGb = (bf16*)(dout + 96 * MiB); bf16* AQKb = (bf16*)(ws + WS_GAQK); float* GLb = (float*)(ws + WS_GGL);
    bf16* RS = (bf16*)(ws + WS_H);
    LAS unsigned char* L = F.lds + RING_OFF;
    for (int grp = F.vcu; grp < NCH / 8; grp += F.G) {
        {
            const int lane = pg8::lane_now(), ch = grp * 8 + w, n = ch & 63, bh = ch >> 6, h = bh & 3, b = bh >> 2;
            const size_t m0 = (size_t)b * SEQ + n * 64;
            LAS float* Gs = (LAS float*)(L + L_G8 + w * 1024);
            float gq = bg[(m0 + lane) * 8 + 4 + h]; const float be = bg[(m0 + lane) * 8 + h];
#pragma unroll
            for (int o = 1; o < 64; o <<= 1) { const float t = __shfl_up(gq, o); if (lane >= o) gq += t; }
            const float glast = __shfl(gq, 63);
            Gs[lane] = gq; Gs[64 + lane] = __expf(gq); Gs[128 + lane] = be; Gs[192 + lane] = __expf(glast - gq);
            if (lane == 0) GLb[ch] = __expf(glast);
        }
        unsigned rq[11], rk[11], rv[11];
#define A1_LOADRAW(ci_) do { const int ch_ = grp * 8 + (ci_), n_ = ch_ & 63, bh_ = ch_ >> 6, h_ = bh_ & 3, b_ = bh_ >> 2; const int ln_ = pg8::lane_now(); \
            _Pragma("unroll") for (int t = 0; t < 11; ++t) { const int tt = n_ * 64 + 8 * w - 3 + t; \
                if (tt >= 0) { const size_t m = ((size_t)(b_ * 4 + h_) * SEQ + tt) * 384 + 2 * ln_; rq[t] = *(const GAS unsigned*)(qkva + m); rk[t] = *(const GAS unsigned*)(qkva + m + 128); rv[t] = *(const GAS unsigned*)(qkva + m + 256); } \
                else { rq[t] = 0u; rk[t] = 0u; rv[t] = 0u; } } } while (0)
        A1_LOADRAW(0);
        float wq[4][2], wk[4][2], wv[4][2];
        { const int ln_ = pg8::lane_now(), cq = ((grp >> 3) & 3) * 128 + 2 * ln_, ck = 512 + cq, cv = 1024 + cq;
#pragma unroll
          for (int t = 0; t < 4; ++t) { wq[t][0] = wconv[t * 1536 + cq]; wq[t][1] = wconv[t * 1536 + cq + 1]; wk[t][0] = wconv[t * 1536 + ck]; wk[t][1] = wconv[t * 1536 + ck + 1];
              wv[t][0] = wconv[t * 1536 + cv]; wv[t][1] = wconv[t * 1536 + cv + 1]; } }
        for (int ci = 0; ci < 8; ++ci) {
            const int ch = grp * 8 + ci, n = ch & 63, bh = ch >> 6, h = bh & 3, b = bh >> 2;
            const int t0 = n * 64; const size_t m0 = (size_t)b * SEQ + t0;
            const int lane = pg8::lane_now(), tid = w * 64 + lane, i32 = lane & 31, h2 = lane >> 5;
            __syncthreads(); PROFX(0);
            LAS float* Gs = (LAS float*)(L + L_G8 + ci * 1024); LAS float* eG = Gs + 64; LAS float* bet = Gs + 128; LAS float* eGl = Gs + 192;
            {
                float kg0[8], kg1[8];
#pragma unroll
                for (int rr = 0; rr < 8; ++rr) {
                    const int c = 8 * w + rr;
                    unsigned xq[4], xk[4], xv[4];
#pragma unroll
                    for (int t = 0; t < 4; ++t) { xq[t] = rq[rr + t]; xk[t] = rk[rr + t]; xv[t] = rv[rr + t]; }
                    float q0 = 0.f, q1 = 0.f, k0 = 0.f, k1 = 0.f, v0 = 0.f, v1 = 0.f;
#pragma unroll
                    for (int t = 0; t < 4; ++t) { q0 += wq[t][0] * bflo(xq[t]); q1 += wq[t][1] * bfhi(xq[t]); k0 += wk[t][0] * bflo(xk[t]); k1 += wk[t][1] * bfhi(xk[t]);
                        v0 += wv[t][0] * bflo(xv[t]); v1 += wv[t][1] * bfhi(xv[t]); }
                    q0 = fsilu(q0); q1 = fsilu(q1); k0 = fsilu(k0); k1 = fsilu(k1); v0 = fsilu(v0); v1 = fsilu(v1);
                    const float sq = wave_sum(q0 * q0 + q1 * q1), sk = wave_sum(k0 * k0 + k1 * k1);
                    const float rq = rsqrtf(sq + EPS) * 0.08838834764831845f, rk = rsqrtf(sk + EPS);
                    q0 *= rq; q1 *= rq; k0 *= rk; k1 *= rk;
                    const float be = bet[c], eg = eG[c], egl = eGl[c];
                    const int kc = 2 * lane;
                    *(LAS unsigned*)(L + L_QN + sw256(c, kc)) = cvtpk(q0, q1);
                    *(LAS unsigned*)(L + L_KN + sw256(c, kc)) = cvtpk(k0, k1);
                    kg0[rr] = k0 * egl; kg1[rr] = k1 * egl;
                    *(GAS unsigned*)(QGb + (size_t)ch * 8192 + c * 128 + sigma_inv(kc)) = cvtpk(q0 * eg, q1 * eg);
                    *(GAS unsigned*)(RS + (size_t)ch * 16384 + c * 256 + kc) = cvtpk(k0 * be * eg, k1 * be * eg);
                    *(GAS unsigned*)(RS + (size_t)ch * 16384 + c * 256 + 128 + kc) = cvtpk(v0 * be, v1 * be);
                }
                { const int kc = 2 * lane, c0 = 8 * w, p0 = (c0 & ~31) | (((c0 >> 2) & 3) << 3) | (((c0 >> 4) & 1) << 2);
                  typedef unsigned u32x2 __attribute__((ext_vector_type(2)));
                  *(LAS u32x2*)(L + L_KGT + sw128(kc, p0)) = (u32x2){cvtpk(kg0[0], kg0[1]), cvtpk(kg0[2], kg0[3])};
                  *(LAS u32x2*)(L + L_KGT + sw128(kc, p0 + 8)) = (u32x2){cvtpk(kg0[4], kg0[5]), cvtpk(kg0[6], kg0[7])};
                  *(LAS u32x2*)(L + L_KGT + sw128(kc + 1, p0)) = (u32x2){cvtpk(kg1[0], kg1[1]), cvtpk(kg1[2], kg1[3])};
                  *(LAS u32x2*)(L + L_KGT + sw128(kc + 1, p0 + 8)) = (u32x2){cvtpk(kg1[4], kg1[5]), cvtpk(kg1[6], kg1[7])}; }
            }
            if (ci < 7) A1_LOADRAW(ci + 1);
            __syncthreads(); PROFX(1);
            {
                const int pw = w >> 2, ti = (w >> 1) & 1, tj = w & 1;
                f32x16 acc = {0.f, 0.f, 0.f, 0.f, 0.f, 0.f, 0.f, 0.f, 0.f, 0.f, 0.f, 0.f, 0.f, 0.f, 0.f, 0.f};
                const LAS unsigned char* Ab = L + (pw ? L_QN : L_KN);
#pragma unroll
                for (int s = 0; s < 8; ++s) {
                    const bf16x8 af = *(const LAS bf16x8*)(Ab + sw256(32 * ti + i32, 16 * s + 8 * h2));
                    const bf16x8 bf = *(const LAS bf16x8*)(L + L_KN + sw256(32 * tj + i32, 16 * s + 8 * h2));
                    acc = __builtin_amdgcn_mfma_f32_32x32x16_bf16(af, bf, acc, 0, 0, 0);
                }
                const int j = 32 * tj + i32; const float Gj = Gs[j];
                if (pw == 0) {
                    LAS unsigned char* As = L + L_A + ci * 8192;
#pragma unroll
                    for (int rg = 0; rg < 16; ++rg) { const int i = 32 * ti + crow(rg, h2);
                        const float v = (j < i) ? bet[i] * acc[rg] * __expf(Gs[i] - Gj) : 0.f;
                        *(LAS bf16*)(As + i * 128 + j * 2) = (bf16)f2bf(v); }
                } else {
                    const int pj = sigma_inv(j);
#pragma unroll
                    for (int rg = 0; rg < 16; ++rg) { const int i = 32 * ti + crow(rg, h2);
                        const float v = (j <= i) ? acc[rg] * __expf(Gs[i] - Gj) : 0.f;
                        *(LAS bf16*)(L + L_AQK + i * 128 + pj * 2) = (bf16)f2bf(v); }
                }
            }
            __syncthreads(); PROFX(2);
            {
#pragma unroll
                for (int q = 0; q < 2; ++q) { const int off = (tid + 512 * q) * 16; *(GAS u32x4*)(scanops + (size_t)ch * SCAN_BYTES + 16384 + off) = *(const LAS u32x4*)(L + L_KGT + off); }
                { const int off = tid * 16; *(GAS u32x4*)((unsigned char*)AQKb + (size_t)ch * 8192 + off) = *(const LAS u32x4*)(L + L_AQK + off); }
            }
        }
        __syncthreads(); PROFX(3);
#if MK_A1 == 1
        {
            const int lane = pg8::lane_now(), tid = w * 64 + lane;
#pragma unroll
            for (int q = 0; q < 8; ++q) { const int off = (tid + 512 * q) * 16; *(GAS u32x4*)(ws + WS_PART2 + (size_t)grp * 65536 + off) = *(const LAS u32x4*)(L + L_A + off); }
        }
#else
        {
            const int lane = pg8::lane_now();
            LAS unsigned char* As = L + L_A + w * 8192;
            unsigned tp[32];
            float tprev = 0.f;
#pragma unroll
            for (int i = 0; i < 64; ++i) {
                float acc = 0.f;
#pragma unroll
                for (int p = 0; p < i / 2; ++p) { const unsigned lwp = *(const LAS unsigned*)(As + i * 128 + p * 4);
                    acc = __builtin_amdgcn_fdot2_f32_bf16(__builtin_bit_cast(bf16x2_t, lwp), __builtin_bit_cast(bf16x2_t, tp[p]), acc, false); }
                if (i & 1) { const unsigned lw1 = *(const LAS unsigned*)(As + i * 128 + (i - 1) * 2); acc += bflo(lw1) * tprev; }
                const float ti = ((lane == i) ? 1.f : 0.f) - acc;
                if (i & 1) tp[i >> 1] = cvtpk(tprev, ti);
                tprev = ti;
            }
#pragma unroll
            for (int p = 0; p < 32; ++p) { *(LAS bf16*)(As + (2 * p) * 128 + lane * 2) = (bf16)(tp[p] & 0xFFFFu); *(LAS bf16*)(As + (2 * p + 1) * 128 + lane * 2) = (bf16)(tp[p] >> 16); }
        }
        __syncthreads(); PROFX(4);
        u32x4 rpre[4];
        for (int ci = 0; ci < 8; ++ci) {
            const int ch = grp * 8 + ci;
            const int lane = pg8::lane_now(), tid = w * 64 + lane, i32 = lane & 31, h2 = lane >> 5;
            __syncthreads();
            if (ci == 0) {
#pragma unroll
                for (int q = 0; q < 4; ++q) rpre[q] = *(const GAS u32x4*)((const unsigned char*)RS + (size_t)ch * 32768 + (tid + 512 * q) * 16); }
#pragma unroll
            for (int q = 0; q < 4; ++q) *(LAS u32x4*)(L + (tid + 512 * q) * 16) = rpre[q];
            if (ci < 7) {
#pragma unroll
                for (int q = 0; q < 4; ++q) rpre[q] = *(const GAS u32x4*)((const unsigned char*)RS + (size_t)(ch + 1) * 32768 + (tid + 512 * q) * 16); }
            __syncthreads();
            const LAS unsigned char* Ts = L + L_A + ci * 8192;
            f32x16 x0 = {0.f, 0.f, 0.f, 0.f, 0.f, 0.f, 0.f, 0.f, 0.f, 0.f, 0.f, 0.f, 0.f, 0.f, 0.f, 0.f}, x1 = x0;
            const LAS unsigned char* rb = L + (8 * h2 + ((lane & 15) >> 2)) * 512 + (32 * w + 16 * ((lane >> 4) & 1) + 4 * (lane & 3)) * 2;
#pragma unroll
            for (int s = 0; s < 4; ++s) {
                const s16x4 lo = vtr(rb + (16 * s) * 512), hi = vtr(rb + (16 * s + 4) * 512);
                const bf16x8 bf = (bf16x8){lo[0], lo[1], lo[2], lo[3], hi[0], hi[1], hi[2], hi[3]};
                const bf16x8 a0 = *(const LAS bf16x8*)(Ts + i32 * 128 + (16 * s + 8 * h2) * 2), a1 = *(const LAS bf16x8*)(Ts + (32 + i32) * 128 + (16 * s + 8 * h2) * 2);
                x0 = __builtin_amdgcn_mfma_f32_32x32x16_bf16(a0, bf, x0, 0, 0, 0);
                x1 = __builtin_amdgcn_mfma_f32_32x32x16_bf16(a1, bf, x1, 0, 0, 0);
            }
            __syncthreads();
            {
                const int x = 32 * w + i32;
#pragma unroll
                for (int rg = 0; rg < 16; ++rg) {
#pragma unroll
                    for (int mt = 0; mt < 2; ++mt) { const int c = 32 * mt + crow(rg, h2); const float v = mt ? x1[rg] : x0[rg];
                        if (x < 128) *(LAS bf16*)(L + sw256(c, sigma_inv(x))) = (bf16)f2bf(-v);
                        else { const int vv = x - 128; const int idx = (((vv >> 4) * 64 + (vv & 15) + 16 * ((c >> 2) & 3)) * 16 + (c >> 4) * 4 + (c & 3));
                               *(LAS bf16*)(L + 16384 + idx * 2) = (bf16)f2bf(v); } }
                }
            }
            __syncthreads();
#pragma unroll
            for (int q = 0; q < 2; ++q) { const int off = (tid + 512 * q) * 16;
                *(GAS u32x4*)(scanops + (size_t)ch * SCAN_BYTES + off) = *(const LAS u32x4*)(L + off);
                *(GAS u32x4*)(scanops + (size_t)ch * SCAN_BYTES + 32768 + off) = *(const LAS u32x4*)(L + 16384 + off); }
        }
#endif
        __syncthreads(); PROFX(5);
    }
}

__device__ __forceinline__ void glds16(const void* gsrc, unsigned lds_dst) { unsigned keep;
    asm volatile("s_mov_b32 %0, m0\n\ts_mov_b32 m0, %2\n\ts_nop 0\n\tglobal_load_lds_dwordx4 %1, off\n\ts_mov_b32 m0, %0" : "=&s"(keep) : "v"(gsrc), "s"(lds_dst) : "memory"); }

__device__ __forceinline__ void scan_phase(Frame& F, unsigned char* ws, const unsigned char* dout, int bh) {
    const int lane = pg8::lane_now(), w = F.wave;
    const unsigned char* scanops = dout; const float* GLb = (const float*)(ws + WS_GGL);
    bf16* ST = (bf16*)(ws + WS_QKVA); bf16* UT = (bf16*)(ws + WS_QKVA + 64 * MiB);
    LAS unsigned char* L = F.lds + RING_OFF;
    const unsigned lds0 = (unsigned)(uintptr_t)(F.lds + RING_OFF);
    const int v16 = lane & 15, kg = lane >> 4;
    f32x4 Sf[8];
#pragma unroll
    for (int mt = 0; mt < 8; ++mt) Sf[mt] = (f32x4){0.f, 0.f, 0.f, 0.f};
    float glv = GLb[bh * 64 + lane];
    asm volatile("s_waitcnt vmcnt(0)" : "+v"(glv));
#define GDN_STAGE3(n, sl_) do { const unsigned char* src_ = scanops + (size_t)(bh * 64 + (n)) * SCAN_BYTES + lane * 16; \
        _Pragma("unroll") for (int q_ = 0; q_ < 6; ++q_) { const int piece_ = w * 6 + q_; \
            glds16(src_ + piece_ * 1024, (unsigned)__builtin_amdgcn_readfirstlane(lds0 + (sl_) * SCAN_BYTES + piece_ * 1024)); } } while (0)
#define GDN_STAGE(n) GDN_STAGE3(n, n)
    GDN_STAGE(0); GDN_STAGE(1);
    asm volatile("s_waitcnt vmcnt(6)" ::: "memory");
    int slot = 0, slot2 = 2;
    u32x4 Sb[4], Ub[2];
    for (int n = 0; n < 64; ++n) {
        __builtin_amdgcn_s_barrier();
        asm volatile("" ::: "memory");
        if (n + 2 < 64) GDN_STAGE3(n + 2, slot2);
        const LAS unsigned char* sl = L + slot * SCAN_BYTES;
        const float gl = __shfl(glv, n);
#pragma unroll
        for (int s = 0; s < 4; ++s) { Sb[s].x = cvtpk(Sf[2 * s][0], Sf[2 * s][1]); Sb[s].y = cvtpk(Sf[2 * s][2], Sf[2 * s][3]); Sb[s].z = cvtpk(Sf[2 * s + 1][0], Sf[2 * s + 1][1]); Sb[s].w = cvtpk(Sf[2 * s + 1][2], Sf[2 * s + 1][3]); }
        f32x4 Uf[4];
        { const u32x4 u0 = *(const LAS u32x4*)(sl + 32768 + (w * 64 + lane) * 32), u1 = *(const LAS u32x4*)(sl + 32768 + (w * 64 + lane) * 32 + 16);
          Uf[0] = (f32x4){bflo(u0.x), bfhi(u0.x), bflo(u0.y), bfhi(u0.y)}; Uf[1] = (f32x4){bflo(u0.z), bfhi(u0.z), bflo(u0.w), bfhi(u0.w)};
          Uf[2] = (f32x4){bflo(u1.x), bfhi(u1.x), bflo(u1.y), bfhi(u1.y)}; Uf[3] = (f32x4){bflo(u1.z), bfhi(u1.z), bflo(u1.w), bfhi(u1.w)}; }
        bf16x8 ak[16];
        {
            bf16x8 aw[16];
#pragma unroll
            for (int mt = 0; mt < 4; ++mt)
#pragma unroll
                for (int s = 0; s < 4; ++s) aw[mt * 4 + s] = *(const LAS bf16x8*)(sl + sw256(16 * mt + v16, 32 * s + 8 * kg));
#pragma unroll
            for (int s = 0; s < 4; ++s)
#pragma unroll
                for (int mt = 0; mt < 4; ++mt) Uf[mt] = __builtin_amdgcn_mfma_f32_16x16x32_bf16(aw[mt * 4 + s], __builtin_bit_cast(bf16x8, Sb[s]), Uf[mt], 0, 0, 0);
#pragma unroll
            for (int mt = 0; mt < 8; ++mt)
#pragma unroll
                for (int s = 0; s < 2; ++s) ak[mt * 2 + s] = *(const LAS bf16x8*)(sl + 16384 + sw128(16 * mt + v16, 32 * s + 8 * kg));
            __builtin_amdgcn_sched_group_barrier(0x100, 34, 0);
            __builtin_amdgcn_sched_group_barrier(0x008, 16, 0);
        }
#pragma unroll
        for (int s = 0; s < 2; ++s) { Ub[s].x = cvtpk(Uf[2 * s][0], Uf[2 * s][1]); Ub[s].y = cvtpk(Uf[2 * s][2], Uf[2 * s][3]); Ub[s].z = cvtpk(Uf[2 * s + 1][0], Uf[2 * s + 1][1]); Ub[s].w = cvtpk(Uf[2 * s + 1][2], Uf[2 * s + 1][3]); }
        {
#pragma unroll
            for (int mt = 0; mt < 8; ++mt) Sf[mt] = Sf[mt] * gl;
#pragma unroll
            for (int s = 0; s < 2; ++s)
#pragma unroll
                for (int mt = 0; mt < 8; ++mt) Sf[mt] = __builtin_amdgcn_mfma_f32_16x16x32_bf16(ak[mt * 2 + s], __builtin_bit_cast(bf16x8, Ub[s]), Sf[mt], 0, 0, 0);
        }
        if (n + 2 < 64) asm volatile("s_waitcnt vmcnt(6) lgkmcnt(0)" ::: "memory"); else asm volatile("s_waitcnt vmcnt(0) lgkmcnt(0)" ::: "memory");
        { bf16* dst = ST + (size_t)(bh * 64 + n) * 16384 + (w * 4 * 64 + lane) * 8;
#pragma unroll
          for (int s = 0; s < 4; ++s) *(GAS u32x4*)(dst + s * 512) = Sb[s]; }
        { bf16* dst = UT + (size_t)(bh * 64 + n) * 8192 + (w * 2 * 64 + lane) * 8;
#pragma unroll
          for (int s = 0; s < 2; ++s) *(GAS u32x4*)(dst + s * 512) = Ub[s]; }
        slot = (slot == 2) ? 0 : slot + 1; slot2 = (slot2 == 2) ? 0 : slot2 + 1;
    }
    asm volatile("s_waitcnt vmcnt(0) lgkmcnt(0)" ::: "memory");
    __builtin_amdgcn_s_barrier();
#undef GDN_STAGE
#undef GDN_STAGE3
}

__device__ __forceinline__ void a3_phase(Frame& F, unsigned char* ws, const unsigned char* dout, const float* gdn_norm) {
    const int lane = pg8::lane_now(), w = F.wave, tid = w * 64 + lane;
    const bf16* QGb = (const bf16*)(dout + 96 * MiB); const bf16* AQKb = (const bf16*)(ws + WS_GAQK);
    const bf16* ST = (const bf16*)(ws + WS_QKVA); const bf16* UT = (const bf16*)(ws + WS_QKVA + 64 * MiB);
    const bf16* Z = (const bf16*)(ws + WS_Z); bf16* Y = (bf16*)(ws + WS_Y);
    LAS float* Ot = (LAS float*)(F.lds + RING_OFF);
    const int v16 = lane & 15, kg = lane >> 4;
    const int c = tid >> 3, v0 = 16 * (tid & 7);
    f32x4 gn[4];
#pragma unroll
    for (int q = 0; q < 4; ++q) gn[q] = *(const GAS f32x4*)(gdn_norm + v0 + 4 * q);
    bf16x8 fa[24], fb[6];
#define A3_LOAD(ch_) do { const int ch__ = (ch_); \
        const bf16* sp_ = ST + (size_t)ch__ * 16384 + (w * 4 * 64 + lane) * 8; const bf16* up_ = UT + (size_t)ch__ * 8192 + (w * 2 * 64 + lane) * 8; \
        const bf16* qp_ = QGb + (size_t)ch__ * 8192 + v16 * 128 + 8 * kg; const bf16* ap_ = AQKb + (size_t)ch__ * 4096 + v16 * 64 + 8 * kg; \
        _Pragma("unroll") for (int s = 0; s < 4; ++s) { fb[s] = *(const GAS bf16x8*)(sp_ + 512 * s); \
            _Pragma("unroll") for (int mt = 0; mt < 4; ++mt) fa[4 * s + mt] = *(const GAS bf16x8*)(qp_ + (16 * mt) * 128 + 32 * s); } \
        _Pragma("unroll") for (int s = 0; s < 2; ++s) { fb[4 + s] = *(const GAS bf16x8*)(up_ + 512 * s); \
            _Pragma("unroll") for (int mt = 0; mt < 4; ++mt) fa[16 + 4 * s + mt] = *(const GAS bf16x8*)(ap_ + (16 * mt) * 64 + 32 * s); } } while (0)
    if (F.vcu < NCH) A3_LOAD(F.vcu);
    for (int ch = F.vcu; ch < NCH; ch += F.G) {
        const int n = ch & 63, bh = ch >> 6, h = bh & 3, b = bh >> 2;
        const size_t m = (size_t)b * SEQ + n * 64 + c;
        const size_t zo = ((size_t)(b * 4 + h) * SEQ + n * 64 + c) * 128 + v0;
        const u32x4 z0 = *(const GAS u32x4*)(Z + zo), z1 = *(const GAS u32x4*)(Z + zo + 8);
        f32x4 acc[4];
#pragma unroll
        for (int mt = 0; mt < 4; ++mt) acc[mt] = (f32x4){0.f, 0.f, 0.f, 0.f};
#pragma unroll
        for (int s = 0; s < 6; ++s)
#pragma unroll
            for (int mt = 0; mt < 4; ++mt) acc[mt] = __builtin_amdgcn_mfma_f32_16x16x32_bf16(fa[4 * s + mt], fb[s], acc[mt], 0, 0, 0);
        if (ch + F.G < NCH) A3_LOAD(ch + F.G);
        __syncthreads();
#pragma unroll
        for (int mt = 0; mt < 4; ++mt)
#pragma unroll
            for (int rg = 0; rg < 4; ++rg) Ot[(16 * mt + 4 * kg + rg) * 132 + 16 * w + v16] = acc[mt][rg];
        __syncthreads();
        {
            f32x4 o[4]; float ss = 0.f;
#pragma unroll
            for (int q = 0; q < 4; ++q) { o[q] = *(const LAS f32x4*)(Ot + c * 132 + v0 + 4 * q); ss += (o[q].x * o[q].x + o[q].y * o[q].y) + (o[q].z * o[q].z + o[q].w * o[q].w); }
            ss = dpp_add(ss, 0); ss = dpp_add(ss, 1);
            ss += __builtin_bit_cast(float, __builtin_amdgcn_mov_dpp(__builtin_bit_cast(int, ss), 0x141, 0xF, 0xF, false));
            const float rg = rsqrtf(ss * (1.f / 128.f) + EPS);
            u32x4 y0, y1;
#pragma unroll
            for (int q = 0; q < 2; ++q) {
                const f32x4 a = o[q] * rg * gn[q], bq = o[2 + q] * rg * gn[2 + q];
                y0[2 * q] = cvtpk(a.x * fsilu(bflo(z0[2 * q])), a.y * fsilu(bfhi(z0[2 * q]))); y0[2 * q + 1] = cvtpk(a.z * fsilu(bflo(z0[2 * q + 1])), a.w * fsilu(bfhi(z0[2 * q + 1])));
                y1[2 * q] = cvtpk(bq.x * fsilu(bflo(z1[2 * q])), bq.y * fsilu(bfhi(z1[2 * q]))); y1[2 * q + 1] = cvtpk(bq.z * fsilu(bflo(z1[2 * q + 1])), bq.w * fsilu(bfhi(z1[2 * q + 1]))); }
            *(GAS u32x4*)(Y + m * 1024 + h * 128 + v0) = y0; *(GAS u32x4*)(Y + m * 1024 + h * 128 + v0 + 8) = y1;
        }
    }
#undef A3_LOAD
}
}

__global__ void __launch_bounds__(NWAVES * 64, 2) mega_fwd(Args args) {
    extern __shared__ __attribute__((aligned(16))) unsigned char lds[];
    Frame F;
    F.lds = (LAS unsigned char*)lds;
    F.MISC = (volatile LAS unsigned*)(F.lds + MISC_OFF);
    F.wave = __builtin_amdgcn_readfirstlane(threadIdx.x >> 6);
    F.G = gridDim.x; { const int bx = blockIdx.x; F.vcu = (F.G % 8 == 0) ? (bx % 8) * (F.G / 8) + bx / 8 : bx; }
    unsigned char* ws = args.ws;
    F.ctl = (gu32*)(ws + WS_CTL);
    for (int u = threadIdx.x; u < (LDS_BYTES - LDSCTL_OFF) / 4; u += NWAVES * 64) ((LAS unsigned*)(F.lds + LDSCTL_OFF))[u] = 0u;
    __syncthreads();
    const int lo = args.ph_lo, hi = args.ph_hi;
    const bool multi = (hi - lo) > 1;
    XcdBarrier bar; bar.bar = (unsigned*)(F.ctl + CW_BAR) + args.li * XCD_BAR_WORDS; bar.x = 0; bar.st = nullptr; bar.wave = F.wave;
    if (multi) bar = xcd_barrier_post((unsigned*)(F.ctl + CW_BAR) + args.li * XCD_BAR_WORDS, F.MISC + 8, F.wave);
#ifndef MK_REP
#define MK_REP -1
#endif
#define REPS(k) (((k) == MK_REP) ? 2 : 1)
#define IN(k) (lo <= (k) && (k) < hi)
#define BOTH(k) (IN(k) && IN((k) + 1))
#define GRID_BAR() do { xcd_barrier(bar); PROF_STAMP(); } while (0)
#if MK_PROF_A >= 0
    if (F.wave == 0 && pg8::lane_now() == 0) { const unsigned long long t_ = __builtin_amdgcn_s_memrealtime(); F.MISC[16] = (unsigned)t_; F.MISC[17] = (unsigned)(t_ >> 32); F.MISC[18] = (unsigned)lo; F.MISC[19] = 0u; F.MISC[20] = 0u; }
#define PROF_STAMP() do { if (F.wave == 0 && pg8::lane_now() == 0) { const unsigned long long t_ = __builtin_amdgcn_s_memrealtime(); \
        const unsigned long long p_ = ((unsigned long long)F.MISC[17] << 32) | F.MISC[16]; const float d_ = (float)(t_ - p_) * 0.01f; const int k_ = (int)F.MISC[18]; \
        if (k_ == MK_PROF_A) F.MISC[19] = __float_as_uint(d_); if (k_ == MK_PROF_B) F.MISC[20] = __float_as_uint(d_); F.MISC[16] = (unsigned)t_; F.MISC[17] = (unsigned)(t_ >> 32); F.MISC[18] = (unsigned)(k_ + 1); } } while (0)
#else
#define PROF_STAMP() do {} while (0)
#endif

#if MK_PROF_A >= 120 && MK_PROF_A < 130
#define PROFM(idx) do { if (blockIdx.x == 0 && F.wave == 0 && pg8::lane_now() == 0) { const unsigned long long t_ = __builtin_amdgcn_s_memrealtime(); \
        const unsigned long long p_ = ((unsigned long long)F.MISC[23] << 32) | F.MISC[22]; if ((idx) >= 0) F.MISC[24 + (idx)] = __float_as_uint(__uint_as_float(F.MISC[24 + (idx)]) + (float)(t_ - p_) * 0.01f); \
        F.MISC[22] = (unsigned)t_; F.MISC[23] = (unsigned)(t_ >> 32); } } while (0)
#else
#define PROFM(idx) do {} while (0)
#endif
    if (IN(0)) { p0_phase(F, ws, args.in[1], args.in[2], args.in[3], args.in[5], args.in[11], args.in[16], args.in[17], args.in[18], args.in[14], args.in[15]);
        asm volatile("s_waitcnt vmcnt(0)" ::: "memory"); __syncthreads();
        if ((int)blockIdx.x < 192 && F.wave == 0 && pg8::lane_now() == 0) { __builtin_amdgcn_fence(__ATOMIC_RELEASE, "agent"); asm volatile("s_waitcnt vmcnt(0)" ::: "memory"); (void)xb_add((unsigned*)(F.ctl + CW_MODF), 1u); }
        PROF_STAMP(); }
    if (IN(1)) { p0b_phase(F, ws, args.in[5], args.in[11], args.in[16], args.in[17], args.in[18]);
        if (F.wave == 0 && pg8::lane_now() == 0) { unsigned* bw_ = (unsigned*)(F.ctl + CW_BAR) + args.li * XCD_BAR_WORDS; const unsigned need_ = (unsigned)(F.G < 192 ? F.G : 192);
            XB_SPIN(xb_ld((unsigned*)(F.ctl + CW_MODF)) < need_, bw_);
            __builtin_amdgcn_fence(__ATOMIC_ACQUIRE, "agent"); asm volatile("s_waitcnt vmcnt(0)" ::: "memory"); }
        __syncthreads();
        p1_phase(F, ws, args.in[0], args.in[4], args.in[5], args.in[7], args.in[8]);
        if (BOTH(1)) GRID_BAR(); }
    if (IN(2)) { for (int rep_ = 0; rep_ < REPS(2); ++rep_) {
        pg8::Gemm g{(const pg8::bf16_t*)(ws + WS_H), (const pg8::bf16_t*)(ws + WS_WIN), T, NPROJ, D};
        pg8::StaticOrder S; S.init(T, NPROJ, F.G, (int)blockIdx.x);
        pg8::EpiProj E{ws, 0.125f * 1.4426950408889634f};
        pg8::gemm_phase<pg8::EpiProj, pg8::StaticOrder, true, true>(F.lds + RING_OFF, g, S, E, F.wave); }
        if (BOTH(2)) GRID_BAR();
    }
    if (IN(3)) { for (int rep_ = 0; rep_ < REPS(3); ++rep_) gdn::a1_phase(F, ws, (unsigned char*)args.out, args.in[6]); if (BOTH(3)) GRID_BAR(); }
    if (IN(4)) { for (int rep_ = 0; rep_ < REPS(4); ++rep_) {
        if ((int)blockIdx.x < 32) {
#if MK_PROF_A >= 200
            unsigned long long ts0_ = __builtin_amdgcn_s_memrealtime();
#endif
            for (int r2_ = 0; r2_ < 1 + MK_REPSCAN; ++r2_) gdn::scan_phase(F, ws, (const unsigned char*)args.out, (int)blockIdx.x);
#if MK_PROF_A >= 200
            if (pg8::lane_now() == 0) atomicMax((unsigned*)(F.ctl + CW_CNT + 71), (unsigned)(__builtin_amdgcn_s_memrealtime() - ts0_));
#endif
        }
#if MK_SERIAL_SCAN
        if ((int)blockIdx.x < 32) { __syncthreads(); if (F.wave == 0 && pg8::lane_now() == 0) (void)xb_add((unsigned*)(F.ctl + CW_MODF + 32), 1u); }
        else { if (F.wave == 0 && pg8::lane_now() == 0) { unsigned* bw_ = (unsigned*)(F.ctl + CW_BAR) + args.li * XCD_BAR_WORDS; XB_SPIN(xb_ld((unsigned*)(F.ctl + CW_MODF + 32)) < 32u, bw_); } __syncthreads(); }
#endif
        attn_phase(F, ws, args.in[12]);
        }
        if (BOTH(4)) GRID_BAR(); }
#if MK_PROF_A >= 200
    if (blockIdx.x == 32 && F.wave == 0 && pg8::lane_now() == 0) { for (int q_ = 0; q_ < 4; ++q_) F.ctl[CW_CNT + 64 + q_] = F.MISC[24 + q_]; }
#endif
    if (IN(5)) { for (int rep_ = 0; rep_ < REPS(5); ++rep_) {
        PROFM(-1);
#if MK_MODE != 2 && MK_MODE != 3
        gdn::a3_phase(F, ws, (const unsigned char*)args.out, args.in[9]);
#endif
        PROFM(0);
        attn_combine_phase(F, ws, args.in[10]); PROFM(1); }
        if (BOTH(5)) GRID_BAR(); }

    if (IN(6)) { for (int rep_ = 0; rep_ < REPS(6); ++rep_) {
        pg8::Gemm g{(const pg8::bf16_t*)(ws + WS_Y), (const pg8::bf16_t*)(ws + WS_WOUT), T, D, D};
        pg8::StaticOrder S; S.init(T, D, F.G, (int)blockIdx.x);
        pg8::EpiRes E{args.in[0], (const float*)(ws + WS_MOD), (pg8::bf16_t*)(ws + WS_XM), 2048};
        pg8::gemm_phase<pg8::EpiRes, pg8::StaticOrder, true, true>(F.lds + RING_OFF, g, S, E, F.wave); }
        if (BOTH(6)) GRID_BAR();
    }
    if (IN(7)) { p5_phase(F, ws, (const bf16*)(ws + WS_XM), args.in[13]); if (BOTH(7)) GRID_BAR(); }
    if (IN(8) || IN(9) || IN(10)) moe_setup(F);
    if (IN(8)) { for (int rep_ = 0; rep_ < REPS(8); ++rep_) {
        pg8::Gemm g{(const pg8::bf16_t*)(ws + WS_H), (const pg8::bf16_t*)(ws + WS_WGU), PROWS, 256, D};
        pg8::MoeOrder<true, 2> S{(const LAS int*)(F.lds + MOE_OFF), (const LAS int*)(F.lds + MOE_OFF) + 33, (const int*)(ws + WS_LTOK), CAP, F.G, F.vcu, (unsigned*)(F.ctl + CW_TCNT), F.wave};
        pg8::EpiHid E{(pg8::bf16_t*)(ws + WS_HID), PROWS * 256 * 2};
        pg8::gemm_phase<pg8::EpiHid, pg8::MoeOrder<true, 2>, true, true>(F.lds + RING_OFF, g, S, E, F.wave); }
        if (BOTH(8)) { __syncthreads(); PROF_STAMP(); }
    }
    if (IN(9)) { for (int rep_ = 0; rep_ < REPS(9); ++rep_) {
        pg8::Gemm g{(const pg8::bf16_t*)(ws + WS_HID), (const pg8::bf16_t*)(ws + WS_WDN), PROWS, D, DEXP};
        pg8::MoeOrder<false, 4> S{(const LAS int*)(F.lds + MOE_OFF), (const LAS int*)(F.lds + MOE_OFF) + 33, (const int*)(ws + WS_LTOK), CAP, F.G, F.vcu, (unsigned*)(F.ctl + CW_TCNT), F.wave};
        pg8::EpiYs E{(pg8::bf16_t*)(ws + WS_YS), (const float*)(ws + WS_LW), (const LAS int*)(F.lds + MOE_OFF) + 33, CAP};
        pg8::gemm_phase<pg8::EpiYs, pg8::MoeOrder<false, 4>, true, true>(F.lds + RING_OFF, g, S, E, F.wave); }
        if (BOTH(9)) GRID_BAR();
    }
    if (IN(10)) { p8_phase(F, ws, args.out, args.in[19]); }
#if MK_PROF_A >= 0
    GRID_BAR();
    if (blockIdx.x == 0) { const int t_ = F.wave * 64 + pg8::lane_now(); if (MK_PROF_A >= 200 && t_ == 0) { for (int q_ = 0; q_ < 4; ++q_) F.MISC[24 + q_] = F.ctl[CW_CNT + 64 + q_]; F.MISC[30] = __float_as_uint((float)F.ctl[CW_CNT + 70] * 0.01f); F.MISC[31] = __float_as_uint((float)F.ctl[CW_CNT + 71] * 0.01f); } __syncthreads();
        const float prof_a = (MK_PROF_A >= 100) ? __uint_as_float(F.MISC[24 + (MK_PROF_A % 10)]) : __uint_as_float(F.MISC[19]), prof_b = (MK_PROF_B >= 100) ? __uint_as_float(F.MISC[24 + (MK_PROF_B % 10)]) : __uint_as_float(F.MISC[20]);
        for (int r = t_; r < T; r += NWAVES * 64) args.out[(size_t)r * D + 1] += prof_b * (1.f / (float)MK_PROF_SB);
        if (t_ == 0) args.out[0] += 10.f + prof_a * (0.01f * (float)MK_PROF_SA); }
#endif
#undef IN
#undef BOTH
}


static int g_grid = 0;
static void launch_mega(Args a, int lo, int hi, int li, hipStream_t stream) {
    a.ph_lo = lo; a.ph_hi = hi; a.li = li;
    void* params[] = {&a};
    hipError_t e = hipLaunchCooperativeKernel((const void*)mega_fwd, dim3(g_grid), dim3(NWAVES * 64), params, LDS_BYTES, stream);
    if (e != hipSuccess) fprintf(stderr, "kernel_launch: cooperative launch [%d,%d) failed: %s (grid %d)\n", lo, hi, hipGetErrorString(e), g_grid);
}

extern "C" void kernel_launch(void* const* d_in, const int* in_sizes, int n_in, void* d_out, int out_size, void* d_ws, size_t ws_size, hipStream_t stream) {
    if (g_grid == 0) {
        if (n_in != 20 || ws_size < WS_NEED || out_size != T * D) { fprintf(stderr, "kernel_launch: unexpected shapes (n_in %d, ws %zu, out %d)\n", n_in, ws_size, out_size); g_grid = -1; return; }
        int dev = 0, cus = 0, per_cu = 0;
        (void)hipGetDevice(&dev); (void)hipDeviceGetAttribute(&cus, hipDeviceAttributeMultiprocessorCount, dev);
        if (hipFuncSetAttribute((const void*)mega_fwd, hipFuncAttributeMaxDynamicSharedMemorySize, LDS_BYTES) != hipSuccess) { fprintf(stderr, "kernel_launch: hipFuncSetAttribute failed\n"); g_grid = -1; return; }
        if (hipOccupancyMaxActiveBlocksPerMultiprocessor(&per_cu, (const void*)mega_fwd, NWAVES * 64, LDS_BYTES) != hipSuccess || per_cu < 1) { fprintf(stderr, "kernel_launch: occupancy query says %d\n", per_cu); per_cu = 1; }
        (void)hipGetLastError();
        g_grid = cus;
        fprintf(stderr, "kernel_launch: cus %d per_cu %d grid %d\n", cus, per_cu, g_grid);
    }
    if (g_grid < 0) return;
    (void)hipMemsetAsync((char*)d_ws + WS_CTL, 0, CTL_ZERO_BYTES, stream);
    Args a{};
    for (int i = 0; i < 20; ++i) a.in[i] = (const float*)d_in[i];
    a.out = (float*)d_out; a.ws = (unsigned char*)d_ws;
#if MK_DEV
#if MK_SPLIT
    launch_mega(a, 0, 1, 0, stream); launch_mega(a, 1, 2, 0, stream); launch_mega(a, 2, 3, 0, stream);
#else
    launch_mega(a, 0, 3, 0, stream);
#endif
#if MK_MODE == 2
    naive_gdn(a, stream); launch_mega(a, 4, 6, 1, stream); naive_yfin_gdn(a, stream); launch_mega(a, 6, 11, 2, stream);
#elif MK_MODE == 5
    launch_mega(a, 3, 4, 1, stream); naive_solve(a, stream); launch_mega(a, 4, 11, 2, stream);
#elif MK_MODE == 4
    launch_mega(a, 3, 4, 1, stream); naive_scan(a, stream); launch_mega(a, 4, 11, 2, stream);
#elif MK_MODE == 3
    launch_mega(a, 3, 6, 1, stream); naive_a3(a, stream); launch_mega(a, 6, 11, 2, stream);
#else
    launch_mega(a, 3, 11, 1, stream);
#endif
#else
    launch_mega(a, 0, 11, 0, stream);
#endif
}
```

```cpp
#define MK_DEV 0
#define MK_SPLIT 0
#define MK_MODE 0
#define MK_A1 0
#define MK_REP -1
#define MK_REPSCAN 0
#define MK_REPATT 0
#define MK_PROF_A -1
#define MK_PROF_B -1
#define MK_ATT_PF 0
#define MK_SERIAL_SCAN 0
#define MK_PROF_SA 25
#define MK_PROF_SB 250
#include <hip/hip_runtime.h>
#include <hip/hip_cooperative_groups.h>
#include <cstdio>
#include <cstdint>
#include <cmath>

namespace pg8 {
#define PG8_LAS __attribute__((address_space(3)))
typedef unsigned short bf16_t;
typedef short bf16x8 __attribute__((ext_vector_type(8)));
typedef float f32x4 __attribute__((ext_vector_type(4)));
typedef unsigned u32x4 __attribute__((ext_vector_type(4)));
constexpr int BM = 256, BK = 64, HALF = 128, HTB = HALF * BK * 2  , STAGE_BYTES = 8 * HTB, NXCD = 8, WGM = 8;

__host__ __device__ __forceinline__ int lds_byte(int r, int c) { const int st = (r >> 4) * 2 + (c >> 5), rr = r & 15, cc = c & 31, ob = rr * 64 + cc * 2; return st * 1024 + (ob ^ (((ob >> 9) & 1) << 5)); }
__host__ __device__ __forceinline__ void stage_rc(int b, int& R, int& C) { const int st = b / 1024, sb = b % 1024, swz = sb ^ (((sb >> 9) & 1) << 5); R = (st >> 1) * 16 + swz / 64; C = (st & 1) * 32 + (swz % 64) / 2; }
__host__ __device__ __forceinline__ int perm32(int rho) { const int n = rho >> 4, i = rho & 15; return 8 * (i >> 2) + 4 * n + (i & 3); }

__device__ __forceinline__ int lane_now() { int l; asm volatile("v_mbcnt_lo_u32_b32 %0, -1, 0\n\tv_mbcnt_hi_u32_b32 %0, -1, %0" : "=v"(l)); return l; }
constexpr int GATH_LDS_OFF = 148480;
struct Unit { int pm, pn, pb, e, mt; };
struct Gemm { const bf16_t* A; const bf16_t* Bt; int M, N, K; };

struct StaticOrder {
    int nM, nN, nwg, G, c;
    __host__ __device__ void init(int M, int N, int G_, int c_) { nM = M / BM; nN = N / BM; nwg = nM * nN; G = G_; c = c_; }
    __host__ __device__ bool next(int i, Unit& u) const {
        const long L = (long)i * G + c; if (L >= nwg) return false;
        int wgid = (int)L; { const int q = nwg / NXCD, r = nwg % NXCD, xcd = wgid % NXCD, off = wgid / NXCD; wgid = (xcd < r ? xcd * (q + 1) : r * (q + 1) + (xcd - r) * q) + off; }
        const int nig = WGM * nN, gid = wgid / nig, fm = gid * WGM, gsz = (nM - fm) < WGM ? (nM - fm) : WGM;
        u.pm = fm + ((wgid % nig) % gsz); u.pn = (wgid % nig) / gsz; u.pb = u.pn; u.e = 0; u.mt = 0; return true;
    }
    static constexpr bool GATHER = false;
    __device__ __forceinline__ void a_ready(const Unit&) const {}
    __device__ __forceinline__ void done(const Unit&) const {}
};

__device__ __forceinline__ unsigned cvt_pk_bf16(float lo, float hi) { typedef float f32x2_t_ __attribute__((ext_vector_type(2))); typedef __bf16 bf16x2_t_ __attribute__((ext_vector_type(2))); const f32x2_t_ v_ = {lo, hi}; return __builtin_bit_cast(unsigned, __builtin_convertvector(v_, bf16x2_t_)); }
struct EpiProj {
    static constexpr bool PERM = true, AFTER_DRAIN = false;
    unsigned char* ws; float qscale;
    __device__ __forceinline__ void operator()(const f32x4 (&acc)[2][2][4][2], const Unit& u, int wr, int wc, int fr, int fq) const {
        { const int ln_ = lane_now(); fr = ln_ & 15; fq = ln_ >> 4; }
        const int pn = u.pn;
        const int t = (pn - 6) >> 1;
        const bool a = pn < 6;
        const size_t off = a ? ((size_t)160 << 20) : (((size_t)256 + 32 * (size_t)t) << 20);
        const bool hm = !a && t >= 1;
        const int colt = a ? pn * 256 : ((pn - 6) & 1) * 256;
        const float sc = (t == 1 && !a) ? qscale : 1.f;
        const int row0 = u.pm * BM + wr * 64 + fr, col0 = colt + wc * 32 + 8 * fq;
        const int rowe = row0 & 4095, bq = row0 >> 12;
        const int ldc = a ? 384 : (hm ? 64 : 128);
        const int hh = hm ? (col0 >> 6) : ((col0 >> 7) & 3), nh = hm ? 8 : 4;
        const size_t cole = (size_t)(bq * nh + hh) * 4096 * ldc + (a ? (size_t)(col0 >> 9) * 128 : (size_t)0) + (size_t)(hm ? (col0 & 63) : (col0 & 127));
        const size_t bjstep = (size_t)(hm ? 2 : 1) * 4096 * ldc;
        bf16_t* base = (bf16_t*)(ws + off);
#pragma unroll
        for (int ai = 0; ai < 2; ++ai)
#pragma unroll
            for (int m = 0; m < 4; ++m) { bf16_t* rowp = base + (size_t)(rowe + ai * HALF + m * 16) * ldc + cole;
#pragma unroll
                for (int bj = 0; bj < 2; ++bj) { const f32x4 v0 = acc[ai][bj][m][0] * sc, v1 = acc[ai][bj][m][1] * sc;
                    u32x4 w; w.x = cvt_pk_bf16(v0[0], v0[1]); w.y = cvt_pk_bf16(v0[2], v0[3]); w.z = cvt_pk_bf16(v1[0], v1[1]); w.w = cvt_pk_bf16(v1[2], v1[3]);
                    *(u32x4*)(rowp + bj * bjstep) = w; } }
    }
};

struct EpiRes {
    static constexpr bool PERM = true, AFTER_DRAIN = false;
    const float* x; const float* mod; bf16_t* out; int gate_off;
    __device__ __forceinline__ void operator()(const f32x4 (&acc)[2][2][4][2], const Unit& u, int wr, int wc, int fr, int fq) const {
        { const int ln_ = lane_now(); fr = ln_ & 15; fq = ln_ >> 4; }
        const int col0 = u.pn * BM + wc * 32 + 8 * fq, b = (u.pm * BM) >> 12;
#pragma unroll
        for (int bj = 0; bj < 2; ++bj) {
            const f32x4 g0 = *(const f32x4*)(mod + b * 6144 + gate_off + col0 + bj * HALF), g1 = *(const f32x4*)(mod + b * 6144 + gate_off + col0 + bj * HALF + 4);
#pragma unroll
            for (int ai = 0; ai < 2; ++ai) {
                f32x4 xv[4][2];
#pragma unroll
                for (int m = 0; m < 4; ++m) { const size_t off = (size_t)(u.pm * BM + ai * HALF + wr * 64 + m * 16 + fr) * 1024 + col0 + bj * HALF;
                    xv[m][0] = *(const f32x4*)(x + off); xv[m][1] = *(const f32x4*)(x + off + 4); }
#pragma unroll
                for (int m = 0; m < 4; ++m) { const size_t off = (size_t)(u.pm * BM + ai * HALF + wr * 64 + m * 16 + fr) * 1024 + col0 + bj * HALF;
                    const f32x4 v0 = xv[m][0] + g0 * acc[ai][bj][m][0], v1 = xv[m][1] + g1 * acc[ai][bj][m][1];
                    u32x4 w; w.x = cvt_pk_bf16(v0[0], v0[1]); w.y = cvt_pk_bf16(v0[2], v0[3]); w.z = cvt_pk_bf16(v1[0], v1[1]); w.w = cvt_pk_bf16(v1[2], v1[3]);
                    *(u32x4*)(out + off) = w; }
            }
            asm volatile("" ::: "memory"); }
    }
};
__device__ __forceinline__ float silu_f(float v) { return v * __builtin_amdgcn_rcpf(1.f + __builtin_amdgcn_exp2f(-1.4426950408889634f * v)); }
struct EpiHid {
    static constexpr bool PERM = true, AFTER_DRAIN = false;
    bf16_t* hid; int hid_bytes;
    __device__ __forceinline__ void operator()(const f32x4 (&acc)[2][2][4][2], const Unit& u, int wr, int wc, int fr, int fq) const {
        { const int ln_ = lane_now(); fr = ln_ & 15; fq = ln_ >> 4; }
        const __amdgpu_buffer_rsrc_t rs = __builtin_amdgcn_make_buffer_rsrc((void*)hid, 0, hid_bytes, 0x00020000);
        const int col0 = u.pn * HALF + wc * 32 + 8 * fq;
#pragma unroll
        for (int ai = 0; ai < 2; ++ai)
#pragma unroll
            for (int m = 0; m < 4; ++m) { const size_t row = (size_t)u.pm * BM + ai * HALF + wr * 64 + m * 16 + fr;
                const f32x4 g0 = acc[ai][0][m][0], g1 = acc[ai][0][m][1], u0 = acc[ai][1][m][0], u1 = acc[ai][1][m][1];
                u32x4 w; w.x = cvt_pk_bf16(silu_f(g0[0]) * u0[0], silu_f(g0[1]) * u0[1]); w.y = cvt_pk_bf16(silu_f(g0[2]) * u0[2], silu_f(g0[3]) * u0[3]);
                w.z = cvt_pk_bf16(silu_f(g1[0]) * u1[0], silu_f(g1[1]) * u1[1]); w.w = cvt_pk_bf16(silu_f(g1[2]) * u1[2], silu_f(g1[3]) * u1[3]);
                __builtin_amdgcn_raw_buffer_store_b128(w, rs, (unsigned)((row * 256 + col0) * 2), 0,   16); }
    }
};
struct EpiYs {
    static constexpr bool PERM = true, AFTER_DRAIN = false;
    bf16_t* ys; const float* lw; const PG8_LAS int* cnt; int cap;
    __device__ __forceinline__ void operator()(const f32x4 (&acc)[2][2][4][2], const Unit& u, int wr, int wc, int fr, int fq) const {
        { const int ln_ = lane_now(); fr = ln_ & 15; fq = ln_ >> 4; }
        const int col0 = u.pn * BM + wc * 32 + 8 * fq, n_e = cnt[u.e];
#pragma unroll
        for (int ai = 0; ai < 2; ++ai)
#pragma unroll
            for (int m = 0; m < 4; ++m) { const int rl = u.mt * BM + ai * HALF + wr * 64 + m * 16 + fr;
                const float wv = rl < n_e ? lw[(size_t)u.e * cap + rl] : 0.f;
                bf16_t* rowp = ys + ((size_t)u.pm * BM + ai * HALF + wr * 64 + m * 16 + fr) * 1024 + col0;
#pragma unroll
                for (int bj = 0; bj < 2; ++bj) { const f32x4 v0 = acc[ai][bj][m][0] * wv, v1 = acc[ai][bj][m][1] * wv;
                    u32x4 w; w.x = cvt_pk_bf16(v0[0], v0[1]); w.y = cvt_pk_bf16(v0[2], v0[3]); w.z = cvt_pk_bf16(v1[0], v1[1]); w.w = cvt_pk_bf16(v1[2], v1[3]);
                    *(u32x4*)(rowp + bj * HALF) = w; } }
    }
};
template <bool GATHER_, int NPN> struct MoeOrder {
    static constexpr bool GATHER = GATHER_;
    const PG8_LAS int* tpre; const PG8_LAS int* cnt; const int* ltok; int cap, G, c; unsigned* tcnt; int wave;
    __device__ __forceinline__ bool next(int i, Unit& u) const {
        const int NT = __builtin_amdgcn_readfirstlane(tpre[32]); int L;
        if constexpr (GATHER) { L = i * G + c; }
        else { const int x = (2 * NT) % G, F = G - x;
            if (c >= x) L = i < 2 ? (c - x) + i * F : 2 * F + (i - 2) * G + (c - x);
            else L = 2 * F + i * G + F + c; }
        if (L >= NT * NPN) return false;
        const int tt = L / NPN, pn = L % NPN; int e = 0;
#pragma unroll
        for (int k = 1; k < 32; ++k) e += (tt >= tpre[k]) ? 1 : 0;
        e = __builtin_amdgcn_readfirstlane(e);
        u.pm = tt; u.pn = pn; u.e = e; u.mt = tt - __builtin_amdgcn_readfirstlane(tpre[e]); u.pb = e * NPN + pn; return true;
    }
    __device__ __forceinline__ void avoff(const Unit& u, int tid, int K, unsigned (&v0)[2], unsigned (&v1)[2]) const {
        const int n_e = cnt[u.e];
#pragma unroll
        for (int i = 0; i < 2; ++i) { int R, C; stage_rc(tid * 16 + i * 8192, R, C); const int r0 = u.mt * BM + R, r1 = r0 + HALF;
            const int t0 = ltok[(size_t)u.e * cap + (r0 < n_e ? r0 : 0)], t1 = ltok[(size_t)u.e * cap + (r1 < n_e ? r1 : 0)];
            v0[i] = (unsigned)(t0 * K + C) * 2u; v1[i] = (unsigned)(t1 * K + C) * 2u; }
    }
    __device__ __forceinline__ void a_ready(const Unit& u) const {
        if constexpr (!GATHER) {
            if (wave == 0 && lane_now() == 0) {
                unsigned sp = 0u;
                while (__hip_atomic_load(tcnt + u.pm, __ATOMIC_RELAXED, __HIP_MEMORY_SCOPE_AGENT) < 2u && ++sp < (1u << 22)) __builtin_amdgcn_s_sleep(1);
                __builtin_amdgcn_fence(__ATOMIC_ACQUIRE, "agent"); asm volatile("s_waitcnt vmcnt(0)" ::: "memory"); }
            __builtin_amdgcn_s_barrier();
        }
    }
    __device__ __forceinline__ void done(const Unit& u) const {
        if constexpr (GATHER) {
            asm volatile("s_waitcnt vmcnt(0)" ::: "memory");
            __builtin_amdgcn_s_barrier();
            if (wave == 0 && lane_now() == 0) (void)__hip_atomic_fetch_add(tcnt + u.pm, 1u, __ATOMIC_RELAXED, __HIP_MEMORY_SCOPE_AGENT);
        }
    }
};
template <class Epi, class Sched, bool ALIGN_EPI = false, bool SP2 = false>
__device__ __forceinline__ void gemm_phase(PG8_LAS unsigned char* lds, const Gemm g, const Sched& S, const Epi& E, int wave_sgpr) {
    const int wid = __builtin_amdgcn_readfirstlane(wave_sgpr), lane = lane_now(), tid = wid * 64 + lane, wr = wid >> 2, wc = wid & 3, fr = lane & 15, fq = lane >> 4;
    const int K = g.K, nt = K / BK;
    unsigned voffA[2], voffB[2];
#pragma unroll
    for (int i = 0; i < 2; ++i) { int R, C; stage_rc(tid * 16 + i * 8192, R, C); const int Rb = Epi::PERM ? ((R & ~31) + perm32(R & 31)) : R;
        voffA[i] = (unsigned)(R * K + C) * 2u; voffB[i] = (unsigned)(Rb * K + C) * 2u; }
    const size_t kstep = (size_t)(BK * 2);
    const size_t hstep = (size_t)HALF * K * 2;
    const size_t tstep = 2 * hstep;
    const unsigned ldsw = (unsigned)wid * 1024u;
    const int aoff = lds_byte(wr * 64 + fr, fq * 8), boff = lds_byte(wc * 32 + fr, fq * 8);
#define PG8_SA(b, h) (((b) * 2 + (h)) * HTB)
#define PG8_SB(b, h) ((4 + (b) * 2 + (h)) * HTB)
#define PG8_STAGE(bufoff, gbase, voff) do { _Pragma("unroll") for (int _i = 0; _i < 2; ++_i) \
        __builtin_amdgcn_global_load_lds((const unsigned*)((const char*)(gbase) + (voff)[_i]), (PG8_LAS unsigned*)(lds + (bufoff) + ldsw + _i * 8192), 16, 0, 0); } while (0)
#define PG8_STAGE_A(bufoff, kptr, h, nxtsel) do { if constexpr (Sched::GATHER) { unsigned _v[2]; _v[0] = cv##h[0]; _v[1] = cv##h[1]; \
            if (nxtsel) { const u32x4 _p = *(const PG8_LAS u32x4*)(lds + GATH_LDS_OFF + tid * 16); _v[0] = (h) ? _p.z : _p.x; _v[1] = (h) ? _p.w : _p.y; } PG8_STAGE(bufoff, kptr, _v); } \
        else { PG8_STAGE(bufoff, (kptr) + (h) * hstep, voffA); } } while (0)
#define PG8_LDA(dst, b, h) do { _Pragma("unroll") for (int m = 0; m < 4; ++m) _Pragma("unroll") for (int k = 0; k < 2; ++k) dst[m][k] = *(const PG8_LAS bf16x8*)(lds + PG8_SA(b, h) + aoff + m * 2048 + k * 1024); } while (0)
#define PG8_LDB(dst, b, h) do { _Pragma("unroll") for (int n = 0; n < 2; ++n) _Pragma("unroll") for (int k = 0; k < 2; ++k) dst[n][k] = *(const PG8_LAS bf16x8*)(lds + PG8_SB(b, h) + boff + n * 2048 + k * 1024); } while (0)
#define PG8_MMA(ai, bj, At, Bt) do { __builtin_amdgcn_s_setprio(1); _Pragma("unroll") for (int m = 0; m < 4; ++m) _Pragma("unroll") for (int n = 0; n < 2; ++n) _Pragma("unroll") for (int k = 0; k < 2; ++k) \
        acc[ai][bj][m][n] = __builtin_amdgcn_mfma_f32_16x16x32_bf16(Bt[n][k], At[m][k], acc[ai][bj][m][n], 0, 0, 0); __builtin_amdgcn_s_setprio(0); } while (0)
#define PG8_WAIT_V(n) asm volatile("s_waitcnt vmcnt(" #n ")" ::: "memory")
#define PG8_WAIT_L(n) asm volatile("s_waitcnt lgkmcnt(" #n ")" ::: "memory")
#define PG8_BAR __builtin_amdgcn_s_barrier()
#define PG8_SCHED __builtin_amdgcn_sched_barrier(0)
    Unit cur, nxt; int ui = 0;
    if (!S.next(0, cur)) return;
    f32x4 acc[2][2][4][2];
#pragma unroll
    for (int a = 0; a < 2; ++a)
#pragma unroll
        for (int b = 0; b < 2; ++b)
#pragma unroll
            for (int m = 0; m < 4; ++m)
#pragma unroll
                for (int n = 0; n < 2; ++n) acc[a][b][m][n] = (f32x4){0.f, 0.f, 0.f, 0.f};
    bf16x8 At[4][2], B0[2][2], B1[2][2];
    const char* cA = (const char*)g.A + (Sched::GATHER ? (size_t)0 : (size_t)cur.pm * tstep); const char* cB = (const char*)g.Bt + (size_t)cur.pb * tstep;
    unsigned cv0[2] = {0u, 0u}, cv1[2] = {0u, 0u};
    if constexpr (Sched::GATHER) S.avoff(cur, tid, K, cv0, cv1);
    S.a_ready(cur);
    if constexpr (SP2) {
        PG8_STAGE(PG8_SB(0, 0), cB, voffB); PG8_STAGE(PG8_SB(0, 1), cB + hstep, voffB); PG8_STAGE_A(PG8_SA(0, 0), cA, 0, false); PG8_STAGE_A(PG8_SA(0, 1), cA, 1, false);
        if (wr == 1) PG8_BAR;
        PG8_WAIT_V(2); PG8_BAR;
        PG8_STAGE(PG8_SB(1, 0), cB + kstep, voffB); PG8_STAGE_A(PG8_SA(1, 0), cA + kstep, 0, false); PG8_STAGE(PG8_SB(1, 1), cB + hstep + kstep, voffB);
        PG8_WAIT_V(6); PG8_BAR;
    } else {
        PG8_STAGE(PG8_SB(0, 0), cB, voffB); PG8_STAGE_A(PG8_SA(0, 0), cA, 0, false); PG8_STAGE(PG8_SB(0, 1), cB + hstep, voffB); PG8_STAGE_A(PG8_SA(0, 1), cA, 1, false);
        if (wr == 1) PG8_BAR;
        PG8_WAIT_V(4); PG8_BAR;
        PG8_STAGE(PG8_SB(1, 0), cB + kstep, voffB); PG8_STAGE_A(PG8_SA(1, 0), cA + kstep, 0, false); PG8_STAGE(PG8_SB(1, 1), cB + hstep + kstep, voffB);
        PG8_WAIT_V(6); PG8_BAR;
    }
    for (;;) {
        const bool has_next = S.next(ui + 1, nxt);
        if (has_next) S.a_ready(nxt);
        const char* nA = has_next ? (const char*)g.A + (Sched::GATHER ? (size_t)0 : (size_t)nxt.pm * tstep) : cA; const char* nB = has_next ? (const char*)g.Bt + (size_t)nxt.pb * tstep : cB;
        if constexpr (Sched::GATHER) { unsigned nv0[2], nv1[2];
            if (has_next) S.avoff(nxt, tid, K, nv0, nv1); else { nv0[0] = cv0[0]; nv0[1] = cv0[1]; nv1[0] = cv1[0]; nv1[1] = cv1[1]; }
            *(PG8_LAS u32x4*)(lds + GATH_LDS_OFF + tid * 16) = (u32x4){nv0[0], nv0[1], nv1[0], nv1[1]}; }
        for (int t = 0; t < nt; t += 2) {
            const bool last = (t == nt - 2);
            const char* a1 = cA + (size_t)(t + 1) * kstep;
            const char* a2 = last ? nA : cA + (size_t)(t + 2) * kstep; const char* b2 = last ? nB : cB + (size_t)(t + 2) * kstep;
            const char* a3 = a2 + kstep; const char* b3 = b2 + kstep;
            if constexpr (SP2) {
            PG8_LDB(B0, 0, 0); PG8_LDB(B1, 0, 1); PG8_SCHED; PG8_LDA(At, 0, 0); PG8_STAGE_A(PG8_SA(1, 1), a1, 1, false);
            PG8_WAIT_V(8); PG8_WAIT_L(0); PG8_BAR; PG8_MMA(0, 0, At, B0); PG8_MMA(0, 1, At, B1); PG8_BAR; PG8_SCHED;
            PG8_LDA(At, 0, 1); PG8_STAGE(PG8_SB(0, 0), b2, voffB); PG8_STAGE(PG8_SB(0, 1), b2 + hstep, voffB); PG8_STAGE_A(PG8_SA(0, 0), a2, 0, last);
            PG8_WAIT_V(8); PG8_WAIT_L(0); PG8_BAR; PG8_MMA(1, 0, At, B0); PG8_MMA(1, 1, At, B1); PG8_BAR; PG8_SCHED;
            PG8_LDB(B0, 1, 0); PG8_LDB(B1, 1, 1); PG8_SCHED; PG8_LDA(At, 1, 0); PG8_STAGE_A(PG8_SA(0, 1), a2, 1, last);
            PG8_WAIT_V(8); PG8_WAIT_L(0); PG8_BAR; PG8_MMA(0, 0, At, B0); PG8_MMA(0, 1, At, B1); PG8_BAR; PG8_SCHED;
            PG8_LDA(At, 1, 1); PG8_STAGE(PG8_SB(1, 0), b3, voffB); PG8_STAGE(PG8_SB(1, 1), b3 + hstep, voffB); PG8_STAGE_A(PG8_SA(1, 0), a3, 0, last);
            PG8_WAIT_V(8); PG8_WAIT_L(0); PG8_BAR; PG8_MMA(1, 0, At, B0); PG8_MMA(1, 1, At, B1); PG8_BAR; PG8_SCHED;
            } else {
            PG8_LDB(B0, 0, 0); PG8_SCHED; PG8_LDA(At, 0, 0); PG8_STAGE_A(PG8_SA(1, 1), a1, 1, false);
            PG8_WAIT_L(8); PG8_BAR; PG8_WAIT_L(0); PG8_MMA(0, 0, At, B0); PG8_BAR; PG8_SCHED;
            PG8_LDB(B1, 0, 1); PG8_STAGE(PG8_SB(0, 0), b2, voffB);
            PG8_BAR; PG8_WAIT_L(0); PG8_MMA(0, 1, At, B1); PG8_BAR;
            PG8_LDA(At, 0, 1); PG8_STAGE_A(PG8_SA(0, 0), a2, 0, last);
            PG8_BAR; PG8_WAIT_L(0); PG8_MMA(1, 0, At, B0); PG8_BAR; PG8_SCHED;
            PG8_STAGE(PG8_SB(0, 1), b2 + hstep, voffB);
            PG8_WAIT_V(6); PG8_BAR; PG8_MMA(1, 1, At, B1); PG8_BAR;
            PG8_LDB(B0, 1, 0); PG8_SCHED; PG8_LDA(At, 1, 0); PG8_STAGE_A(PG8_SA(0, 1), a2, 1, last);
            PG8_WAIT_L(8); PG8_BAR; PG8_WAIT_L(0); PG8_MMA(0, 0, At, B0); PG8_BAR; PG8_SCHED;
            PG8_LDB(B1, 1, 1); PG8_STAGE(PG8_SB(1, 0), b3, voffB);
            PG8_BAR; PG8_WAIT_L(0); PG8_MMA(0, 1, At, B1); PG8_BAR;
            PG8_LDA(At, 1, 1); PG8_STAGE_A(PG8_SA(1, 0), a3, 0, last);
            PG8_BAR; PG8_WAIT_L(0); PG8_MMA(1, 0, At, B0); PG8_BAR; PG8_SCHED;
            PG8_STAGE(PG8_SB(1, 1), b3 + hstep, voffB);
            PG8_WAIT_V(6); PG8_BAR; PG8_MMA(1, 1, At, B1); PG8_BAR;
            }
        }
        if constexpr (ALIGN_EPI) { if (wr == 0) PG8_BAR; }
        if constexpr (!Epi::AFTER_DRAIN) { E(acc, cur, wr, wc, fr, fq); S.done(cur); }
        if (!has_next) break;
#pragma unroll
        for (int a = 0; a < 2; ++a)
#pragma unroll
            for (int b = 0; b < 2; ++b)
#pragma unroll
                for (int m = 0; m < 4; ++m)
#pragma unroll
                    for (int n = 0; n < 2; ++n) acc[a][b][m][n] = (f32x4){0.f, 0.f, 0.f, 0.f};
        cur = nxt; cA = nA; cB = nB; ++ui; if constexpr (Sched::GATHER) { const u32x4 _p = *(const PG8_LAS u32x4*)(lds + GATH_LDS_OFF + tid * 16); cv0[0] = _p.x; cv0[1] = _p.y; cv1[0] = _p.z; cv1[1] = _p.w; }
        if constexpr (ALIGN_EPI) { if (wr == 1) PG8_BAR; }
    }
    PG8_WAIT_V(0);
    if constexpr (!ALIGN_EPI) { if (wr == 0) PG8_BAR; }
    PG8_BAR;
    if constexpr (Epi::AFTER_DRAIN) { E.fused(acc, cur, wr, wc, fr, fq, lds, wid, lane); S.done(cur); }
#undef PG8_SA
#undef PG8_SB
#undef PG8_STAGE
#undef PG8_STAGE_A
#undef PG8_LDA
#undef PG8_LDB
#undef PG8_MMA
#undef PG8_WAIT_V
#undef PG8_WAIT_L
#undef PG8_BAR
#undef PG8_SCHED
}
}

constexpr int NWAVES = 8;
constexpr int D = 1024, BATCH = 8, SEQ = 4096, T = BATCH * SEQ;
constexpr int IN_COLS = 3592, NPROJ = 3584, NEXP = 32, DEXP = 256, CAP = 65536;
constexpr float EPS = 1e-6f;
constexpr size_t MiB = 1u << 20;
constexpr size_t WS_CTL = 0, CTL_ZERO_BYTES = 1 * MiB;
constexpr size_t WS_MOD = 1 * MiB;
constexpr size_t WS_BG = 2 * MiB;
constexpr size_t WS_TOKSLOT = 3 * MiB;
constexpr size_t WS_WRT = 6 * MiB;
constexpr size_t WS_WIN = 8 * MiB;
constexpr size_t WS_WOUT = 15 * MiB;
constexpr size_t WS_WGU = 32 * MiB;
constexpr size_t WS_WDN = 64 * MiB;
constexpr size_t WS_LTOK = 80 * MiB;
constexpr size_t WS_LW = 88 * MiB;
constexpr size_t WS_H = 96 * MiB;
constexpr size_t WS_QKVA = 160 * MiB;
constexpr size_t WS_Z = 256 * MiB;
constexpr size_t WS_QB = 288 * MiB, WS_KB = 320 * MiB, WS_VB = 352 * MiB;
constexpr size_t WS_Y = 384 * MiB;
constexpr int PROWS = 65536 + 32 * 256;
constexpr size_t WS_HID = 448 * MiB;
constexpr size_t WS_YS = 160 * MiB;
constexpr size_t WS_PART0 = 96 * MiB, WS_PART1 = 128 * MiB, WS_PART2 = 448 * MiB;
constexpr size_t WS_LSE = 480 * MiB;
constexpr size_t WS_GAQK = 484 * MiB;
constexpr size_t WS_GGL = 500 * MiB;
constexpr size_t WS_XM = 320 * MiB;
constexpr size_t WS_NEED = 512 * MiB;
static_assert(WS_QKVA == (size_t)160 << 20 && WS_Z == (size_t)256 << 20 && WS_QB == (size_t)288 << 20 && WS_KB == (size_t)320 << 20 && WS_VB == (size_t)352 << 20, "EpiProj offsets");
constexpr int CW_MODF = 992;
constexpr int CW_ATTQ = 2048;
constexpr int CW_TCNT = 2560;
constexpr int CW_CNT = 1024;
constexpr int CW_BAR = 4096;

constexpr int RING_OFF = 0, RING_BYTES = 131072;
constexpr int PHASE_LDS = 147456;
constexpr int LDSCTL_OFF = PHASE_LDS, MISC_OFF = LDSCTL_OFF + 320, MOE_OFF = MISC_OFF + 128;
constexpr int LDS_BYTES = 163840;
static_assert(RING_OFF == 0 && MOE_OFF + 512 <= pg8::GATH_LDS_OFF && pg8::GATH_LDS_OFF + 8192 <= LDS_BYTES, "LDS map");

#define GAS __attribute__((address_space(1)))
#define LAS __attribute__((address_space(3)))
typedef unsigned short bf16;
typedef unsigned v4u __attribute__((ext_vector_type(4)));
typedef float f32x4 __attribute__((ext_vector_type(4)));
typedef short bf16x8 __attribute__((ext_vector_type(8)));
typedef GAS unsigned gu32;
typedef GAS unsigned long long gu64;
#define RLX_AGENT __ATOMIC_RELAXED, __HIP_MEMORY_SCOPE_AGENT
#define LDS_WAIT() asm volatile("s_waitcnt lgkmcnt(0)" ::: "memory")
#define VM_WAIT() asm volatile("s_waitcnt vmcnt(0)" ::: "memory")
__device__ __forceinline__ unsigned long long rt() { return __builtin_amdgcn_s_memrealtime(); }
__device__ __forceinline__ unsigned f2bf(float f) { unsigned u = __builtin_bit_cast(unsigned, f); return (u + 0x7fffu + ((u >> 16) & 1u)) >> 16; }
__device__ __forceinline__ unsigned pk2(float lo, float hi) { return f2bf(lo) | (f2bf(hi) << 16); }

#define XB_TMO      128
#define XB_XCNT(j)  (256  + 64 * (j))
#define XB_XSUB(j)  (1280 + 64 * (j))
#define XB_XGEN(j)  (2304 + 64 * (j))
#define XB_TOP      3328
#define XB_TOPGEN   3392
#define XCD_BAR_WORDS 3456
#define XB_SPIN_CAP (1u << 18)

__device__ __forceinline__ unsigned xb_ld(unsigned* p)              { return __hip_atomic_load(p, __ATOMIC_RELAXED, __HIP_MEMORY_SCOPE_AGENT); }
__device__ __forceinline__ unsigned xb_add(unsigned* p, unsigned v) { return __hip_atomic_fetch_add(p, v, __ATOMIC_RELAXED, __HIP_MEMORY_SCOPE_AGENT); }
__device__ __forceinline__ unsigned xb_xcc_id() { return (unsigned)__builtin_amdgcn_s_getreg((3 << 11) | 20) & 0xFu; }
#define XB_SPIN(cond, bar) do { unsigned _sp = 0; while (cond) { __builtin_amdgcn_s_sleep(1); \
    if ((++_sp & 255u) == 0u) { if (xb_ld(&(bar)[XB_TMO])) break; if (_sp > XB_SPIN_CAP) { atomicAdd(&(bar)[XB_TMO], 1u); break; } } } } while (0)

struct XcdBarrier {
    unsigned* bar; unsigned x; int wave;
    volatile LAS unsigned* st;
};

__device__ __forceinline__ XcdBarrier xcd_barrier_post(unsigned* bar, volatile LAS unsigned* st, int wave) {
    XcdBarrier b; b.bar = bar; b.x = xb_xcc_id(); b.st = st; b.wave = wave;
    if (wave == 0 && pg8::lane_now() == 0) (void)xb_add(&bar[XB_XCNT(b.x)], 1u);
    return b;
}
__device__ __forceinline__ void xcd_barrier_complete(unsigned* bar, unsigned x, unsigned& nloc, unsigned& nx) {
    const unsigned G = gridDim.x * gridDim.y * gridDim.z;
    unsigned sum, cnt, mine, sp = 0u;
    for (;;) {
        sum = 0u; cnt = 0u; mine = 0u;
#pragma unroll
        for (unsigned j = 0; j < 16; ++j) { const unsigned c = xb_ld(&bar[XB_XCNT(j)]); sum += c; cnt += (c > 0u) ? 1u : 0u; mine = (j == x) ? c : mine; }
        if (sum == G) break;
        __builtin_amdgcn_s_sleep(1);
        if ((++sp & 255u) == 0u) { if (xb_ld(&bar[XB_TMO])) break; if (sp > XB_SPIN_CAP) { atomicAdd(&bar[XB_TMO], 1u); break; } }
    }
    nloc = mine > 0u ? mine : 1u; nx = cnt > 0u ? cnt : 1u;
}

__device__ __forceinline__ void xcd_barrier(const XcdBarrier& b) {
    asm volatile("s_waitcnt vmcnt(0)" ::: "memory");
    __syncthreads();
    if (b.wave == 0 && pg8::lane_now() == 0) {
        unsigned* bar = b.bar;
        __builtin_amdgcn_s_waitcnt(0);
        unsigned nloc = b.st[0], nx = b.st[1];
        if (nloc == 0u) { xcd_barrier_complete(bar, b.x, nloc, nx); b.st[0] = nloc; b.st[1] = nx; }
        const unsigned old = xb_add(&bar[XB_XSUB(b.x)], 1u);
        const unsigned gen = old / nloc;
        if (old + 1u == (gen + 1u) * nloc) {
            __builtin_amdgcn_fence(__ATOMIC_RELEASE, "agent");
            asm volatile("s_waitcnt vmcnt(0)" ::: "memory");
            const unsigned og = xb_add(&bar[XB_TOP], 1u);
            const unsigned tg = og / nx;
            if (og + 1u == (tg + 1u) * nx) xb_add(&bar[XB_TOPGEN], 1u);
            else XB_SPIN(xb_ld(&bar[XB_TOPGEN]) == tg, bar);
            __builtin_amdgcn_fence(__ATOMIC_ACQUIRE, "agent");
            xb_add(&bar[XB_XGEN(b.x)], 1u);
            asm volatile("s_waitcnt vmcnt(0)" ::: "memory");
        } else {
            XB_SPIN(xb_ld(&bar[XB_XGEN(b.x)]) == gen, bar);
            __builtin_amdgcn_fence(__ATOMIC_ACQUIRE, "agent");
            asm volatile("s_waitcnt vmcnt(0)" ::: "memory");
        }
    }
    __syncthreads();
}

__device__ __forceinline__ float dpp_add(float v, const int ctrl_sel) {
    int r;
    if (ctrl_sel == 0) r = __builtin_amdgcn_mov_dpp(__builtin_bit_cast(int, v), 0xB1, 0xF, 0xF, false);
    else if (ctrl_sel == 1) r = __builtin_amdgcn_mov_dpp(__builtin_bit_cast(int, v), 0x4E, 0xF, 0xF, false);
    else if (ctrl_sel == 2) r = __builtin_amdgcn_mov_dpp(__builtin_bit_cast(int, v), 0x124, 0xF, 0xF, false);
    else r = __builtin_amdgcn_mov_dpp(__builtin_bit_cast(int, v), 0x128, 0xF, 0xF, false);
    return v + __builtin_bit_cast(float, r);
}
__device__ __forceinline__ float row16_sum(float v) { v = dpp_add(v, 0); v = dpp_add(v, 1); v = dpp_add(v, 2); v = dpp_add(v, 3); return v; }
__device__ __forceinline__ float wave_sum(float v) {
    v = row16_sum(v);
    v += __shfl_xor(v, 16);
    v += __shfl_xor(v, 32);
    return v;
}
__device__ __forceinline__ void p0_transpose_item(const float* W, int K, int N, bf16* WT, int row_off, LAS float* scr, int item, int lane) {
    const int nblk = N / 32, kb = item / nblk, nb = item % nblk, k0 = 64 * kb, n0 = 32 * nb;
#pragma unroll 8
    for (int i = 0; i < 32; ++i) { const int kk = 2 * i + (lane >> 5); scr[kk * 33 + (lane & 31)] = W[(size_t)(k0 + kk) * N + n0 + (lane & 31)]; }
    LDS_WAIT(); asm volatile("" ::: "memory");
    const int c = lane & 7;
#pragma unroll
    for (int j = 0; j < 4; ++j) { const int n = (lane >> 3) + 8 * j; const LAS float* s = scr + (8 * c) * 33 + n;
        v4u o; o.x = pk2(s[0 * 33], s[1 * 33]); o.y = pk2(s[2 * 33], s[3 * 33]); o.z = pk2(s[4 * 33], s[5 * 33]); o.w = pk2(s[6 * 33], s[7 * 33]);
        *(GAS v4u*)(WT + (size_t)(row_off + n0 + n) * K + k0 + 8 * c) = o; }
    LDS_WAIT(); asm volatile("" ::: "memory");
}

__device__ __forceinline__ float bf2f(bf16 v) { return __uint_as_float((unsigned)v << 16); }
__device__ __forceinline__ float siluf(float x) { return x / (1.f + __expf(-x)); }
__device__ __forceinline__ float sigmoidf(float x) { return 1.f / (1.f + __expf(-x)); }

struct Args { const float* in[20]; float* out; unsigned char* ws; int ph_lo, ph_hi, li, pad; };

struct Frame {
    LAS unsigned char* lds; volatile LAS unsigned* MISC; gu32* ctl;
    int wave, vcu, G;
};

__device__ __forceinline__ void transpose_item(const float* W, int K, int pitch, int ncols, bf16* WT, int row_off, LAS float* scr, int item, int lane) {
    const int nblk = ncols / 32, kb = item / nblk, nb = item % nblk, k0 = 64 * kb, n0 = 32 * nb;
#pragma unroll 8
    for (int i = 0; i < 32; ++i) { const int kk = 2 * i + (lane >> 5); scr[kk * 33 + (lane & 31)] = W[(size_t)(k0 + kk) * pitch + n0 + (lane & 31)]; }
    LDS_WAIT(); asm volatile("" ::: "memory");
    const int c = lane & 7;
#pragma unroll
    for (int j = 0; j < 4; ++j) { const int n = (lane >> 3) + 8 * j; const LAS float* s = scr + (8 * c) * 33 + n;
        v4u o; o.x = pk2(s[0 * 33], s[1 * 33]); o.y = pk2(s[2 * 33], s[3 * 33]); o.z = pk2(s[4 * 33], s[5 * 33]); o.w = pk2(s[6 * 33], s[7 * 33]);
        *(GAS v4u*)(WT + (size_t)(row_off + n0 + n) * K + k0 + 8 * c) = o; }
    LDS_WAIT(); asm volatile("" ::: "memory");
}

__device__ __forceinline__ void p0_phase(Frame& F, unsigned char* ws, const float* c, const float* w_ada, const float* b_ada, const float* w_in, const float* w_out, const float* w_gate, const float* w_up, const float* w_down, const float* w_rg, const float* w_re) {
    const int lane_ = pg8::lane_now(), tid_ = F.wave * 64 + lane_;
    float* mod = (float*)(ws + WS_MOD);
    if ((int)blockIdx.x < 192) {
        LAS float* cs = (LAS float*)(F.lds + RING_OFF);
        LAS float* red = cs + 8192;
        for (int i = tid_; i < 8192; i += NWAVES * 64) cs[i] = c[i];
        __syncthreads();
        for (int item = blockIdx.x; item < 192; item += F.G) {
            const int col = tid_ & 31, kq = tid_ >> 5, n = item * 32 + col;
            float acc[8];
#pragma unroll
            for (int b = 0; b < 8; ++b) acc[b] = 0.f;
            float wa[32], wb[32];
#pragma unroll
            for (int k = 0; k < 32; ++k) wa[k] = w_ada[(size_t)(kq * 64 + k) * 6144 + n];
#pragma unroll
            for (int k = 0; k < 32; ++k) wb[k] = w_ada[(size_t)(kq * 64 + 32 + k) * 6144 + n];
#pragma unroll
            for (int k = 0; k < 32; ++k) {
#pragma unroll
                for (int b = 0; b < 8; ++b) acc[b] += cs[b * D + kq * 64 + k] * wa[k]; }
#pragma unroll
            for (int k = 0; k < 32; ++k) {
#pragma unroll
                for (int b = 0; b < 8; ++b) acc[b] += cs[b * D + kq * 64 + 32 + k] * wb[k]; }
#pragma unroll
            for (int b = 0; b < 8; ++b) red[(kq * 8 + b) * 32 + col] = acc[b];
            __syncthreads();
            if (tid_ < 256) { const int b = tid_ >> 5; float s = 0.f;
#pragma unroll
              for (int q = 0; q < 16; ++q) s += red[(q * 8 + b) * 32 + col];
              mod[b * 6144 + n] = s + b_ada[n]; }
            __syncthreads();
        }
    }
    { bf16* wrt = (bf16*)(ws + WS_WRT);
      for (int i = blockIdx.x * (NWAVES * 64) + tid_; i < 48 * 1024; i += F.G * NWAVES * 64) { const int e = i >> 10, k = i & 1023;
          const float v = e < 4 ? w_rg[k * 4 + e] : (e < 36 ? w_re[k * 32 + e - 4] : 0.f); wrt[i] = (bf16)f2bf(v); } }
}
__device__ __forceinline__ void p0b_phase(Frame& F, unsigned char* ws, const float* w_in, const float* w_out, const float* w_gate, const float* w_up, const float* w_down) {
    const int lane_ = pg8::lane_now();
    LAS float* scr = (LAS float*)(F.lds + RING_OFF + F.wave * 16384);
    const int gw = F.vcu * NWAVES + F.wave, NGW = F.G * NWAVES;
    bf16* win_t = (bf16*)(ws + WS_WIN); bf16* wout_t = (bf16*)(ws + WS_WOUT); bf16* wgu_t = (bf16*)(ws + WS_WGU); bf16* wdn_t = (bf16*)(ws + WS_WDN);
    constexpr int I_A = 16 * 64, I_B = 16 * 48, I_C = 16 * 32, I_D = 32 * 256, I_E = 32 * 128, I_ALL = I_A + I_B + I_C + I_D + I_E;
#define P0_DECODE(it_, W_, K_, pitch_, ncols_, WT_, roff_, li_) do { int r = (it_); \
        if (r < I_A) { W_ = w_in; K_ = D; pitch_ = IN_COLS; ncols_ = 2048; WT_ = win_t; roff_ = 0; li_ = r; } \
        else if ((r -= I_A) < I_B) { W_ = w_in + 2056; K_ = D; pitch_ = IN_COLS; ncols_ = 1536; WT_ = win_t; roff_ = 2048; li_ = r; } \
        else if ((r -= I_B) < I_C) { W_ = w_out; K_ = D; pitch_ = D; ncols_ = D; WT_ = wout_t; roff_ = 0; li_ = r; } \
        else if ((r -= I_C) < I_D) { const int e = r >> 8, q = r & 255, piece = q >> 6; \
            W_ = (piece < 2 ? w_gate : w_up) + (size_t)e * D * DEXP + (piece & 1) * 128; K_ = D; pitch_ = DEXP; ncols_ = 128; WT_ = wgu_t + (size_t)e * 512 * D; roff_ = (piece & 1) * 256 + (piece >> 1) * 128; li_ = q & 63; } \
        else { r -= I_D; const int e = r >> 7; W_ = w_down + (size_t)e * DEXP * D; K_ = DEXP; pitch_ = D; ncols_ = D; WT_ = wdn_t + (size_t)e * D * DEXP; roff_ = 0; li_ = r & 127; } } while (0)
#define P0_LOAD(dst, W_, pitch_, ncols_, li_) do { const int nblk_ = (ncols_) / 32, k0_ = 64 * ((li_) / nblk_), n0_ = 32 * ((li_) % nblk_); \
        _Pragma("unroll") for (int i = 0; i < 32; ++i) dst[i] = (W_)[(size_t)(k0_ + 2 * i + (lane_ >> 5)) * (pitch_) + n0_ + (lane_ & 31)]; } while (0)
    float tv[32];
    const float* cW = nullptr; int cK = 0, cP = 0, cN = 32, cR = 0, cL = 0; bf16* cT = nullptr;
    if (gw < I_ALL) { P0_DECODE(gw, cW, cK, cP, cN, cT, cR, cL); P0_LOAD(tv, cW, cP, cN, cL); }
    for (int it = gw; it < I_ALL; it += NGW) {
#pragma unroll
        for (int i = 0; i < 32; ++i) scr[(2 * i + (lane_ >> 5)) * 33 + (lane_ & 31)] = tv[i];
        const int K = cK, roff = cR; bf16* WT = cT; const int nblk = cN / 32, k0 = 64 * (cL / nblk), n0 = 32 * (cL % nblk);
        if (it + NGW < I_ALL) { P0_DECODE(it + NGW, cW, cK, cP, cN, cT, cR, cL); P0_LOAD(tv, cW, cP, cN, cL); }
        LDS_WAIT(); asm volatile("" ::: "memory");
        const int c = lane_ & 7;
#pragma unroll
        for (int j = 0; j < 4; ++j) { const int n = (lane_ >> 3) + 8 * j; const LAS float* s = scr + (8 * c) * 33 + n;
            v4u o; o.x = pk2(s[0 * 33], s[1 * 33]); o.y = pk2(s[2 * 33], s[3 * 33]); o.z = pk2(s[4 * 33], s[5 * 33]); o.w = pk2(s[6 * 33], s[7 * 33]);
            *(GAS v4u*)(WT + (size_t)(roff + n0 + n) * K + k0 + 8 * c) = o; }
        LDS_WAIT(); asm volatile("" ::: "memory");
    }
#undef P0_DECODE
#undef P0_LOAD
}

__device__ __forceinline__ void p1_rows(f32x4 (&v)[2][4], int mb, int lane_, const f32x4 (&gm)[4], const f32x4 (&sh)[4], bf16* H, const LAS float* w8, float* bg, const float* a_log, const float* dt_bias) {
            float ss[2];
#pragma unroll
            for (int r = 0; r < 2; ++r) { float s = 0.f;
#pragma unroll
                for (int j = 0; j < 4; ++j) s += (v[r][j].x * v[r][j].x + v[r][j].y * v[r][j].y) + (v[r][j].z * v[r][j].z + v[r][j].w * v[r][j].w);
                ss[r] = s; }
#pragma unroll
    for (int r = 0; r < 2; ++r) ss[r] = wave_sum(ss[r]);
            float dots[2][8];
#pragma unroll
            for (int r = 0; r < 2; ++r)
#pragma unroll
                for (int q = 0; q < 8; ++q) dots[r][q] = 0.f;
#pragma unroll
            for (int r = 0; r < 2; ++r) { const float rs = rsqrtf(ss[r] * (1.f / D) + EPS);
                GAS unsigned long long* o8 = (GAS unsigned long long*)(H + (size_t)(mb + r) * D) + lane_;
#pragma unroll
                for (int j = 0; j < 4; ++j) { v[r][j] = v[r][j] * rs * gm[j] + sh[j];
                    o8[64 * j] = (unsigned long long)pk2(v[r][j].x, v[r][j].y) | ((unsigned long long)pk2(v[r][j].z, v[r][j].w) << 32); } }
            asm volatile("" ::: "memory");
#pragma unroll
            for (int j = 0; j < 4; ++j)
#pragma unroll
                for (int q = 0; q < 8; ++q) { const f32x4 w = *(const LAS f32x4*)(w8 + q * 1024 + 4 * lane_ + 256 * j);
#pragma unroll
                    for (int r = 0; r < 2; ++r) dots[r][q] += (v[r][j].x * w.x + v[r][j].y * w.y) + (v[r][j].z * w.z + v[r][j].w * w.w); }
#pragma unroll
            for (int r = 0; r < 2; ++r)
#pragma unroll
                for (int q = 0; q < 8; ++q) dots[r][q] = wave_sum(dots[r][q]);
            if (lane_ < 16) {
                const int r = lane_ >> 3, q = lane_ & 7;
                float raw = 0.f;
#pragma unroll
                for (int rr = 0; rr < 2; ++rr)
#pragma unroll
                    for (int qq = 0; qq < 8; ++qq) raw = (r == rr && q == qq) ? dots[rr][qq] : raw;
                float o;
                if (q < 4) o = sigmoidf(raw);
                else { const int hh = q - 4; const float xr2 = raw + dt_bias[hh]; const float sp = xr2 > 20.f ? xr2 : log1pf(expf(xr2)); o = -expf(a_log[hh]) * sp; }
                bg[(size_t)(mb + r) * 8 + q] = o;
            }
}
__device__ __forceinline__ void p1_phase(Frame& F, unsigned char* ws, const float* x, const float* norm_mix, const float* w_in, const float* a_log, const float* dt_bias) {
    const int lane_ = pg8::lane_now(), tid_ = F.wave * 64 + lane_;
    const float* mod = (const float*)(ws + WS_MOD); float* bg = (float*)(ws + WS_BG); bf16* H = (bf16*)(ws + WS_H);
    LAS float* w8 = (LAS float*)(F.lds + RING_OFF);
    for (int i = tid_; i < 8 * 1024; i += NWAVES * 64) { const int j = i >> 10, k = i & 1023; w8[i] = w_in[(size_t)k * IN_COLS + 2048 + j]; }
    __syncthreads();
    for (int tl = F.vcu * NWAVES + F.wave; tl < T / 16; tl += F.G * NWAVES) {
        const int m0 = tl * 16, bb = m0 >> 12;
        f32x4 gm[4], sh[4];
#pragma unroll
        for (int j = 0; j < 4; ++j) { const f32x4 g = ((const GAS f32x4*)norm_mix)[lane_ + 64 * j]; const f32x4 sc = ((const GAS f32x4*)(mod + bb * 6144 + 1024))[lane_ + 64 * j];
            sh[j] = ((const GAS f32x4*)(mod + bb * 6144))[lane_ + 64 * j]; gm[j] = g * (sc + 1.f); }
        f32x4 vA[2][4], vB[2][4], vC[2][4];
#define P1_LOAD(dst, mb_) do { _Pragma("unroll") for (int r = 0; r < 2; ++r) { const GAS f32x4* xr = (const GAS f32x4*)(x + (size_t)((mb_) + r) * D) + lane_; \
            _Pragma("unroll") for (int j = 0; j < 4; ++j) dst[r][j] = xr[64 * j]; } } while (0)
        P1_LOAD(vA, m0); P1_LOAD(vB, m0 + 2);
        P1_LOAD(vC, m0 + 4);  p1_rows(vA, m0, lane_, gm, sh, H, w8, bg, a_log, dt_bias);
        P1_LOAD(vA, m0 + 6);  p1_rows(vB, m0 + 2, lane_, gm, sh, H, w8, bg, a_log, dt_bias);
        P1_LOAD(vB, m0 + 8);  p1_rows(vC, m0 + 4, lane_, gm, sh, H, w8, bg, a_log, dt_bias);
        P1_LOAD(vC, m0 + 10); p1_rows(vA, m0 + 6, lane_, gm, sh, H, w8, bg, a_log, dt_bias);
        P1_LOAD(vA, m0 + 12); p1_rows(vB, m0 + 8, lane_, gm, sh, H, w8, bg, a_log, dt_bias);
        P1_LOAD(vB, m0 + 14); p1_rows(vC, m0 + 10, lane_, gm, sh, H, w8, bg, a_log, dt_bias);
        p1_rows(vA, m0 + 12, lane_, gm, sh, H, w8, bg, a_log, dt_bias);
        p1_rows(vB, m0 + 14, lane_, gm, sh, H, w8, bg, a_log, dt_bias);
#undef P1_LOAD
    }
}


__device__ __forceinline__ f32x4 bf4_to_f32(unsigned long long a) { f32x4 y; y.x = __uint_as_float((unsigned)(a & 0xFFFFu) << 16); y.y = __uint_as_float((unsigned)(a >> 16) << 16); y.z = __uint_as_float((unsigned)((a >> 32) & 0xFFFFu) << 16); y.w = __uint_as_float((unsigned)(a >> 48) << 16); return y; }
__device__ __forceinline__ void p7_rows(const unsigned long long (&raw)[2][4], int mb, int lane_, const f32x4 (&gm)[4], const f32x4 (&sh)[4], bf16* H) {
    float ss[2]; f32x4 v[2][4];
#pragma unroll
    for (int r = 0; r < 2; ++r)
#pragma unroll
        for (int j = 0; j < 4; ++j) v[r][j] = bf4_to_f32(raw[r][j]);
#pragma unroll
    for (int r = 0; r < 2; ++r) { float s = 0.f;
#pragma unroll
        for (int j = 0; j < 4; ++j) s += (v[r][j].x * v[r][j].x + v[r][j].y * v[r][j].y) + (v[r][j].z * v[r][j].z + v[r][j].w * v[r][j].w);
        ss[r] = s; }
#pragma unroll
    for (int r = 0; r < 2; ++r) ss[r] = wave_sum(ss[r]);
#pragma unroll
    for (int r = 0; r < 2; ++r) { const float rs = rsqrtf(ss[r] * (1.f / D) + EPS);
        GAS unsigned long long* o8 = (GAS unsigned long long*)(H + (size_t)(mb + r) * D) + lane_;
#pragma unroll
        for (int j = 0; j < 4; ++j) { const f32x4 h = v[r][j] * rs * gm[j] + sh[j];
            o8[64 * j] = (unsigned long long)pk2(h.x, h.y) | ((unsigned long long)pk2(h.z, h.w) << 32); } }
}
#if MK_PROF_A >= 110 && MK_PROF_A < 120
#define PROF7(idx) do { if (blockIdx.x == 0 && F.wave == 0 && pg8::lane_now() == 0) { const unsigned long long t_ = __builtin_amdgcn_s_memrealtime(); \
        const unsigned long long p_ = ((unsigned long long)F.MISC[23] << 32) | F.MISC[22]; if ((idx) >= 0) F.MISC[24 + (idx)] = __float_as_uint(__uint_as_float(F.MISC[24 + (idx)]) + (float)(t_ - p_) * 0.01f); \
        F.MISC[22] = (unsigned)t_; F.MISC[23] = (unsigned)(t_ >> 32); } } while (0)
#else
#define PROF7(idx) do {} while (0)
#endif
__device__ __forceinline__ void p5_phase(Frame& F, unsigned char* ws, const bf16* xmid, const float* norm_ffn) {
    const int lane_ = pg8::lane_now(), tid_ = F.wave * 64 + lane_;
    const float* mod = (const float*)(ws + WS_MOD); bf16* H = (bf16*)(ws + WS_H); const bf16* wrt = (const bf16*)(ws + WS_WRT);
    int* ltok = (int*)(ws + WS_LTOK); float* lw = (float*)(ws + WS_LW); int* tokslot = (int*)(ws + WS_TOKSLOT);
    gu32* gcnt = F.ctl + CW_CNT;
    LAS float* lg = (LAS float*)(F.lds + RING_OFF) + F.wave * (16 * 48);
    LAS unsigned* lcnt = (LAS unsigned*)(F.lds + RING_OFF + 32768);
    LAS unsigned* gbase = lcnt + 32;
    constexpr int NT = T / 16;
    LAS unsigned char* wrtL = F.lds + RING_OFF + 40960;
    for (int i = tid_; i < 48 * 128; i += NWAVES * 64) { const int row = i >> 7, p = i & 127;
        *(LAS v4u*)(wrtL + row * 2048 + ((p ^ (row & 7)) << 4)) = *(const GAS v4u*)(wrt + (size_t)row * D + 8 * p); }
    for (int tl0 = F.vcu * NWAVES; tl0 < NT; tl0 += F.G * NWAVES) {
        const int tl = tl0 + F.wave; const bool active = tl < NT; const int m0 = tl * 16;
        if (tid_ < 32) lcnt[tid_] = 0u;
        __syncthreads(); PROF7(-1);
        int e1 = 0, e2 = 0, ls1 = 0, ls2 = 0; float w1 = 0.f, w2 = 0.f;
        if (active) {
            {
                const int bb = m0 >> 12;
                f32x4 gm[4], sh[4];
#pragma unroll
                for (int j = 0; j < 4; ++j) { const f32x4 g = ((const GAS f32x4*)norm_ffn)[lane_ + 64 * j]; const f32x4 sc = ((const GAS f32x4*)(mod + bb * 6144 + 4096))[lane_ + 64 * j];
                    sh[j] = ((const GAS f32x4*)(mod + bb * 6144 + 3072))[lane_ + 64 * j]; gm[j] = g * (sc + 1.f); }
                unsigned long long vA[2][4], vB[2][4], vC[2][4], vD[2][4];
#define P7_LOAD(dst, mb_) do { _Pragma("unroll") for (int r = 0; r < 2; ++r) { const GAS unsigned long long* xr = (const GAS unsigned long long*)(xmid + (size_t)((mb_) + r) * D) + lane_; \
                    _Pragma("unroll") for (int j = 0; j < 4; ++j) dst[r][j] = xr[64 * j]; } } while (0)
                P7_LOAD(vA, m0); P7_LOAD(vB, m0 + 2); P7_LOAD(vC, m0 + 4);
#pragma unroll 1
                for (int gp = 0; gp < 2; ++gp) {
                    P7_LOAD(vD, m0 + 8 * gp + 6);
                    p7_rows(vA, m0 + 8 * gp, lane_, gm, sh, H);
                    if (gp < 1) P7_LOAD(vA, m0 + 8);
                    p7_rows(vB, m0 + 8 * gp + 2, lane_, gm, sh, H);
                    if (gp < 1) P7_LOAD(vB, m0 + 10);
                    p7_rows(vC, m0 + 8 * gp + 4, lane_, gm, sh, H);
                    if (gp < 1) P7_LOAD(vC, m0 + 12);
                    p7_rows(vD, m0 + 8 * gp + 6, lane_, gm, sh, H);
                }
#undef P7_LOAD
            }
            PROF7(0);
            __threadfence_block();
            asm volatile("s_waitcnt vmcnt(0)" ::: "memory");
            f32x4 acc0 = {0.f, 0.f, 0.f, 0.f}, acc1 = acc0, acc2 = acc0;
            const bf16* ap = H + (size_t)(m0 + (lane_ & 15)) * D + 8 * (lane_ >> 4);
            const LAS unsigned char* bp = wrtL + (lane_ & 15) * 2048; const int bg_ = lane_ >> 4, bx_ = lane_ & 7;
#pragma unroll 16
            for (int sI = 0; sI < 32; ++sI) {
                const bf16x8 av = *(const GAS bf16x8*)(ap + 32 * sI);
                const int po = ((4 * sI + bg_) ^ bx_) << 4;
                const bf16x8 b0 = *(const LAS bf16x8*)(bp + po), b1 = *(const LAS bf16x8*)(bp + 16 * 2048 + po), b2 = *(const LAS bf16x8*)(bp + 32 * 2048 + po);
                acc0 = __builtin_amdgcn_mfma_f32_16x16x32_bf16(av, b0, acc0, 0, 0, 0);
                acc1 = __builtin_amdgcn_mfma_f32_16x16x32_bf16(av, b1, acc1, 0, 0, 0);
                acc2 = __builtin_amdgcn_mfma_f32_16x16x32_bf16(av, b2, acc2, 0, 0, 0);
            }
            PROF7(1);
#pragma unroll
            for (int rg = 0; rg < 4; ++rg) { const int row = 4 * (lane_ >> 4) + rg;
                lg[row * 48 + (lane_ & 15)] = acc0[rg]; lg[row * 48 + 16 + (lane_ & 15)] = acc1[rg]; lg[row * 48 + 32 + (lane_ & 15)] = acc2[rg]; }
            LDS_WAIT(); asm volatile("" ::: "memory");
            if (lane_ < 16) {
                const LAS float* l = lg + lane_ * 48;
                float gmax = l[0]; int gi = 0;
#pragma unroll
                for (int i = 1; i < 4; ++i) { const float v = l[i]; if (v > gmax) { gmax = v; gi = i; } }
                float gs = 0.f;
#pragma unroll
                for (int i = 0; i < 4; ++i) gs += __expf(l[i] - gmax);
                const float gprob = 1.f / gs;
                float a1 = -1e30f, a2 = -1e30f; int i1 = 0, i2 = 0;
#pragma unroll
                for (int i = 0; i < 8; ++i) { const float v = l[4 + gi * 8 + i]; if (v > a1) { a2 = a1; i2 = i1; a1 = v; i1 = i; } else if (v > a2) { a2 = v; i2 = i; } }
                const float p2 = __expf(a2 - a1);
                w1 = gprob / (1.f + p2); w2 = gprob * p2 / (1.f + p2);
                e1 = gi * 8 + i1; e2 = gi * 8 + i2;
                ls1 = (int)atomicAdd((unsigned*)&lcnt[e1], 1u); ls2 = (int)atomicAdd((unsigned*)&lcnt[e2], 1u);
            }
        }
        __syncthreads(); PROF7(2);
        if (tid_ < 32) gbase[tid_] = __hip_atomic_fetch_add(gcnt + tid_, lcnt[tid_], __ATOMIC_RELAXED, __HIP_MEMORY_SCOPE_AGENT);
        __syncthreads(); PROF7(3);
        if (active && lane_ < 16) {
            const int m = m0 + lane_; const int s1 = (int)gbase[e1] + ls1, s2 = (int)gbase[e2] + ls2;
            ltok[(size_t)e1 * CAP + s1] = m; lw[(size_t)e1 * CAP + s1] = w1;
            ltok[(size_t)e2 * CAP + s2] = m; lw[(size_t)e2 * CAP + s2] = w2;
            tokslot[2 * m] = (e1 << 20) | s1; tokslot[2 * m + 1] = (e2 << 20) | s2;
        }
        PROF7(4);
    }
}

__device__ __forceinline__ void moe_setup(Frame& F) {
    const int lane_ = pg8::lane_now(), tid_ = F.wave * 64 + lane_;
    LAS int* tpre = (LAS int*)(F.lds + MOE_OFF); LAS int* cn = tpre + 33;
    if (tid_ == 0) { int acc = 0;
        for (int e = 0; e < 32; ++e) { const int c = (int)__hip_atomic_load(F.ctl + CW_CNT + e, RLX_AGENT); cn[e] = c; tpre[e] = acc; acc += (c + 255) >> 8; }
        tpre[32] = acc; }
    __syncthreads();
}

__device__ __forceinline__ void p10_rows(const unsigned long long (&xraw)[2][4], const unsigned long long (&ya)[2][4], const unsigned long long (&yb)[2][4], int mb, int lane_, const f32x4 (&gt)[4], const f32x4 (&nf)[4], float* xo) {
    float ss[2]; f32x4 v[2][4];
#pragma unroll
    for (int r = 0; r < 2; ++r)
#pragma unroll
        for (int j = 0; j < 4; ++j) v[r][j] = bf4_to_f32(xraw[r][j]);
#pragma unroll
    for (int r = 0; r < 2; ++r) { float s = 0.f;
#pragma unroll
        for (int j = 0; j < 4; ++j) { const unsigned long long a = ya[r][j], b = yb[r][j]; f32x4 y;
            y.x = __uint_as_float((unsigned)(a & 0xFFFFu) << 16) + __uint_as_float((unsigned)(b & 0xFFFFu) << 16);
            y.y = __uint_as_float((unsigned)(a >> 16) << 16) + __uint_as_float((unsigned)(b >> 16) << 16);
            y.z = __uint_as_float((unsigned)((a >> 32) & 0xFFFFu) << 16) + __uint_as_float((unsigned)((b >> 32) & 0xFFFFu) << 16);
            y.w = __uint_as_float((unsigned)(a >> 48) << 16) + __uint_as_float((unsigned)(b >> 48) << 16);
            v[r][j] = v[r][j] + gt[j] * y;
            s += (v[r][j].x * v[r][j].x + v[r][j].y * v[r][j].y) + (v[r][j].z * v[r][j].z + v[r][j].w * v[r][j].w); }
        ss[r] = s; }
#pragma unroll
    for (int r = 0; r < 2; ++r) ss[r] = wave_sum(ss[r]);
#pragma unroll
    for (int r = 0; r < 2; ++r) { const float rs = rsqrtf(ss[r] * (1.f / D) + EPS);
        GAS f32x4* xr = (GAS f32x4*)(xo + (size_t)(mb + r) * D) + lane_;
#pragma unroll
        for (int j = 0; j < 4; ++j) xr[64 * j] = v[r][j] * rs * nf[j]; }
}
__device__ __forceinline__ void p8_phase(Frame& F, unsigned char* ws, float* xo, const float* norm_final) {
    const bf16* xm = (const bf16*)(ws + WS_XM);
    const int lane_ = pg8::lane_now();
    const float* mod = (const float*)(ws + WS_MOD); const int* tokslot = (const int*)(ws + WS_TOKSLOT); const bf16* ys = (const bf16*)(ws + WS_YS);
    const LAS int* tpre = (const LAS int*)(F.lds + MOE_OFF);
    f32x4 nf[4];
#pragma unroll
    for (int j = 0; j < 4; ++j) nf[j] = ((const GAS f32x4*)norm_final)[lane_ + 64 * j];
    for (int tl = F.vcu * NWAVES + F.wave; tl < T / 16; tl += F.G * NWAVES) {
        const int m0 = tl * 16, bb = m0 >> 12;
        int myrow = 0;
        if (lane_ < 32) { const int t = tokslot[2 * m0 + lane_]; myrow = tpre[t >> 20] * 256 + (t & 0xFFFFF); }
        f32x4 gt[4];
#pragma unroll
        for (int j = 0; j < 4; ++j) gt[j] = ((const GAS f32x4*)(mod + bb * 6144 + 5120))[lane_ + 64 * j];
        unsigned long long vA[2][4], vB[2][4], yaA[2][4], ybA[2][4], yaB[2][4], ybB[2][4];
#define P10_LOAD(dv, da, db, g_) do { _Pragma("unroll") for (int r = 0; r < 2; ++r) { \
            const size_t r0 = (size_t)__shfl(myrow, 2 * (2 * (g_) + r)), r1 = (size_t)__shfl(myrow, 2 * (2 * (g_) + r) + 1); \
            const GAS unsigned long long* xr = (const GAS unsigned long long*)(xm + (size_t)(m0 + 2 * (g_) + r) * D) + lane_; \
            const GAS unsigned long long* y0 = (const GAS unsigned long long*)(ys + r0 * D) + lane_; const GAS unsigned long long* y1 = (const GAS unsigned long long*)(ys + r1 * D) + lane_; \
            _Pragma("unroll") for (int j = 0; j < 4; ++j) { dv[r][j] = xr[64 * j]; da[r][j] = y0[64 * j]; db[r][j] = y1[64 * j]; } } } while (0)
        P10_LOAD(vA, yaA, ybA, 0);
#pragma unroll 1
        for (int gp = 0; gp < 4; ++gp) {
            P10_LOAD(vB, yaB, ybB, 2 * gp + 1);
            p10_rows(vA, yaA, ybA, m0 + 4 * gp, lane_, gt, nf, xo);
            if (gp < 3) P10_LOAD(vA, yaA, ybA, 2 * gp + 2);
            p10_rows(vB, yaB, ybB, m0 + 4 * gp + 2, lane_, gt, nf, xo);
        }
#undef P10_LOAD
    }
}

#if MK_PROF_A >= 200
#define PROFA(idx) do { if (blockIdx.x == 32 && wid_ == 0 && lane == 0) { const unsigned long long t_ = __builtin_amdgcn_s_memrealtime(); \
        const unsigned long long p_ = ((unsigned long long)misc_[23] << 32) | misc_[22]; if ((idx) >= 0) misc_[24 + (idx)] = __float_as_uint(__uint_as_float(misc_[24 + (idx)]) + (float)(t_ - p_) * 0.01f); \
        misc_[22] = (unsigned)t_; misc_[23] = (unsigned)(t_ >> 32); } } while (0)
#else
#define PROFA(idx) do {} while (0)
#endif
#ifndef ATT_NPF
#define ATT_NPF 2
#endif
namespace att {
typedef short bf16x8 __attribute__((ext_vector_type(8)));
typedef short s16x4 __attribute__((ext_vector_type(4)));
typedef float f32x16 __attribute__((ext_vector_type(16)));
typedef unsigned u32x4 __attribute__((ext_vector_type(4)));
constexpr int TBL_N = 192;
constexpr int LDS_TBL = 0;
constexpr int LDS_WAVE = 18432;
constexpr int WAVE_BYTES = 8448;
constexpr float LOG2E = 1.4426950408889634f;
__device__ __forceinline__ int crow(int r, int hi) { return (r & 3) + 8 * (r >> 2) + 4 * hi; }
__device__ __forceinline__ unsigned cvtpk(float lo, float hi) { typedef float f32x2_t_ __attribute__((ext_vector_type(2))); typedef __bf16 bf16x2_t_ __attribute__((ext_vector_type(2))); const f32x2_t_ v_ = {lo, hi}; return __builtin_bit_cast(unsigned, __builtin_convertvector(v_, bf16x2_t_)); }
__device__ __forceinline__ s16x4 vtr(const LAS unsigned char* p) { typedef short v4i16_t __attribute__((ext_vector_type(4)));
    return __builtin_bit_cast(s16x4, __builtin_amdgcn_ds_read_tr16_b64_v4i16((LAS v4i16_t*)p)); }

__device__ __forceinline__ void build_tables(LAS float* tbl, const float* rel_bias, int tid) {
    for (int i = tid; i < 24 * TBL_N; i += NWAVES * 64) {
        const int bh = i / TBL_N, u = i % TBL_N, br = bh >> 3, h = bh & 7, delta = 159 - u, dil = br == 0 ? 1 : (br == 1 ? 4 : 16);
        float v = -1e30f;
        if (delta >= 0 && delta <= 128) { const int dist = delta * dil; int bucket;
            if (dist < 16) bucket = dist; else { const double vv = log((double)dist / 16.0) / log(128.0) * 16.0; const int l = 16 + (int)vv; bucket = l < 31 ? l : 31; }
            v = rel_bias[bucket * 8 + h] * LOG2E; }
        tbl[i] = v;
    }
}
__device__ __forceinline__ void build_tables_max(LAS float* tbl, int tid) {
    if (tid < 24) { float mx = -1e30f; for (int u = 31; u <= 159; ++u) mx = fmaxf(mx, tbl[tid * TBL_N + u]); tbl[tid * TBL_N + TBL_N - 1] = mx; }
}

struct TileP { int rowbase, h, dil, r, I0; };
__device__ __forceinline__ unsigned lane_kofs(int dil, int lane) { return (unsigned)((lane & 31) * dil * 128 + (lane >> 5) * 16); }
__device__ __forceinline__ unsigned lane_vofs(int dil, int lane) { return (unsigned)((lane >> 3) * dil * 128 + (lane & 7) * 16); }
__device__ __forceinline__ const GAS unsigned char* tile_row(const void* B, const TileP& t, int J) {
    const long tok = (long)(t.rowbase * 8 + t.h * 4096) + t.r + (long)t.dil * J; return (const GAS unsigned char*)B + tok * 128; }
__device__ __forceinline__ unsigned lane_pofs(int dil, int lane) { return (unsigned)((lane >> 3) * dil * 1024 + (lane & 7) * 16); }
__device__ __forceinline__ void load_q(const bf16* QB, const TileP& t, unsigned kofs, bf16x8 (&qf)[4]) {
    const GAS unsigned char* b = tile_row(QB, t, t.I0);
#pragma unroll
    for (int s = 0; s < 4; ++s) qf[s] = *(const GAS bf16x8*)(b + kofs + 32 * s);
}
__device__ __forceinline__ void load_k(const bf16* KB, const TileP& t, unsigned kofs, int kt, bf16x8 (&kfk)[4]) {
    const GAS unsigned char* b = tile_row(KB, t, t.I0 - 128 + 32 * kt);
#pragma unroll
    for (int s = 0; s < 4; ++s) kfk[s] = *(const GAS bf16x8*)(b + kofs + 32 * s);
}
__device__ __forceinline__ void load_v(const bf16* VB, const TileP& t, unsigned vofs, int kt, u32x4 (&vv)[4]) {
#pragma unroll
    for (int ii = 0; ii < 4; ++ii) vv[ii] = *(const GAS u32x4*)(tile_row(VB, t, t.I0 - 128 + 32 * kt + 8 * ii) + vofs);
}
__device__ __forceinline__ void wave_tile(const bf16* QB, const bf16* KB, const bf16* VB, bf16* part, float* lse, const LAS float* tb, LAS unsigned char* wl,
                                          const TileP& tc, bool has_next, const TileP& tn, int lane, volatile LAS unsigned* misc_, int wid_,
                                          bf16x8 (&qf)[4], bf16x8 (&qn)[4], bf16x8 (&ks0)[4], u32x4 (&vx)[4], u32x4 (&vy)[4]) {
    const int h = tc.h, I0 = tc.I0;
    const int i = lane & 31, h2 = lane >> 5;
    PROFA(-1);
    LAS unsigned char* vt = wl; LAS unsigned char* ost = wl + 4096;
    const bool needmask = I0 < 128;
    const LAS float* tbase = tb + (31 - i + 4 * h2);
    const int vrow_l = lane >> 3, vch = lane & 7;
    const LAS unsigned char* vrd = vt + ((lane >> 4) & 1) * 32 + (lane & 3) * 8 + (4 * h2 + ((lane & 15) >> 2)) * 64;
    const unsigned kofs = lane_kofs(tc.dil, lane), vofs = lane_vofs(tc.dil, lane);
    bf16x8 ks1[4], ks2[4], ks3[4], ks4[4];
    load_k(KB, tc, kofs, 3, ks1);
    float m = 0.f, l = 0.f;
    f32x16 o0 = {0.f, 0.f, 0.f, 0.f, 0.f, 0.f, 0.f, 0.f, 0.f, 0.f, 0.f, 0.f, 0.f, 0.f, 0.f, 0.f}, o1 = o0;
#define ATT_STEP(j_, KF_, VV_, PRE_) do { constexpr int kt = 4 - (j_); \
        _Pragma("unroll") for (int ii = 0; ii < 4; ++ii) *(LAS u32x4*)(vt + (vch >> 2) * 2048 + (vrow_l + 8 * ii) * 64 + (vch & 3) * 16) = VV_[ii]; \
        if ((j_) < 3) load_v(VB, tc, vofs, kt - 2, VV_); else if (has_next) load_v(VB, tn, lane_vofs(tn.dil, lane), 7 - (j_), VV_);     \
        f32x16 acc; \
        if ((j_) == 0) { _Pragma("unroll") for (int rr = 0; rr < 16; ++rr) acc[rr] = 0.f; } else { _Pragma("unroll") for (int rr = 0; rr < 16; ++rr) acc[rr] = -m; } \
        _Pragma("unroll") for (int s = 0; s < 4; ++s) acc = __builtin_amdgcn_mfma_f32_32x32x16_bf16(KF_[s], qf[s], acc, 0, 0, 0); \
        PRE_; \
        if ((j_) == 0) { float mx = acc[0]; _Pragma("unroll") for (int rr = 1; rr < 16; ++rr) mx = fmaxf(mx, acc[rr]); \
            { float w_ = mx; asm volatile("" : "+v"(w_)); auto rx = __builtin_amdgcn_permlane32_swap(__float_as_uint(mx), __float_as_uint(w_), false, false); mx = fmaxf(__uint_as_float(rx[0]), __uint_as_float(rx[1])); } \
            m = mx + tb[att::TBL_N - 1]; _Pragma("unroll") for (int rr = 0; rr < 16; ++rr) acc[rr] -= m; } \
        if (needmask) {                                       \
            const int jlim = 128 - 32 * kt - I0 - 4 * h2; asm volatile("" ::: "memory"); \
            _Pragma("unroll") for (int rr = 0; rr < 16; ++rr) { const int kk = (rr & 3) + 8 * (rr >> 2); if (kk < jlim) acc[rr] = -1e30f; } } \
        float p[16]; \
        _Pragma("unroll") for (int rr = 0; rr < 16; ++rr) { const int kk = (rr & 3) + 8 * (rr >> 2); \
            p[rr] = __builtin_amdgcn_exp2f(acc[rr] + tbase[32 * kt + kk]); l += p[rr]; } \
        u32x4 pw0, pw1; \
        pw0.x = cvtpk(p[0], p[1]); pw0.y = cvtpk(p[2], p[3]); pw0.z = cvtpk(p[4], p[5]); pw0.w = cvtpk(p[6], p[7]); \
        pw1.x = cvtpk(p[8], p[9]); pw1.y = cvtpk(p[10], p[11]); pw1.z = cvtpk(p[12], p[13]); pw1.w = cvtpk(p[14], p[15]); \
        const bf16x8 pa0 = __builtin_bit_cast(bf16x8, pw0), pa1 = __builtin_bit_cast(bf16x8, pw1); \
        asm volatile("s_waitcnt lgkmcnt(0)" ::: "memory"); \
        _Pragma("unroll") for (int db = 0; db < 2; ++db) { \
            const s16x4 a0 = vtr(vrd + db * 2048), a1 = vtr(vrd + db * 2048 + 512), b0 = vtr(vrd + db * 2048 + 1024), b1 = vtr(vrd + db * 2048 + 1536); \
            const bf16x8 v0 = (bf16x8){a0[0], a0[1], a0[2], a0[3], a1[0], a1[1], a1[2], a1[3]}, v1 = (bf16x8){b0[0], b0[1], b0[2], b0[3], b1[0], b1[1], b1[2], b1[3]}; \
            if (db == 0) { o0 = __builtin_amdgcn_mfma_f32_32x32x16_bf16(v0, pa0, o0, 0, 0, 0); o0 = __builtin_amdgcn_mfma_f32_32x32x16_bf16(v1, pa1, o0, 0, 0, 0); } \
            else         { o1 = __builtin_amdgcn_mfma_f32_32x32x16_bf16(v0, pa0, o1, 0, 0, 0); o1 = __builtin_amdgcn_mfma_f32_32x32x16_bf16(v1, pa1, o1, 0, 0, 0); } } \
        asm volatile("s_waitcnt lgkmcnt(0)" ::: "memory"); } while (0)
    ATT_STEP(0, ks0, vx, load_k(KB, tc, kofs, 2, ks2));
    PROFA(0);
    ATT_STEP(1, ks1, vy, load_k(KB, tc, kofs, 1, ks3));
    ATT_STEP(2, ks2, vx, { load_k(KB, tc, kofs, 0, ks4); if (has_next) load_q(QB, tn, lane_kofs(tn.dil, lane), qn); });
    ATT_STEP(3, ks3, vy, if (has_next) load_k(KB, tn, lane_kofs(tn.dil, lane), 4, ks0));
    ATT_STEP(4, ks4, vx, (void)0);
#undef ATT_STEP
    PROFA(1);
    { float w_ = l; asm volatile("" : "+v"(w_)); auto rr = __builtin_amdgcn_permlane32_swap(__float_as_uint(l), __float_as_uint(w_), false, false); l = __uint_as_float(rr[0]) + __uint_as_float(rr[1]); }
    const float il = 1.f / l;
    if (h2 == 0) *(GAS float*)((GAS unsigned char*)lse + ((long)tc.rowbase + tc.r + (long)tc.dil * I0) * 32 + h * 4 + (size_t)(i * tc.dil * 32)) = m + __log2f(l);
#pragma unroll
    for (int qd = 0; qd < 4; ++qd) { typedef unsigned u32x2_ __attribute__((ext_vector_type(2)));
        LAS unsigned char* wp = ost + i * 128 + h2 * 8;
        *(LAS u32x2_*)(wp + ((qd ^ (i & 7)) << 4)) = (u32x2_){cvtpk(o0[4 * qd] * il, o0[4 * qd + 1] * il), cvtpk(o0[4 * qd + 2] * il, o0[4 * qd + 3] * il)};
        *(LAS u32x2_*)(wp + (((qd + 4) ^ (i & 7)) << 4)) = (u32x2_){cvtpk(o1[4 * qd] * il, o1[4 * qd + 1] * il), cvtpk(o1[4 * qd + 2] * il, o1[4 * qd + 3] * il)}; }
    asm volatile("s_waitcnt lgkmcnt(0)" ::: "memory");
    { GAS unsigned char* pb = (GAS unsigned char*)part + ((long)tc.rowbase + tc.r + (long)tc.dil * I0) * 1024 + h * 128; const unsigned pofs = lane_pofs(tc.dil, lane);
#pragma unroll
      for (int ii = 0; ii < 4; ++ii) { const int row = ii * 8 + vrow_l;
        const u32x4 v = *(const LAS u32x4*)(ost + row * 128 + ((vch ^ (row & 7)) << 4));
        *(GAS u32x4*)(pb + (size_t)(ii * 8 * tc.dil) * 1024 + pofs) = v; } }
    asm volatile("s_waitcnt lgkmcnt(0)" ::: "memory");
    PROFA(2);
}
}

struct AttTile { int br, h, b, dil, r, I0; };
__device__ __forceinline__ AttTile att_tile(int u, int wt) {
    AttTile t; t.h = u / 192; const int nu = u % 192; t.br = nu % 3; const int bb = nu / 3; t.b = bb >> 3; const int blk = bb & 7;
    t.dil = t.br == 0 ? 1 : (t.br == 1 ? 4 : 16);
    if (t.br == 0) { t.r = 0; t.I0 = blk * 512 + 32 * wt; } else if (t.br == 1) { t.r = wt & 3; t.I0 = blk * 128 + 32 * (wt >> 2); } else { t.r = wt; t.I0 = blk * 32; }
    return t;
}
__device__ __forceinline__ unsigned att_draw_unit(gu32* qctr, volatile LAS unsigned* Q, unsigned x) {
    unsigned k = Q[1];
    while (k < 8u) { const unsigned y = (x + k) & 7u; const unsigned nu = __hip_atomic_fetch_add(qctr + 32 * y, 1u, __ATOMIC_RELAXED, __HIP_MEMORY_SCOPE_AGENT);
        if (nu < 192u) return y * 192u + nu;
        ++k; Q[1] = k; }
    return 1536u;
}
__device__ __forceinline__ void att_prefetch(const bf16* QB, const bf16* KB, const bf16* VB, const AttTile& t, int lane, unsigned (&pf)[6]) {
#pragma unroll
    for (int q = 0; q < 6; ++q) { const int xidx = lane + 64 * q; const bf16* base; int J;
        if (xidx < 32) { base = QB; J = t.I0 + xidx; } else if (xidx < 192) { base = KB; J = t.I0 - 128 + (xidx - 32); } else { base = VB; J = t.I0 - 128 + (xidx - 192); }
        if (J < 0) J = 0; if (xidx >= 352) J = t.I0;
        pf[q] = *(const GAS unsigned*)(base + ((size_t)t.b * SEQ + t.r + (size_t)t.dil * J) * 512 + 64 * t.h); }
}
__device__ __forceinline__ void attn_phase(Frame& F, unsigned char* ws, const float* rel_bias) {
    const int lane_ = pg8::lane_now(), tid_ = F.wave * 64 + lane_;
    LAS float* tbl = (LAS float*)(F.lds + RING_OFF + att::LDS_TBL);
    volatile LAS unsigned* Q = (volatile LAS unsigned*)(F.lds + LDSCTL_OFF);
    gu32* qctr = F.ctl + CW_ATTQ; const unsigned xq_ = xb_xcc_id() & 7u;
    if (tid_ < 32) Q[tid_] = 0u;
    att::build_tables(tbl, rel_bias, tid_);
    __syncthreads();
    att::build_tables_max(tbl, tid_);
    if (tid_ == 0) { Q[8] = att_draw_unit(qctr, Q, xq_); Q[9] = att_draw_unit(qctr, Q, xq_); Q[16] = 1u; Q[17] = 2u; }
    __syncthreads();
    const bf16* QB = (const bf16*)(ws + WS_QB); const bf16* KB = (const bf16*)(ws + WS_KB); const bf16* VB = (const bf16*)(ws + WS_VB);
    LAS unsigned char* wl = F.lds + RING_OFF + att::LDS_WAVE + F.wave * att::WAVE_BYTES;
#define ATT_DRAW(u_, wt_) do { unsigned g_ = 0u; if (pg8::lane_now() == 0) g_ = atomicAdd((unsigned*)&Q[0], 1u); g_ = (unsigned)__builtin_amdgcn_readfirstlane((int)g_); \
        const unsigned s_ = g_ >> 4; wt_ = (int)(g_ & 15u); \
        if (wt_ == 0 && pg8::lane_now() == 0) { const unsigned nu_ = att_draw_unit(qctr, Q, xq_); Q[8 + ((s_ + 2u) & 7u)] = nu_; \
            asm volatile("s_waitcnt lgkmcnt(0)" ::: "memory"); Q[16 + ((s_ + 2u) & 7u)] = s_ + 3u; } \
        while (Q[16 + (s_ & 7u)] != s_ + 1u) __builtin_amdgcn_s_sleep(1); \
        u_ = __builtin_amdgcn_readfirstlane((int)Q[8 + (s_ & 7u)]); } while (0)
#if MK_PROF_A >= 200
    const unsigned long long tph0_ = __builtin_amdgcn_s_memrealtime(); unsigned long long tdraw_ = 0; int ntile_ = 0;
#endif
    int u_cur, wt_cur, u_nxt, wt_nxt;
    ATT_DRAW(u_cur, wt_cur);
    att::bf16x8 qA[4], qB[4], ks0[4]; att::u32x4 vA[4], vB[4];
    if (u_cur < 1536) { const AttTile t0 = att_tile(u_cur, wt_cur); const att::TileP p0{t0.b * SEQ, t0.h, t0.dil, t0.r, t0.I0}; const int ln = pg8::lane_now();
        const unsigned ko = att::lane_kofs(p0.dil, ln), vo = att::lane_vofs(p0.dil, ln);
        att::load_q(QB, p0, ko, qA); att::load_k(KB, p0, ko, 4, ks0); att::load_v(VB, p0, vo, 4, vA); att::load_v(VB, p0, vo, 3, vB); }
#if MK_PROF_A >= 200
#define ATT_PROF_DRAW0() const unsigned long long td0_ = __builtin_amdgcn_s_memrealtime()
#define ATT_PROF_DRAW1() do { tdraw_ += __builtin_amdgcn_s_memrealtime() - td0_; ++ntile_; } while (0)
#else
#define ATT_PROF_DRAW0() do {} while (0)
#define ATT_PROF_DRAW1() do {} while (0)
#endif
#define ATT_ONE_TILE(QC_, QN_, VX_, VY_) do { \
        ATT_PROF_DRAW0(); \
        ATT_DRAW(u_nxt, wt_nxt);                               \
        ATT_PROF_DRAW1(); \
        const int ln = pg8::lane_now();                        \
        const AttTile t = att_tile(u_cur, wt_cur); \
        const bool has_next = u_nxt < 1536; \
        const AttTile tn = att_tile(has_next ? u_nxt : u_cur, has_next ? wt_nxt : wt_cur); \
        const att::TileP pc{t.b * SEQ, t.h, t.dil, t.r, t.I0}, pn{tn.b * SEQ, tn.h, tn.dil, tn.r, tn.I0}; \
        bf16* part = (bf16*)(ws + (t.br == 0 ? WS_PART0 : (t.br == 1 ? WS_PART1 : WS_PART2))); \
        float* lse = (float*)(ws + WS_LSE) + (size_t)t.br * T * 8; \
        att::wave_tile(QB, KB, VB, part, lse, tbl + (t.br * 8 + t.h) * att::TBL_N, wl, pc, has_next, pn, ln, F.MISC, F.wave, QC_, QN_, ks0, VX_, VY_); \
        u_cur = u_nxt; wt_cur = wt_nxt; } while (0)
    while (u_cur < 1536) {
        ATT_ONE_TILE(qA, qB, vA, vB);
        if (u_cur >= 1536) break;
        ATT_ONE_TILE(qB, qA, vB, vA);
    }
#undef ATT_ONE_TILE
#undef ATT_DRAW
#if MK_PROF_A >= 200
    if (pg8::lane_now() == 0) atomicMax((unsigned*)(F.ctl + CW_CNT + 70), (unsigned)(__builtin_amdgcn_s_memrealtime() - tph0_));
    if (blockIdx.x == 32 && tid_ == 0) { F.MISC[27] = __float_as_uint((float)(__builtin_amdgcn_s_memrealtime() - tph0_) * 0.01f); F.MISC[26] = __float_as_uint((float)ntile_ * 5.f); F.MISC[25] = __float_as_uint((float)tdraw_ * 0.01f); }
#endif
    __syncthreads();
}

__device__ __forceinline__ void attn_combine_phase(Frame& F, unsigned char* ws, const float* attn_norm) {
    const int lane_ = pg8::lane_now();
    const int gw = F.vcu * NWAVES + F.wave, NGW = F.G * NWAVES;
    const float* lse = (const float*)(ws + WS_LSE); bf16* Y = (bf16*)(ws + WS_Y);
    const bf16* p0 = (const bf16*)(ws + WS_PART0); const bf16* p1 = (const bf16*)(ws + WS_PART1); const bf16* p2 = (const bf16*)(ws + WS_PART2);
    const int h = lane_ >> 3;
    f32x4 an0 = ((const GAS f32x4*)attn_norm)[2 * lane_], an1 = ((const GAS f32x4*)attn_norm)[2 * lane_ + 1];
    for (int tl = gw; tl < T / 16; tl += NGW) {
#pragma unroll 1
        for (int g4 = 0; g4 < 4; ++g4) {
            const int mb = tl * 16 + 4 * g4;
            float l0[4], l1[4], l2[4]; v4u pa[4], pb[4], pc[4];
#pragma unroll
            for (int r = 0; r < 4; ++r) { const size_t m = (size_t)(mb + r);
                l0[r] = lse[m * 8 + h]; l1[r] = lse[(size_t)T * 8 + m * 8 + h]; l2[r] = lse[(size_t)2 * T * 8 + m * 8 + h];
                pa[r] = *(const GAS v4u*)(p0 + m * 512 + 8 * lane_); pb[r] = *(const GAS v4u*)(p1 + m * 512 + 8 * lane_); pc[r] = *(const GAS v4u*)(p2 + m * 512 + 8 * lane_); }
            float o[4][8], ss[4];
#pragma unroll
            for (int r = 0; r < 4; ++r) {
                const float mx = fmaxf(l0[r], fmaxf(l1[r], l2[r]));
                float w0 = __builtin_amdgcn_exp2f(l0[r] - mx), w1 = __builtin_amdgcn_exp2f(l1[r] - mx), w2 = __builtin_amdgcn_exp2f(l2[r] - mx);
                const float inv = 1.f / (w0 + w1 + w2); w0 *= inv; w1 *= inv; w2 *= inv;
                float s = 0.f;
#pragma unroll
                for (int q = 0; q < 4; ++q) { const unsigned ua = pa[r][q], ub = pb[r][q], uc = pc[r][q];
                    o[r][2 * q] = w0 * __uint_as_float(ua << 16) + w1 * __uint_as_float(ub << 16) + w2 * __uint_as_float(uc << 16);
                    o[r][2 * q + 1] = w0 * __uint_as_float(ua & 0xFFFF0000u) + w1 * __uint_as_float(ub & 0xFFFF0000u) + w2 * __uint_as_float(uc & 0xFFFF0000u);
                    s += o[r][2 * q] * o[r][2 * q] + o[r][2 * q + 1] * o[r][2 * q + 1]; }
                ss[r] = s; }
#pragma unroll
            for (int r = 0; r < 4; ++r) ss[r] = wave_sum(ss[r]);
#pragma unroll
            for (int r = 0; r < 4; ++r) { const float ra = rsqrtf(ss[r] * (1.f / 512.f) + EPS);
                v4u w;
                w.x = pk2(o[r][0] * ra * an0.x, o[r][1] * ra * an0.y); w.y = pk2(o[r][2] * ra * an0.z, o[r][3] * ra * an0.w);
                w.z = pk2(o[r][4] * ra * an1.x, o[r][5] * ra * an1.y); w.w = pk2(o[r][6] * ra * an1.z, o[r][7] * ra * an1.w);
                *(GAS v4u*)(Y + (size_t)(mb + r) * 1024 + 512 + 8 * lane_) = w; }
        }
    }
}
namespace gdn {
__device__ __forceinline__ float fsilu(float x) { return x * __builtin_amdgcn_rcpf(1.f + __builtin_amdgcn_exp2f(-1.4426950408889634f * x)); }
typedef short bf16x8 __attribute__((ext_vector_type(8)));
typedef short s16x4 __attribute__((ext_vector_type(4)));
typedef float f32x4 __attribute__((ext_vector_type(4)));
typedef float f32x16 __attribute__((ext_vector_type(16)));
typedef unsigned u32x4 __attribute__((ext_vector_type(4)));
typedef __bf16 bf16x2_t __attribute__((ext_vector_type(2)));
constexpr int NCH = 2048;
constexpr int SCAN_BYTES = 49152;
__device__ __forceinline__ int sigma_inv(int x) { return (x & ~31) | (((x >> 2) & 3) << 3) | (((x >> 4) & 1) << 2) | (x & 3); }
__device__ __forceinline__ int crow(int r, int hi) { return (r & 3) + 8 * (r >> 2) + 4 * hi; }
__device__ __forceinline__ unsigned cvtpk(float lo, float hi) { typedef float f32x2_t_ __attribute__((ext_vector_type(2))); typedef __bf16 bf16x2_t_ __attribute__((ext_vector_type(2))); const f32x2_t_ v_ = {lo, hi}; return __builtin_bit_cast(unsigned, __builtin_convertvector(v_, bf16x2_t_)); }
__device__ __forceinline__ float bflo(unsigned w) { return __uint_as_float(w << 16); }
__device__ __forceinline__ float bfhi(unsigned w) { return __uint_as_float(w & 0xFFFF0000u); }
__device__ __forceinline__ s16x4 vtr(const LAS unsigned char* p) { typedef short v4i16_t __attribute__((ext_vector_type(4)));
    return __builtin_bit_cast(s16x4, __builtin_amdgcn_ds_read_tr16_b64_v4i16((LAS v4i16_t*)p)); }
__device__ __forceinline__ int sw256(int row, int col) { return row * 256 + ((((col >> 3) ^ (row & 15)) << 4) | ((col & 7) << 1)); }
__device__ __forceinline__ int sw128(int row, int col) { return row * 128 + ((((col >> 3) ^ ((row >> 1) & 7)) << 4) | ((col & 7) << 1)); }

constexpr int L_QN = 0, L_KN = 16384, L_KGT = 32768, L_AQK = 49152, L_G = 57344  , L_A = 59392  , L_G8 = 124928  ;

#if MK_PROF_A >= 100 && MK_PROF_A < 110
#define PROFX(idx) do { if (blockIdx.x == 0 && F.wave == 0 && pg8::lane_now() == 0) { const unsigned long long t_ = __builtin_amdgcn_s_memrealtime(); \
        const unsigned long long p_ = ((unsigned long long)F.MISC[23] << 32) | F.MISC[22]; if ((idx) >= 0) F.MISC[24 + (idx)] = __float_as_uint(__uint_as_float(F.MISC[24 + (idx)]) + (float)(t_ - p_) * 0.01f); \
        F.MISC[22] = (unsigned)t_; F.MISC[23] = (unsigned)(t_ >> 32); } } while (0)
#else
#define PROFX(idx) do {} while (0)
#endif
__device__ __forceinline__ void a1_phase(Frame& F, unsigned char* ws, unsigned char* dout, const float* wconv) {
    const int w = F.wave;
    PROFX(-1);
    const bf16* qkva = (const bf16*)(ws + WS_QKVA); const float* bg = (const float*)(ws + WS_BG);
    unsigned char* scanops = dout; bf16* QGb = (bf16*)(dout + 96 * MiB); bf16* AQKb = (bf16*)(ws + WS_GAQK); float* GLb = (float*)(ws + WS_GGL);
    bf16* RS = (bf16*)(ws + WS_H);
    LAS unsigned char* L = F.lds + RING_OFF;
    for (int grp = F.vcu; grp < NCH / 8; grp += F.G) {
        {
            const int lane = pg8::lane_now(), ch = grp * 8 + w, n = ch & 63, bh = ch >> 6, h = bh & 3, b = bh >> 2;
            const size_t m0 = (size_t)b * SEQ + n * 64;
            LAS float* Gs = (LAS float*)(L + L_G8 + w * 1024);
            float gq = bg[(m0 + lane) * 8 + 4 + h]; const float be = bg[(m0 + lane) * 8 + h];
#pragma unroll
            for (int o = 1; o < 64; o <<= 1) { const float t = __shfl_up(gq, o); if (lane >= o) gq += t; }
            const float glast = __shfl(gq, 63);
            Gs[lane] = gq; Gs[64 + lane] = __expf(gq); Gs[128 + lane] = be; Gs[192 + lane] = __expf(glast - gq);
            if (lane == 0) GLb[ch] = __expf(glast);
        }
        unsigned rq[11], rk[11], rv[11];
#define A1_LOADRAW(ci_) do { const int ch_ = grp * 8 + (ci_), n_ = ch_ & 63, bh_ = ch_ >> 6, h_ = bh_ & 3, b_ = bh_ >> 2; const int ln_ = pg8::lane_now(); \
            _Pragma("unroll") for (int t = 0; t < 11; ++t) { const int tt = n_ * 64 + 8 * w - 3 + t; \
                if (tt >= 0) { const size_t m = ((size_t)(b_ * 4 + h_) * SEQ + tt) * 384 + 2 * ln_; rq[t] = *(const GAS unsigned*)(qkva + m); rk[t] = *(const GAS unsigned*)(qkva + m + 128); rv[t] = *(const GAS unsigned*)(qkva + m + 256); } \
                else { rq[t] = 0u; rk[t] = 0u; rv[t] = 0u; } } } while (0)
        A1_LOADRAW(0);
        float wq[4][2], wk[4][2], wv[4][2];
        { const int ln_ = pg8::lane_now(), cq = ((grp >> 3) & 3) * 128 + 2 * ln_, ck = 512 + cq, cv = 1024 + cq;
#pragma unroll
          for (int t = 0; t < 4; ++t) { wq[t][0] = wconv[t * 1536 + cq]; wq[t][1] = wconv[t * 1536 + cq + 1]; wk[t][0] = wconv[t * 1536 + ck]; wk[t][1] = wconv[t * 1536 + ck + 1];
              wv[t][0] = wconv[t * 1536 + cv]; wv[t][1] = wconv[t * 1536 + cv + 1]; } }
        for (int ci = 0; ci < 8; ++ci) {
            const int ch = grp * 8 + ci, n = ch & 63, bh = ch >> 6, h = bh & 3, b = bh >> 2;
            const int t0 = n * 64; const size_t m0 = (size_t)b * SEQ + t0;
            const int lane = pg8::lane_now(), tid = w * 64 + lane, i32 = lane & 31, h2 = lane >> 5;
            __syncthreads(); PROFX(0);
            LAS float* Gs = (LAS float*)(L + L_G8 + ci * 1024); LAS float* eG = Gs + 64; LAS float* bet = Gs + 128; LAS float* eGl = Gs + 192;
            {
                float kg0[8], kg1[8];
#pragma unroll
                for (int rr = 0; rr < 8; ++rr) {
                    const int c = 8 * w + rr;
                    unsigned xq[4], xk[4], xv[4];
#pragma unroll
                    for (int t = 0; t < 4; ++t) { xq[t] = rq[rr + t]; xk[t] = rk[rr + t]; xv[t] = rv[rr + t]; }
                    float q0 = 0.f, q1 = 0.f, k0 = 0.f, k1 = 0.f, v0 = 0.f, v1 = 0.f;
#pragma unroll
                    for (int t = 0; t < 4; ++t) { q0 += wq[t][0] * bflo(xq[t]); q1 += wq[t][1] * bfhi(xq[t]); k0 += wk[t][0] * bflo(xk[t]); k1 += wk[t][1] * bfhi(xk[t]);
                        v0 += wv[t][0] * bflo(xv[t]); v1 += wv[t][1] * bfhi(xv[t]); }
                    q0 = fsilu(q0); q1 = fsilu(q1); k0 = fsilu(k0); k1 = fsilu(k1); v0 = fsilu(v0); v1 = fsilu(v1);
                    const float sq = wave_sum(q0 * q0 + q1 * q1), sk = wave_sum(k0 * k0 + k1 * k1);
                    const float rq = rsqrtf(sq + EPS) * 0.08838834764831845f, rk = rsqrtf(sk + EPS);
                    q0 *= rq; q1 *= rq; k0 *= rk; k1 *= rk;
                    const float be = bet[c], eg = eG[c], egl = eGl[c];
                    const int kc = 2 * lane;
                    *(LAS unsigned*)(L + L_QN + sw256(c, kc)) = cvtpk(q0, q1);
                    *(LAS unsigned*)(L + L_KN + sw256(c, kc)) = cvtpk(k0, k1);
                    kg0[rr] = k0 * egl; kg1[rr] = k1 * egl;
                    *(GAS unsigned*)(QGb + (size_t)ch * 8192 + c * 128 + sigma_inv(kc)) = cvtpk(q0 * eg, q1 * eg);
                    *(GAS unsigned*)(RS + (size_t)ch * 16384 + c * 256 + kc) = cvtpk(k0 * be * eg, k1 * be * eg);
                    *(GAS unsigned*)(RS + (size_t)ch * 16384 + c * 256 + 128 + kc) = cvtpk(v0 * be, v1 * be);
                }
                { const int kc = 2 * lane, c0 = 8 * w, p0 = (c0 & ~31) | (((c0 >> 2) & 3) << 3) | (((c0 >> 4) & 1) << 2);
                  typedef unsigned u32x2 __attribute__((ext_vector_type(2)));
                  *(LAS u32x2*)(L + L_KGT + sw128(kc, p0)) = (u32x2){cvtpk(kg0[0], kg0[1]), cvtpk(kg0[2], kg0[3])};
                  *(LAS u32x2*)(L + L_KGT + sw128(kc, p0 + 8)) = (u32x2){cvtpk(kg0[4], kg0[5]), cvtpk(kg0[6], kg0[7])};
                  *(LAS u32x2*)(L + L_KGT + sw128(kc + 1, p0)) = (u32x2){cvtpk(kg1[0], kg1[1]), cvtpk(kg1[2], kg1[3])};
                  *(LAS u32x2*)(L + L_KGT + sw128(kc + 1, p0 + 8)) = (u32x2){cvtpk(kg1[4], kg1[5]), cvtpk(kg1[6], kg1[7])}; }
            }
            if (ci < 7) A1_LOADRAW(ci + 1);
            __syncthreads(); PROFX(1);
            {
                const int pw = w >> 2, ti = (w >> 1) & 1, tj = w & 1;
                f32x16 acc = {0.f, 0.f, 0.f, 0.f, 0.f, 0.f, 0.f, 0.f, 0.f, 0.f, 0.f, 0.f, 0.f, 0.f, 0.f, 0.f};
                const LAS unsigned char* Ab = L + (pw ? L_QN : L_KN);
#pragma unroll
                for (int s = 0; s < 8; ++s) {
                    const bf16x8 af = *(const LAS bf16x8*)(Ab + sw256(32 * ti + i32, 16 * s + 8 * h2));
                    const bf16x8 bf = *(const LAS bf16x8*)(L + L_KN + sw256(32 * tj + i32, 16 * s + 8 * h2));
                    acc = __builtin_amdgcn_mfma_f32_32x32x16_bf16(af, bf, acc, 0, 0, 0);
                }
                const int j = 32 * tj + i32; const float Gj = Gs[j];
                if (pw == 0) {
                    LAS unsigned char* As = L + L_A + ci * 8192;
#pragma unroll
                    for (int rg = 0; rg < 16; ++rg) { const int i = 32 * ti + crow(rg, h2);
                        const float v = (j < i) ? bet[i] * acc[rg] * __expf(Gs[i] - Gj) : 0.f;
                        *(LAS bf16*)(As + i * 128 + j * 2) = (bf16)f2bf(v); }
                } else {
                    const int pj = sigma_inv(j);
#pragma unroll
                    for (int rg = 0; rg < 16; ++rg) { const int i = 32 * ti + crow(rg, h2);
                        const float v = (j <= i) ? acc[rg] * __expf(Gs[i] - Gj) : 0.f;
                        *(LAS bf16*)(L + L_AQK + i * 128 + pj * 2) = (bf16)f2bf(v); }
                }
            }
            __syncthreads(); PROFX(2);
            {
#pragma unroll
                for (int q = 0; q < 2; ++q) { const int off = (tid + 512 * q) * 16; *(GAS u32x4*)(scanops + (size_t)ch * SCAN_BYTES + 16384 + off) = *(const LAS u32x4*)(L + L_KGT + off); }
                { const int off = tid * 16; *(GAS u32x4*)((unsigned char*)AQKb + (size_t)ch * 8192 + off) = *(const LAS u32x4*)(L + L_AQK + off); }
            }
        }
        __syncthreads(); PROFX(3);
#if MK_A1 == 1
        {
            const int lane = pg8::lane_now(), tid = w * 64 + lane;
#pragma unroll
            for (int q = 0; q < 8; ++q) { const int off = (tid + 512 * q) * 16; *(GAS u32x4*)(ws + WS_PART2 + (size_t)grp * 65536 + off) = *(const LAS u32x4*)(L + L_A + off); }
        }
#else
        {
            const int lane = pg8::lane_now();
            LAS unsigned char* As = L + L_A + w * 8192;
            unsigned tp[32];
            float tprev = 0.f;
#pragma unroll
            for (int i = 0; i < 64; ++i) {
                float acc = 0.f;
#pragma unroll
                for (int p = 0; p < i / 2; ++p) { const unsigned lwp = *(const LAS unsigned*)(As + i * 128 + p * 4);
                    acc = __builtin_amdgcn_fdot2_f32_bf16(__builtin_bit_cast(bf16x2_t, lwp), __builtin_bit_cast(bf16x2_t, tp[p]), acc, false); }
                if (i & 1) { const unsigned lw1 = *(const LAS unsigned*)(As + i * 128 + (i - 1) * 2); acc += bflo(lw1) * tprev; }
                const float ti = ((lane == i) ? 1.f : 0.f) - acc;
                if (i & 1) tp[i >> 1] = cvtpk(tprev, ti);
                tprev = ti;
            }
#pragma unroll
            for (int p = 0; p < 32; ++p) { *(LAS bf16*)(As + (2 * p) * 128 + lane * 2) = (bf16)(tp[p] & 0xFFFFu); *(LAS bf16*)(As + (2 * p + 1) * 128 + lane * 2) = (bf16)(tp[p] >> 16); }
        }
        __syncthreads(); PROFX(4);
        u32x4 rpre[4];
        for (int ci = 0; ci < 8; ++ci) {
            const int ch = grp * 8 + ci;
            const int lane = pg8::lane_now(), tid = w * 64 + lane, i32 = lane & 31, h2 = lane >> 5;
            __syncthreads();
            if (ci == 0) {
#pragma unroll
                for (int q = 0; q < 4; ++q) rpre[q] = *(const GAS u32x4*)((const unsigned char*)RS + (size_t)ch * 32768 + (tid + 512 * q) * 16); }
#pragma unroll
            for (int q = 0; q < 4; ++q) *(LAS u32x4*)(L + (tid + 512 * q) * 16) = rpre[q];
            if (ci < 7) {
#pragma unroll
                for (int q = 0; q < 4; ++q) rpre[q] = *(const GAS u32x4*)((const unsigned char*)RS + (size_t)(ch + 1) * 32768 + (tid + 512 * q) * 16); }
            __syncthreads();
            const LAS unsigned char* Ts = L + L_A + ci * 8192;
            f32x16 x0 = {0.f, 0.f, 0.f, 0.f, 0.f, 0.f, 0.f, 0.f, 0.f, 0.f, 0.f, 0.f, 0.f, 0.f, 0.f, 0.f}, x1 = x0;
            const LAS unsigned char* rb = L + (8 * h2 + ((lane & 15) >> 2)) * 512 + (32 * w + 16 * ((lane >> 4) & 1) + 4 * (lane & 3)) * 2;
#pragma unroll
            for (int s = 0; s < 4; ++s) {
                const s16x4 lo = vtr(rb + (16 * s) * 512), hi = vtr(rb + (16 * s + 4) * 512);
                const bf16x8 bf = (bf16x8){lo[0], lo[1], lo[2], lo[3], hi[0], hi[1], hi[2], hi[3]};
                const bf16x8 a0 = *(const LAS bf16x8*)(Ts + i32 * 128 + (16 * s + 8 * h2) * 2), a1 = *(const LAS bf16x8*)(Ts + (32 + i32) * 128 + (16 * s + 8 * h2) * 2);
                x0 = __builtin_amdgcn_mfma_f32_32x32x16_bf16(a0, bf, x0, 0, 0, 0);
                x1 = __builtin_amdgcn_mfma_f32_32x32x16_bf16(a1, bf, x1, 0, 0, 0);
            }
            __syncthreads();
            {
                const int x = 32 * w + i32;
#pragma unroll
                for (int rg = 0; rg < 16; ++rg) {
#pragma unroll
                    for (int mt = 0; mt < 2; ++mt) { const int c = 32 * mt + crow(rg, h2); const float v = mt ? x1[rg] : x0[rg];
                        if (x < 128) *(LAS bf16*)(L + sw256(c, sigma_inv(x))) = (bf16)f2bf(-v);
                        else { const int vv = x - 128; const int idx = (((vv >> 4) * 64 + (vv & 15) + 16 * ((c >> 2) & 3)) * 16 + (c >> 4) * 4 + (c & 3));
                               *(LAS bf16*)(L + 16384 + idx * 2) = (bf16)f2bf(v); } }
                }
            }
            __syncthreads();
#pragma unroll
            for (int q = 0; q < 2; ++q) { const int off = (tid + 512 * q) * 16;
                *(GAS u32x4*)(scanops + (size_t)ch * SCAN_BYTES + off) = *(const LAS u32x4*)(L + off);
                *(GAS u32x4*)(scanops + (size_t)ch * SCAN_BYTES + 32768 + off) = *(const LAS u32x4*)(L + 16384 + off); }
        }
#endif
        __syncthreads(); PROFX(5);
    }
}

__device__ __forceinline__ void glds16(const void* gsrc, unsigned lds_dst) { unsigned keep;
    asm volatile("s_mov_b32 %0, m0\n\ts_mov_b32 m0, %2\n\ts_nop 0\n\tglobal_load_lds_dwordx4 %1, off\n\ts_mov_b32 m0, %0" : "=&s"(keep) : "v"(gsrc), "s"(lds_dst) : "memory"); }

__device__ __forceinline__ void scan_phase(Frame& F, unsigned char* ws, const unsigned char* dout, int bh) {
    const int lane = pg8::lane_now(), w = F.wave;
    const unsigned char* scanops = dout; const float* GLb = (const float*)(ws + WS_GGL);
    bf16* ST = (bf16*)(ws + WS_QKVA); bf16* UT = (bf16*)(ws + WS_QKVA + 64 * MiB);
    LAS unsigned char* L = F.lds + RING_OFF;
    const unsigned lds0 = (unsigned)(uintptr_t)(F.lds + RING_OFF);
    const int v16 = lane & 15, kg = lane >> 4;
    f32x4 Sf[8];
#pragma unroll
    for (int mt = 0; mt < 8; ++mt) Sf[mt] = (f32x4){0.f, 0.f, 0.f, 0.f};
    float glv = GLb[bh * 64 + lane];
    asm volatile("s_waitcnt vmcnt(0)" : "+v"(glv));
#define GDN_STAGE3(n, sl_) do { const unsigned char* src_ = scanops + (size_t)(bh * 64 + (n)) * SCAN_BYTES + lane * 16; \
        _Pragma("unroll") for (int q_ = 0; q_ < 6; ++q_) { const int piece_ = w * 6 + q_; \
            glds16(src_ + piece_ * 1024, (unsigned)__builtin_amdgcn_readfirstlane(lds0 + (sl_) * SCAN_BYTES + piece_ * 1024)); } } while (0)
#define GDN_STAGE(n) GDN_STAGE3(n, n)
    GDN_STAGE(0); GDN_STAGE(1);
    asm volatile("s_waitcnt vmcnt(6)" ::: "memory");
    int slot = 0, slot2 = 2;
    u32x4 Sb[4], Ub[2];
    for (int n = 0; n < 64; ++n) {
        __builtin_amdgcn_s_barrier();
        asm volatile("" ::: "memory");
        if (n + 2 < 64) GDN_STAGE3(n + 2, slot2);
        const LAS unsigned char* sl = L + slot * SCAN_BYTES;
        const float gl = __shfl(glv, n);
#pragma unroll
        for (int s = 0; s < 4; ++s) { Sb[s].x = cvtpk(Sf[2 * s][0], Sf[2 * s][1]); Sb[s].y = cvtpk(Sf[2 * s][2], Sf[2 * s][3]); Sb[s].z = cvtpk(Sf[2 * s + 1][0], Sf[2 * s + 1][1]); Sb[s].w = cvtpk(Sf[2 * s + 1][2], Sf[2 * s + 1][3]); }
        f32x4 Uf[4];
        { const u32x4 u0 = *(const LAS u32x4*)(sl + 32768 + (w * 64 + lane) * 32), u1 = *(const LAS u32x4*)(sl + 32768 + (w * 64 + lane) * 32 + 16);
          Uf[0] = (f32x4){bflo(u0.x), bfhi(u0.x), bflo(u0.y), bfhi(u0.y)}; Uf[1] = (f32x4){bflo(u0.z), bfhi(u0.z), bflo(u0.w), bfhi(u0.w)};
          Uf[2] = (f32x4){bflo(u1.x), bfhi(u1.x), bflo(u1.y), bfhi(u1.y)}; Uf[3] = (f32x4){bflo(u1.z), bfhi(u1.z), bflo(u1.w), bfhi(u1.w)}; }
        bf16x8 ak[16];
        {
            bf16x8 aw[16];
#pragma unroll
            for (int mt = 0; mt < 4; ++mt)
#pragma unroll
                for (int s = 0; s < 4; ++s) aw[mt * 4 + s] = *(const LAS bf16x8*)(sl + sw256(16 * mt + v16, 32 * s + 8 * kg));
#pragma unroll
            for (int s = 0; s < 4; ++s)
#pragma unroll
                for (int mt = 0; mt < 4; ++mt) Uf[mt] = __builtin_amdgcn_mfma_f32_16x16x32_bf16(aw[mt * 4 + s], __builtin_bit_cast(bf16x8, Sb[s]), Uf[mt], 0, 0, 0);
#pragma unroll
            for (int mt = 0; mt < 8; ++mt)
#pragma unroll
                for (int s = 0; s < 2; ++s) ak[mt * 2 + s] = *(const LAS bf16x8*)(sl + 16384 + sw128(16 * mt + v16, 32 * s + 8 * kg));
            __builtin_amdgcn_sched_group_barrier(0x100, 34, 0);
            __builtin_amdgcn_sched_group_barrier(0x008, 16, 0);
        }
#pragma unroll
        for (int s = 0; s < 2; ++s) { Ub[s].x = cvtpk(Uf[2 * s][0], Uf[2 * s][1]); Ub[s].y = cvtpk(Uf[2 * s][2], Uf[2 * s][3]); Ub[s].z = cvtpk(Uf[2 * s + 1][0], Uf[2 * s + 1][1]); Ub[s].w = cvtpk(Uf[2 * s + 1][2], Uf[2 * s + 1][3]); }
        {
#pragma unroll
            for (int mt = 0; mt < 8; ++mt) Sf[mt] = Sf[mt] * gl;
#pragma unroll
            for (int s = 0; s < 2; ++s)
#pragma unroll
                for (int mt = 0; mt < 8; ++mt) Sf[mt] = __builtin_amdgcn_mfma_f32_16x16x32_bf16(ak[mt * 2 + s], __builtin_bit_cast(bf16x8, Ub[s]), Sf[mt], 0, 0, 0);
        }
        if (n + 2 < 64) asm volatile("s_waitcnt vmcnt(6) lgkmcnt(0)" ::: "memory"); else asm volatile("s_waitcnt vmcnt(0) lgkmcnt(0)" ::: "memory");
        { bf16* dst = ST + (size_t)(bh * 64 + n) * 16384 + (w * 4 * 64 + lane) * 8;
#pragma unroll
          for (int s = 0; s < 4; ++s) *(GAS u32x4*)(dst + s * 512) = Sb[s]; }
        { bf16* dst = UT + (size_t)(bh * 64 + n) * 8192 + (w * 2 * 64 + lane) * 8;
#pragma unroll
          for (int s = 0; s < 2; ++s) *(GAS u32x4*)(dst + s * 512) = Ub[s]; }
        slot = (slot == 2) ? 0 : slot + 1; slot2 = (slot2 == 2) ? 0 : slot2 + 1;
    }
    asm volatile("s_waitcnt vmcnt(0) lgkmcnt(0)" ::: "memory");
    __builtin_amdgcn_s_barrier();
#undef GDN_STAGE
#undef GDN_STAGE3
}

__device__ __forceinline__ void a3_phase(Frame& F, unsigned char* ws, const unsigned char* dout, const float* gdn_norm) {
    const int lane = pg8::lane_now(), w = F.wave, tid = w * 64 + lane;
    const bf16* QGb = (const bf16*)(dout + 96 * MiB); const bf16* AQKb = (const bf16*)(ws + WS_GAQK);
    const bf16* ST = (const bf16*)(ws + WS_QKVA); const bf16* UT = (const bf16*)(ws + WS_QKVA + 64 * MiB);
    const bf16* Z = (const bf16*)(ws + WS_Z); bf16* Y = (bf16*)(ws + WS_Y);
    LAS float* Ot = (LAS float*)(F.lds + RING_OFF);
    const int v16 = lane & 15, kg = lane >> 4;
    const int c = tid >> 3, v0 = 16 * (tid & 7);
    f32x4 gn[4];
#pragma unroll
    for (int q = 0; q < 4; ++q) gn[q] = *(const GAS f32x4*)(gdn_norm + v0 + 4 * q);
    LAS unsigned char* LQ = F.lds + RING_OFF + 34816; LAS unsigned char* LA = LQ + 16384;
    bf16x8 fb[6]; u32x4 gq[3];
#define A3_LOADB(ch_) do { const int ch__ = (ch_); \
        const bf16* sp_ = ST + (size_t)ch__ * 16384 + (w * 4 * 64 + lane) * 8; const bf16* up_ = UT + (size_t)ch__ * 8192 + (w * 2 * 64 + lane) * 8; \
        _Pragma("unroll") for (int s = 0; s < 4; ++s) fb[s] = *(const GAS bf16x8*)(sp_ + 512 * s); \
        _Pragma("unroll") for (int s = 0; s < 2; ++s) fb[4 + s] = *(const GAS bf16x8*)(up_ + 512 * s); } while (0)
#define A3_LOADA(ch_) do { const int ch__ = (ch_); \
        gq[0] = *(const GAS u32x4*)((const unsigned char*)QGb + (size_t)ch__ * 16384 + tid * 16); gq[1] = *(const GAS u32x4*)((const unsigned char*)QGb + (size_t)ch__ * 16384 + (tid + 512) * 16); \
        gq[2] = *(const GAS u32x4*)((const unsigned char*)AQKb + (size_t)ch__ * 8192 + tid * 16); } while (0)
    if (F.vcu < NCH) { A3_LOADA(F.vcu); A3_LOADB(F.vcu); }
    for (int ch = F.vcu; ch < NCH; ch += F.G) {
        const int n = ch & 63, bh = ch >> 6, h = bh & 3, b = bh >> 2;
        const size_t m = (size_t)b * SEQ + n * 64 + c;
        const size_t zo = ((size_t)(b * 4 + h) * SEQ + n * 64 + c) * 128 + v0;
        const u32x4 z0 = *(const GAS u32x4*)(Z + zo), z1 = *(const GAS u32x4*)(Z + zo + 8);
        { const int r0 = tid >> 4, r1 = (tid + 512) >> 4, r2 = tid >> 3;
          *(LAS u32x4*)(LQ + r0 * 256 + (((tid & 15) ^ (r0 & 15)) << 4)) = gq[0]; *(LAS u32x4*)(LQ + r1 * 256 + (((tid & 15) ^ (r1 & 15)) << 4)) = gq[1];
          *(LAS u32x4*)(LA + r2 * 128 + (((tid & 7) ^ (r2 & 7)) << 4)) = gq[2]; }
        __syncthreads();
        if (ch + F.G < NCH) A3_LOADA(ch + F.G);
        f32x4 acc[4];
#pragma unroll
        for (int mt = 0; mt < 4; ++mt) acc[mt] = (f32x4){0.f, 0.f, 0.f, 0.f};
#pragma unroll
        for (int s = 0; s < 4; ++s) {
            bf16x8 fa[4];
#pragma unroll
            for (int mt = 0; mt < 4; ++mt) fa[mt] = *(const LAS bf16x8*)(LQ + (16 * mt + v16) * 256 + (((4 * s + kg) ^ v16) << 4));
#pragma unroll
            for (int mt = 0; mt < 4; ++mt) acc[mt] = __builtin_amdgcn_mfma_f32_16x16x32_bf16(fa[mt], fb[s], acc[mt], 0, 0, 0); }
#pragma unroll
        for (int s = 0; s < 2; ++s) {
            bf16x8 fa[4];
#pragma unroll
            for (int mt = 0; mt < 4; ++mt) fa[mt] = *(const LAS bf16x8*)(LA + (16 * mt + v16) * 128 + (((4 * s + kg) ^ (v16 & 7)) << 4));
#pragma unroll
            for (int mt = 0; mt < 4; ++mt) acc[mt] = __builtin_amdgcn_mfma_f32_16x16x32_bf16(fa[mt], fb[4 + s], acc[mt], 0, 0, 0); }
        if (ch + F.G < NCH) A3_LOADB(ch + F.G);
        __syncthreads();
#pragma unroll
        for (int mt = 0; mt < 4; ++mt)
#pragma unroll
            for (int rg = 0; rg < 4; ++rg) Ot[(16 * mt + 4 * kg + rg) * 132 + 16 * w + v16] = acc[mt][rg];
        __syncthreads();
        {
            f32x4 o[4]; float ss = 0.f;
#pragma unroll
            for (int q = 0; q < 4; ++q) { o[q] = *(const LAS f32x4*)(Ot + c * 132 + v0 + 4 * q); ss += (o[q].x * o[q].x + o[q].y * o[q].y) + (o[q].z * o[q].z + o[q].w * o[q].w); }
            ss = dpp_add(ss, 0); ss = dpp_add(ss, 1);
            ss += __builtin_bit_cast(float, __builtin_amdgcn_mov_dpp(__builtin_bit_cast(int, ss), 0x141, 0xF, 0xF, false));
            const float rg = rsqrtf(ss * (1.f / 128.f) + EPS);
            u32x4 y0, y1;
#pragma unroll
            for (int q = 0; q < 2; ++q) {
                const f32x4 a = o[q] * rg * gn[q], bq = o[2 + q] * rg * gn[2 + q];
                y0[2 * q] = cvtpk(a.x * fsilu(bflo(z0[2 * q])), a.y * fsilu(bfhi(z0[2 * q]))); y0[2 * q + 1] = cvtpk(a.z * fsilu(bflo(z0[2 * q + 1])), a.w * fsilu(bfhi(z0[2 * q + 1])));
                y1[2 * q] = cvtpk(bq.x * fsilu(bflo(z1[2 * q])), bq.y * fsilu(bfhi(z1[2 * q]))); y1[2 * q + 1] = cvtpk(bq.z * fsilu(bflo(z1[2 * q + 1])), bq.w * fsilu(bfhi(z1[2 * q + 1]))); }
            *(GAS u32x4*)(Y + m * 1024 + h * 128 + v0) = y0; *(GAS u32x4*)(Y + m * 1024 + h * 128 + v0 + 8) = y1;
        }
    }
#undef A3_LOADA
#undef A3_LOADB
}
}

__global__ void __launch_bounds__(NWAVES * 64, 2) mega_fwd(Args args) {
    extern __shared__ __attribute__((aligned(16))) unsigned char lds[];
    Frame F;
    F.lds = (LAS unsigned char*)lds;
    F.MISC = (volatile LAS unsigned*)(F.lds + MISC_OFF);
    F.wave = __builtin_amdgcn_readfirstlane(threadIdx.x >> 6);
    F.G = gridDim.x; { const int bx = blockIdx.x; F.vcu = (F.G % 8 == 0) ? (bx % 8) * (F.G / 8) + bx / 8 : bx; }
    unsigned char* ws = args.ws;
    F.ctl = (gu32*)(ws + WS_CTL);
    for (int u = threadIdx.x; u < (LDS_BYTES - LDSCTL_OFF) / 4; u += NWAVES * 64) ((LAS unsigned*)(F.lds + LDSCTL_OFF))[u] = 0u;
    __syncthreads();
    const int lo = args.ph_lo, hi = args.ph_hi;
    const bool multi = (hi - lo) > 1;
    XcdBarrier bar; bar.bar = (unsigned*)(F.ctl + CW_BAR) + args.li * XCD_BAR_WORDS; bar.x = 0; bar.st = nullptr; bar.wave = F.wave;
    if (multi) bar = xcd_barrier_post((unsigned*)(F.ctl + CW_BAR) + args.li * XCD_BAR_WORDS, F.MISC + 8, F.wave);
#ifndef MK_REP
#define MK_REP -1
#endif
#define REPS(k) (((k) == MK_REP) ? 2 : 1)
#define IN(k) (lo <= (k) && (k) < hi)
#define BOTH(k) (IN(k) && IN((k) + 1))
#define GRID_BAR() do { xcd_barrier(bar); PROF_STAMP(); } while (0)
#if MK_PROF_A >= 0
    if (F.wave == 0 && pg8::lane_now() == 0) { const unsigned long long t_ = __builtin_amdgcn_s_memrealtime(); F.MISC[16] = (unsigned)t_; F.MISC[17] = (unsigned)(t_ >> 32); F.MISC[18] = (unsigned)lo; F.MISC[19] = 0u; F.MISC[20] = 0u; }
#define PROF_STAMP() do { if (F.wave == 0 && pg8::lane_now() == 0) { const unsigned long long t_ = __builtin_amdgcn_s_memrealtime(); \
        const unsigned long long p_ = ((unsigned long long)F.MISC[17] << 32) | F.MISC[16]; const float d_ = (float)(t_ - p_) * 0.01f; const int k_ = (int)F.MISC[18]; \
        if (k_ == MK_PROF_A) F.MISC[19] = __float_as_uint(d_); if (k_ == MK_PROF_B) F.MISC[20] = __float_as_uint(d_); F.MISC[16] = (unsigned)t_; F.MISC[17] = (unsigned)(t_ >> 32); F.MISC[18] = (unsigned)(k_ + 1); } } while (0)
#else
#define PROF_STAMP() do {} while (0)
#endif

#if MK_PROF_A >= 120 && MK_PROF_A < 130
#define PROFM(idx) do { if (blockIdx.x == 0 && F.wave == 0 && pg8::lane_now() == 0) { const unsigned long long t_ = __builtin_amdgcn_s_memrealtime(); \
        const unsigned long long p_ = ((unsigned long long)F.MISC[23] << 32) | F.MISC[22]; if ((idx) >= 0) F.MISC[24 + (idx)] = __float_as_uint(__uint_as_float(F.MISC[24 + (idx)]) + (float)(t_ - p_) * 0.01f); \
        F.MISC[22] = (unsigned)t_; F.MISC[23] = (unsigned)(t_ >> 32); } } while (0)
#else
#define PROFM(idx) do {} while (0)
#endif
    if (IN(0)) { p0_phase(F, ws, args.in[1], args.in[2], args.in[3], args.in[5], args.in[11], args.in[16], args.in[17], args.in[18], args.in[14], args.in[15]);
        asm volatile("s_waitcnt vmcnt(0)" ::: "memory"); __syncthreads();
        if ((int)blockIdx.x < 192 && F.wave == 0 && pg8::lane_now() == 0) { __builtin_amdgcn_fence(__ATOMIC_RELEASE, "agent"); asm volatile("s_waitcnt vmcnt(0)" ::: "memory"); (void)xb_add((unsigned*)(F.ctl + CW_MODF), 1u); }
        PROF_STAMP(); }
    if (IN(1)) { p0b_phase(F, ws, args.in[5], args.in[11], args.in[16], args.in[17], args.in[18]);
        if (F.wave == 0 && pg8::lane_now() == 0) { unsigned* bw_ = (unsigned*)(F.ctl + CW_BAR) + args.li * XCD_BAR_WORDS; const unsigned need_ = (unsigned)(F.G < 192 ? F.G : 192);
            XB_SPIN(xb_ld((unsigned*)(F.ctl + CW_MODF)) < need_, bw_);
            __builtin_amdgcn_fence(__ATOMIC_ACQUIRE, "agent"); asm volatile("s_waitcnt vmcnt(0)" ::: "memory"); }
        __syncthreads();
        p1_phase(F, ws, args.in[0], args.in[4], args.in[5], args.in[7], args.in[8]);
        if (BOTH(1)) GRID_BAR(); }
    if (IN(2)) { for (int rep_ = 0; rep_ < REPS(2); ++rep_) {
        pg8::Gemm g{(const pg8::bf16_t*)(ws + WS_H), (const pg8::bf16_t*)(ws + WS_WIN), T, NPROJ, D};
        pg8::StaticOrder S; S.init(T, NPROJ, F.G, (int)blockIdx.x);
        pg8::EpiProj E{ws, 0.125f * 1.4426950408889634f};
        pg8::gemm_phase<pg8::EpiProj, pg8::StaticOrder, true, true>(F.lds + RING_OFF, g, S, E, F.wave); }
        if (BOTH(2)) GRID_BAR();
    }
    if (IN(3)) { for (int rep_ = 0; rep_ < REPS(3); ++rep_) gdn::a1_phase(F, ws, (unsigned char*)args.out, args.in[6]); if (BOTH(3)) GRID_BAR(); }
    if (IN(4)) { for (int rep_ = 0; rep_ < REPS(4); ++rep_) {
        if ((int)blockIdx.x < 32) {
#if MK_PROF_A >= 200
            unsigned long long ts0_ = __builtin_amdgcn_s_memrealtime();
#endif
            for (int r2_ = 0; r2_ < 1 + MK_REPSCAN; ++r2_) gdn::scan_phase(F, ws, (const unsigned char*)args.out, (int)blockIdx.x);
#if MK_PROF_A >= 200
            if (pg8::lane_now() == 0) atomicMax((unsigned*)(F.ctl + CW_CNT + 71), (unsigned)(__builtin_amdgcn_s_memrealtime() - ts0_));
#endif
        }
#if MK_SERIAL_SCAN
        if ((int)blockIdx.x < 32) { __syncthreads(); if (F.wave == 0 && pg8::lane_now() == 0) (void)xb_add((unsigned*)(F.ctl + CW_MODF + 32), 1u); }
        else { if (F.wave == 0 && pg8::lane_now() == 0) { unsigned* bw_ = (unsigned*)(F.ctl + CW_BAR) + args.li * XCD_BAR_WORDS; XB_SPIN(xb_ld((unsigned*)(F.ctl + CW_MODF + 32)) < 32u, bw_); } __syncthreads(); }
#endif
        attn_phase(F, ws, args.in[12]);
        }
        if (BOTH(4)) GRID_BAR(); }
#if MK_PROF_A >= 200
    if (blockIdx.x == 32 && F.wave == 0 && pg8::lane_now() == 0) { for (int q_ = 0; q_ < 4; ++q_) F.ctl[CW_CNT + 64 + q_] = F.MISC[24 + q_]; }
#endif
    if (IN(5)) { for (int rep_ = 0; rep_ < REPS(5); ++rep_) {
        PROFM(-1);
#if MK_MODE != 2 && MK_MODE != 3
        gdn::a3_phase(F, ws, (const unsigned char*)args.out, args.in[9]);
#endif
        PROFM(0);
        attn_combine_phase(F, ws, args.in[10]); PROFM(1); }
        if (BOTH(5)) GRID_BAR(); }

    if (IN(6)) { for (int rep_ = 0; rep_ < REPS(6); ++rep_) {
        pg8::Gemm g{(const pg8::bf16_t*)(ws + WS_Y), (const pg8::bf16_t*)(ws + WS_WOUT), T, D, D};
        pg8::StaticOrder S; S.init(T, D, F.G, (int)blockIdx.x);
        pg8::EpiRes E{args.in[0], (const float*)(ws + WS_MOD), (pg8::bf16_t*)(ws + WS_XM), 2048};
        pg8::gemm_phase<pg8::EpiRes, pg8::StaticOrder, true, true>(F.lds + RING_OFF, g, S, E, F.wave); }
        if (BOTH(6)) GRID_BAR();
    }
    if (IN(7)) { p5_phase(F, ws, (const bf16*)(ws + WS_XM), args.in[13]); if (BOTH(7)) GRID_BAR(); }
    if (IN(8) || IN(9) || IN(10)) moe_setup(F);
    if (IN(8)) { for (int rep_ = 0; rep_ < REPS(8); ++rep_) {
        pg8::Gemm g{(const pg8::bf16_t*)(ws + WS_H), (const pg8::bf16_t*)(ws + WS_WGU), PROWS, 256, D};
        pg8::MoeOrder<true, 2> S{(const LAS int*)(F.lds + MOE_OFF), (const LAS int*)(F.lds + MOE_OFF) + 33, (const int*)(ws + WS_LTOK), CAP, F.G, F.vcu, (unsigned*)(F.ctl + CW_TCNT), F.wave};
        pg8::EpiHid E{(pg8::bf16_t*)(ws + WS_HID), PROWS * 256 * 2};
        pg8::gemm_phase<pg8::EpiHid, pg8::MoeOrder<true, 2>, true, true>(F.lds + RING_OFF, g, S, E, F.wave); }
        if (BOTH(8)) { __syncthreads(); PROF_STAMP(); }
    }
    if (IN(9)) { for (int rep_ = 0; rep_ < REPS(9); ++rep_) {
        pg8::Gemm g{(const pg8::bf16_t*)(ws + WS_HID), (const pg8::bf16_t*)(ws + WS_WDN), PROWS, D, DEXP};
        pg8::MoeOrder<false, 4> S{(const LAS int*)(F.lds + MOE_OFF), (const LAS int*)(F.lds + MOE_OFF) + 33, (const int*)(ws + WS_LTOK), CAP, F.G, F.vcu, (unsigned*)(F.ctl + CW_TCNT), F.wave};
        pg8::EpiYs E{(pg8::bf16_t*)(ws + WS_YS), (const float*)(ws + WS_LW), (const LAS int*)(F.lds + MOE_OFF) + 33, CAP};
        pg8::gemm_phase<pg8::EpiYs, pg8::MoeOrder<false, 4>, true, true>(F.lds + RING_OFF, g, S, E, F.wave); }
        if (BOTH(9)) GRID_BAR();
    }
    if (IN(10)) { p8_phase(F, ws, args.out, args.in[19]); }
#if MK_PROF_A >= 0
    GRID_BAR();
    if (blockIdx.x == 0) { const int t_ = F.wave * 64 + pg8::lane_now(); if (MK_PROF_A >= 200 && t_ == 0) { for (int q_ = 0; q_ < 4; ++q_) F.MISC[24 + q_] = F.ctl[CW_CNT + 64 + q_]; F.MISC[30] = __float_as_uint((float)F.ctl[CW_CNT + 70] * 0.01f); F.MISC[31] = __float_as_uint((float)F.ctl[CW_CNT + 71] * 0.01f); } __syncthreads();
        const float prof_a = (MK_PROF_A >= 100) ? __uint_as_float(F.MISC[24 + (MK_PROF_A % 10)]) : __uint_as_float(F.MISC[19]), prof_b = (MK_PROF_B >= 100) ? __uint_as_float(F.MISC[24 + (MK_PROF_B % 10)]) : __uint_as_float(F.MISC[20]);
        for (int r = t_; r < T; r += NWAVES * 64) args.out[(size_t)r * D + 1] += prof_b * (1.f / (float)MK_PROF_SB);
        if (t_ == 0) args.out[0] += 10.f + prof_a * (0.01f * (float)MK_PROF_SA); }
#endif
#undef IN
#undef BOTH
}


static int g_grid = 0;
static void launch_mega(Args a, int lo, int hi, int li, hipStream_t stream) {
    a.ph_lo = lo; a.ph_hi = hi; a.li = li;
    void* params[] = {&a};
    hipError_t e = hipLaunchCooperativeKernel((const void*)mega_fwd, dim3(g_grid), dim3(NWAVES * 64), params, LDS_BYTES, stream);
    if (e != hipSuccess) fprintf(stderr, "kernel_launch: cooperative launch [%d,%d) failed: %s (grid %d)\n", lo, hi, hipGetErrorString(e), g_grid);
}

extern "C" void kernel_launch(void* const* d_in, const int* in_sizes, int n_in, void* d_out, int out_size, void* d_ws, size_t ws_size, hipStream_t stream) {
    if (g_grid == 0) {
        if (n_in != 20 || ws_size < WS_NEED || out_size != T * D) { fprintf(stderr, "kernel_launch: unexpected shapes (n_in %d, ws %zu, out %d)\n", n_in, ws_size, out_size); g_grid = -1; return; }
        int dev = 0, cus = 0, per_cu = 0;
        (void)hipGetDevice(&dev); (void)hipDeviceGetAttribute(&cus, hipDeviceAttributeMultiprocessorCount, dev);
        if (hipFuncSetAttribute((const void*)mega_fwd, hipFuncAttributeMaxDynamicSharedMemorySize, LDS_BYTES) != hipSuccess) { fprintf(stderr, "kernel_launch: hipFuncSetAttribute failed\n"); g_grid = -1; return; }
        if (hipOccupancyMaxActiveBlocksPerMultiprocessor(&per_cu, (const void*)mega_fwd, NWAVES * 64, LDS_BYTES) != hipSuccess || per_cu < 1) { fprintf(stderr, "kernel_launch: occupancy query says %d\n", per_cu); per_cu = 1; }
        (void)hipGetLastError();
        g_grid = cus;
        fprintf(stderr, "kernel_launch: cus %d per_cu %d grid %d\n", cus, per_cu, g_grid);
    }
    if (g_grid < 0) return;
    (void)hipMemsetAsync((char*)d_ws + WS_CTL, 0, CTL_ZERO_BYTES, stream);
    Args a{};
    for (int i = 0; i < 20; ++i) a.in[i] = (const float*)d_in[i];
    a.out = (float*)d_out; a.ws = (unsigned char*)d_ws;
#if MK_DEV
#if MK_SPLIT
    launch_mega(a, 0, 1, 0, stream); launch_mega(a, 1, 2, 0, stream); launch_mega(a, 2, 3, 0, stream);
#else
    launch_mega(a, 0, 3, 0, stream);
#endif
#if MK_MODE == 2
    naive_gdn(a, stream); launch_mega(a, 4, 6, 1, stream); naive_yfin_gdn(a, stream); launch_mega(a, 6, 11, 2, stream);
#elif MK_MODE == 5
    launch_mega(a, 3, 4, 1, stream); naive_solve(a, stream); launch_mega(a, 4, 11, 2, stream);
#elif MK_MODE == 4
    launch_mega(a, 3, 4, 1, stream); naive_scan(a, stream); launch_mega(a, 4, 11, 2, stream);
#elif MK_MODE == 3
    launch_mega(a, 3, 6, 1, stream); naive_a3(a, stream); launch_mega(a, 6, 11, 2, stream);
#else
    launch_mega(a, 3, 11, 1, stream);
#endif
#else
    launch_mega(a, 0, 11, 0, stream);
#endif
}
```

```cpp
#define MK_DEV 0
#define MK_SPLIT 0
#define MK_MODE 0
#define MK_A1 0
#define MK_REP -1
#define MK_REPSCAN 0
#define MK_REPATT 0
#define MK_PROF_A -1
#define MK_PROF_B -1
#define MK_ATT_PF 0
#define MK_SERIAL_SCAN 0
#define MK_PROF_SA 25
#define MK_PROF_SB 250
#include <hip/hip_runtime.h>
#include <hip/hip_cooperative_groups.h>
#include <cstdio>
#include <cstdint>
#include <cmath>

namespace pg8 {
#define PG8_LAS __attribute__((address_space(3)))
typedef unsigned short bf16_t;
typedef short bf16x8 __attribute__((ext_vector_type(8)));
typedef float f32x4 __attribute__((ext_vector_type(4)));
typedef unsigned u32x4 __attribute__((ext_vector_type(4)));
constexpr int BM = 256, BK = 64, HALF = 128, HTB = HALF * BK * 2  , STAGE_BYTES = 8 * HTB, NXCD = 8, WGM = 8;

__host__ __device__ __forceinline__ int lds_byte(int r, int c) { const int st = (r >> 4) * 2 + (c >> 5), rr = r & 15, cc = c & 31, ob = rr * 64 + cc * 2; return st * 1024 + (ob ^ (((ob >> 9) & 1) << 5)); }
__host__ __device__ __forceinline__ void stage_rc(int b, int& R, int& C) { const int st = b / 1024, sb = b % 1024, swz = sb ^ (((sb >> 9) & 1) << 5); R = (st >> 1) * 16 + swz / 64; C = (st & 1) * 32 + (swz % 64) / 2; }
__host__ __device__ __forceinline__ int perm32(int rho) { const int n = rho >> 4, i = rho & 15; return 8 * (i >> 2) + 4 * n + (i & 3); }

__device__ __forceinline__ int lane_now() { int l; asm volatile("v_mbcnt_lo_u32_b32 %0, -1, 0\n\tv_mbcnt_hi_u32_b32 %0, -1, %0" : "=v"(l)); return l; }
constexpr int GATH_LDS_OFF = 148480;
struct Unit { int pm, pn, pb, e, mt; };
struct Gemm { const bf16_t* A; const bf16_t* Bt; int M, N, K; };

struct StaticOrder {
    int nM, nN, nwg, G, c;
    __host__ __device__ void init(int M, int N, int G_, int c_) { nM = M / BM; nN = N / BM; nwg = nM * nN; G = G_; c = c_; }
    __host__ __device__ bool next(int i, Unit& u) const {
        const long L = (long)i * G + c; if (L >= nwg) return false;
        int wgid = (int)L; { const int q = nwg / NXCD, r = nwg % NXCD, xcd = wgid % NXCD, off = wgid / NXCD; wgid = (xcd < r ? xcd * (q + 1) : r * (q + 1) + (xcd - r) * q) + off; }
        const int nig = WGM * nN, gid = wgid / nig, fm = gid * WGM, gsz = (nM - fm) < WGM ? (nM - fm) : WGM;
        u.pm = fm + ((wgid % nig) % gsz); u.pn = (wgid % nig) / gsz; u.pb = u.pn; u.e = 0; u.mt = 0; return true;
    }
    static constexpr bool GATHER = false;
    __device__ __forceinline__ void a_ready(const Unit&) const {}
    __device__ __forceinline__ void done(const Unit&) const {}
};

__device__ __forceinline__ unsigned cvt_pk_bf16(float lo, float hi) { typedef float f32x2_t_ __attribute__((ext_vector_type(2))); typedef __bf16 bf16x2_t_ __attribute__((ext_vector_type(2))); const f32x2_t_ v_ = {lo, hi}; return __builtin_bit_cast(unsigned, __builtin_convertvector(v_, bf16x2_t_)); }
struct EpiProj {
    static constexpr bool PERM = true, AFTER_DRAIN = false;
    unsigned char* ws; float qscale;
    __device__ __forceinline__ void operator()(const f32x4 (&acc)[2][2][4][2], const Unit& u, int wr, int wc, int fr, int fq) const {
        { const int ln_ = lane_now(); fr = ln_ & 15; fq = ln_ >> 4; }
        const int pn = u.pn;
        const int t = (pn - 6) >> 1;
        const bool a = pn < 6;
        const size_t off = a ? ((size_t)160 << 20) : (((size_t)256 + 32 * (size_t)t) << 20);
        const bool hm = !a && t >= 1;
        const int colt = a ? pn * 256 : ((pn - 6) & 1) * 256;
        const float sc = (t == 1 && !a) ? qscale : 1.f;
        const int row0 = u.pm * BM + wr * 64 + fr, col0 = colt + wc * 32 + 8 * fq;
        const int rowe = row0 & 4095, bq = row0 >> 12;
        const int ldc = a ? 384 : (hm ? 64 : 128);
        const int hh = hm ? (col0 >> 6) : ((col0 >> 7) & 3), nh = hm ? 8 : 4;
        const size_t cole = (size_t)(bq * nh + hh) * 4096 * ldc + (a ? (size_t)(col0 >> 9) * 128 : (size_t)0) + (size_t)(hm ? (col0 & 63) : (col0 & 127));
        const size_t bjstep = (size_t)(hm ? 2 : 1) * 4096 * ldc;
        bf16_t* base = (bf16_t*)(ws + off);
#pragma unroll
        for (int ai = 0; ai < 2; ++ai)
#pragma unroll
            for (int m = 0; m < 4; ++m) { bf16_t* rowp = base + (size_t)(rowe + ai * HALF + m * 16) * ldc + cole;
#pragma unroll
                for (int bj = 0; bj < 2; ++bj) { const f32x4 v0 = acc[ai][bj][m][0] * sc, v1 = acc[ai][bj][m][1] * sc;
                    u32x4 w; w.x = cvt_pk_bf16(v0[0], v0[1]); w.y = cvt_pk_bf16(v0[2], v0[3]); w.z = cvt_pk_bf16(v1[0], v1[1]); w.w = cvt_pk_bf16(v1[2], v1[3]);
                    *(u32x4*)(rowp + bj * bjstep) = w; } }
    }
};

struct EpiRes {
    static constexpr bool PERM = true, AFTER_DRAIN = false;
    const float* x; const float* mod; bf16_t* out; int gate_off;
    __device__ __forceinline__ void operator()(const f32x4 (&acc)[2][2][4][2], const Unit& u, int wr, int wc, int fr, int fq) const {
        { const int ln_ = lane_now(); fr = ln_ & 15; fq = ln_ >> 4; }
        const int col0 = u.pn * BM + wc * 32 + 8 * fq, b = (u.pm * BM) >> 12;
#pragma unroll
        for (int bj = 0; bj < 2; ++bj) {
            const f32x4 g0 = *(const f32x4*)(mod + b * 6144 + gate_off + col0 + bj * HALF), g1 = *(const f32x4*)(mod + b * 6144 + gate_off + col0 + bj * HALF + 4);
#pragma unroll
            for (int ai = 0; ai < 2; ++ai) {
                f32x4 xv[4][2];
#pragma unroll
                for (int m = 0; m < 4; ++m) { const size_t off = (size_t)(u.pm * BM + ai * HALF + wr * 64 + m * 16 + fr) * 1024 + col0 + bj * HALF;
                    xv[m][0] = *(const f32x4*)(x + off); xv[m][1] = *(const f32x4*)(x + off + 4); }
#pragma unroll
                for (int m = 0; m < 4; ++m) { const size_t off = (size_t)(u.pm * BM + ai * HALF + wr * 64 + m * 16 + fr) * 1024 + col0 + bj * HALF;
                    const f32x4 v0 = xv[m][0] + g0 * acc[ai][bj][m][0], v1 = xv[m][1] + g1 * acc[ai][bj][m][1];
                    u32x4 w; w.x = cvt_pk_bf16(v0[0], v0[1]); w.y = cvt_pk_bf16(v0[2], v0[3]); w.z = cvt_pk_bf16(v1[0], v1[1]); w.w = cvt_pk_bf16(v1[2], v1[3]);
                    *(u32x4*)(out + off) = w; }
            }
            asm volatile("" ::: "memory"); }
    }
};
__device__ __forceinline__ float silu_f(float v) { return v * __builtin_amdgcn_rcpf(1.f + __builtin_amdgcn_exp2f(-1.4426950408889634f * v)); }
struct EpiHid {
    static constexpr bool PERM = true, AFTER_DRAIN = false;
    bf16_t* hid; int hid_bytes;
    __device__ __forceinline__ void operator()(const f32x4 (&acc)[2][2][4][2], const Unit& u, int wr, int wc, int fr, int fq) const {
        { const int ln_ = lane_now(); fr = ln_ & 15; fq = ln_ >> 4; }
        const __amdgpu_buffer_rsrc_t rs = __builtin_amdgcn_make_buffer_rsrc((void*)hid, 0, hid_bytes, 0x00020000);
        const int col0 = u.pn * HALF + wc * 32 + 8 * fq;
#pragma unroll
        for (int ai = 0; ai < 2; ++ai)
#pragma unroll
            for (int m = 0; m < 4; ++m) { const size_t row = (size_t)u.pm * BM + ai * HALF + wr * 64 + m * 16 + fr;
                const f32x4 g0 = acc[ai][0][m][0], g1 = acc[ai][0][m][1], u0 = acc[ai][1][m][0], u1 = acc[ai][1][m][1];
                u32x4 w; w.x = cvt_pk_bf16(silu_f(g0[0]) * u0[0], silu_f(g0[1]) * u0[1]); w.y = cvt_pk_bf16(silu_f(g0[2]) * u0[2], silu_f(g0[3]) * u0[3]);
                w.z = cvt_pk_bf16(silu_f(g1[0]) * u1[0], silu_f(g1[1]) * u1[1]); w.w = cvt_pk_bf16(silu_f(g1[2]) * u1[2], silu_f(g1[3]) * u1[3]);
                __builtin_amdgcn_raw_buffer_store_b128(w, rs, (unsigned)((row * 256 + col0) * 2), 0,   16); }
    }
};
struct EpiYs {
    static constexpr bool PERM = true, AFTER_DRAIN = false;
    bf16_t* ys; const float* lw; const PG8_LAS int* cnt; int cap;
    __device__ __forceinline__ void operator()(const f32x4 (&acc)[2][2][4][2], const Unit& u, int wr, int wc, int fr, int fq) const {
        { const int ln_ = lane_now(); fr = ln_ & 15; fq = ln_ >> 4; }
        const int col0 = u.pn * BM + wc * 32 + 8 * fq, n_e = cnt[u.e];
#pragma unroll
        for (int ai = 0; ai < 2; ++ai)
#pragma unroll
            for (int m = 0; m < 4; ++m) { const int rl = u.mt * BM + ai * HALF + wr * 64 + m * 16 + fr;
                const float wv = rl < n_e ? lw[(size_t)u.e * cap + rl] : 0.f;
                bf16_t* rowp = ys + ((size_t)u.pm * BM + ai * HALF + wr * 64 + m * 16 + fr) * 1024 + col0;
#pragma unroll
                for (int bj = 0; bj < 2; ++bj) { const f32x4 v0 = acc[ai][bj][m][0] * wv, v1 = acc[ai][bj][m][1] * wv;
                    u32x4 w; w.x = cvt_pk_bf16(v0[0], v0[1]); w.y = cvt_pk_bf16(v0[2], v0[3]); w.z = cvt_pk_bf16(v1[0], v1[1]); w.w = cvt_pk_bf16(v1[2], v1[3]);
                    *(u32x4*)(rowp + bj * HALF) = w; } }
    }
};
template <bool GATHER_, int NPN> struct MoeOrder {
    static constexpr bool GATHER = GATHER_;
    const PG8_LAS int* tpre; const PG8_LAS int* cnt; const int* ltok; int cap, G, c; unsigned* tcnt; int wave;
    __device__ __forceinline__ bool next(int i, Unit& u) const {
        const int NT = __builtin_amdgcn_readfirstlane(tpre[32]); int L;
        if constexpr (GATHER) { L = i * G + c; }
        else { const int x = (2 * NT) % G, F = G - x;
            if (c >= x) L = i < 2 ? (c - x) + i * F : 2 * F + (i - 2) * G + (c - x);
            else L = 2 * F + i * G + F + c; }
        if (L >= NT * NPN) return false;
        const int tt = L / NPN, pn = L % NPN; int e = 0;
#pragma unroll
        for (int k = 1; k < 32; ++k) e += (tt >= tpre[k]) ? 1 : 0;
        e = __builtin_amdgcn_readfirstlane(e);
        u.pm = tt; u.pn = pn; u.e = e; u.mt = tt - __builtin_amdgcn_readfirstlane(tpre[e]); u.pb = e * NPN + pn; return true;
    }
    __device__ __forceinline__ void avoff(const Unit& u, int tid, int K, unsigned (&v0)[2], unsigned (&v1)[2]) const {
        const int n_e = cnt[u.e];
#pragma unroll
        for (int i = 0; i < 2; ++i) { int R, C; stage_rc(tid * 16 + i * 8192, R, C); const int r0 = u.mt * BM + R, r1 = r0 + HALF;
            const int t0 = ltok[(size_t)u.e * cap + (r0 < n_e ? r0 : 0)], t1 = ltok[(size_t)u.e * cap + (r1 < n_e ? r1 : 0)];
            v0[i] = (unsigned)(t0 * K + C) * 2u; v1[i] = (unsigned)(t1 * K + C) * 2u; }
    }
    __device__ __forceinline__ void a_ready(const Unit& u) const {
        if constexpr (!GATHER) {
            if (wave == 0 && lane_now() == 0) {
                unsigned sp = 0u;
                while (__hip_atomic_load(tcnt + u.pm, __ATOMIC_RELAXED, __HIP_MEMORY_SCOPE_AGENT) < 2u && ++sp < (1u << 22)) __builtin_amdgcn_s_sleep(1);
                __builtin_amdgcn_fence(__ATOMIC_ACQUIRE, "agent"); asm volatile("s_waitcnt vmcnt(0)" ::: "memory"); }
            __builtin_amdgcn_s_barrier();
        }
    }
    __device__ __forceinline__ void done(const Unit& u) const {
        if constexpr (GATHER) {
            asm volatile("s_waitcnt vmcnt(0)" ::: "memory");
            __builtin_amdgcn_s_barrier();
            if (wave == 0 && lane_now() == 0) (void)__hip_atomic_fetch_add(tcnt + u.pm, 1u, __ATOMIC_RELAXED, __HIP_MEMORY_SCOPE_AGENT);
        }
    }
};
template <class Epi, class Sched, bool ALIGN_EPI = false, bool SP2 = false>
__device__ __forceinline__ void gemm_phase(PG8_LAS unsigned char* lds, const Gemm g, const Sched& S, const Epi& E, int wave_sgpr) {
    const int wid = __builtin_amdgcn_readfirstlane(wave_sgpr), lane = lane_now(), tid = wid * 64 + lane, wr = wid >> 2, wc = wid & 3, fr = lane & 15, fq = lane >> 4;
    const int K = g.K, nt = K / BK;
    const int skew = ((int)blockIdx.x >> 3) & (nt - 1);
#define PG8_KOFF(t_) ((size_t)(((t_) + skew) & (nt - 1)) * kstep)
    unsigned voffA[2], voffB[2];
#pragma unroll
    for (int i = 0; i < 2; ++i) { int R, C; stage_rc(tid * 16 + i * 8192, R, C); const int Rb = Epi::PERM ? ((R & ~31) + perm32(R & 31)) : R;
        voffA[i] = (unsigned)(R * K + C) * 2u; voffB[i] = (unsigned)(Rb * K + C) * 2u; }
    const size_t kstep = (size_t)(BK * 2);
    const size_t hstep = (size_t)HALF * K * 2;
    const size_t tstep = 2 * hstep;
    const unsigned ldsw = (unsigned)wid * 1024u;
    const int aoff = lds_byte(wr * 64 + fr, fq * 8), boff = lds_byte(wc * 32 + fr, fq * 8);
#define PG8_SA(b, h) (((b) * 2 + (h)) * HTB)
#define PG8_SB(b, h) ((4 + (b) * 2 + (h)) * HTB)
#define PG8_STAGE(bufoff, gbase, voff) do { _Pragma("unroll") for (int _i = 0; _i < 2; ++_i) \
        __builtin_amdgcn_global_load_lds((const unsigned*)((const char*)(gbase) + (voff)[_i]), (PG8_LAS unsigned*)(lds + (bufoff) + ldsw + _i * 8192), 16, 0, 0); } while (0)
#define PG8_STAGE_A(bufoff, kptr, h, nxtsel) do { if constexpr (Sched::GATHER) { unsigned _v[2]; _v[0] = cv##h[0]; _v[1] = cv##h[1]; \
            if (nxtsel) { const u32x4 _p = *(const PG8_LAS u32x4*)(lds + GATH_LDS_OFF + tid * 16); _v[0] = (h) ? _p.z : _p.x; _v[1] = (h) ? _p.w : _p.y; } PG8_STAGE(bufoff, kptr, _v); } \
        else { PG8_STAGE(bufoff, (kptr) + (h) * hstep, voffA); } } while (0)
#define PG8_LDA(dst, b, h) do { _Pragma("unroll") for (int m = 0; m < 4; ++m) _Pragma("unroll") for (int k = 0; k < 2; ++k) dst[m][k] = *(const PG8_LAS bf16x8*)(lds + PG8_SA(b, h) + aoff + m * 2048 + k * 1024); } while (0)
#define PG8_LDB(dst, b, h) do { _Pragma("unroll") for (int n = 0; n < 2; ++n) _Pragma("unroll") for (int k = 0; k < 2; ++k) dst[n][k] = *(const PG8_LAS bf16x8*)(lds + PG8_SB(b, h) + boff + n * 2048 + k * 1024); } while (0)
#define PG8_MMA(ai, bj, At, Bt) do { __builtin_amdgcn_s_setprio(1); _Pragma("unroll") for (int m = 0; m < 4; ++m) _Pragma("unroll") for (int n = 0; n < 2; ++n) _Pragma("unroll") for (int k = 0; k < 2; ++k) \
        acc[ai][bj][m][n] = __builtin_amdgcn_mfma_f32_16x16x32_bf16(Bt[n][k], At[m][k], acc[ai][bj][m][n], 0, 0, 0); __builtin_amdgcn_s_setprio(0); } while (0)
#define PG8_WAIT_V(n) asm volatile("s_waitcnt vmcnt(" #n ")" ::: "memory")
#define PG8_WAIT_L(n) asm volatile("s_waitcnt lgkmcnt(" #n ")" ::: "memory")
#define PG8_BAR __builtin_amdgcn_s_barrier()
#define PG8_SCHED __builtin_amdgcn_sched_barrier(0)
    Unit cur, nxt; int ui = 0;
    if (!S.next(0, cur)) return;
    f32x4 acc[2][2][4][2];
#pragma unroll
    for (int a = 0; a < 2; ++a)
#pragma unroll
        for (int b = 0; b < 2; ++b)
#pragma unroll
            for (int m = 0; m < 4; ++m)
#pragma unroll
                for (int n = 0; n < 2; ++n) acc[a][b][m][n] = (f32x4){0.f, 0.f, 0.f, 0.f};
    bf16x8 At[4][2], B0[2][2], B1[2][2];
    const char* cA = (const char*)g.A + (Sched::GATHER ? (size_t)0 : (size_t)cur.pm * tstep); const char* cB = (const char*)g.Bt + (size_t)cur.pb * tstep;
    unsigned cv0[2] = {0u, 0u}, cv1[2] = {0u, 0u};
    if constexpr (Sched::GATHER) S.avoff(cur, tid, K, cv0, cv1);
    S.a_ready(cur);
    if constexpr (SP2) {
        PG8_STAGE(PG8_SB(0, 0), cB + PG8_KOFF(0), voffB); PG8_STAGE(PG8_SB(0, 1), cB + hstep + PG8_KOFF(0), voffB); PG8_STAGE_A(PG8_SA(0, 0), cA + PG8_KOFF(0), 0, false); PG8_STAGE_A(PG8_SA(0, 1), cA + PG8_KOFF(0), 1, false);
        if (wr == 1) PG8_BAR;
        PG8_WAIT_V(2); PG8_BAR;
        PG8_STAGE(PG8_SB(1, 0), cB + PG8_KOFF(1), voffB); PG8_STAGE_A(PG8_SA(1, 0), cA + PG8_KOFF(1), 0, false); PG8_STAGE(PG8_SB(1, 1), cB + hstep + PG8_KOFF(1), voffB);
        PG8_WAIT_V(6); PG8_BAR;
    } else {
        PG8_STAGE(PG8_SB(0, 0), cB + PG8_KOFF(0), voffB); PG8_STAGE_A(PG8_SA(0, 0), cA + PG8_KOFF(0), 0, false); PG8_STAGE(PG8_SB(0, 1), cB + hstep + PG8_KOFF(0), voffB); PG8_STAGE_A(PG8_SA(0, 1), cA + PG8_KOFF(0), 1, false);
        if (wr == 1) PG8_BAR;
        PG8_WAIT_V(4); PG8_BAR;
        PG8_STAGE(PG8_SB(1, 0), cB + PG8_KOFF(1), voffB); PG8_STAGE_A(PG8_SA(1, 0), cA + PG8_KOFF(1), 0, false); PG8_STAGE(PG8_SB(1, 1), cB + hstep + PG8_KOFF(1), voffB);
        PG8_WAIT_V(6); PG8_BAR;
    }
    for (;;) {
        const bool has_next = S.next(ui + 1, nxt);
        if (has_next) S.a_ready(nxt);
        const char* nA = has_next ? (const char*)g.A + (Sched::GATHER ? (size_t)0 : (size_t)nxt.pm * tstep) : cA; const char* nB = has_next ? (const char*)g.Bt + (size_t)nxt.pb * tstep : cB;
        if constexpr (Sched::GATHER) { unsigned nv0[2], nv1[2];
            if (has_next) S.avoff(nxt, tid, K, nv0, nv1); else { nv0[0] = cv0[0]; nv0[1] = cv0[1]; nv1[0] = cv1[0]; nv1[1] = cv1[1]; }
            *(PG8_LAS u32x4*)(lds + GATH_LDS_OFF + tid * 16) = (u32x4){nv0[0], nv0[1], nv1[0], nv1[1]}; }
        for (int t = 0; t < nt; t += 2) {
            const bool last = (t == nt - 2);
            const char* a1 = cA + PG8_KOFF(t + 1);
            const char* a2 = (last ? nA : cA) + PG8_KOFF(t + 2); const char* b2 = (last ? nB : cB) + PG8_KOFF(t + 2);
            const char* a3 = (last ? nA : cA) + PG8_KOFF(t + 3); const char* b3 = (last ? nB : cB) + PG8_KOFF(t + 3);
            if constexpr (SP2) {
            PG8_LDB(B0, 0, 0); PG8_LDB(B1, 0, 1); PG8_SCHED; PG8_LDA(At, 0, 0); PG8_STAGE_A(PG8_SA(1, 1), a1, 1, false);
            PG8_WAIT_V(8); PG8_WAIT_L(0); PG8_BAR; PG8_MMA(0, 0, At, B0); PG8_MMA(0, 1, At, B1); PG8_BAR; PG8_SCHED;
            PG8_LDA(At, 0, 1); PG8_STAGE(PG8_SB(0, 0), b2, voffB); PG8_STAGE(PG8_SB(0, 1), b2 + hstep, voffB); PG8_STAGE_A(PG8_SA(0, 0), a2, 0, last);
            PG8_WAIT_V(8); PG8_WAIT_L(0); PG8_BAR; PG8_MMA(1, 0, At, B0); PG8_MMA(1, 1, At, B1); PG8_BAR; PG8_SCHED;
            PG8_LDB(B0, 1, 0); PG8_LDB(B1, 1, 1); PG8_SCHED; PG8_LDA(At, 1, 0); PG8_STAGE_A(PG8_SA(0, 1), a2, 1, last);
            PG8_WAIT_V(8); PG8_WAIT_L(0); PG8_BAR; PG8_MMA(0, 0, At, B0); PG8_MMA(0, 1, At, B1); PG8_BAR; PG8_SCHED;
            PG8_LDA(At, 1, 1); PG8_STAGE(PG8_SB(1, 0), b3, voffB); PG8_STAGE(PG8_SB(1, 1), b3 + hstep, voffB); PG8_STAGE_A(PG8_SA(1, 0), a3, 0, last);
            PG8_WAIT_V(8); PG8_WAIT_L(0); PG8_BAR; PG8_MMA(1, 0, At, B0); PG8_MMA(1, 1, At, B1); PG8_BAR; PG8_SCHED;
            } else {
            PG8_LDB(B0, 0, 0); PG8_SCHED; PG8_LDA(At, 0, 0); PG8_STAGE_A(PG8_SA(1, 1), a1, 1, false);
            PG8_WAIT_L(8); PG8_BAR; PG8_WAIT_L(0); PG8_MMA(0, 0, At, B0); PG8_BAR; PG8_SCHED;
            PG8_LDB(B1, 0, 1); PG8_STAGE(PG8_SB(0, 0), b2, voffB);
            PG8_BAR; PG8_WAIT_L(0); PG8_MMA(0, 1, At, B1); PG8_BAR;
            PG8_LDA(At, 0, 1); PG8_STAGE_A(PG8_SA(0, 0), a2, 0, last);
            PG8_BAR; PG8_WAIT_L(0); PG8_MMA(1, 0, At, B0); PG8_BAR; PG8_SCHED;
            PG8_STAGE(PG8_SB(0, 1), b2 + hstep, voffB);
            PG8_WAIT_V(6); PG8_BAR; PG8_MMA(1, 1, At, B1); PG8_BAR;
            PG8_LDB(B0, 1, 0); PG8_SCHED; PG8_LDA(At, 1, 0); PG8_STAGE_A(PG8_SA(0, 1), a2, 1, last);
            PG8_WAIT_L(8); PG8_BAR; PG8_WAIT_L(0); PG8_MMA(0, 0, At, B0); PG8_BAR; PG8_SCHED;
            PG8_LDB(B1, 1, 1); PG8_STAGE(PG8_SB(1, 0), b3, voffB);
            PG8_BAR; PG8_WAIT_L(0); PG8_MMA(0, 1, At, B1); PG8_BAR;
            PG8_LDA(At, 1, 1); PG8_STAGE_A(PG8_SA(1, 0), a3, 0, last);
            PG8_BAR; PG8_WAIT_L(0); PG8_MMA(1, 0, At, B0); PG8_BAR; PG8_SCHED;
            PG8_STAGE(PG8_SB(1, 1), b3 + hstep, voffB);
            PG8_WAIT_V(6); PG8_BAR; PG8_MMA(1, 1, At, B1); PG8_BAR;
            }
        }
        if constexpr (ALIGN_EPI) { if (wr == 0) PG8_BAR; }
        if constexpr (!Epi::AFTER_DRAIN) { E(acc, cur, wr, wc, fr, fq); S.done(cur); }
        if (!has_next) break;
#pragma unroll
        for (int a = 0; a < 2; ++a)
#pragma unroll
            for (int b = 0; b < 2; ++b)
#pragma unroll
                for (int m = 0; m < 4; ++m)
#pragma unroll
                    for (int n = 0; n < 2; ++n) acc[a][b][m][n] = (f32x4){0.f, 0.f, 0.f, 0.f};
        cur = nxt; cA = nA; cB = nB; ++ui; if constexpr (Sched::GATHER) { const u32x4 _p = *(const PG8_LAS u32x4*)(lds + GATH_LDS_OFF + tid * 16); cv0[0] = _p.x; cv0[1] = _p.y; cv1[0] = _p.z; cv1[1] = _p.w; }
        if constexpr (ALIGN_EPI) { if (wr == 1) PG8_BAR; }
    }
    PG8_WAIT_V(0);
    if constexpr (!ALIGN_EPI) { if (wr == 0) PG8_BAR; }
    PG8_BAR;
    if constexpr (Epi::AFTER_DRAIN) { E.fused(acc, cur, wr, wc, fr, fq, lds, wid, lane); S.done(cur); }
#undef PG8_KOFF
#undef PG8_SA
#undef PG8_SB
#undef PG8_STAGE
#undef PG8_STAGE_A
#undef PG8_LDA
#undef PG8_LDB
#undef PG8_MMA
#undef PG8_WAIT_V
#undef PG8_WAIT_L
#undef PG8_BAR
#undef PG8_SCHED
}
}

constexpr int NWAVES = 8;
constexpr int D = 1024, BATCH = 8, SEQ = 4096, T = BATCH * SEQ;
constexpr int IN_COLS = 3592, NPROJ = 3584, NEXP = 32, DEXP = 256, CAP = 65536;
constexpr float EPS = 1e-6f;
constexpr size_t MiB = 1u << 20;
constexpr size_t WS_CTL = 0, CTL_ZERO_BYTES = 1 * MiB;
constexpr size_t WS_MOD = 1 * MiB;
constexpr size_t WS_BG = 2 * MiB;
constexpr size_t WS_TOKSLOT = 3 * MiB;
constexpr size_t WS_WRT = 6 * MiB;
constexpr size_t WS_WIN = 8 * MiB;
constexpr size_t WS_WOUT = 15 * MiB;
constexpr size_t WS_WGU = 32 * MiB;
constexpr size_t WS_WDN = 64 * MiB;
constexpr size_t WS_LTOK = 80 * MiB;
constexpr size_t WS_LW = 88 * MiB;
constexpr size_t WS_H = 96 * MiB;
constexpr size_t WS_QKVA = 160 * MiB;
constexpr size_t WS_Z = 256 * MiB;
constexpr size_t WS_QB = 288 * MiB, WS_KB = 320 * MiB, WS_VB = 352 * MiB;
constexpr size_t WS_Y = 384 * MiB;
constexpr int PROWS = 65536 + 32 * 256;
constexpr size_t WS_HID = 448 * MiB;
constexpr size_t WS_YS = 160 * MiB;
constexpr size_t WS_PART0 = 96 * MiB, WS_PART1 = 128 * MiB, WS_PART2 = 448 * MiB;
constexpr size_t WS_LSE = 480 * MiB;
constexpr size_t WS_GAQK = 484 * MiB;
constexpr size_t WS_GGL = 500 * MiB;
constexpr size_t WS_XM = 320 * MiB;
constexpr size_t WS_NEED = 512 * MiB;
static_assert(WS_QKVA == (size_t)160 << 20 && WS_Z == (size_t)256 << 20 && WS_QB == (size_t)288 << 20 && WS_KB == (size_t)320 << 20 && WS_VB == (size_t)352 << 20, "EpiProj offsets");
constexpr int CW_MODF = 992;
constexpr int CW_ATTQ = 2048;
constexpr int CW_TCNT = 2560;
constexpr int CW_CNT = 1024;
constexpr int CW_BAR = 4096;

constexpr int RING_OFF = 0, RING_BYTES = 131072;
constexpr int PHASE_LDS = 147456;
constexpr int LDSCTL_OFF = PHASE_LDS, MISC_OFF = LDSCTL_OFF + 320, MOE_OFF = MISC_OFF + 128;
constexpr int LDS_BYTES = 163840;
static_assert(RING_OFF == 0 && MOE_OFF + 512 <= pg8::GATH_LDS_OFF && pg8::GATH_LDS_OFF + 8192 <= LDS_BYTES, "LDS map");

#define GAS __attribute__((address_space(1)))
#define LAS __attribute__((address_space(3)))
typedef unsigned short bf16;
typedef unsigned v4u __attribute__((ext_vector_type(4)));
typedef float f32x4 __attribute__((ext_vector_type(4)));
typedef short bf16x8 __attribute__((ext_vector_type(8)));
typedef GAS unsigned gu32;
typedef GAS unsigned long long gu64;
#define RLX_AGENT __ATOMIC_RELAXED, __HIP_MEMORY_SCOPE_AGENT
#define LDS_WAIT() asm volatile("s_waitcnt lgkmcnt(0)" ::: "memory")
#define VM_WAIT() asm volatile("s_waitcnt vmcnt(0)" ::: "memory")
__device__ __forceinline__ unsigned long long rt() { return __builtin_amdgcn_s_memrealtime(); }
__device__ __forceinline__ unsigned f2bf(float f) { unsigned u = __builtin_bit_cast(unsigned, f); return (u + 0x7fffu + ((u >> 16) & 1u)) >> 16; }
__device__ __forceinline__ unsigned pk2(float lo, float hi) { return f2bf(lo) | (f2bf(hi) << 16); }

#define XB_TMO      128
#define XB_XCNT(j)  (256  + 64 * (j))
#define XB_XSUB(j)  (1280 + 64 * (j))
#define XB_XGEN(j)  (2304 + 64 * (j))
#define XB_TOP      3328
#define XB_TOPGEN   3392
#define XCD_BAR_WORDS 3456
#define XB_SPIN_CAP (1u << 18)

__device__ __forceinline__ unsigned xb_ld(unsigned* p)              { return __hip_atomic_load(p, __ATOMIC_RELAXED, __HIP_MEMORY_SCOPE_AGENT); }
__device__ __forceinline__ unsigned xb_add(unsigned* p, unsigned v) { return __hip_atomic_fetch_add(p, v, __ATOMIC_RELAXED, __HIP_MEMORY_SCOPE_AGENT); }
__device__ __forceinline__ unsigned xb_xcc_id() { return (unsigned)__builtin_amdgcn_s_getreg((3 << 11) | 20) & 0xFu; }
#define XB_SPIN(cond, bar) do { unsigned _sp = 0; while (cond) { __builtin_amdgcn_s_sleep(1); \
    if ((++_sp & 255u) == 0u) { if (xb_ld(&(bar)[XB_TMO])) break; if (_sp > XB_SPIN_CAP) { atomicAdd(&(bar)[XB_TMO], 1u); break; } } } } while (0)

struct XcdBarrier {
    unsigned* bar; unsigned x; int wave;
    volatile LAS unsigned* st;
};

__device__ __forceinline__ XcdBarrier xcd_barrier_post(unsigned* bar, volatile LAS unsigned* st, int wave) {
    XcdBarrier b; b.bar = bar; b.x = xb_xcc_id(); b.st = st; b.wave = wave;
    if (wave == 0 && pg8::lane_now() == 0) (void)xb_add(&bar[XB_XCNT(b.x)], 1u);
    return b;
}
__device__ __forceinline__ void xcd_barrier_complete(unsigned* bar, unsigned x, unsigned& nloc, unsigned& nx) {
    const unsigned G = gridDim.x * gridDim.y * gridDim.z;
    unsigned sum, cnt, mine, sp = 0u;
    for (;;) {
        sum = 0u; cnt = 0u; mine = 0u;
#pragma unroll
        for (unsigned j = 0; j < 16; ++j) { const unsigned c = xb_ld(&bar[XB_XCNT(j)]); sum += c; cnt += (c > 0u) ? 1u : 0u; mine = (j == x) ? c : mine; }
        if (sum == G) break;
        __builtin_amdgcn_s_sleep(1);
        if ((++sp & 255u) == 0u) { if (xb_ld(&bar[XB_TMO])) break; if (sp > XB_SPIN_CAP) { atomicAdd(&bar[XB_TMO], 1u); break; } }
    }
    nloc = mine > 0u ? mine : 1u; nx = cnt > 0u ? cnt : 1u;
}

__device__ __forceinline__ void xcd_barrier(const XcdBarrier& b) {
    asm volatile("s_waitcnt vmcnt(0)" ::: "memory");
    __syncthreads();
    if (b.wave == 0 && pg8::lane_now() == 0) {
        unsigned* bar = b.bar;
        __builtin_amdgcn_s_waitcnt(0);
        unsigned nloc = b.st[0], nx = b.st[1];
        if (nloc == 0u) { xcd_barrier_complete(bar, b.x, nloc, nx); b.st[0] = nloc; b.st[1] = nx; }
        const unsigned old = xb_add(&bar[XB_XSUB(b.x)], 1u);
        const unsigned gen = old / nloc;
        if (old + 1u == (gen + 1u) * nloc) {
            __builtin_amdgcn_fence(__ATOMIC_RELEASE, "agent");
            asm volatile("s_waitcnt vmcnt(0)" ::: "memory");
            const unsigned og = xb_add(&bar[XB_TOP], 1u);
            const unsigned tg = og / nx;
            if (og + 1u == (tg + 1u) * nx) xb_add(&bar[XB_TOPGEN], 1u);
            else XB_SPIN(xb_ld(&bar[XB_TOPGEN]) == tg, bar);
            __builtin_amdgcn_fence(__ATOMIC_ACQUIRE, "agent");
            xb_add(&bar[XB_XGEN(b.x)], 1u);
            asm volatile("s_waitcnt vmcnt(0)" ::: "memory");
        } else {
            XB_SPIN(xb_ld(&bar[XB_XGEN(b.x)]) == gen, bar);
            __builtin_amdgcn_fence(__ATOMIC_ACQUIRE, "agent");
            asm volatile("s_waitcnt vmcnt(0)" ::: "memory");
        }
    }
    __syncthreads();
}

__device__ __forceinline__ float dpp_add(float v, const int ctrl_sel) {
    int r;
    if (ctrl_sel == 0) r = __builtin_amdgcn_mov_dpp(__builtin_bit_cast(int, v), 0xB1, 0xF, 0xF, false);
    else if (ctrl_sel == 1) r = __builtin_amdgcn_mov_dpp(__builtin_bit_cast(int, v), 0x4E, 0xF, 0xF, false);
    else if (ctrl_sel == 2) r = __builtin_amdgcn_mov_dpp(__builtin_bit_cast(int, v), 0x124, 0xF, 0xF, false);
    else r = __builtin_amdgcn_mov_dpp(__builtin_bit_cast(int, v), 0x128, 0xF, 0xF, false);
    return v + __builtin_bit_cast(float, r);
}
__device__ __forceinline__ float row16_sum(float v) { v = dpp_add(v, 0); v = dpp_add(v, 1); v = dpp_add(v, 2); v = dpp_add(v, 3); return v; }
__device__ __forceinline__ float wave_sum(float v) {
    v = row16_sum(v);
    v += __shfl_xor(v, 16);
    v += __shfl_xor(v, 32);
    return v;
}
__device__ __forceinline__ void p0_transpose_item(const float* W, int K, int N, bf16* WT, int row_off, LAS float* scr, int item, int lane) {
    const int nblk = N / 32, kb = item / nblk, nb = item % nblk, k0 = 64 * kb, n0 = 32 * nb;
#pragma unroll 8
    for (int i = 0; i < 32; ++i) { const int kk = 2 * i + (lane >> 5); scr[kk * 33 + (lane & 31)] = W[(size_t)(k0 + kk) * N + n0 + (lane & 31)]; }
    LDS_WAIT(); asm volatile("" ::: "memory");
    const int c = lane & 7;
#pragma unroll
    for (int j = 0; j < 4; ++j) { const int n = (lane >> 3) + 8 * j; const LAS float* s = scr + (8 * c) * 33 + n;
        v4u o; o.x = pk2(s[0 * 33], s[1 * 33]); o.y = pk2(s[2 * 33], s[3 * 33]); o.z = pk2(s[4 * 33], s[5 * 33]); o.w = pk2(s[6 * 33], s[7 * 33]);
        *(GAS v4u*)(WT + (size_t)(row_off + n0 + n) * K + k0 + 8 * c) = o; }
    LDS_WAIT(); asm volatile("" ::: "memory");
}

__device__ __forceinline__ float bf2f(bf16 v) { return __uint_as_float((unsigned)v << 16); }
__device__ __forceinline__ float siluf(float x) { return x / (1.f + __expf(-x)); }
__device__ __forceinline__ float sigmoidf(float x) { return 1.f / (1.f + __expf(-x)); }

struct Args { const float* in[20]; float* out; unsigned char* ws; int ph_lo, ph_hi, li, pad; };

struct Frame {
    LAS unsigned char* lds; volatile LAS unsigned* MISC; gu32* ctl;
    int wave, vcu, G;
};

__device__ __forceinline__ void transpose_item(const float* W, int K, int pitch, int ncols, bf16* WT, int row_off, LAS float* scr, int item, int lane) {
    const int nblk = ncols / 32, kb = item / nblk, nb = item % nblk, k0 = 64 * kb, n0 = 32 * nb;
#pragma unroll 8
    for (int i = 0; i < 32; ++i) { const int kk = 2 * i + (lane >> 5); scr[kk * 33 + (lane & 31)] = W[(size_t)(k0 + kk) * pitch + n0 + (lane & 31)]; }
    LDS_WAIT(); asm volatile("" ::: "memory");
    const int c = lane & 7;
#pragma unroll
    for (int j = 0; j < 4; ++j) { const int n = (lane >> 3) + 8 * j; const LAS float* s = scr + (8 * c) * 33 + n;
        v4u o; o.x = pk2(s[0 * 33], s[1 * 33]); o.y = pk2(s[2 * 33], s[3 * 33]); o.z = pk2(s[4 * 33], s[5 * 33]); o.w = pk2(s[6 * 33], s[7 * 33]);
        *(GAS v4u*)(WT + (size_t)(row_off + n0 + n) * K + k0 + 8 * c) = o; }
    LDS_WAIT(); asm volatile("" ::: "memory");
}

__device__ __forceinline__ void p0_phase(Frame& F, unsigned char* ws, const float* c, const float* w_ada, const float* b_ada, const float* w_in, const float* w_out, const float* w_gate, const float* w_up, const float* w_down, const float* w_rg, const float* w_re) {
    const int lane_ = pg8::lane_now(), tid_ = F.wave * 64 + lane_;
    float* mod = (float*)(ws + WS_MOD);
    if ((int)blockIdx.x < 192) {
        LAS float* cs = (LAS float*)(F.lds + RING_OFF);
        LAS float* red = cs + 8192;
        for (int i = tid_; i < 8192; i += NWAVES * 64) cs[i] = c[i];
        __syncthreads();
        for (int item = blockIdx.x; item < 192; item += F.G) {
            const int col = tid_ & 31, kq = tid_ >> 5, n = item * 32 + col;
            float acc[8];
#pragma unroll
            for (int b = 0; b < 8; ++b) acc[b] = 0.f;
            float wa[32], wb[32];
#pragma unroll
            for (int k = 0; k < 32; ++k) wa[k] = w_ada[(size_t)(kq * 64 + k) * 6144 + n];
#pragma unroll
            for (int k = 0; k < 32; ++k) wb[k] = w_ada[(size_t)(kq * 64 + 32 + k) * 6144 + n];
#pragma unroll
            for (int k = 0; k < 32; ++k) {
#pragma unroll
                for (int b = 0; b < 8; ++b) acc[b] += cs[b * D + kq * 64 + k] * wa[k]; }
#pragma unroll
            for (int k = 0; k < 32; ++k) {
#pragma unroll
                for (int b = 0; b < 8; ++b) acc[b] += cs[b * D + kq * 64 + 32 + k] * wb[k]; }
#pragma unroll
            for (int b = 0; b < 8; ++b) red[(kq * 8 + b) * 32 + col] = acc[b];
            __syncthreads();
            if (tid_ < 256) { const int b = tid_ >> 5; float s = 0.f;
#pragma unroll
              for (int q = 0; q < 16; ++q) s += red[(q * 8 + b) * 32 + col];
              mod[b * 6144 + n] = s + b_ada[n]; }
            __syncthreads();
        }
    }
    { bf16* wrt = (bf16*)(ws + WS_WRT);
      for (int i = blockIdx.x * (NWAVES * 64) + tid_; i < 48 * 1024; i += F.G * NWAVES * 64) { const int e = i >> 10, k = i & 1023;
          const float v = e < 4 ? w_rg[k * 4 + e] : (e < 36 ? w_re[k * 32 + e - 4] : 0.f); wrt[i] = (bf16)f2bf(v); } }
}
__device__ __forceinline__ void p0b_phase(Frame& F, unsigned char* ws, const float* w_in, const float* w_out, const float* w_gate, const float* w_up, const float* w_down) {
    const int lane_ = pg8::lane_now();
    LAS float* scr = (LAS float*)(F.lds + RING_OFF + F.wave * 16384);
    const int gw = F.vcu * NWAVES + F.wave, NGW = F.G * NWAVES;
    bf16* win_t = (bf16*)(ws + WS_WIN); bf16* wout_t = (bf16*)(ws + WS_WOUT); bf16* wgu_t = (bf16*)(ws + WS_WGU); bf16* wdn_t = (bf16*)(ws + WS_WDN);
    constexpr int I_A = 16 * 64, I_B = 16 * 48, I_C = 16 * 32, I_D = 32 * 256, I_E = 32 * 128, I_ALL = I_A + I_B + I_C + I_D + I_E;
#define P0_DECODE(it_, W_, K_, pitch_, ncols_, WT_, roff_, li_) do { int r = (it_); \
        if (r < I_A) { W_ = w_in; K_ = D; pitch_ = IN_COLS; ncols_ = 2048; WT_ = win_t; roff_ = 0; li_ = r; } \
        else if ((r -= I_A) < I_B) { W_ = w_in + 2056; K_ = D; pitch_ = IN_COLS; ncols_ = 1536; WT_ = win_t; roff_ = 2048; li_ = r; } \
        else if ((r -= I_B) < I_C) { W_ = w_out; K_ = D; pitch_ = D; ncols_ = D; WT_ = wout_t; roff_ = 0; li_ = r; } \
        else if ((r -= I_C) < I_D) { const int e = r >> 8, q = r & 255, piece = q >> 6; \
            W_ = (piece < 2 ? w_gate : w_up) + (size_t)e * D * DEXP + (piece & 1) * 128; K_ = D; pitch_ = DEXP; ncols_ = 128; WT_ = wgu_t + (size_t)e * 512 * D; roff_ = (piece & 1) * 256 + (piece >> 1) * 128; li_ = q & 63; } \
        else { r -= I_D; const int e = r >> 7; W_ = w_down + (size_t)e * DEXP * D; K_ = DEXP; pitch_ = D; ncols_ = D; WT_ = wdn_t + (size_t)e * D * DEXP; roff_ = 0; li_ = r & 127; } } while (0)
#define P0_LOAD(dst, W_, pitch_, ncols_, li_) do { const int nblk_ = (ncols_) / 32, k0_ = 64 * ((li_) / nblk_), n0_ = 32 * ((li_) % nblk_); \
        _Pragma("unroll") for (int i = 0; i < 32; ++i) dst[i] = (W_)[(size_t)(k0_ + 2 * i + (lane_ >> 5)) * (pitch_) + n0_ + (lane_ & 31)]; } while (0)
    float tv[32];
    const float* cW = nullptr; int cK = 0, cP = 0, cN = 32, cR = 0, cL = 0; bf16* cT = nullptr;
    if (gw < I_ALL) { P0_DECODE(gw, cW, cK, cP, cN, cT, cR, cL); P0_LOAD(tv, cW, cP, cN, cL); }
    for (int it = gw; it < I_ALL; it += NGW) {
#pragma unroll
        for (int i = 0; i < 32; ++i) scr[(2 * i + (lane_ >> 5)) * 33 + (lane_ & 31)] = tv[i];
        const int K = cK, roff = cR; bf16* WT = cT; const int nblk = cN / 32, k0 = 64 * (cL / nblk), n0 = 32 * (cL % nblk);
        if (it + NGW < I_ALL) { P0_DECODE(it + NGW, cW, cK, cP, cN, cT, cR, cL); P0_LOAD(tv, cW, cP, cN, cL); }
        LDS_WAIT(); asm volatile("" ::: "memory");
        const int c = lane_ & 7;
#pragma unroll
        for (int j = 0; j < 4; ++j) { const int n = (lane_ >> 3) + 8 * j; const LAS float* s = scr + (8 * c) * 33 + n;
            v4u o; o.x = pk2(s[0 * 33], s[1 * 33]); o.y = pk2(s[2 * 33], s[3 * 33]); o.z = pk2(s[4 * 33], s[5 * 33]); o.w = pk2(s[6 * 33], s[7 * 33]);
            *(GAS v4u*)(WT + (size_t)(roff + n0 + n) * K + k0 + 8 * c) = o; }
        LDS_WAIT(); asm volatile("" ::: "memory");
    }
#undef P0_DECODE
#undef P0_LOAD
}

__device__ __forceinline__ void p1_rows(f32x4 (&v)[2][4], int mb, int lane_, const f32x4 (&gm)[4], const f32x4 (&sh)[4], bf16* H, const LAS float* w8, float* bg, const float* a_log, const float* dt_bias) {
            float ss[2];
#pragma unroll
            for (int r = 0; r < 2; ++r) { float s = 0.f;
#pragma unroll
                for (int j = 0; j < 4; ++j) s += (v[r][j].x * v[r][j].x + v[r][j].y * v[r][j].y) + (v[r][j].z * v[r][j].z + v[r][j].w * v[r][j].w);
                ss[r] = s; }
#pragma unroll
    for (int r = 0; r < 2; ++r) ss[r] = wave_sum(ss[r]);
            float dots[2][8];
#pragma unroll
            for (int r = 0; r < 2; ++r)
#pragma unroll
                for (int q = 0; q < 8; ++q) dots[r][q] = 0.f;
#pragma unroll
            for (int r = 0; r < 2; ++r) { const float rs = rsqrtf(ss[r] * (1.f / D) + EPS);
                GAS unsigned long long* o8 = (GAS unsigned long long*)(H + (size_t)(mb + r) * D) + lane_;
#pragma unroll
                for (int j = 0; j < 4; ++j) { v[r][j] = v[r][j] * rs * gm[j] + sh[j];
                    o8[64 * j] = (unsigned long long)pk2(v[r][j].x, v[r][j].y) | ((unsigned long long)pk2(v[r][j].z, v[r][j].w) << 32); } }
            asm volatile("" ::: "memory");
#pragma unroll
            for (int j = 0; j < 4; ++j)
#pragma unroll
                for (int q = 0; q < 8; ++q) { const f32x4 w = *(const LAS f32x4*)(w8 + q * 1024 + 4 * lane_ + 256 * j);
#pragma unroll
                    for (int r = 0; r < 2; ++r) dots[r][q] += (v[r][j].x * w.x + v[r][j].y * w.y) + (v[r][j].z * w.z + v[r][j].w * w.w); }
#pragma unroll
            for (int r = 0; r < 2; ++r)
#pragma unroll
                for (int q = 0; q < 8; ++q) dots[r][q] = wave_sum(dots[r][q]);
            if (lane_ < 16) {
                const int r = lane_ >> 3, q = lane_ & 7;
                float raw = 0.f;
#pragma unroll
                for (int rr = 0; rr < 2; ++rr)
#pragma unroll
                    for (int qq = 0; qq < 8; ++qq) raw = (r == rr && q == qq) ? dots[rr][qq] : raw;
                float o;
                if (q < 4) o = sigmoidf(raw);
                else { const int hh = q - 4; const float xr2 = raw + dt_bias[hh]; const float sp = xr2 > 20.f ? xr2 : log1pf(expf(xr2)); o = -expf(a_log[hh]) * sp; }
                bg[(size_t)(mb + r) * 8 + q] = o;
            }
}
__device__ __forceinline__ void p1_phase(Frame& F, unsigned char* ws, const float* x, const float* norm_mix, const float* w_in, const float* a_log, const float* dt_bias) {
    const int lane_ = pg8::lane_now(), tid_ = F.wave * 64 + lane_;
    const float* mod = (const float*)(ws + WS_MOD); float* bg = (float*)(ws + WS_BG); bf16* H = (bf16*)(ws + WS_H);
    LAS float* w8 = (LAS float*)(F.lds + RING_OFF);
    for (int i = tid_; i < 8 * 1024; i += NWAVES * 64) { const int j = i >> 10, k = i & 1023; w8[i] = w_in[(size_t)k * IN_COLS + 2048 + j]; }
    __syncthreads();
    for (int tl = F.vcu * NWAVES + F.wave; tl < T / 16; tl += F.G * NWAVES) {
        const int m0 = tl * 16, bb = m0 >> 12;
        f32x4 gm[4], sh[4];
#pragma unroll
        for (int j = 0; j < 4; ++j) { const f32x4 g = ((const GAS f32x4*)norm_mix)[lane_ + 64 * j]; const f32x4 sc = ((const GAS f32x4*)(mod + bb * 6144 + 1024))[lane_ + 64 * j];
            sh[j] = ((const GAS f32x4*)(mod + bb * 6144))[lane_ + 64 * j]; gm[j] = g * (sc + 1.f); }
        f32x4 vA[2][4], vB[2][4], vC[2][4];
#define P1_LOAD(dst, mb_) do { _Pragma("unroll") for (int r = 0; r < 2; ++r) { const GAS f32x4* xr = (const GAS f32x4*)(x + (size_t)((mb_) + r) * D) + lane_; \
            _Pragma("unroll") for (int j = 0; j < 4; ++j) dst[r][j] = xr[64 * j]; } } while (0)
        P1_LOAD(vA, m0); P1_LOAD(vB, m0 + 2);
        P1_LOAD(vC, m0 + 4);  p1_rows(vA, m0, lane_, gm, sh, H, w8, bg, a_log, dt_bias);
        P1_LOAD(vA, m0 + 6);  p1_rows(vB, m0 + 2, lane_, gm, sh, H, w8, bg, a_log, dt_bias);
        P1_LOAD(vB, m0 + 8);  p1_rows(vC, m0 + 4, lane_, gm, sh, H, w8, bg, a_log, dt_bias);
        P1_LOAD(vC, m0 + 10); p1_rows(vA, m0 + 6, lane_, gm, sh, H, w8, bg, a_log, dt_bias);
        P1_LOAD(vA, m0 + 12); p1_rows(vB, m0 + 8, lane_, gm, sh, H, w8, bg, a_log, dt_bias);
        P1_LOAD(vB, m0 + 14); p1_rows(vC, m0 + 10, lane_, gm, sh, H, w8, bg, a_log, dt_bias);
        p1_rows(vA, m0 + 12, lane_, gm, sh, H, w8, bg, a_log, dt_bias);
        p1_rows(vB, m0 + 14, lane_, gm, sh, H, w8, bg, a_log, dt_bias);
#undef P1_LOAD
    }
}


__device__ __forceinline__ f32x4 bf4_to_f32(unsigned long long a) { f32x4 y; y.x = __uint_as_float((unsigned)(a & 0xFFFFu) << 16); y.y = __uint_as_float((unsigned)(a >> 16) << 16); y.z = __uint_as_float((unsigned)((a >> 32) & 0xFFFFu) << 16); y.w = __uint_as_float((unsigned)(a >> 48) << 16); return y; }
__device__ __forceinline__ void p7_rows(const unsigned long long (&raw)[2][4], int mb, int lane_, const f32x4 (&gm)[4], const f32x4 (&sh)[4], bf16* H) {
    float ss[2]; f32x4 v[2][4];
#pragma unroll
    for (int r = 0; r < 2; ++r)
#pragma unroll
        for (int j = 0; j < 4; ++j) v[r][j] = bf4_to_f32(raw[r][j]);
#pragma unroll
    for (int r = 0; r < 2; ++r) { float s = 0.f;
#pragma unroll
        for (int j = 0; j < 4; ++j) s += (v[r][j].x * v[r][j].x + v[r][j].y * v[r][j].y) + (v[r][j].z * v[r][j].z + v[r][j].w * v[r][j].w);
        ss[r] = s; }
#pragma unroll
    for (int r = 0; r < 2; ++r) ss[r] = wave_sum(ss[r]);
#pragma unroll
    for (int r = 0; r < 2; ++r) { const float rs = rsqrtf(ss[r] * (1.f / D) + EPS);
        GAS unsigned long long* o8 = (GAS unsigned long long*)(H + (size_t)(mb + r) * D) + lane_;
#pragma unroll
        for (int j = 0; j < 4; ++j) { const f32x4 h = v[r][j] * rs * gm[j] + sh[j];
            o8[64 * j] = (unsigned long long)pk2(h.x, h.y) | ((unsigned long long)pk2(h.z, h.w) << 32); } }
}
#if MK_PROF_A >= 110 && MK_PROF_A < 120
#define PROF7(idx) do { if (blockIdx.x == 0 && F.wave == 0 && pg8::lane_now() == 0) { const unsigned long long t_ = __builtin_amdgcn_s_memrealtime(); \
        const unsigned long long p_ = ((unsigned long long)F.MISC[23] << 32) | F.MISC[22]; if ((idx) >= 0) F.MISC[24 + (idx)] = __float_as_uint(__uint_as_float(F.MISC[24 + (idx)]) + (float)(t_ - p_) * 0.01f); \
        F.MISC[22] = (unsigned)t_; F.MISC[23] = (unsigned)(t_ >> 32); } } while (0)
#else
#define PROF7(idx) do {} while (0)
#endif
__device__ __forceinline__ void p5_phase(Frame& F, unsigned char* ws, const bf16* xmid, const float* norm_ffn) {
    const int lane_ = pg8::lane_now(), tid_ = F.wave * 64 + lane_;
    const float* mod = (const float*)(ws + WS_MOD); bf16* H = (bf16*)(ws + WS_H); const bf16* wrt = (const bf16*)(ws + WS_WRT);
    int* ltok = (int*)(ws + WS_LTOK); float* lw = (float*)(ws + WS_LW); int* tokslot = (int*)(ws + WS_TOKSLOT);
    gu32* gcnt = F.ctl + CW_CNT;
    LAS float* lg = (LAS float*)(F.lds + RING_OFF) + F.wave * (16 * 48);
    LAS unsigned* lcnt = (LAS unsigned*)(F.lds + RING_OFF + 32768);
    LAS unsigned* gbase = lcnt + 32;
    constexpr int NT = T / 16;
    LAS unsigned char* wrtL = F.lds + RING_OFF + 40960;
    for (int i = tid_; i < 48 * 128; i += NWAVES * 64) { const int row = i >> 7, p = i & 127;
        *(LAS v4u*)(wrtL + row * 2048 + ((p ^ (row & 7)) << 4)) = *(const GAS v4u*)(wrt + (size_t)row * D + 8 * p); }
    for (int tl0 = F.vcu * NWAVES; tl0 < NT; tl0 += F.G * NWAVES) {
        const int tl = tl0 + F.wave; const bool active = tl < NT; const int m0 = tl * 16;
        if (tid_ < 32) lcnt[tid_] = 0u;
        __syncthreads(); PROF7(-1);
        int e1 = 0, e2 = 0, ls1 = 0, ls2 = 0; float w1 = 0.f, w2 = 0.f;
        if (active) {
            {
                const int bb = m0 >> 12;
                f32x4 gm[4], sh[4];
#pragma unroll
                for (int j = 0; j < 4; ++j) { const f32x4 g = ((const GAS f32x4*)norm_ffn)[lane_ + 64 * j]; const f32x4 sc = ((const GAS f32x4*)(mod + bb * 6144 + 4096))[lane_ + 64 * j];
                    sh[j] = ((const GAS f32x4*)(mod + bb * 6144 + 3072))[lane_ + 64 * j]; gm[j] = g * (sc + 1.f); }
                unsigned long long vA[2][4], vB[2][4], vC[2][4], vD[2][4];
#define P7_LOAD(dst, mb_) do { _Pragma("unroll") for (int r = 0; r < 2; ++r) { const GAS unsigned long long* xr = (const GAS unsigned long long*)(xmid + (size_t)((mb_) + r) * D) + lane_; \
                    _Pragma("unroll") for (int j = 0; j < 4; ++j) dst[r][j] = xr[64 * j]; } } while (0)
                P7_LOAD(vA, m0); P7_LOAD(vB, m0 + 2); P7_LOAD(vC, m0 + 4);
#pragma unroll 1
                for (int gp = 0; gp < 2; ++gp) {
                    P7_LOAD(vD, m0 + 8 * gp + 6);
                    p7_rows(vA, m0 + 8 * gp, lane_, gm, sh, H);
                    if (gp < 1) P7_LOAD(vA, m0 + 8);
                    p7_rows(vB, m0 + 8 * gp + 2, lane_, gm, sh, H);
                    if (gp < 1) P7_LOAD(vB, m0 + 10);
                    p7_rows(vC, m0 + 8 * gp + 4, lane_, gm, sh, H);
                    if (gp < 1) P7_LOAD(vC, m0 + 12);
                    p7_rows(vD, m0 + 8 * gp + 6, lane_, gm, sh, H);
                }
#undef P7_LOAD
            }
            PROF7(0);
            __threadfence_block();
            asm volatile("s_waitcnt vmcnt(0)" ::: "memory");
            f32x4 acc0 = {0.f, 0.f, 0.f, 0.f}, acc1 = acc0, acc2 = acc0;
            const bf16* ap = H + (size_t)(m0 + (lane_ & 15)) * D + 8 * (lane_ >> 4);
            const LAS unsigned char* bp = wrtL + (lane_ & 15) * 2048; const int bg_ = lane_ >> 4, bx_ = lane_ & 7;
#pragma unroll 16
            for (int sI = 0; sI < 32; ++sI) {
                const bf16x8 av = *(const GAS bf16x8*)(ap + 32 * sI);
                const int po = ((4 * sI + bg_) ^ bx_) << 4;
                const bf16x8 b0 = *(const LAS bf16x8*)(bp + po), b1 = *(const LAS bf16x8*)(bp + 16 * 2048 + po), b2 = *(const LAS bf16x8*)(bp + 32 * 2048 + po);
                acc0 = __builtin_amdgcn_mfma_f32_16x16x32_bf16(av, b0, acc0, 0, 0, 0);
                acc1 = __builtin_amdgcn_mfma_f32_16x16x32_bf16(av, b1, acc1, 0, 0, 0);
                acc2 = __builtin_amdgcn_mfma_f32_16x16x32_bf16(av, b2, acc2, 0, 0, 0);
            }
            PROF7(1);
#pragma unroll
            for (int rg = 0; rg < 4; ++rg) { const int row = 4 * (lane_ >> 4) + rg;
                lg[row * 48 + (lane_ & 15)] = acc0[rg]; lg[row * 48 + 16 + (lane_ & 15)] = acc1[rg]; lg[row * 48 + 32 + (lane_ & 15)] = acc2[rg]; }
            LDS_WAIT(); asm volatile("" ::: "memory");
            if (lane_ < 16) {
                const LAS float* l = lg + lane_ * 48;
                float gmax = l[0]; int gi = 0;
#pragma unroll
                for (int i = 1; i < 4; ++i) { const float v = l[i]; if (v > gmax) { gmax = v; gi = i; } }
                float gs = 0.f;
#pragma unroll
                for (int i = 0; i < 4; ++i) gs += __expf(l[i] - gmax);
                const float gprob = 1.f / gs;
                float a1 = -1e30f, a2 = -1e30f; int i1 = 0, i2 = 0;
#pragma unroll
                for (int i = 0; i < 8; ++i) { const float v = l[4 + gi * 8 + i]; if (v > a1) { a2 = a1; i2 = i1; a1 = v; i1 = i; } else if (v > a2) { a2 = v; i2 = i; } }
                const float p2 = __expf(a2 - a1);
                w1 = gprob / (1.f + p2); w2 = gprob * p2 / (1.f + p2);
                e1 = gi * 8 + i1; e2 = gi * 8 + i2;
                ls1 = (int)atomicAdd((unsigned*)&lcnt[e1], 1u); ls2 = (int)atomicAdd((unsigned*)&lcnt[e2], 1u);
            }
        }
        __syncthreads(); PROF7(2);
        if (tid_ < 32) gbase[tid_] = __hip_atomic_fetch_add(gcnt + tid_, lcnt[tid_], __ATOMIC_RELAXED, __HIP_MEMORY_SCOPE_AGENT);
        __syncthreads(); PROF7(3);
        if (active && lane_ < 16) {
            const int m = m0 + lane_; const int s1 = (int)gbase[e1] + ls1, s2 = (int)gbase[e2] + ls2;
            ltok[(size_t)e1 * CAP + s1] = m; lw[(size_t)e1 * CAP + s1] = w1;
            ltok[(size_t)e2 * CAP + s2] = m; lw[(size_t)e2 * CAP + s2] = w2;
            tokslot[2 * m] = (e1 << 20) | s1; tokslot[2 * m + 1] = (e2 << 20) | s2;
        }
        PROF7(4);
    }
}

__device__ __forceinline__ void moe_setup(Frame& F) {
    const int lane_ = pg8::lane_now(), tid_ = F.wave * 64 + lane_;
    LAS int* tpre = (LAS int*)(F.lds + MOE_OFF); LAS int* cn = tpre + 33;
    if (tid_ == 0) { int acc = 0;
        for (int e = 0; e < 32; ++e) { const int c = (int)__hip_atomic_load(F.ctl + CW_CNT + e, RLX_AGENT); cn[e] = c; tpre[e] = acc; acc += (c + 255) >> 8; }
        tpre[32] = acc; }
    __syncthreads();
}

__device__ __forceinline__ void p10_rows(const unsigned long long (&xraw)[2][4], const unsigned long long (&ya)[2][4], const unsigned long long (&yb)[2][4], int mb, int lane_, const f32x4 (&gt)[4], const f32x4 (&nf)[4], float* xo) {
    float ss[2]; f32x4 v[2][4];
#pragma unroll
    for (int r = 0; r < 2; ++r)
#pragma unroll
        for (int j = 0; j < 4; ++j) v[r][j] = bf4_to_f32(xraw[r][j]);
#pragma unroll
    for (int r = 0; r < 2; ++r) { float s = 0.f;
#pragma unroll
        for (int j = 0; j < 4; ++j) { const unsigned long long a = ya[r][j], b = yb[r][j]; f32x4 y;
            y.x = __uint_as_float((unsigned)(a & 0xFFFFu) << 16) + __uint_as_float((unsigned)(b & 0xFFFFu) << 16);
            y.y = __uint_as_float((unsigned)(a >> 16) << 16) + __uint_as_float((unsigned)(b >> 16) << 16);
            y.z = __uint_as_float((unsigned)((a >> 32) & 0xFFFFu) << 16) + __uint_as_float((unsigned)((b >> 32) & 0xFFFFu) << 16);
            y.w = __uint_as_float((unsigned)(a >> 48) << 16) + __uint_as_float((unsigned)(b >> 48) << 16);
            v[r][j] = v[r][j] + gt[j] * y;
            s += (v[r][j].x * v[r][j].x + v[r][j].y * v[r][j].y) + (v[r][j].z * v[r][j].z + v[r][j].w * v[r][j].w); }
        ss[r] = s; }
#pragma unroll
    for (int r = 0; r < 2; ++r) ss[r] = wave_sum(ss[r]);
#pragma unroll
    for (int r = 0; r < 2; ++r) { const float rs = rsqrtf(ss[r] * (1.f / D) + EPS);
        GAS f32x4* xr = (GAS f32x4*)(xo + (size_t)(mb + r) * D) + lane_;
#pragma unroll
        for (int j = 0; j < 4; ++j) xr[64 * j] = v[r][j] * rs * nf[j]; }
}
__device__ __forceinline__ void p8_phase(Frame& F, unsigned char* ws, float* xo, const float* norm_final) {
    const bf16* xm = (const bf16*)(ws + WS_XM);
    const int lane_ = pg8::lane_now();
    const float* mod = (const float*)(ws + WS_MOD); const int* tokslot = (const int*)(ws + WS_TOKSLOT); const bf16* ys = (const bf16*)(ws + WS_YS);
    const LAS int* tpre = (const LAS int*)(F.lds + MOE_OFF);
    f32x4 nf[4];
#pragma unroll
    for (int j = 0; j < 4; ++j) nf[j] = ((const GAS f32x4*)norm_final)[lane_ + 64 * j];
    for (int tl = F.vcu * NWAVES + F.wave; tl < T / 16; tl += F.G * NWAVES) {
        const int m0 = tl * 16, bb = m0 >> 12;
        int myrow = 0;
        if (lane_ < 32) { const int t = tokslot[2 * m0 + lane_]; myrow = tpre[t >> 20] * 256 + (t & 0xFFFFF); }
        f32x4 gt[4];
#pragma unroll
        for (int j = 0; j < 4; ++j) gt[j] = ((const GAS f32x4*)(mod + bb * 6144 + 5120))[lane_ + 64 * j];
        unsigned long long vA[2][4], vB[2][4], yaA[2][4], ybA[2][4], yaB[2][4], ybB[2][4];
#define P10_LOAD(dv, da, db, g_) do { _Pragma("unroll") for (int r = 0; r < 2; ++r) { \
            const size_t r0 = (size_t)__shfl(myrow, 2 * (2 * (g_) + r)), r1 = (size_t)__shfl(myrow, 2 * (2 * (g_) + r) + 1); \
            const GAS unsigned long long* xr = (const GAS unsigned long long*)(xm + (size_t)(m0 + 2 * (g_) + r) * D) + lane_; \
            const GAS unsigned long long* y0 = (const GAS unsigned long long*)(ys + r0 * D) + lane_; const GAS unsigned long long* y1 = (const GAS unsigned long long*)(ys + r1 * D) + lane_; \
            _Pragma("unroll") for (int j = 0; j < 4; ++j) { dv[r][j] = xr[64 * j]; da[r][j] = y0[64 * j]; db[r][j] = y1[64 * j]; } } } while (0)
        P10_LOAD(vA, yaA, ybA, 0);
#pragma unroll 1
        for (int gp = 0; gp < 4; ++gp) {
            P10_LOAD(vB, yaB, ybB, 2 * gp + 1);
            p10_rows(vA, yaA, ybA, m0 + 4 * gp, lane_, gt, nf, xo);
            if (gp < 3) P10_LOAD(vA, yaA, ybA, 2 * gp + 2);
            p10_rows(vB, yaB, ybB, m0 + 4 * gp + 2, lane_, gt, nf, xo);
        }
#undef P10_LOAD
    }
}

#if MK_PROF_A >= 200
#define PROFA(idx) do { if (blockIdx.x == 32 && wid_ == 0 && lane == 0) { const unsigned long long t_ = __builtin_amdgcn_s_memrealtime(); \
        const unsigned long long p_ = ((unsigned long long)misc_[23] << 32) | misc_[22]; if ((idx) >= 0) misc_[24 + (idx)] = __float_as_uint(__uint_as_float(misc_[24 + (idx)]) + (float)(t_ - p_) * 0.01f); \
        misc_[22] = (unsigned)t_; misc_[23] = (unsigned)(t_ >> 32); } } while (0)
#else
#define PROFA(idx) do {} while (0)
#endif
#ifndef ATT_NPF
#define ATT_NPF 2
#endif
namespace att {
typedef short bf16x8 __attribute__((ext_vector_type(8)));
typedef short s16x4 __attribute__((ext_vector_type(4)));
typedef float f32x16 __attribute__((ext_vector_type(16)));
typedef unsigned u32x4 __attribute__((ext_vector_type(4)));
constexpr int TBL_N = 192;
constexpr int LDS_TBL = 0;
constexpr int LDS_WAVE = 18432;
constexpr int WAVE_BYTES = 8448;
constexpr float LOG2E = 1.4426950408889634f;
__device__ __forceinline__ int crow(int r, int hi) { return (r & 3) + 8 * (r >> 2) + 4 * hi; }
__device__ __forceinline__ unsigned cvtpk(float lo, float hi) { typedef float f32x2_t_ __attribute__((ext_vector_type(2))); typedef __bf16 bf16x2_t_ __attribute__((ext_vector_type(2))); const f32x2_t_ v_ = {lo, hi}; return __builtin_bit_cast(unsigned, __builtin_convertvector(v_, bf16x2_t_)); }
__device__ __forceinline__ s16x4 vtr(const LAS unsigned char* p) { typedef short v4i16_t __attribute__((ext_vector_type(4)));
    return __builtin_bit_cast(s16x4, __builtin_amdgcn_ds_read_tr16_b64_v4i16((LAS v4i16_t*)p)); }

__device__ __forceinline__ void build_tables(LAS float* tbl, const float* rel_bias, int tid) {
    for (int i = tid; i < 24 * TBL_N; i += NWAVES * 64) {
        const int bh = i / TBL_N, u = i % TBL_N, br = bh >> 3, h = bh & 7, delta = 159 - u, dil = br == 0 ? 1 : (br == 1 ? 4 : 16);
        float v = -1e30f;
        if (delta >= 0 && delta <= 128) { const int dist = delta * dil; int bucket;
            if (dist < 16) bucket = dist; else { const double vv = log((double)dist / 16.0) / log(128.0) * 16.0; const int l = 16 + (int)vv; bucket = l < 31 ? l : 31; }
            v = rel_bias[bucket * 8 + h] * LOG2E; }
        tbl[i] = v;
    }
}
__device__ __forceinline__ void build_tables_max(LAS float* tbl, int tid) {
    if (tid < 24) { float mx = -1e30f; for (int u = 31; u <= 159; ++u) mx = fmaxf(mx, tbl[tid * TBL_N + u]); tbl[tid * TBL_N + TBL_N - 1] = mx; }
}

struct TileP { int rowbase, h, dil, r, I0; };
__device__ __forceinline__ unsigned lane_kofs(int dil, int lane) { return (unsigned)((lane & 31) * dil * 128 + (lane >> 5) * 16); }
__device__ __forceinline__ unsigned lane_vofs(int dil, int lane) { return (unsigned)((lane >> 3) * dil * 128 + (lane & 7) * 16); }
__device__ __forceinline__ const GAS unsigned char* tile_row(const void* B, const TileP& t, int J) {
    const long tok = (long)(t.rowbase * 8 + t.h * 4096) + t.r + (long)t.dil * J; return (const GAS unsigned char*)B + tok * 128; }
__device__ __forceinline__ unsigned lane_pofs(int dil, int lane) { return (unsigned)((lane >> 3) * dil * 1024 + (lane & 7) * 16); }
__device__ __forceinline__ void load_q(const bf16* QB, const TileP& t, unsigned kofs, bf16x8 (&qf)[4]) {
    const GAS unsigned char* b = tile_row(QB, t, t.I0);
#pragma unroll
    for (int s = 0; s < 4; ++s) qf[s] = *(const GAS bf16x8*)(b + kofs + 32 * s);
}
__device__ __forceinline__ void load_k(const bf16* KB, const TileP& t, unsigned kofs, int kt, bf16x8 (&kfk)[4]) {
    const GAS unsigned char* b = tile_row(KB, t, t.I0 - 128 + 32 * kt);
#pragma unroll
    for (int s = 0; s < 4; ++s) kfk[s] = *(const GAS bf16x8*)(b + kofs + 32 * s);
}
__device__ __forceinline__ void load_v(const bf16* VB, const TileP& t, unsigned vofs, int kt, u32x4 (&vv)[4]) {
#pragma unroll
    for (int ii = 0; ii < 4; ++ii) vv[ii] = *(const GAS u32x4*)(tile_row(VB, t, t.I0 - 128 + 32 * kt + 8 * ii) + vofs);
}
__device__ __forceinline__ void wave_tile(const bf16* QB, const bf16* KB, const bf16* VB, bf16* part, float* lse, const LAS float* tb, LAS unsigned char* wl,
                                          const TileP& tc, bool has_next, const TileP& tn, int lane, volatile LAS unsigned* misc_, int wid_,
                                          bf16x8 (&qf)[4], bf16x8 (&qn)[4], bf16x8 (&ks0)[4], u32x4 (&vx)[4], u32x4 (&vy)[4]) {
    const int h = tc.h, I0 = tc.I0;
    const int i = lane & 31, h2 = lane >> 5;
    PROFA(-1);
    LAS unsigned char* vt = wl; LAS unsigned char* ost = wl + 4096;
    const bool needmask = I0 < 128;
    const LAS float* tbase = tb + (31 - i + 4 * h2);
    const int vrow_l = lane >> 3, vch = lane & 7;
    const LAS unsigned char* vrd = vt + ((lane >> 4) & 1) * 32 + (lane & 3) * 8 + (4 * h2 + ((lane & 15) >> 2)) * 64;
    const unsigned kofs = lane_kofs(tc.dil, lane), vofs = lane_vofs(tc.dil, lane);
    bf16x8 ks1[4], ks2[4], ks3[4], ks4[4];
    load_k(KB, tc, kofs, 3, ks1);
    float m = 0.f, l = 0.f;
    f32x16 o0 = {0.f, 0.f, 0.f, 0.f, 0.f, 0.f, 0.f, 0.f, 0.f, 0.f, 0.f, 0.f, 0.f, 0.f, 0.f, 0.f}, o1 = o0;
#define ATT_STEP(j_, KF_, VV_, PRE_) do { constexpr int kt = 4 - (j_); \
        _Pragma("unroll") for (int ii = 0; ii < 4; ++ii) *(LAS u32x4*)(vt + (vch >> 2) * 2048 + (vrow_l + 8 * ii) * 64 + (vch & 3) * 16) = VV_[ii]; \
        if ((j_) < 3) load_v(VB, tc, vofs, kt - 2, VV_); else if (has_next) load_v(VB, tn, lane_vofs(tn.dil, lane), 7 - (j_), VV_);     \
        f32x16 acc; \
        if ((j_) == 0) { _Pragma("unroll") for (int rr = 0; rr < 16; ++rr) acc[rr] = 0.f; } else { _Pragma("unroll") for (int rr = 0; rr < 16; ++rr) acc[rr] = -m; } \
        _Pragma("unroll") for (int s = 0; s < 4; ++s) acc = __builtin_amdgcn_mfma_f32_32x32x16_bf16(KF_[s], qf[s], acc, 0, 0, 0); \
        PRE_; \
        if ((j_) == 0) { float mx = acc[0]; _Pragma("unroll") for (int rr = 1; rr < 16; ++rr) mx = fmaxf(mx, acc[rr]); \
            { float w_ = mx; asm volatile("" : "+v"(w_)); auto rx = __builtin_amdgcn_permlane32_swap(__float_as_uint(mx), __float_as_uint(w_), false, false); mx = fmaxf(__uint_as_float(rx[0]), __uint_as_float(rx[1])); } \
            m = mx + tb[att::TBL_N - 1]; _Pragma("unroll") for (int rr = 0; rr < 16; ++rr) acc[rr] -= m; } \
        if (needmask) {                                       \
            const int jlim = 128 - 32 * kt - I0 - 4 * h2; asm volatile("" ::: "memory"); \
            _Pragma("unroll") for (int rr = 0; rr < 16; ++rr) { const int kk = (rr & 3) + 8 * (rr >> 2); if (kk < jlim) acc[rr] = -1e30f; } } \
        float p[16]; \
        _Pragma("unroll") for (int rr = 0; rr < 16; ++rr) { const int kk = (rr & 3) + 8 * (rr >> 2); \
            p[rr] = __builtin_amdgcn_exp2f(acc[rr] + tbase[32 * kt + kk]); l += p[rr]; } \
        u32x4 pw0, pw1; \
        pw0.x = cvtpk(p[0], p[1]); pw0.y = cvtpk(p[2], p[3]); pw0.z = cvtpk(p[4], p[5]); pw0.w = cvtpk(p[6], p[7]); \
        pw1.x = cvtpk(p[8], p[9]); pw1.y = cvtpk(p[10], p[11]); pw1.z = cvtpk(p[12], p[13]); pw1.w = cvtpk(p[14], p[15]); \
        const bf16x8 pa0 = __builtin_bit_cast(bf16x8, pw0), pa1 = __builtin_bit_cast(bf16x8, pw1); \
        asm volatile("s_waitcnt lgkmcnt(0)" ::: "memory"); \
        _Pragma("unroll") for (int db = 0; db < 2; ++db) { \
            const s16x4 a0 = vtr(vrd + db * 2048), a1 = vtr(vrd + db * 2048 + 512), b0 = vtr(vrd + db * 2048 + 1024), b1 = vtr(vrd + db * 2048 + 1536); \
            const bf16x8 v0 = (bf16x8){a0[0], a0[1], a0[2], a0[3], a1[0], a1[1], a1[2], a1[3]}, v1 = (bf16x8){b0[0], b0[1], b0[2], b0[3], b1[0], b1[1], b1[2], b1[3]}; \
            if (db == 0) { o0 = __builtin_amdgcn_mfma_f32_32x32x16_bf16(v0, pa0, o0, 0, 0, 0); o0 = __builtin_amdgcn_mfma_f32_32x32x16_bf16(v1, pa1, o0, 0, 0, 0); } \
            else         { o1 = __builtin_amdgcn_mfma_f32_32x32x16_bf16(v0, pa0, o1, 0, 0, 0); o1 = __builtin_amdgcn_mfma_f32_32x32x16_bf16(v1, pa1, o1, 0, 0, 0); } } \
        asm volatile("s_waitcnt lgkmcnt(0)" ::: "memory"); } while (0)
    ATT_STEP(0, ks0, vx, load_k(KB, tc, kofs, 2, ks2));
    PROFA(0);
    ATT_STEP(1, ks1, vy, load_k(KB, tc, kofs, 1, ks3));
    ATT_STEP(2, ks2, vx, { load_k(KB, tc, kofs, 0, ks4); if (has_next) load_q(QB, tn, lane_kofs(tn.dil, lane), qn); });
    ATT_STEP(3, ks3, vy, if (has_next) load_k(KB, tn, lane_kofs(tn.dil, lane), 4, ks0));
    ATT_STEP(4, ks4, vx, (void)0);
#undef ATT_STEP
    PROFA(1);
    { float w_ = l; asm volatile("" : "+v"(w_)); auto rr = __builtin_amdgcn_permlane32_swap(__float_as_uint(l), __float_as_uint(w_), false, false); l = __uint_as_float(rr[0]) + __uint_as_float(rr[1]); }
    const float il = 1.f / l;
    if (h2 == 0) *(GAS float*)((GAS unsigned char*)lse + ((long)tc.rowbase + tc.r + (long)tc.dil * I0) * 32 + h * 4 + (size_t)(i * tc.dil * 32)) = m + __log2f(l);
#pragma unroll
    for (int qd = 0; qd < 4; ++qd) { typedef unsigned u32x2_ __attribute__((ext_vector_type(2)));
        LAS unsigned char* wp = ost + i * 128 + h2 * 8;
        *(LAS u32x2_*)(wp + ((qd ^ (i & 7)) << 4)) = (u32x2_){cvtpk(o0[4 * qd] * il, o0[4 * qd + 1] * il), cvtpk(o0[4 * qd + 2] * il, o0[4 * qd + 3] * il)};
        *(LAS u32x2_*)(wp + (((qd + 4) ^ (i & 7)) << 4)) = (u32x2_){cvtpk(o1[4 * qd] * il, o1[4 * qd + 1] * il), cvtpk(o1[4 * qd + 2] * il, o1[4 * qd + 3] * il)}; }
    asm volatile("s_waitcnt lgkmcnt(0)" ::: "memory");
    { GAS unsigned char* pb = (GAS unsigned char*)part + ((long)tc.rowbase + tc.r + (long)tc.dil * I0) * 1024 + h * 128; const unsigned pofs = lane_pofs(tc.dil, lane);
#pragma unroll
      for (int ii = 0; ii < 4; ++ii) { const int row = ii * 8 + vrow_l;
        const u32x4 v = *(const LAS u32x4*)(ost + row * 128 + ((vch ^ (row & 7)) << 4));
        *(GAS u32x4*)(pb + (size_t)(ii * 8 * tc.dil) * 1024 + pofs) = v; } }
    asm volatile("s_waitcnt lgkmcnt(0)" ::: "memory");
    PROFA(2);
}
}

struct AttTile { int br, h, b, dil, r, I0; };
__device__ __forceinline__ AttTile att_tile(int u, int wt) {
    AttTile t; t.h = u / 192; const int nu = u % 192; t.br = nu % 3; const int bb = nu / 3; t.b = bb >> 3; const int blk = bb & 7;
    t.dil = t.br == 0 ? 1 : (t.br == 1 ? 4 : 16);
    if (t.br == 0) { t.r = 0; t.I0 = blk * 512 + 32 * wt; } else if (t.br == 1) { t.r = wt & 3; t.I0 = blk * 128 + 32 * (wt >> 2); } else { t.r = wt; t.I0 = blk * 32; }
    return t;
}
__device__ __forceinline__ unsigned att_draw_unit(gu32* qctr, volatile LAS unsigned* Q, unsigned x) {
    unsigned k = Q[1];
    while (k < 8u) { const unsigned y = (x + k) & 7u; const unsigned nu = __hip_atomic_fetch_add(qctr + 32 * y, 1u, __ATOMIC_RELAXED, __HIP_MEMORY_SCOPE_AGENT);
        if (nu < 192u) return y * 192u + nu;
        ++k; Q[1] = k; }
    return 1536u;
}
__device__ __forceinline__ void att_prefetch(const bf16* QB, const bf16* KB, const bf16* VB, const AttTile& t, int lane, unsigned (&pf)[6]) {
#pragma unroll
    for (int q = 0; q < 6; ++q) { const int xidx = lane + 64 * q; const bf16* base; int J;
        if (xidx < 32) { base = QB; J = t.I0 + xidx; } else if (xidx < 192) { base = KB; J = t.I0 - 128 + (xidx - 32); } else { base = VB; J = t.I0 - 128 + (xidx - 192); }
        if (J < 0) J = 0; if (xidx >= 352) J = t.I0;
        pf[q] = *(const GAS unsigned*)(base + ((size_t)t.b * SEQ + t.r + (size_t)t.dil * J) * 512 + 64 * t.h); }
}
__device__ __forceinline__ void attn_phase(Frame& F, unsigned char* ws, const float* rel_bias) {
    const int lane_ = pg8::lane_now(), tid_ = F.wave * 64 + lane_;
    LAS float* tbl = (LAS float*)(F.lds + RING_OFF + att::LDS_TBL);
    volatile LAS unsigned* Q = (volatile LAS unsigned*)(F.lds + LDSCTL_OFF);
    gu32* qctr = F.ctl + CW_ATTQ; const unsigned xq_ = xb_xcc_id() & 7u;
    if (tid_ < 32) Q[tid_] = 0u;
    att::build_tables(tbl, rel_bias, tid_);
    __syncthreads();
    att::build_tables_max(tbl, tid_);
    if (tid_ == 0) { Q[8] = att_draw_unit(qctr, Q, xq_); Q[9] = att_draw_unit(qctr, Q, xq_); Q[16] = 1u; Q[17] = 2u; }
    __syncthreads();
    const bf16* QB = (const bf16*)(ws + WS_QB); const bf16* KB = (const bf16*)(ws + WS_KB); const bf16* VB = (const bf16*)(ws + WS_VB);
    LAS unsigned char* wl = F.lds + RING_OFF + att::LDS_WAVE + F.wave * att::WAVE_BYTES;
#define ATT_DRAW(u_, wt_) do { unsigned g_ = 0u; if (pg8::lane_now() == 0) g_ = atomicAdd((unsigned*)&Q[0], 1u); g_ = (unsigned)__builtin_amdgcn_readfirstlane((int)g_); \
        const unsigned s_ = g_ >> 4; wt_ = (int)(g_ & 15u); \
        if (wt_ == 0 && pg8::lane_now() == 0) { const unsigned nu_ = att_draw_unit(qctr, Q, xq_); Q[8 + ((s_ + 2u) & 7u)] = nu_; \
            asm volatile("s_waitcnt lgkmcnt(0)" ::: "memory"); Q[16 + ((s_ + 2u) & 7u)] = s_ + 3u; } \
        while (Q[16 + (s_ & 7u)] != s_ + 1u) __builtin_amdgcn_s_sleep(1); \
        u_ = __builtin_amdgcn_readfirstlane((int)Q[8 + (s_ & 7u)]); } while (0)
#if MK_PROF_A >= 200
    const unsigned long long tph0_ = __builtin_amdgcn_s_memrealtime(); unsigned long long tdraw_ = 0; int ntile_ = 0;
#endif
    int u_cur, wt_cur, u_nxt, wt_nxt;
    ATT_DRAW(u_cur, wt_cur);
    att::bf16x8 qA[4], qB[4], ks0[4]; att::u32x4 vA[4], vB[4];
    if (u_cur < 1536) { const AttTile t0 = att_tile(u_cur, wt_cur); const att::TileP p0{t0.b * SEQ, t0.h, t0.dil, t0.r, t0.I0}; const int ln = pg8::lane_now();
        const unsigned ko = att::lane_kofs(p0.dil, ln), vo = att::lane_vofs(p0.dil, ln);
        att::load_q(QB, p0, ko, qA); att::load_k(KB, p0, ko, 4, ks0); att::load_v(VB, p0, vo, 4, vA); att::load_v(VB, p0, vo, 3, vB); }
#if MK_PROF_A >= 200
#define ATT_PROF_DRAW0() const unsigned long long td0_ = __builtin_amdgcn_s_memrealtime()
#define ATT_PROF_DRAW1() do { tdraw_ += __builtin_amdgcn_s_memrealtime() - td0_; ++ntile_; } while (0)
#else
#define ATT_PROF_DRAW0() do {} while (0)
#define ATT_PROF_DRAW1() do {} while (0)
#endif
#define ATT_ONE_TILE(QC_, QN_, VX_, VY_) do { \
        ATT_PROF_DRAW0(); \
        ATT_DRAW(u_nxt, wt_nxt);                               \
        ATT_PROF_DRAW1(); \
        const int ln = pg8::lane_now();                        \
        const AttTile t = att_tile(u_cur, wt_cur); \
        const bool has_next = u_nxt < 1536; \
        const AttTile tn = att_tile(has_next ? u_nxt : u_cur, has_next ? wt_nxt : wt_cur); \
        const att::TileP pc{t.b * SEQ, t.h, t.dil, t.r, t.I0}, pn{tn.b * SEQ, tn.h, tn.dil, tn.r, tn.I0}; \
        bf16* part = (bf16*)(ws + (t.br == 0 ? WS_PART0 : (t.br == 1 ? WS_PART1 : WS_PART2))); \
        float* lse = (float*)(ws + WS_LSE) + (size_t)t.br * T * 8; \
        att::wave_tile(QB, KB, VB, part, lse, tbl + (t.br * 8 + t.h) * att::TBL_N, wl, pc, has_next, pn, ln, F.MISC, F.wave, QC_, QN_, ks0, VX_, VY_); \
        u_cur = u_nxt; wt_cur = wt_nxt; } while (0)
    while (u_cur < 1536) {
        ATT_ONE_TILE(qA, qB, vA, vB);
        if (u_cur >= 1536) break;
        ATT_ONE_TILE(qB, qA, vB, vA);
    }
#undef ATT_ONE_TILE
#undef ATT_DRAW
#if MK_PROF_A >= 200
    if (pg8::lane_now() == 0) atomicMax((unsigned*)(F.ctl + CW_CNT + 70), (unsigned)(__builtin_amdgcn_s_memrealtime() - tph0_));
    if (blockIdx.x == 32 && tid_ == 0) { F.MISC[27] = __float_as_uint((float)(__builtin_amdgcn_s_memrealtime() - tph0_) * 0.01f); F.MISC[26] = __float_as_uint((float)ntile_ * 5.f); F.MISC[25] = __float_as_uint((float)tdraw_ * 0.01f); }
#endif
    __syncthreads();
}

__device__ __forceinline__ void attn_combine_phase(Frame& F, unsigned char* ws, const float* attn_norm) {
    const int lane_ = pg8::lane_now();
    const int gw = F.vcu * NWAVES + F.wave, NGW = F.G * NWAVES;
    const float* lse = (const float*)(ws + WS_LSE); bf16* Y = (bf16*)(ws + WS_Y);
    const bf16* p0 = (const bf16*)(ws + WS_PART0); const bf16* p1 = (const bf16*)(ws + WS_PART1); const bf16* p2 = (const bf16*)(ws + WS_PART2);
    const int h = lane_ >> 3;
    f32x4 an0 = ((const GAS f32x4*)attn_norm)[2 * lane_], an1 = ((const GAS f32x4*)attn_norm)[2 * lane_ + 1];
    for (int tl = gw; tl < T / 16; tl += NGW) {
#pragma unroll 1
        for (int g4 = 0; g4 < 4; ++g4) {
            const int mb = tl * 16 + 4 * g4;
            float l0[4], l1[4], l2[4]; v4u pa[4], pb[4], pc[4];
#pragma unroll
            for (int r = 0; r < 4; ++r) { const size_t m = (size_t)(mb + r);
                l0[r] = lse[m * 8 + h]; l1[r] = lse[(size_t)T * 8 + m * 8 + h]; l2[r] = lse[(size_t)2 * T * 8 + m * 8 + h];
                pa[r] = *(const GAS v4u*)(p0 + m * 512 + 8 * lane_); pb[r] = *(const GAS v4u*)(p1 + m * 512 + 8 * lane_); pc[r] = *(const GAS v4u*)(p2 + m * 512 + 8 * lane_); }
            float o[4][8], ss[4];
#pragma unroll
            for (int r = 0; r < 4; ++r) {
                const float mx = fmaxf(l0[r], fmaxf(l1[r], l2[r]));
                float w0 = __builtin_amdgcn_exp2f(l0[r] - mx), w1 = __builtin_amdgcn_exp2f(l1[r] - mx), w2 = __builtin_amdgcn_exp2f(l2[r] - mx);
                const float inv = 1.f / (w0 + w1 + w2); w0 *= inv; w1 *= inv; w2 *= inv;
                float s = 0.f;
#pragma unroll
                for (int q = 0; q < 4; ++q) { const unsigned ua = pa[r][q], ub = pb[r][q], uc = pc[r][q];
                    o[r][2 * q] = w0 * __uint_as_float(ua << 16) + w1 * __uint_as_float(ub << 16) + w2 * __uint_as_float(uc << 16);
                    o[r][2 * q + 1] = w0 * __uint_as_float(ua & 0xFFFF0000u) + w1 * __uint_as_float(ub & 0xFFFF0000u) + w2 * __uint_as_float(uc & 0xFFFF0000u);
                    s += o[r][2 * q] * o[r][2 * q] + o[r][2 * q + 1] * o[r][2 * q + 1]; }
                ss[r] = s; }
#pragma unroll
            for (int r = 0; r < 4; ++r) ss[r] = wave_sum(ss[r]);
#pragma unroll
            for (int r = 0; r < 4; ++r) { const float ra = rsqrtf(ss[r] * (1.f / 512.f) + EPS);
                v4u w;
                w.x = pk2(o[r][0] * ra * an0.x, o[r][1] * ra * an0.y); w.y = pk2(o[r][2] * ra * an0.z, o[r][3] * ra * an0.w);
                w.z = pk2(o[r][4] * ra * an1.x, o[r][5] * ra * an1.y); w.w = pk2(o[r][6] * ra * an1.z, o[r][7] * ra * an1.w);
                *(GAS v4u*)(Y + (size_t)(mb + r) * 1024 + 512 + 8 * lane_) = w; }
        }
    }
}
namespace gdn {
__device__ __forceinline__ float fsilu(float x) { return x * __builtin_amdgcn_rcpf(1.f + __builtin_amdgcn_exp2f(-1.4426950408889634f * x)); }
typedef short bf16x8 __attribute__((ext_vector_type(8)));
typedef short s16x4 __attribute__((ext_vector_type(4)));
typedef float f32x4 __attribute__((ext_vector_type(4)));
typedef float f32x16 __attribute__((ext_vector_type(16)));
typedef unsigned u32x4 __attribute__((ext_vector_type(4)));
typedef __bf16 bf16x2_t __attribute__((ext_vector_type(2)));
constexpr int NCH = 2048;
constexpr int SCAN_BYTES = 49152;
__device__ __forceinline__ int sigma_inv(int x) { return (x & ~31) | (((x >> 2) & 3) << 3) | (((x >> 4) & 1) << 2) | (x & 3); }
__device__ __forceinline__ int crow(int r, int hi) { return (r & 3) + 8 * (r >> 2) + 4 * hi; }
__device__ __forceinline__ unsigned cvtpk(float lo, float hi) { typedef float f32x2_t_ __attribute__((ext_vector_type(2))); typedef __bf16 bf16x2_t_ __attribute__((ext_vector_type(2))); const f32x2_t_ v_ = {lo, hi}; return __builtin_bit_cast(unsigned, __builtin_convertvector(v_, bf16x2_t_)); }
__device__ __forceinline__ float bflo(unsigned w) { return __uint_as_float(w << 16); }
__device__ __forceinline__ float bfhi(unsigned w) { return __uint_as_float(w & 0xFFFF0000u); }
__device__ __forceinline__ s16x4 vtr(const LAS unsigned char* p) { typedef short v4i16_t __attribute__((ext_vector_type(4)));
    return __builtin_bit_cast(s16x4, __builtin_amdgcn_ds_read_tr16_b64_v4i16((LAS v4i16_t*)p)); }
__device__ __forceinline__ int sw256(int row, int col) { return row * 256 + ((((col >> 3) ^ (row & 15)) << 4) | ((col & 7) << 1)); }
__device__ __forceinline__ int sw128(int row, int col) { return row * 128 + ((((col >> 3) ^ ((row >> 1) & 7)) << 4) | ((col & 7) << 1)); }

constexpr int L_QN = 0, L_KN = 16384, L_KGT = 32768, L_AQK = 49152, L_G = 57344  , L_A = 59392  , L_G8 = 124928  ;

#if MK_PROF_A >= 100 && MK_PROF_A < 110
#define PROFX(idx) do { if (blockIdx.x == 0 && F.wave == 0 && pg8::lane_now() == 0) { const unsigned long long t_ = __builtin_amdgcn_s_memrealtime(); \
        const unsigned long long p_ = ((unsigned long long)F.MISC[23] << 32) | F.MISC[22]; if ((idx) >= 0) F.MISC[24 + (idx)] = __float_as_uint(__uint_as_float(F.MISC[24 + (idx)]) + (float)(t_ - p_) * 0.01f); \
        F.MISC[22] = (unsigned)t_; F.MISC[23] = (unsigned)(t_ >> 32); } } while (0)
#else
#define PROFX(idx) do {} while (0)
#endif
__device__ __forceinline__ void a1_phase(Frame& F, unsigned char* ws, unsigned char* dout, const float* wconv) {
    const int w = F.wave;
    PROFX(-1);
    const bf16* qkva = (const bf16*)(ws + WS_QKVA); const float* bg = (const float*)(ws + WS_BG);
    unsigned char* scanops = dout; bf16* QGb = (bf16*)(dout + 96 * MiB); bf16* AQKb = (bf16*)(ws + WS_GAQK); float* GLb = (float*)(ws + WS_GGL);
    bf16* RS = (bf16*)(ws + WS_H);
    LAS unsigned char* L = F.lds + RING_OFF;
    for (int grp = F.vcu; grp < NCH / 8; grp += F.G) {
        {
            const int lane = pg8::lane_now(), ch = grp * 8 + w, n = ch & 63, bh = ch >> 6, h = bh & 3, b = bh >> 2;
            const size_t m0 = (size_t)b * SEQ + n * 64;
            LAS float* Gs = (LAS float*)(L + L_G8 + w * 1024);
            float gq = bg[(m0 + lane) * 8 + 4 + h]; const float be = bg[(m0 + lane) * 8 + h];
#pragma unroll
            for (int o = 1; o < 64; o <<= 1) { const float t = __shfl_up(gq, o); if (lane >= o) gq += t; }
            const float glast = __shfl(gq, 63);
            Gs[lane] = gq; Gs[64 + lane] = __expf(gq); Gs[128 + lane] = be; Gs[192 + lane] = __expf(glast - gq);
            if (lane == 0) GLb[ch] = __expf(glast);
        }
        unsigned rq[11], rk[11], rv[11];
#define A1_LOADRAW(ci_) do { const int ch_ = grp * 8 + (ci_), n_ = ch_ & 63, bh_ = ch_ >> 6, h_ = bh_ & 3, b_ = bh_ >> 2; const int ln_ = pg8::lane_now(); \
            _Pragma("unroll") for (int t = 0; t < 11; ++t) { const int tt = n_ * 64 + 8 * w - 3 + t; \
                if (tt >= 0) { const size_t m = ((size_t)(b_ * 4 + h_) * SEQ + tt) * 384 + 2 * ln_; rq[t] = *(const GAS unsigned*)(qkva + m); rk[t] = *(const GAS unsigned*)(qkva + m + 128); rv[t] = *(const GAS unsigned*)(qkva + m + 256); } \
                else { rq[t] = 0u; rk[t] = 0u; rv[t] = 0u; } } } while (0)
        A1_LOADRAW(0);
        float wq[4][2], wk[4][2], wv[4][2];
        { const int ln_ = pg8::lane_now(), cq = ((grp >> 3) & 3) * 128 + 2 * ln_, ck = 512 + cq, cv = 1024 + cq;
#pragma unroll
          for (int t = 0; t < 4; ++t) { wq[t][0] = wconv[t * 1536 + cq]; wq[t][1] = wconv[t * 1536 + cq + 1]; wk[t][0] = wconv[t * 1536 + ck]; wk[t][1] = wconv[t * 1536 + ck + 1];
              wv[t][0] = wconv[t * 1536 + cv]; wv[t][1] = wconv[t * 1536 + cv + 1]; } }
        for (int ci = 0; ci < 8; ++ci) {
            const int ch = grp * 8 + ci, n = ch & 63, bh = ch >> 6, h = bh & 3, b = bh >> 2;
            const int t0 = n * 64; const size_t m0 = (size_t)b * SEQ + t0;
            const int lane = pg8::lane_now(), tid = w * 64 + lane, i32 = lane & 31, h2 = lane >> 5;
            __syncthreads(); PROFX(0);
            LAS float* Gs = (LAS float*)(L + L_G8 + ci * 1024); LAS float* eG = Gs + 64; LAS float* bet = Gs + 128; LAS float* eGl = Gs + 192;
            {
                float kg0[8], kg1[8];
#pragma unroll
                for (int rr = 0; rr < 8; ++rr) {
                    const int c = 8 * w + rr;
                    unsigned xq[4], xk[4], xv[4];
#pragma unroll
                    for (int t = 0; t < 4; ++t) { xq[t] = rq[rr + t]; xk[t] = rk[rr + t]; xv[t] = rv[rr + t]; }
                    float q0 = 0.f, q1 = 0.f, k0 = 0.f, k1 = 0.f, v0 = 0.f, v1 = 0.f;
#pragma unroll
                    for (int t = 0; t < 4; ++t) { q0 += wq[t][0] * bflo(xq[t]); q1 += wq[t][1] * bfhi(xq[t]); k0 += wk[t][0] * bflo(xk[t]); k1 += wk[t][1] * bfhi(xk[t]);
                        v0 += wv[t][0] * bflo(xv[t]); v1 += wv[t][1] * bfhi(xv[t]); }
                    q0 = fsilu(q0); q1 = fsilu(q1); k0 = fsilu(k0); k1 = fsilu(k1); v0 = fsilu(v0); v1 = fsilu(v1);
                    const float sq = wave_sum(q0 * q0 + q1 * q1), sk = wave_sum(k0 * k0 + k1 * k1);
                    const float rq = rsqrtf(sq + EPS) * 0.08838834764831845f, rk = rsqrtf(sk + EPS);
                    q0 *= rq; q1 *= rq; k0 *= rk; k1 *= rk;
                    const float be = bet[c], eg = eG[c], egl = eGl[c];
                    const int kc = 2 * lane;
                    *(LAS unsigned*)(L + L_QN + sw256(c, kc)) = cvtpk(q0, q1);
                    *(LAS unsigned*)(L + L_KN + sw256(c, kc)) = cvtpk(k0, k1);
                    kg0[rr] = k0 * egl; kg1[rr] = k1 * egl;
                    *(GAS unsigned*)(QGb + (size_t)ch * 8192 + c * 128 + sigma_inv(kc)) = cvtpk(q0 * eg, q1 * eg);
                    *(GAS unsigned*)(RS + (size_t)ch * 16384 + c * 256 + kc) = cvtpk(k0 * be * eg, k1 * be * eg);
                    *(GAS unsigned*)(RS + (size_t)ch * 16384 + c * 256 + 128 + kc) = cvtpk(v0 * be, v1 * be);
                }
                { const int kc = 2 * lane, c0 = 8 * w, p0 = (c0 & ~31) | (((c0 >> 2) & 3) << 3) | (((c0 >> 4) & 1) << 2);
                  typedef unsigned u32x2 __attribute__((ext_vector_type(2)));
                  *(LAS u32x2*)(L + L_KGT + sw128(kc, p0)) = (u32x2){cvtpk(kg0[0], kg0[1]), cvtpk(kg0[2], kg0[3])};
                  *(LAS u32x2*)(L + L_KGT + sw128(kc, p0 + 8)) = (u32x2){cvtpk(kg0[4], kg0[5]), cvtpk(kg0[6], kg0[7])};
                  *(LAS u32x2*)(L + L_KGT + sw128(kc + 1, p0)) = (u32x2){cvtpk(kg1[0], kg1[1]), cvtpk(kg1[2], kg1[3])};
                  *(LAS u32x2*)(L + L_KGT + sw128(kc + 1, p0 + 8)) = (u32x2){cvtpk(kg1[4], kg1[5]), cvtpk(kg1[6], kg1[7])}; }
            }
            if (ci < 7) A1_LOADRAW(ci + 1);
            __syncthreads(); PROFX(1);
            {
                const int pw = w >> 2, ti = (w >> 1) & 1, tj = w & 1;
                f32x16 acc = {0.f, 0.f, 0.f, 0.f, 0.f, 0.f, 0.f, 0.f, 0.f, 0.f, 0.f, 0.f, 0.f, 0.f, 0.f, 0.f};
                const LAS unsigned char* Ab = L + (pw ? L_QN : L_KN);
#pragma unroll
                for (int s = 0; s < 8; ++s) {
                    const bf16x8 af = *(const LAS bf16x8*)(Ab + sw256(32 * ti + i32, 16 * s + 8 * h2));
                    const bf16x8 bf = *(const LAS bf16x8*)(L + L_KN + sw256(32 * tj + i32, 16 * s + 8 * h2));
                    acc = __builtin_amdgcn_mfma_f32_32x32x16_bf16(af, bf, acc, 0, 0, 0);
                }
                const int j = 32 * tj + i32; const float Gj = Gs[j];
                if (pw == 0) {
                    LAS unsigned char* As = L + L_A + ci * 8192;
#pragma unroll
                    for (int rg = 0; rg < 16; ++rg) { const int i = 32 * ti + crow(rg, h2);
                        const float v = (j < i) ? bet[i] * acc[rg] * __expf(Gs[i] - Gj) : 0.f;
                        *(LAS bf16*)(As + i * 128 + j * 2) = (bf16)f2bf(v); }
                } else {
                    const int pj = sigma_inv(j);
#pragma unroll
                    for (int rg = 0; rg < 16; ++rg) { const int i = 32 * ti + crow(rg, h2);
                        const float v = (j <= i) ? acc[rg] * __expf(Gs[i] - Gj) : 0.f;
                        *(LAS bf16*)(L + L_AQK + i * 128 + pj * 2) = (bf16)f2bf(v); }
                }
            }
            __syncthreads(); PROFX(2);
            {
#pragma unroll
                for (int q = 0; q < 2; ++q) { const int off = (tid + 512 * q) * 16; *(GAS u32x4*)(scanops + (size_t)ch * SCAN_BYTES + 16384 + off) = *(const LAS u32x4*)(L + L_KGT + off); }
                { const int off = tid * 16; *(GAS u32x4*)((unsigned char*)AQKb + (size_t)ch * 8192 + off) = *(const LAS u32x4*)(L + L_AQK + off); }
            }
        }
        __syncthreads(); PROFX(3);
#if MK_A1 == 1
        {
            const int lane = pg8::lane_now(), tid = w * 64 + lane;
#pragma unroll
            for (int q = 0; q < 8; ++q) { const int off = (tid + 512 * q) * 16; *(GAS u32x4*)(ws + WS_PART2 + (size_t)grp * 65536 + off) = *(const LAS u32x4*)(L + L_A + off); }
        }
#else
        {
            const int lane = pg8::lane_now();
            LAS unsigned char* As = L + L_A + w * 8192;
            unsigned tp[32];
            float tprev = 0.f;
#pragma unroll
            for (int i = 0; i < 64; ++i) {
                float acc = 0.f;
#pragma unroll
                for (int p = 0; p < i / 2; ++p) { const unsigned lwp = *(const LAS unsigned*)(As + i * 128 + p * 4);
                    acc = __builtin_amdgcn_fdot2_f32_bf16(__builtin_bit_cast(bf16x2_t, lwp), __builtin_bit_cast(bf16x2_t, tp[p]), acc, false); }
                if (i & 1) { const unsigned lw1 = *(const LAS unsigned*)(As + i * 128 + (i - 1) * 2); acc += bflo(lw1) * tprev; }
                const float ti = ((lane == i) ? 1.f : 0.f) - acc;
                if (i & 1) tp[i >> 1] = cvtpk(tprev, ti);
                tprev = ti;
            }
#pragma unroll
            for (int p = 0; p < 32; ++p) { *(LAS bf16*)(As + (2 * p) * 128 + lane * 2) = (bf16)(tp[p] & 0xFFFFu); *(LAS bf16*)(As + (2 * p + 1) * 128 + lane * 2) = (bf16)(tp[p] >> 16); }
        }
        __syncthreads(); PROFX(4);
        u32x4 rpre[4];
        for (int ci = 0; ci < 8; ++ci) {
            const int ch = grp * 8 + ci;
            const int lane = pg8::lane_now(), tid = w * 64 + lane, i32 = lane & 31, h2 = lane >> 5;
            __syncthreads();
            if (ci == 0) {
#pragma unroll
                for (int q = 0; q < 4; ++q) rpre[q] = *(const GAS u32x4*)((const unsigned char*)RS + (size_t)ch * 32768 + (tid + 512 * q) * 16); }
#pragma unroll
            for (int q = 0; q < 4; ++q) *(LAS u32x4*)(L + (tid + 512 * q) * 16) = rpre[q];
            if (ci < 7) {
#pragma unroll
                for (int q = 0; q < 4; ++q) rpre[q] = *(const GAS u32x4*)((const unsigned char*)RS + (size_t)(ch + 1) * 32768 + (tid + 512 * q) * 16); }
            __syncthreads();
            const LAS unsigned char* Ts = L + L_A + ci * 8192;
            f32x16 x0 = {0.f, 0.f, 0.f, 0.f, 0.f, 0.f, 0.f, 0.f, 0.f, 0.f, 0.f, 0.f, 0.f, 0.f, 0.f, 0.f}, x1 = x0;
            const LAS unsigned char* rb = L + (8 * h2 + ((lane & 15) >> 2)) * 512 + (32 * w + 16 * ((lane >> 4) & 1) + 4 * (lane & 3)) * 2;
#pragma unroll
            for (int s = 0; s < 4; ++s) {
                const s16x4 lo = vtr(rb + (16 * s) * 512), hi = vtr(rb + (16 * s + 4) * 512);
                const bf16x8 bf = (bf16x8){lo[0], lo[1], lo[2], lo[3], hi[0], hi[1], hi[2], hi[3]};
                const bf16x8 a0 = *(const LAS bf16x8*)(Ts + i32 * 128 + (16 * s + 8 * h2) * 2), a1 = *(const LAS bf16x8*)(Ts + (32 + i32) * 128 + (16 * s + 8 * h2) * 2);
                x0 = __builtin_amdgcn_mfma_f32_32x32x16_bf16(a0, bf, x0, 0, 0, 0);
                x1 = __builtin_amdgcn_mfma_f32_32x32x16_bf16(a1, bf, x1, 0, 0, 0);
            }
            __syncthreads();
            {
                const int x = 32 * w + i32;
#pragma unroll
                for (int rg = 0; rg < 16; ++rg) {
#pragma unroll
                    for (int mt = 0; mt < 2; ++mt) { const int c = 32 * mt + crow(rg, h2); const float v = mt ? x1[rg] : x0[rg];
                        if (x < 128) *(LAS bf16*)(L + sw256(c, sigma_inv(x))) = (bf16)f2bf(-v);
                        else { const int vv = x - 128; const int idx = (((vv >> 4) * 64 + (vv & 15) + 16 * ((c >> 2) & 3)) * 16 + (c >> 4) * 4 + (c & 3));
                               *(LAS bf16*)(L + 16384 + idx * 2) = (bf16)f2bf(v); } }
                }
            }
            __syncthreads();
#pragma unroll
            for (int q = 0; q < 2; ++q) { const int off = (tid + 512 * q) * 16;
                *(GAS u32x4*)(scanops + (size_t)ch * SCAN_BYTES + off) = *(const LAS u32x4*)(L + off);
                *(GAS u32x4*)(scanops + (size_t)ch * SCAN_BYTES + 32768 + off) = *(const LAS u32x4*)(L + 16384 + off); }
        }
#endif
        __syncthreads(); PROFX(5);
    }
}

__device__ __forceinline__ void glds16(const void* gsrc, unsigned lds_dst) { unsigned keep;
    asm volatile("s_mov_b32 %0, m0\n\ts_mov_b32 m0, %2\n\ts_nop 0\n\tglobal_load_lds_dwordx4 %1, off\n\ts_mov_b32 m0, %0" : "=&s"(keep) : "v"(gsrc), "s"(lds_dst) : "memory"); }

__device__ __forceinline__ void scan_phase(Frame& F, unsigned char* ws, const unsigned char* dout, int bh) {
    const int lane = pg8::lane_now(), w = F.wave;
    const unsigned char* scanops = dout; const float* GLb = (const float*)(ws + WS_GGL);
    bf16* ST = (bf16*)(ws + WS_QKVA); bf16* UT = (bf16*)(ws + WS_QKVA + 64 * MiB);
    LAS unsigned char* L = F.lds + RING_OFF;
    const unsigned lds0 = (unsigned)(uintptr_t)(F.lds + RING_OFF);
    const int v16 = lane & 15, kg = lane >> 4;
    f32x4 Sf[8];
#pragma unroll
    for (int mt = 0; mt < 8; ++mt) Sf[mt] = (f32x4){0.f, 0.f, 0.f, 0.f};
    float glv = GLb[bh * 64 + lane];
    asm volatile("s_waitcnt vmcnt(0)" : "+v"(glv));
#define GDN_STAGE3(n, sl_) do { const unsigned char* src_ = scanops + (size_t)(bh * 64 + (n)) * SCAN_BYTES + lane * 16; \
        _Pragma("unroll") for (int q_ = 0; q_ < 6; ++q_) { const int piece_ = w * 6 + q_; \
            glds16(src_ + piece_ * 1024, (unsigned)__builtin_amdgcn_readfirstlane(lds0 + (sl_) * SCAN_BYTES + piece_ * 1024)); } } while (0)
#define GDN_STAGE(n) GDN_STAGE3(n, n)
    GDN_STAGE(0); GDN_STAGE(1);
    asm volatile("s_waitcnt vmcnt(6)" ::: "memory");
    int slot = 0, slot2 = 2;
    u32x4 Sb[4], Ub[2];
    for (int n = 0; n < 64; ++n) {
        __builtin_amdgcn_s_barrier();
        asm volatile("" ::: "memory");
        if (n + 2 < 64) GDN_STAGE3(n + 2, slot2);
        const LAS unsigned char* sl = L + slot * SCAN_BYTES;
        const float gl = __shfl(glv, n);
#pragma unroll
        for (int s = 0; s < 4; ++s) { Sb[s].x = cvtpk(Sf[2 * s][0], Sf[2 * s][1]); Sb[s].y = cvtpk(Sf[2 * s][2], Sf[2 * s][3]); Sb[s].z = cvtpk(Sf[2 * s + 1][0], Sf[2 * s + 1][1]); Sb[s].w = cvtpk(Sf[2 * s + 1][2], Sf[2 * s + 1][3]); }
        f32x4 Uf[4];
        { const u32x4 u0 = *(const LAS u32x4*)(sl + 32768 + (w * 64 + lane) * 32), u1 = *(const LAS u32x4*)(sl + 32768 + (w * 64 + lane) * 32 + 16);
          Uf[0] = (f32x4){bflo(u0.x), bfhi(u0.x), bflo(u0.y), bfhi(u0.y)}; Uf[1] = (f32x4){bflo(u0.z), bfhi(u0.z), bflo(u0.w), bfhi(u0.w)};
          Uf[2] = (f32x4){bflo(u1.x), bfhi(u1.x), bflo(u1.y), bfhi(u1.y)}; Uf[3] = (f32x4){bflo(u1.z), bfhi(u1.z), bflo(u1.w), bfhi(u1.w)}; }
        bf16x8 ak[16];
        {
            bf16x8 aw[16];
#pragma unroll
            for (int mt = 0; mt < 4; ++mt)
#pragma unroll
                for (int s = 0; s < 4; ++s) aw[mt * 4 + s] = *(const LAS bf16x8*)(sl + sw256(16 * mt + v16, 32 * s + 8 * kg));
#pragma unroll
            for (int s = 0; s < 4; ++s)
#pragma unroll
                for (int mt = 0; mt < 4; ++mt) Uf[mt] = __builtin_amdgcn_mfma_f32_16x16x32_bf16(aw[mt * 4 + s], __builtin_bit_cast(bf16x8, Sb[s]), Uf[mt], 0, 0, 0);
#pragma unroll
            for (int mt = 0; mt < 8; ++mt)
#pragma unroll
                for (int s = 0; s < 2; ++s) ak[mt * 2 + s] = *(const LAS bf16x8*)(sl + 16384 + sw128(16 * mt + v16, 32 * s + 8 * kg));
            __builtin_amdgcn_sched_group_barrier(0x100, 34, 0);
            __builtin_amdgcn_sched_group_barrier(0x008, 16, 0);
        }
#pragma unroll
        for (int s = 0; s < 2; ++s) { Ub[s].x = cvtpk(Uf[2 * s][0], Uf[2 * s][1]); Ub[s].y = cvtpk(Uf[2 * s][2], Uf[2 * s][3]); Ub[s].z = cvtpk(Uf[2 * s + 1][0], Uf[2 * s + 1][1]); Ub[s].w = cvtpk(Uf[2 * s + 1][2], Uf[2 * s + 1][3]); }
        {
#pragma unroll
            for (int mt = 0; mt < 8; ++mt) Sf[mt] = Sf[mt] * gl;
#pragma unroll
            for (int s = 0; s < 2; ++s)
#pragma unroll
                for (int mt = 0; mt < 8; ++mt) Sf[mt] = __builtin_amdgcn_mfma_f32_16x16x32_bf16(ak[mt * 2 + s], __builtin_bit_cast(bf16x8, Ub[s]), Sf[mt], 0, 0, 0);
        }
        if (n + 2 < 64) asm volatile("s_waitcnt vmcnt(6) lgkmcnt(0)" ::: "memory"); else asm volatile("s_waitcnt vmcnt(0) lgkmcnt(0)" ::: "memory");
        { bf16* dst = ST + (size_t)(bh * 64 + n) * 16384 + (w * 4 * 64 + lane) * 8;
#pragma unroll
          for (int s = 0; s < 4; ++s) *(GAS u32x4*)(dst + s * 512) = Sb[s]; }
        { bf16* dst = UT + (size_t)(bh * 64 + n) * 8192 + (w * 2 * 64 + lane) * 8;
#pragma unroll
          for (int s = 0; s < 2; ++s) *(GAS u32x4*)(dst + s * 512) = Ub[s]; }
        slot = (slot == 2) ? 0 : slot + 1; slot2 = (slot2 == 2) ? 0 : slot2 + 1;
    }
    asm volatile("s_waitcnt vmcnt(0) lgkmcnt(0)" ::: "memory");
    __builtin_amdgcn_s_barrier();
#undef GDN_STAGE
#undef GDN_STAGE3
}

__device__ __forceinline__ void a3_phase(Frame& F, unsigned char* ws, const unsigned char* dout, const float* gdn_norm) {
    const int lane = pg8::lane_now(), w = F.wave, tid = w * 64 + lane;
    const bf16* QGb = (const bf16*)(dout + 96 * MiB); const bf16* AQKb = (const bf16*)(ws + WS_GAQK);
    const bf16* ST = (const bf16*)(ws + WS_QKVA); const bf16* UT = (const bf16*)(ws + WS_QKVA + 64 * MiB);
    const bf16* Z = (const bf16*)(ws + WS_Z); bf16* Y = (bf16*)(ws + WS_Y);
    LAS float* Ot = (LAS float*)(F.lds + RING_OFF);
    const int v16 = lane & 15, kg = lane >> 4;
    const int c = tid >> 3, v0 = 16 * (tid & 7);
    f32x4 gn[4];
#pragma unroll
    for (int q = 0; q < 4; ++q) gn[q] = *(const GAS f32x4*)(gdn_norm + v0 + 4 * q);
    LAS unsigned char* LQ = F.lds + RING_OFF + 34816; LAS unsigned char* LA = LQ + 16384;
    bf16x8 fb[6]; u32x4 gq[3];
#define A3_LOADB(ch_) do { const int ch__ = (ch_); \
        const bf16* sp_ = ST + (size_t)ch__ * 16384 + (w * 4 * 64 + lane) * 8; const bf16* up_ = UT + (size_t)ch__ * 8192 + (w * 2 * 64 + lane) * 8; \
        _Pragma("unroll") for (int s = 0; s < 4; ++s) fb[s] = *(const GAS bf16x8*)(sp_ + 512 * s); \
        _Pragma("unroll") for (int s = 0; s < 2; ++s) fb[4 + s] = *(const GAS bf16x8*)(up_ + 512 * s); } while (0)
#define A3_LOADA(ch_) do { const int ch__ = (ch_); \
        gq[0] = *(const GAS u32x4*)((const unsigned char*)QGb + (size_t)ch__ * 16384 + tid * 16); gq[1] = *(const GAS u32x4*)((const unsigned char*)QGb + (size_t)ch__ * 16384 + (tid + 512) * 16); \
        gq[2] = *(const GAS u32x4*)((const unsigned char*)AQKb + (size_t)ch__ * 8192 + tid * 16); } while (0)
    if (F.vcu < NCH) { A3_LOADA(F.vcu); A3_LOADB(F.vcu); }
    for (int ch = F.vcu; ch < NCH; ch += F.G) {
        const int n = ch & 63, bh = ch >> 6, h = bh & 3, b = bh >> 2;
        const size_t m = (size_t)b * SEQ + n * 64 + c;
        const size_t zo = ((size_t)(b * 4 + h) * SEQ + n * 64 + c) * 128 + v0;
        const u32x4 z0 = *(const GAS u32x4*)(Z + zo), z1 = *(const GAS u32x4*)(Z + zo + 8);
        { const int r0 = tid >> 4, r1 = (tid + 512) >> 4, r2 = tid >> 3;
          *(LAS u32x4*)(LQ + r0 * 256 + (((tid & 15) ^ (r0 & 15)) << 4)) = gq[0]; *(LAS u32x4*)(LQ + r1 * 256 + (((tid & 15) ^ (r1 & 15)) << 4)) = gq[1];
          *(LAS u32x4*)(LA + r2 * 128 + (((tid & 7) ^ (r2 & 7)) << 4)) = gq[2]; }
        __syncthreads();
        if (ch + F.G < NCH) A3_LOADA(ch + F.G);
        f32x4 acc[4];
#pragma unroll
        for (int mt = 0; mt < 4; ++mt) acc[mt] = (f32x4){0.f, 0.f, 0.f, 0.f};
#pragma unroll
        for (int s = 0; s < 4; ++s) {
            bf16x8 fa[4];
#pragma unroll
            for (int mt = 0; mt < 4; ++mt) fa[mt] = *(const LAS bf16x8*)(LQ + (16 * mt + v16) * 256 + (((4 * s + kg) ^ v16) << 4));
#pragma unroll
            for (int mt = 0; mt < 4; ++mt) acc[mt] = __builtin_amdgcn_mfma_f32_16x16x32_bf16(fa[mt], fb[s], acc[mt], 0, 0, 0); }
#pragma unroll
        for (int s = 0; s < 2; ++s) {
            bf16x8 fa[4];
#pragma unroll
            for (int mt = 0; mt < 4; ++mt) fa[mt] = *(const LAS bf16x8*)(LA + (16 * mt + v16) * 128 + (((4 * s + kg) ^ (v16 & 7)) << 4));
#pragma unroll
            for (int mt = 0; mt < 4; ++mt) acc[mt] = __builtin_amdgcn_mfma_f32_16x16x32_bf16(fa[mt], fb[4 + s], acc[mt], 0, 0, 0); }
        if (ch + F.G < NCH) A3_LOADB(ch + F.G);
        __syncthreads();
#pragma unroll
        for (int mt = 0; mt < 4; ++mt)
#pragma unroll
            for (int rg = 0; rg < 4; ++rg) Ot[(16 * mt + 4 * kg + rg) * 132 + 16 * w + v16] = acc[mt][rg];
        __syncthreads();
        {
            f32x4 o[4]; float ss = 0.f;
#pragma unroll
            for (int q = 0; q < 4; ++q) { o[q] = *(const LAS f32x4*)(Ot + c * 132 + v0 + 4 * q); ss += (o[q].x * o[q].x + o[q].y * o[q].y) + (o[q].z * o[q].z + o[q].w * o[q].w); }
            ss = dpp_add(ss, 0); ss = dpp_add(ss, 1);
            ss += __builtin_bit_cast(float, __builtin_amdgcn_mov_dpp(__builtin_bit_cast(int, ss), 0x141, 0xF, 0xF, false));
            const float rg = rsqrtf(ss * (1.f / 128.f) + EPS);
            u32x4 y0, y1;
#pragma unroll
            for (int q = 0; q < 2; ++q) {
                const f32x4 a = o[q] * rg * gn[q], bq = o[2 + q] * rg * gn[2 + q];
                y0[2 * q] = cvtpk(a.x * fsilu(bflo(z0[2 * q])), a.y * fsilu(bfhi(z0[2 * q]))); y0[2 * q + 1] = cvtpk(a.z * fsilu(bflo(z0[2 * q + 1])), a.w * fsilu(bfhi(z0[2 * q + 1])));
                y1[2 * q] = cvtpk(bq.x * fsilu(bflo(z1[2 * q])), bq.y * fsilu(bfhi(z1[2 * q]))); y1[2 * q + 1] = cvtpk(bq.z * fsilu(bflo(z1[2 * q + 1])), bq.w * fsilu(bfhi(z1[2 * q + 1]))); }
            *(GAS u32x4*)(Y + m * 1024 + h * 128 + v0) = y0; *(GAS u32x4*)(Y + m * 1024 + h * 128 + v0 + 8) = y1;
        }
    }
#undef A3_LOADA
#undef A3_LOADB
}
}

__global__ void __launch_bounds__(NWAVES * 64, 2) mega_fwd(Args args) {
    extern __shared__ __attribute__((aligned(16))) unsigned char lds[];
    Frame F;
    F.lds = (LAS unsigned char*)lds;
    F.MISC = (volatile LAS unsigned*)(F.lds + MISC_OFF);
    F.wave = __builtin_amdgcn_readfirstlane(threadIdx.x >> 6);
    F.G = gridDim.x; { const int bx = blockIdx.x; F.vcu = (F.G % 8 == 0) ? (bx % 8) * (F.G / 8) + bx / 8 : bx; }
    unsigned char* ws = args.ws;
    F.ctl = (gu32*)(ws + WS_CTL);
    for (int u = threadIdx.x; u < (LDS_BYTES - LDSCTL_OFF) / 4; u += NWAVES * 64) ((LAS unsigned*)(F.lds + LDSCTL_OFF))[u] = 0u;
    __syncthreads();
    const int lo = args.ph_lo, hi = args.ph_hi;
    const bool multi = (hi - lo) > 1;
    XcdBarrier bar; bar.bar = (unsigned*)(F.ctl + CW_BAR) + args.li * XCD_BAR_WORDS; bar.x = 0; bar.st = nullptr; bar.wave = F.wave;
    if (multi) bar = xcd_barrier_post((unsigned*)(F.ctl + CW_BAR) + args.li * XCD_BAR_WORDS, F.MISC + 8, F.wave);
#ifndef MK_REP
#define MK_REP -1
#endif
#define REPS(k) (((k) == MK_REP) ? 2 : 1)
#define IN(k) (lo <= (k) && (k) < hi)
#define BOTH(k) (IN(k) && IN((k) + 1))
#define GRID_BAR() do { xcd_barrier(bar); PROF_STAMP(); } while (0)
#if MK_PROF_A >= 0
    if (F.wave == 0 && pg8::lane_now() == 0) { const unsigned long long t_ = __builtin_amdgcn_s_memrealtime(); F.MISC[16] = (unsigned)t_; F.MISC[17] = (unsigned)(t_ >> 32); F.MISC[18] = (unsigned)lo; F.MISC[19] = 0u; F.MISC[20] = 0u; }
#define PROF_STAMP() do { if (F.wave == 0 && pg8::lane_now() == 0) { const unsigned long long t_ = __builtin_amdgcn_s_memrealtime(); \
        const unsigned long long p_ = ((unsigned long long)F.MISC[17] << 32) | F.MISC[16]; const float d_ = (float)(t_ - p_) * 0.01f; const int k_ = (int)F.MISC[18]; \
        if (k_ == MK_PROF_A) F.MISC[19] = __float_as_uint(d_); if (k_ == MK_PROF_B) F.MISC[20] = __float_as_uint(d_); F.MISC[16] = (unsigned)t_; F.MISC[17] = (unsigned)(t_ >> 32); F.MISC[18] = (unsigned)(k_ + 1); } } while (0)
#else
#define PROF_STAMP() do {} while (0)
#endif

#if MK_PROF_A >= 120 && MK_PROF_A < 130
#define PROFM(idx) do { if (blockIdx.x == 0 && F.wave == 0 && pg8::lane_now() == 0) { const unsigned long long t_ = __builtin_amdgcn_s_memrealtime(); \
        const unsigned long long p_ = ((unsigned long long)F.MISC[23] << 32) | F.MISC[22]; if ((idx) >= 0) F.MISC[24 + (idx)] = __float_as_uint(__uint_as_float(F.MISC[24 + (idx)]) + (float)(t_ - p_) * 0.01f); \
        F.MISC[22] = (unsigned)t_; F.MISC[23] = (unsigned)(t_ >> 32); } } while (0)
#else
#define PROFM(idx) do {} while (0)
#endif
    if (IN(0)) { p0_phase(F, ws, args.in[1], args.in[2], args.in[3], args.in[5], args.in[11], args.in[16], args.in[17], args.in[18], args.in[14], args.in[15]);
        asm volatile("s_waitcnt vmcnt(0)" ::: "memory"); __syncthreads();
        if ((int)blockIdx.x < 192 && F.wave == 0 && pg8::lane_now() == 0) { __builtin_amdgcn_fence(__ATOMIC_RELEASE, "agent"); asm volatile("s_waitcnt vmcnt(0)" ::: "memory"); (void)xb_add((unsigned*)(F.ctl + CW_MODF), 1u); }
        PROF_STAMP(); }
    if (IN(1)) { PROFM(-1); p0b_phase(F, ws, args.in[5], args.in[11], args.in[16], args.in[17], args.in[18]); PROFM(2);
        if (F.wave == 0 && pg8::lane_now() == 0) { unsigned* bw_ = (unsigned*)(F.ctl + CW_BAR) + args.li * XCD_BAR_WORDS; const unsigned need_ = (unsigned)(F.G < 192 ? F.G : 192);
            XB_SPIN(xb_ld((unsigned*)(F.ctl + CW_MODF)) < need_, bw_);
            __builtin_amdgcn_fence(__ATOMIC_ACQUIRE, "agent"); asm volatile("s_waitcnt vmcnt(0)" ::: "memory"); }
        __syncthreads(); PROFM(3);
        p1_phase(F, ws, args.in[0], args.in[4], args.in[5], args.in[7], args.in[8]); PROFM(4);
        if (BOTH(1)) GRID_BAR(); }
    if (IN(2)) { for (int rep_ = 0; rep_ < REPS(2); ++rep_) {
        pg8::Gemm g{(const pg8::bf16_t*)(ws + WS_H), (const pg8::bf16_t*)(ws + WS_WIN), T, NPROJ, D};
        pg8::StaticOrder S; S.init(T, NPROJ, F.G, (int)blockIdx.x);
        pg8::EpiProj E{ws, 0.125f * 1.4426950408889634f};
        pg8::gemm_phase<pg8::EpiProj, pg8::StaticOrder, true, true>(F.lds + RING_OFF, g, S, E, F.wave); }
        if (BOTH(2)) GRID_BAR();
    }
    if (IN(3)) { for (int rep_ = 0; rep_ < REPS(3); ++rep_) gdn::a1_phase(F, ws, (unsigned char*)args.out, args.in[6]); if (BOTH(3)) GRID_BAR(); }
    if (IN(4)) { for (int rep_ = 0; rep_ < REPS(4); ++rep_) {
        if ((int)blockIdx.x < 32) {
#if MK_PROF_A >= 200
            unsigned long long ts0_ = __builtin_amdgcn_s_memrealtime();
#endif
            for (int r2_ = 0; r2_ < 1 + MK_REPSCAN; ++r2_) gdn::scan_phase(F, ws, (const unsigned char*)args.out, (int)blockIdx.x);
#if MK_PROF_A >= 200
            if (pg8::lane_now() == 0) atomicMax((unsigned*)(F.ctl + CW_CNT + 71), (unsigned)(__builtin_amdgcn_s_memrealtime() - ts0_));
#endif
        }
#if MK_SERIAL_SCAN
        if ((int)blockIdx.x < 32) { __syncthreads(); if (F.wave == 0 && pg8::lane_now() == 0) (void)xb_add((unsigned*)(F.ctl + CW_MODF + 32), 1u); }
        else { if (F.wave == 0 && pg8::lane_now() == 0) { unsigned* bw_ = (unsigned*)(F.ctl + CW_BAR) + args.li * XCD_BAR_WORDS; XB_SPIN(xb_ld((unsigned*)(F.ctl + CW_MODF + 32)) < 32u, bw_); } __syncthreads(); }
#endif
        attn_phase(F, ws, args.in[12]);
        }
        if (BOTH(4)) GRID_BAR(); }
#if MK_PROF_A >= 200
    if (blockIdx.x == 32 && F.wave == 0 && pg8::lane_now() == 0) { for (int q_ = 0; q_ < 4; ++q_) F.ctl[CW_CNT + 64 + q_] = F.MISC[24 + q_]; }
#endif
    if (IN(5)) { for (int rep_ = 0; rep_ < REPS(5); ++rep_) {
        PROFM(-1);
#if MK_MODE != 2 && MK_MODE != 3
        gdn::a3_phase(F, ws, (const unsigned char*)args.out, args.in[9]);
#endif
        PROFM(0);
        attn_combine_phase(F, ws, args.in[10]); PROFM(1); }
        if (BOTH(5)) GRID_BAR(); }

    if (IN(6)) { for (int rep_ = 0; rep_ < REPS(6); ++rep_) {
        pg8::Gemm g{(const pg8::bf16_t*)(ws + WS_Y), (const pg8::bf16_t*)(ws + WS_WOUT), T, D, D};
        pg8::StaticOrder S; S.init(T, D, F.G, (int)blockIdx.x);
        pg8::EpiRes E{args.in[0], (const float*)(ws + WS_MOD), (pg8::bf16_t*)(ws + WS_XM), 2048};
        pg8::gemm_phase<pg8::EpiRes, pg8::StaticOrder, true, true>(F.lds + RING_OFF, g, S, E, F.wave); }
        if (BOTH(6)) GRID_BAR();
    }
    if (IN(7)) { p5_phase(F, ws, (const bf16*)(ws + WS_XM), args.in[13]); if (BOTH(7)) GRID_BAR(); }
    if (IN(8) || IN(9) || IN(10)) moe_setup(F);
    if (IN(8)) { for (int rep_ = 0; rep_ < REPS(8); ++rep_) {
        pg8::Gemm g{(const pg8::bf16_t*)(ws + WS_H), (const pg8::bf16_t*)(ws + WS_WGU), PROWS, 256, D};
        pg8::MoeOrder<true, 2> S{(const LAS int*)(F.lds + MOE_OFF), (const LAS int*)(F.lds + MOE_OFF) + 33, (const int*)(ws + WS_LTOK), CAP, F.G, F.vcu, (unsigned*)(F.ctl + CW_TCNT), F.wave};
        pg8::EpiHid E{(pg8::bf16_t*)(ws + WS_HID), PROWS * 256 * 2};
        pg8::gemm_phase<pg8::EpiHid, pg8::MoeOrder<true, 2>, true, true>(F.lds + RING_OFF, g, S, E, F.wave); }
        if (BOTH(8)) { __syncthreads(); PROF_STAMP(); }
    }
    if (IN(9)) { for (int rep_ = 0; rep_ < REPS(9); ++rep_) {
        pg8::Gemm g{(const pg8::bf16_t*)(ws + WS_HID), (const pg8::bf16_t*)(ws + WS_WDN), PROWS, D, DEXP};
        pg8::MoeOrder<false, 4> S{(const LAS int*)(F.lds + MOE_OFF), (const LAS int*)(F.lds + MOE_OFF) + 33, (const int*)(ws + WS_LTOK), CAP, F.G, F.vcu, (unsigned*)(F.ctl + CW_TCNT), F.wave};
        pg8::EpiYs E{(pg8::bf16_t*)(ws + WS_YS), (const float*)(ws + WS_LW), (const LAS int*)(F.lds + MOE_OFF) + 33, CAP};
        pg8::gemm_phase<pg8::EpiYs, pg8::MoeOrder<false, 4>, true, true>(F.lds + RING_OFF, g, S, E, F.wave); }
        if (BOTH(9)) GRID_BAR();
    }
    if (IN(10)) { p8_phase(F, ws, args.out, args.in[19]); }
#if MK_PROF_A >= 0
    GRID_BAR();
    if (blockIdx.x == 0) { const int t_ = F.wave * 64 + pg8::lane_now(); if (MK_PROF_A >= 200 && t_ == 0) { for (int q_ = 0; q_ < 4; ++q_) F.MISC[24 + q_] = F.ctl[CW_CNT + 64 + q_]; F.MISC[30] = __float_as_uint((float)F.ctl[CW_CNT + 70] * 0.01f); F.MISC[31] = __float_as_uint((float)F.ctl[CW_CNT + 71] * 0.01f); } __syncthreads();
        const float prof_a = (MK_PROF_A >= 100) ? __uint_as_float(F.MISC[24 + (MK_PROF_A % 10)]) : __uint_as_float(F.MISC[19]), prof_b = (MK_PROF_B >= 100) ? __uint_as_float(F.MISC[24 + (MK_PROF_B % 10)]) : __uint_as_float(F.MISC[20]);
        for (int r = t_; r < T; r += NWAVES * 64) args.out[(size_t)r * D + 1] += prof_b * (1.f / (float)MK_PROF_SB);
        if (t_ == 0) args.out[0] += 10.f + prof_a * (0.01f * (float)MK_PROF_SA); }
#endif
#undef IN
#undef BOTH
}


static int g_grid = 0;
static void launch_mega(Args a, int lo, int hi, int li, hipStream_t stream) {
    a.ph_lo = lo; a.ph_hi = hi; a.li = li;
    void* params[] = {&a};
    hipError_t e = hipLaunchCooperativeKernel((const void*)mega_fwd, dim3(g_grid), dim3(NWAVES * 64), params, LDS_BYTES, stream);
    if (e != hipSuccess) fprintf(stderr, "kernel_launch: cooperative launch [%d,%d) failed: %s (grid %d)\n", lo, hi, hipGetErrorString(e), g_grid);
}

extern "C" void kernel_launch(void* const* d_in, const int* in_sizes, int n_in, void* d_out, int out_size, void* d_ws, size_t ws_size, hipStream_t stream) {
    if (g_grid == 0) {
        if (n_in != 20 || ws_size < WS_NEED || out_size != T * D) { fprintf(stderr, "kernel_launch: unexpected shapes (n_in %d, ws %zu, out %d)\n", n_in, ws_size, out_size); g_grid = -1; return; }
        int dev = 0, cus = 0, per_cu = 0;
        (void)hipGetDevice(&dev); (void)hipDeviceGetAttribute(&cus, hipDeviceAttributeMultiprocessorCount, dev);
        if (hipFuncSetAttribute((const void*)mega_fwd, hipFuncAttributeMaxDynamicSharedMemorySize, LDS_BYTES) != hipSuccess) { fprintf(stderr, "kernel_launch: hipFuncSetAttribute failed\n"); g_grid = -1; return; }
        if (hipOccupancyMaxActiveBlocksPerMultiprocessor(&per_cu, (const void*)mega_fwd, NWAVES * 64, LDS_BYTES) != hipSuccess || per_cu < 1) { fprintf(stderr, "kernel_launch: occupancy query says %d\n", per_cu); per_cu = 1; }
        (void)hipGetLastError();
        g_grid = cus;
        fprintf(stderr, "kernel_launch: cus %d per_cu %d grid %d\n", cus, per_cu, g_grid);
    }
    if (g_grid < 0) return;
    (void)hipMemsetAsync((char*)d_ws + WS_CTL, 0, CTL_ZERO_BYTES, stream);
    Args a{};
    for (int i = 0; i < 20; ++i) a.in[i] = (const float*)d_in[i];
    a.out = (float*)d_out; a.ws = (unsigned char*)d_ws;
#if MK_DEV
#if MK_SPLIT
    launch_mega(a, 0, 1, 0, stream); launch_mega(a, 1, 2, 0, stream); launch_mega(a, 2, 3, 0, stream);
#else
    launch_mega(a, 0, 3, 0, stream);
#endif
#if MK_MODE == 2
    naive_gdn(a, stream); launch_mega(a, 4, 6, 1, stream); naive_yfin_gdn(a, stream); launch_mega(a, 6, 11, 2, stream);
#elif MK_MODE == 5
    launch_mega(a, 3, 4, 1, stream); naive_solve(a, stream); launch_mega(a, 4, 11, 2, stream);
#elif MK_MODE == 4
    launch_mega(a, 3, 4, 1, stream); naive_scan(a, stream); launch_mega(a, 4, 11, 2, stream);
#elif MK_MODE == 3
    launch_mega(a, 3, 6, 1, stream); naive_a3(a, stream); launch_mega(a, 6, 11, 2, stream);
#else
    launch_mega(a, 3, 11, 1, stream);
#endif
#else
    launch_mega(a, 0, 11, 0, stream);
#endif
}
```

```cpp
#define MK_DEV 0
#define MK_SPLIT 0
#define MK_MODE 0
#define MK_A1 0
#define MK_REP -1
#define MK_REPSCAN 0
#define MK_REPATT 0
#define MK_PROF_A -1
#define MK_PROF_B -1
#define MK_ATT_PF 0
#define MK_SERIAL_SCAN 0
#define MK_PROF_SA 25
#define MK_PROF_SB 250
#define MK_PROF_BLK 32
#define MK_PROF_WV 0
#define MK_PROF_EPI 9
#define MK_KROT 1
#define MK_STAGGER 0
#include <hip/hip_runtime.h>
#include <hip/hip_cooperative_groups.h>
#include <cstdio>
#include <cstdint>
#include <cmath>

namespace pg8 {
#define PG8_LAS __attribute__((address_space(3)))
typedef unsigned short bf16_t;
typedef short bf16x8 __attribute__((ext_vector_type(8)));
typedef float f32x4 __attribute__((ext_vector_type(4)));
typedef unsigned u32x4 __attribute__((ext_vector_type(4)));
constexpr int BM = 256, BK = 64, HALF = 128, HTB = HALF * BK * 2  , STAGE_BYTES = 8 * HTB, NXCD = 8, WGM = 8;

__host__ __device__ __forceinline__ int lds_byte(int r, int c) { const int st = (r >> 4) * 2 + (c >> 5), rr = r & 15, cc = c & 31, ob = rr * 64 + cc * 2; return st * 1024 + (ob ^ (((ob >> 9) & 1) << 5)); }
__host__ __device__ __forceinline__ void stage_rc(int b, int& R, int& C) { const int st = b / 1024, sb = b % 1024, swz = sb ^ (((sb >> 9) & 1) << 5); R = (st >> 1) * 16 + swz / 64; C = (st & 1) * 32 + (swz % 64) / 2; }
__host__ __device__ __forceinline__ int perm32(int rho) { const int n = rho >> 4, i = rho & 15; return 8 * (i >> 2) + 4 * n + (i & 3); }

__device__ __forceinline__ int lane_now() { int l; asm volatile("v_mbcnt_lo_u32_b32 %0, -1, 0\n\tv_mbcnt_hi_u32_b32 %0, -1, %0" : "=v"(l)); return l; }
constexpr int GATH_LDS_OFF = 148480;
struct Unit { int pm, pn, pb, e, mt; };
struct Gemm { const bf16_t* A; const bf16_t* Bt; int M, N, K; };

struct StaticOrder {
    int nM, nN, nwg, G, c;
    __host__ __device__ void init(int M, int N, int G_, int c_) { nM = M / BM; nN = N / BM; nwg = nM * nN; G = G_; c = c_; }
    __host__ __device__ bool next(int i, Unit& u) const {
        const long L = (long)i * G + c; if (L >= nwg) return false;
        int wgid = (int)L; { const int q = nwg / NXCD, r = nwg % NXCD, xcd = wgid % NXCD, off = wgid / NXCD; wgid = (xcd < r ? xcd * (q + 1) : r * (q + 1) + (xcd - r) * q) + off; }
        const int nig = WGM * nN, gid = wgid / nig, fm = gid * WGM, gsz = (nM - fm) < WGM ? (nM - fm) : WGM;
        u.pm = fm + ((wgid % nig) % gsz); u.pn = (wgid % nig) / gsz; u.pb = u.pn; u.e = 0; u.mt = 0; return true;
    }
    static constexpr bool GATHER = false;
    __device__ __forceinline__ void a_ready(const Unit&) const {}
    __device__ __forceinline__ void done(const Unit&) const {}
};

__device__ __forceinline__ unsigned cvt_pk_bf16(float lo, float hi) { typedef float f32x2_t_ __attribute__((ext_vector_type(2))); typedef __bf16 bf16x2_t_ __attribute__((ext_vector_type(2))); const f32x2_t_ v_ = {lo, hi}; return __builtin_bit_cast(unsigned, __builtin_convertvector(v_, bf16x2_t_)); }
struct EpiProj {
    static constexpr bool PERM = true, AFTER_DRAIN = false, PROF = (MK_PROF_EPI == 2);
    unsigned char* ws; float qscale;
    __device__ __forceinline__ void operator()(const f32x4 (&acc)[2][2][4][2], const Unit& u, int wr, int wc, int fr, int fq) const {
        { const int ln_ = lane_now(); fr = ln_ & 15; fq = ln_ >> 4; }
        const int pn = u.pn;
        const int t = (pn - 6) >> 1;
        const bool a = pn < 6;
        const size_t off = a ? ((size_t)160 << 20) : (((size_t)256 + 32 * (size_t)t) << 20);
        const bool hm = !a && t >= 1;
        const int colt = a ? pn * 256 : ((pn - 6) & 1) * 256;
        const float sc = (t == 1 && !a) ? qscale : 1.f;
        const int row0 = u.pm * BM + wr * 64 + fr, col0 = colt + wc * 32 + 8 * fq;
        const int rowe = row0 & 4095, bq = row0 >> 12;
        const int ldc = a ? 384 : (hm ? 64 : 128);
        const int hh = hm ? (col0 >> 6) : ((col0 >> 7) & 3), nh = hm ? 8 : 4;
        const size_t cole = (size_t)(bq * nh + hh) * 4096 * ldc + (a ? (size_t)(col0 >> 9) * 128 : (size_t)0) + (size_t)(hm ? (col0 & 63) : (col0 & 127));
        const size_t bjstep = (size_t)(hm ? 2 : 1) * 4096 * ldc;
        bf16_t* base = (bf16_t*)(ws + off);
#pragma unroll
        for (int ai = 0; ai < 2; ++ai)
#pragma unroll
            for (int m = 0; m < 4; ++m) { bf16_t* rowp = base + (size_t)(rowe + ai * HALF + m * 16) * ldc + cole;
#pragma unroll
                for (int bj = 0; bj < 2; ++bj) { const f32x4 v0 = acc[ai][bj][m][0] * sc, v1 = acc[ai][bj][m][1] * sc;
                    u32x4 w; w.x = cvt_pk_bf16(v0[0], v0[1]); w.y = cvt_pk_bf16(v0[2], v0[3]); w.z = cvt_pk_bf16(v1[0], v1[1]); w.w = cvt_pk_bf16(v1[2], v1[3]);
                    *(u32x4*)(rowp + bj * bjstep) = w; } }
    }
};

struct EpiRes {
    static constexpr bool PERM = true, AFTER_DRAIN = false, PROF = (MK_PROF_EPI == 6);
    const float* x; const float* mod; bf16_t* out; int gate_off;
    __device__ __forceinline__ void operator()(const f32x4 (&acc)[2][2][4][2], const Unit& u, int wr, int wc, int fr, int fq) const {
        { const int ln_ = lane_now(); fr = ln_ & 15; fq = ln_ >> 4; }
        const int col0 = u.pn * BM + wc * 32 + 8 * fq, b = (u.pm * BM) >> 12;
#pragma unroll
        for (int bj = 0; bj < 2; ++bj) {
            const f32x4 g0 = *(const f32x4*)(mod + b * 6144 + gate_off + col0 + bj * HALF), g1 = *(const f32x4*)(mod + b * 6144 + gate_off + col0 + bj * HALF + 4);
#pragma unroll
            for (int ai = 0; ai < 2; ++ai) {
                f32x4 xv[4][2];
#pragma unroll
                for (int m = 0; m < 4; ++m) { const size_t off = (size_t)(u.pm * BM + ai * HALF + wr * 64 + m * 16 + fr) * 1024 + col0 + bj * HALF;
                    xv[m][0] = *(const f32x4*)(x + off); xv[m][1] = *(const f32x4*)(x + off + 4); }
#pragma unroll
                for (int m = 0; m < 4; ++m) { const size_t off = (size_t)(u.pm * BM + ai * HALF + wr * 64 + m * 16 + fr) * 1024 + col0 + bj * HALF;
                    const f32x4 v0 = xv[m][0] + g0 * acc[ai][bj][m][0], v1 = xv[m][1] + g1 * acc[ai][bj][m][1];
                    u32x4 w; w.x = cvt_pk_bf16(v0[0], v0[1]); w.y = cvt_pk_bf16(v0[2], v0[3]); w.z = cvt_pk_bf16(v1[0], v1[1]); w.w = cvt_pk_bf16(v1[2], v1[3]);
                    *(u32x4*)(out + off) = w; }
            }
            asm volatile("" ::: "memory"); }
    }
};
__device__ __forceinline__ float silu_f(float v) { return v * __builtin_amdgcn_rcpf(1.f + __builtin_amdgcn_exp2f(-1.4426950408889634f * v)); }
struct EpiHid {
    static constexpr bool PERM = true, AFTER_DRAIN = false, PROF = (MK_PROF_EPI == 8);
    bf16_t* hid; int hid_bytes;
    __device__ __forceinline__ void operator()(const f32x4 (&acc)[2][2][4][2], const Unit& u, int wr, int wc, int fr, int fq) const {
        { const int ln_ = lane_now(); fr = ln_ & 15; fq = ln_ >> 4; }
        const __amdgpu_buffer_rsrc_t rs = __builtin_amdgcn_make_buffer_rsrc((void*)hid, 0, hid_bytes, 0x00020000);
        const int col0 = u.pn * HALF + wc * 32 + 8 * fq;
#pragma unroll
        for (int ai = 0; ai < 2; ++ai)
#pragma unroll
            for (int m = 0; m < 4; ++m) { const size_t row = (size_t)u.pm * BM + ai * HALF + wr * 64 + m * 16 + fr;
                const f32x4 g0 = acc[ai][0][m][0], g1 = acc[ai][0][m][1], u0 = acc[ai][1][m][0], u1 = acc[ai][1][m][1];
                u32x4 w; w.x = cvt_pk_bf16(silu_f(g0[0]) * u0[0], silu_f(g0[1]) * u0[1]); w.y = cvt_pk_bf16(silu_f(g0[2]) * u0[2], silu_f(g0[3]) * u0[3]);
                w.z = cvt_pk_bf16(silu_f(g1[0]) * u1[0], silu_f(g1[1]) * u1[1]); w.w = cvt_pk_bf16(silu_f(g1[2]) * u1[2], silu_f(g1[3]) * u1[3]);
                __builtin_amdgcn_raw_buffer_store_b128(w, rs, (unsigned)((row * 256 + col0) * 2), 0,   16); }
    }
};
struct EpiYs {
    static constexpr bool PERM = true, AFTER_DRAIN = false, PROF = (MK_PROF_EPI == 9);
    bf16_t* ys; const float* lw; const PG8_LAS int* cnt; int cap;
    __device__ __forceinline__ void operator()(const f32x4 (&acc)[2][2][4][2], const Unit& u, int wr, int wc, int fr, int fq) const {
        { const int ln_ = lane_now(); fr = ln_ & 15; fq = ln_ >> 4; }
        const int col0 = u.pn * BM + wc * 32 + 8 * fq, n_e = cnt[u.e];
#pragma unroll
        for (int ai = 0; ai < 2; ++ai) {
            float wv4[4];
#pragma unroll
            for (int m = 0; m < 4; ++m) { const int rl = u.mt * BM + ai * HALF + wr * 64 + m * 16 + fr; wv4[m] = rl < n_e ? lw[(size_t)u.e * cap + rl] : 0.f; }
#pragma unroll
            for (int m = 0; m < 4; ++m) { const float wv = wv4[m];
                bf16_t* rowp = ys + ((size_t)u.pm * BM + ai * HALF + wr * 64 + m * 16 + fr) * 1024 + col0;
#pragma unroll
                for (int bj = 0; bj < 2; ++bj) { const f32x4 v0 = acc[ai][bj][m][0] * wv, v1 = acc[ai][bj][m][1] * wv;
                    u32x4 w; w.x = cvt_pk_bf16(v0[0], v0[1]); w.y = cvt_pk_bf16(v0[2], v0[3]); w.z = cvt_pk_bf16(v1[0], v1[1]); w.w = cvt_pk_bf16(v1[2], v1[3]);
                    *(u32x4*)(rowp + bj * HALF) = w; } }
            asm volatile("" ::: "memory"); }
    }
};
template <bool GATHER_, int NPN> struct MoeOrder {
    static constexpr bool GATHER = GATHER_;
    const PG8_LAS int* tpre; const PG8_LAS int* cnt; const int* ltok; int cap, G, c; unsigned* tcnt; int wave;
    __device__ __forceinline__ bool next(int i, Unit& u) const {
        const int NT = __builtin_amdgcn_readfirstlane(tpre[32]); int L;
        if constexpr (GATHER) { L = i * G + c; }
        else { const int x = (2 * NT) % G, F = G - x;
            if (c >= x) L = i < 2 ? (c - x) + i * F : 2 * F + (i - 2) * G + (c - x);
            else L = 2 * F + i * G + F + c; }
        if (L >= NT * NPN) return false;
        const int tt = L / NPN, pn = L % NPN; int e = 0;
#pragma unroll
        for (int k = 1; k < 32; ++k) e += (tt >= tpre[k]) ? 1 : 0;
        e = __builtin_amdgcn_readfirstlane(e);
        u.pm = tt; u.pn = pn; u.e = e; u.mt = tt - __builtin_amdgcn_readfirstlane(tpre[e]); u.pb = e * NPN + pn; return true;
    }
    __device__ __forceinline__ void avoff(const Unit& u, int tid, int K, unsigned (&v0)[2], unsigned (&v1)[2]) const {
        const int n_e = cnt[u.e];
#pragma unroll
        for (int i = 0; i < 2; ++i) { int R, C; stage_rc(tid * 16 + i * 8192, R, C); const int r0 = u.mt * BM + R, r1 = r0 + HALF;
            const int t0 = ltok[(size_t)u.e * cap + (r0 < n_e ? r0 : 0)], t1 = ltok[(size_t)u.e * cap + (r1 < n_e ? r1 : 0)];
            v0[i] = (unsigned)(t0 * K + C) * 2u; v1[i] = (unsigned)(t1 * K + C) * 2u; }
    }
    __device__ __forceinline__ void a_ready(const Unit& u) const {
        if constexpr (!GATHER) {
            if (wave == 0 && lane_now() == 0) {
                unsigned sp = 0u;
                while (__hip_atomic_load(tcnt + u.pm, __ATOMIC_RELAXED, __HIP_MEMORY_SCOPE_AGENT) < 2u && ++sp < (1u << 22)) __builtin_amdgcn_s_sleep(1);
                __builtin_amdgcn_fence(__ATOMIC_ACQUIRE, "agent"); asm volatile("s_waitcnt vmcnt(0)" ::: "memory"); }
            __builtin_amdgcn_s_barrier();
        }
    }
    __device__ __forceinline__ void done(const Unit& u) const {
        if constexpr (GATHER) {
            asm volatile("s_waitcnt vmcnt(0)" ::: "memory");
            __builtin_amdgcn_s_barrier();
            if (wave == 0 && lane_now() == 0) (void)__hip_atomic_fetch_add(tcnt + u.pm, 1u, __ATOMIC_RELAXED, __HIP_MEMORY_SCOPE_AGENT);
        }
    }
};
template <class Epi, class Sched, bool ALIGN_EPI = false, bool SP2 = false>
__device__ __forceinline__ void gemm_phase(PG8_LAS unsigned char* lds, const Gemm g, const Sched& S, const Epi& E, int wave_sgpr) {
    const int wid = __builtin_amdgcn_readfirstlane(wave_sgpr), lane = lane_now(), tid = wid * 64 + lane, wr = wid >> 2, wc = wid & 3, fr = lane & 15, fq = lane >> 4;
    const int K = g.K, nt = K / BK;
    const int skew = MK_KROT ? (((int)blockIdx.x >> 3) & (nt - 1)) : 0;
#define PG8_KOFF(t_) ((size_t)(((t_) + skew) & (nt - 1)) * kstep)
    unsigned voffA[2], voffB[2];
#pragma unroll
    for (int i = 0; i < 2; ++i) { int R, C; stage_rc(tid * 16 + i * 8192, R, C); const int Rb = Epi::PERM ? ((R & ~31) + perm32(R & 31)) : R;
        voffA[i] = (unsigned)(R * K + C) * 2u; voffB[i] = (unsigned)(Rb * K + C) * 2u; }
    const size_t kstep = (size_t)(BK * 2);
    const size_t hstep = (size_t)HALF * K * 2;
    const size_t tstep = 2 * hstep;
    const unsigned ldsw = (unsigned)wid * 1024u;
    const int aoff = lds_byte(wr * 64 + fr, fq * 8), boff = lds_byte(wc * 32 + fr, fq * 8);
#define PG8_SA(b, h) (((b) * 2 + (h)) * HTB)
#define PG8_SB(b, h) ((4 + (b) * 2 + (h)) * HTB)
#define PG8_STAGE(bufoff, gbase, voff) do { _Pragma("unroll") for (int _i = 0; _i < 2; ++_i) \
        __builtin_amdgcn_global_load_lds((const unsigned*)((const char*)(gbase) + (voff)[_i]), (PG8_LAS unsigned*)(lds + (bufoff) + ldsw + _i * 8192), 16, 0, 0); } while (0)
#define PG8_STAGE_A(bufoff, kptr, h, nxtsel) do { if constexpr (Sched::GATHER) { unsigned _v[2]; _v[0] = cv##h[0]; _v[1] = cv##h[1]; \
            if (nxtsel) { const u32x4 _p = *(const PG8_LAS u32x4*)(lds + GATH_LDS_OFF + tid * 16); _v[0] = (h) ? _p.z : _p.x; _v[1] = (h) ? _p.w : _p.y; } PG8_STAGE(bufoff, kptr, _v); } \
        else { PG8_STAGE(bufoff, (kptr) + (h) * hstep, voffA); } } while (0)
#define PG8_LDA(dst, b, h) do { _Pragma("unroll") for (int m = 0; m < 4; ++m) _Pragma("unroll") for (int k = 0; k < 2; ++k) dst[m][k] = *(const PG8_LAS bf16x8*)(lds + PG8_SA(b, h) + aoff + m * 2048 + k * 1024); } while (0)
#define PG8_LDB(dst, b, h) do { _Pragma("unroll") for (int n = 0; n < 2; ++n) _Pragma("unroll") for (int k = 0; k < 2; ++k) dst[n][k] = *(const PG8_LAS bf16x8*)(lds + PG8_SB(b, h) + boff + n * 2048 + k * 1024); } while (0)
#define PG8_MMA(ai, bj, At, Bt) do { __builtin_amdgcn_s_setprio(1); _Pragma("unroll") for (int m = 0; m < 4; ++m) _Pragma("unroll") for (int n = 0; n < 2; ++n) _Pragma("unroll") for (int k = 0; k < 2; ++k) \
        acc[ai][bj][m][n] = __builtin_amdgcn_mfma_f32_16x16x32_bf16(Bt[n][k], At[m][k], acc[ai][bj][m][n], 0, 0, 0); __builtin_amdgcn_s_setprio(0); } while (0)
#define PG8_WAIT_V(n) asm volatile("s_waitcnt vmcnt(" #n ")" ::: "memory")
#if MK_PROF_A >= 130 && MK_PROF_A < 140
#define PG8_PROF(idx) do { if constexpr (Epi::PROF) { if (blockIdx.x == MK_PROF_BLK && wid == 0 && lane_now() == 0) { volatile PG8_LAS unsigned* ms_ = (volatile PG8_LAS unsigned*)(lds + 147456 + 320); const unsigned long long t_ = __builtin_amdgcn_s_memrealtime(); \
        const unsigned long long p_ = ((unsigned long long)ms_[23] << 32) | ms_[22]; if ((idx) >= 0) ms_[24 + (idx)] = __float_as_uint(__uint_as_float(ms_[24 + (idx)]) + (float)(t_ - p_) * 0.01f); \
        ms_[22] = (unsigned)t_; ms_[23] = (unsigned)(t_ >> 32); } } } while (0)
#else
#define PG8_PROF(idx) do {} while (0)
#endif
#define PG8_WAIT_L(n) asm volatile("s_waitcnt lgkmcnt(" #n ")" ::: "memory")
#define PG8_BAR __builtin_amdgcn_s_barrier()
#define PG8_SCHED __builtin_amdgcn_sched_barrier(0)
    Unit cur, nxt; int ui = 0;
    if (!S.next(0, cur)) return;
    f32x4 acc[2][2][4][2];
#pragma unroll
    for (int a = 0; a < 2; ++a)
#pragma unroll
        for (int b = 0; b < 2; ++b)
#pragma unroll
            for (int m = 0; m < 4; ++m)
#pragma unroll
                for (int n = 0; n < 2; ++n) acc[a][b][m][n] = (f32x4){0.f, 0.f, 0.f, 0.f};
    bf16x8 At[4][2], B0[2][2], B1[2][2];
    const char* cA = (const char*)g.A + (Sched::GATHER ? (size_t)0 : (size_t)cur.pm * tstep); const char* cB = (const char*)g.Bt + (size_t)cur.pb * tstep;
    unsigned cv0[2] = {0u, 0u}, cv1[2] = {0u, 0u};
    if constexpr (Sched::GATHER) S.avoff(cur, tid, K, cv0, cv1);
    S.a_ready(cur);
    if constexpr (SP2) {
        PG8_STAGE(PG8_SB(0, 0), cB + PG8_KOFF(0), voffB); PG8_STAGE(PG8_SB(0, 1), cB + hstep + PG8_KOFF(0), voffB); PG8_STAGE_A(PG8_SA(0, 0), cA + PG8_KOFF(0), 0, false); PG8_STAGE_A(PG8_SA(0, 1), cA + PG8_KOFF(0), 1, false);
        if (wr == 1) PG8_BAR;
        PG8_WAIT_V(2); PG8_BAR;
        PG8_STAGE(PG8_SB(1, 0), cB + PG8_KOFF(1), voffB); PG8_STAGE_A(PG8_SA(1, 0), cA + PG8_KOFF(1), 0, false); PG8_STAGE(PG8_SB(1, 1), cB + hstep + PG8_KOFF(1), voffB);
        PG8_WAIT_V(6); PG8_BAR;
    } else {
        PG8_STAGE(PG8_SB(0, 0), cB + PG8_KOFF(0), voffB); PG8_STAGE_A(PG8_SA(0, 0), cA + PG8_KOFF(0), 0, false); PG8_STAGE(PG8_SB(0, 1), cB + hstep + PG8_KOFF(0), voffB); PG8_STAGE_A(PG8_SA(0, 1), cA + PG8_KOFF(0), 1, false);
        if (wr == 1) PG8_BAR;
        PG8_WAIT_V(4); PG8_BAR;
        PG8_STAGE(PG8_SB(1, 0), cB + PG8_KOFF(1), voffB); PG8_STAGE_A(PG8_SA(1, 0), cA + PG8_KOFF(1), 0, false); PG8_STAGE(PG8_SB(1, 1), cB + hstep + PG8_KOFF(1), voffB);
        PG8_WAIT_V(6); PG8_BAR;
    }
    for (;;) {
        PG8_PROF(-1);
        const bool has_next = S.next(ui + 1, nxt);
        if (has_next) S.a_ready(nxt);
        const char* nA = has_next ? (const char*)g.A + (Sched::GATHER ? (size_t)0 : (size_t)nxt.pm * tstep) : cA; const char* nB = has_next ? (const char*)g.Bt + (size_t)nxt.pb * tstep : cB;
        if constexpr (Sched::GATHER) { unsigned nv0[2], nv1[2];
            if (has_next) S.avoff(nxt, tid, K, nv0, nv1); else { nv0[0] = cv0[0]; nv0[1] = cv0[1]; nv1[0] = cv1[0]; nv1[1] = cv1[1]; }
            *(PG8_LAS u32x4*)(lds + GATH_LDS_OFF + tid * 16) = (u32x4){nv0[0], nv0[1], nv1[0], nv1[1]}; }
        PG8_PROF(0);
        for (int t = 0; t < nt; t += 2) {
            const bool last = (t == nt - 2);
            const char* a1 = cA + PG8_KOFF(t + 1);
            const char* a2 = (last ? nA : cA) + PG8_KOFF(t + 2); const char* b2 = (last ? nB : cB) + PG8_KOFF(t + 2);
            const char* a3 = (last ? nA : cA) + PG8_KOFF(t + 3); const char* b3 = (last ? nB : cB) + PG8_KOFF(t + 3);
            if constexpr (SP2) {
            PG8_LDB(B0, 0, 0); PG8_LDB(B1, 0, 1); PG8_SCHED; PG8_LDA(At, 0, 0); PG8_STAGE_A(PG8_SA(1, 1), a1, 1, false);
            PG8_WAIT_V(8); PG8_WAIT_L(0); PG8_BAR; PG8_MMA(0, 0, At, B0); PG8_MMA(0, 1, At, B1); PG8_BAR; PG8_SCHED;
            PG8_LDA(At, 0, 1); PG8_STAGE(PG8_SB(0, 0), b2, voffB); PG8_STAGE(PG8_SB(0, 1), b2 + hstep, voffB); PG8_STAGE_A(PG8_SA(0, 0), a2, 0, last);
            PG8_WAIT_V(8); PG8_WAIT_L(0); PG8_BAR; PG8_MMA(1, 0, At, B0); PG8_MMA(1, 1, At, B1); PG8_BAR; PG8_SCHED;
            PG8_LDB(B0, 1, 0); PG8_LDB(B1, 1, 1); PG8_SCHED; PG8_LDA(At, 1, 0); PG8_STAGE_A(PG8_SA(0, 1), a2, 1, last);
            PG8_WAIT_V(8); PG8_WAIT_L(0); PG8_BAR; PG8_MMA(0, 0, At, B0); PG8_MMA(0, 1, At, B1); PG8_BAR; PG8_SCHED;
            PG8_LDA(At, 1, 1); PG8_STAGE(PG8_SB(1, 0), b3, voffB); PG8_STAGE(PG8_SB(1, 1), b3 + hstep, voffB); PG8_STAGE_A(PG8_SA(1, 0), a3, 0, last);
            PG8_WAIT_V(8); PG8_WAIT_L(0); PG8_BAR; PG8_MMA(1, 0, At, B0); PG8_MMA(1, 1, At, B1); PG8_BAR; PG8_SCHED;
            } else {
            PG8_LDB(B0, 0, 0); PG8_SCHED; PG8_LDA(At, 0, 0); PG8_STAGE_A(PG8_SA(1, 1), a1, 1, false);
            PG8_WAIT_L(8); PG8_BAR; PG8_WAIT_L(0); PG8_MMA(0, 0, At, B0); PG8_BAR; PG8_SCHED;
            PG8_LDB(B1, 0, 1); PG8_STAGE(PG8_SB(0, 0), b2, voffB);
            PG8_BAR; PG8_WAIT_L(0); PG8_MMA(0, 1, At, B1); PG8_BAR;
            PG8_LDA(At, 0, 1); PG8_STAGE_A(PG8_SA(0, 0), a2, 0, last);
            PG8_BAR; PG8_WAIT_L(0); PG8_MMA(1, 0, At, B0); PG8_BAR; PG8_SCHED;
            PG8_STAGE(PG8_SB(0, 1), b2 + hstep, voffB);
            PG8_WAIT_V(6); PG8_BAR; PG8_MMA(1, 1, At, B1); PG8_BAR;
            PG8_LDB(B0, 1, 0); PG8_SCHED; PG8_LDA(At, 1, 0); PG8_STAGE_A(PG8_SA(0, 1), a2, 1, last);
            PG8_WAIT_L(8); PG8_BAR; PG8_WAIT_L(0); PG8_MMA(0, 0, At, B0); PG8_BAR; PG8_SCHED;
            PG8_LDB(B1, 1, 1); PG8_STAGE(PG8_SB(1, 0), b3, voffB);
            PG8_BAR; PG8_WAIT_L(0); PG8_MMA(0, 1, At, B1); PG8_BAR;
            PG8_LDA(At, 1, 1); PG8_STAGE_A(PG8_SA(1, 0), a3, 0, last);
            PG8_BAR; PG8_WAIT_L(0); PG8_MMA(1, 0, At, B0); PG8_BAR; PG8_SCHED;
            PG8_STAGE(PG8_SB(1, 1), b3 + hstep, voffB);
            PG8_WAIT_V(6); PG8_BAR; PG8_MMA(1, 1, At, B1); PG8_BAR;
            }
        }
        PG8_PROF(1);
        if constexpr (ALIGN_EPI) { if (wr == 0) PG8_BAR; }
        if constexpr (!Epi::AFTER_DRAIN) { E(acc, cur, wr, wc, fr, fq); S.done(cur); }
        PG8_PROF(2);
        if (!has_next) break;
#pragma unroll
        for (int a = 0; a < 2; ++a)
#pragma unroll
            for (int b = 0; b < 2; ++b)
#pragma unroll
                for (int m = 0; m < 4; ++m)
#pragma unroll
                    for (int n = 0; n < 2; ++n) acc[a][b][m][n] = (f32x4){0.f, 0.f, 0.f, 0.f};
        cur = nxt; cA = nA; cB = nB; ++ui; if constexpr (Sched::GATHER) { const u32x4 _p = *(const PG8_LAS u32x4*)(lds + GATH_LDS_OFF + tid * 16); cv0[0] = _p.x; cv0[1] = _p.y; cv1[0] = _p.z; cv1[1] = _p.w; }
        if constexpr (ALIGN_EPI) { if (wr == 1) PG8_BAR; }
    }
    PG8_WAIT_V(0);
    if constexpr (!ALIGN_EPI) { if (wr == 0) PG8_BAR; }
    PG8_BAR;
    if constexpr (Epi::AFTER_DRAIN) { E.fused(acc, cur, wr, wc, fr, fq, lds, wid, lane); S.done(cur); }
#undef PG8_KOFF
#undef PG8_PROF
#undef PG8_SA
#undef PG8_SB
#undef PG8_STAGE
#undef PG8_STAGE_A
#undef PG8_LDA
#undef PG8_LDB
#undef PG8_MMA
#undef PG8_WAIT_V
#undef PG8_WAIT_L
#undef PG8_BAR
#undef PG8_SCHED
}
}

constexpr int NWAVES = 8;
constexpr int D = 1024, BATCH = 8, SEQ = 4096, T = BATCH * SEQ;
constexpr int IN_COLS = 3592, NPROJ = 3584, NEXP = 32, DEXP = 256, CAP = 65536;
constexpr float EPS = 1e-6f;
constexpr size_t MiB = 1u << 20;
constexpr size_t WS_CTL = 0, CTL_ZERO_BYTES = 1 * MiB;
constexpr size_t WS_MOD = 1 * MiB;
constexpr size_t WS_BG = 2 * MiB;
constexpr size_t WS_TOKSLOT = 3 * MiB;
constexpr size_t WS_WRT = 6 * MiB;
constexpr size_t WS_WIN = 8 * MiB;
constexpr size_t WS_WOUT = 15 * MiB;
constexpr size_t WS_WGU = 32 * MiB;
constexpr size_t WS_WDN = 64 * MiB;
constexpr size_t WS_LTOK = 80 * MiB;
constexpr size_t WS_LW = 88 * MiB;
constexpr size_t WS_H = 96 * MiB;
constexpr size_t WS_QKVA = 160 * MiB;
constexpr size_t WS_Z = 256 * MiB;
constexpr size_t WS_QB = 288 * MiB, WS_KB = 320 * MiB, WS_VB = 352 * MiB;
constexpr size_t WS_Y = 384 * MiB;
constexpr int PROWS = 65536 + 32 * 256;
constexpr size_t WS_HID = 448 * MiB;
constexpr size_t WS_YS = 160 * MiB;
constexpr size_t WS_PART0 = 96 * MiB, WS_PART1 = 128 * MiB, WS_PART2 = 448 * MiB;
constexpr size_t WS_LSE = 480 * MiB;
constexpr size_t WS_GAQK = 484 * MiB;
constexpr size_t WS_GGL = 500 * MiB;
constexpr size_t WS_XM = 320 * MiB;
constexpr size_t WS_NEED = 512 * MiB;
static_assert(WS_QKVA == (size_t)160 << 20 && WS_Z == (size_t)256 << 20 && WS_QB == (size_t)288 << 20 && WS_KB == (size_t)320 << 20 && WS_VB == (size_t)352 << 20, "EpiProj offsets");
constexpr int CW_MODF = 992;
constexpr int CW_ATTQ = 2048;
constexpr int CW_TCNT = 2560;
constexpr int CW_CNT = 1024;
constexpr int CW_BAR = 4096;

constexpr int RING_OFF = 0, RING_BYTES = 131072;
constexpr int PHASE_LDS = 147456;
constexpr int LDSCTL_OFF = PHASE_LDS, MISC_OFF = LDSCTL_OFF + 320, MOE_OFF = MISC_OFF + 128;
constexpr int LDS_BYTES = 163840;
static_assert(RING_OFF == 0 && MOE_OFF + 512 <= pg8::GATH_LDS_OFF && pg8::GATH_LDS_OFF + 8192 <= LDS_BYTES, "LDS map");

#define GAS __attribute__((address_space(1)))
#define LAS __attribute__((address_space(3)))
typedef unsigned short bf16;
typedef unsigned v4u __attribute__((ext_vector_type(4)));
typedef float f32x4 __attribute__((ext_vector_type(4)));
typedef short bf16x8 __attribute__((ext_vector_type(8)));
typedef GAS unsigned gu32;
typedef GAS unsigned long long gu64;
#define RLX_AGENT __ATOMIC_RELAXED, __HIP_MEMORY_SCOPE_AGENT
#define LDS_WAIT() asm volatile("s_waitcnt lgkmcnt(0)" ::: "memory")
#define VM_WAIT() asm volatile("s_waitcnt vmcnt(0)" ::: "memory")
__device__ __forceinline__ unsigned long long rt() { return __builtin_amdgcn_s_memrealtime(); }
__device__ __forceinline__ unsigned pk2(float lo, float hi) { typedef float f32x2_t_ __attribute__((ext_vector_type(2))); typedef __bf16 bf16x2_t_ __attribute__((ext_vector_type(2))); const f32x2_t_ v_ = {lo, hi}; return __builtin_bit_cast(unsigned, __builtin_convertvector(v_, bf16x2_t_)); }
__device__ __forceinline__ unsigned f2bf(float f) { return pk2(f, f) & 0xFFFFu; }

#define XB_TMO      128
#define XB_XCNT(j)  (256  + 64 * (j))
#define XB_XSUB(j)  (1280 + 64 * (j))
#define XB_XGEN(j)  (2304 + 64 * (j))
#define XB_TOP      3328
#define XB_TOPGEN   3392
#define XCD_BAR_WORDS 3456
#define XB_SPIN_CAP (1u << 18)

__device__ __forceinline__ unsigned xb_ld(unsigned* p)              { return __hip_atomic_load(p, __ATOMIC_RELAXED, __HIP_MEMORY_SCOPE_AGENT); }
__device__ __forceinline__ unsigned xb_add(unsigned* p, unsigned v) { return __hip_atomic_fetch_add(p, v, __ATOMIC_RELAXED, __HIP_MEMORY_SCOPE_AGENT); }
__device__ __forceinline__ unsigned xb_xcc_id() { return (unsigned)__builtin_amdgcn_s_getreg((3 << 11) | 20) & 0xFu; }
#define XB_SPIN(cond, bar) do { unsigned _sp = 0; while (cond) { __builtin_amdgcn_s_sleep(1); \
    if ((++_sp & 255u) == 0u) { if (xb_ld(&(bar)[XB_TMO])) break; if (_sp > XB_SPIN_CAP) { atomicAdd(&(bar)[XB_TMO], 1u); break; } } } } while (0)

struct XcdBarrier {
    unsigned* bar; unsigned x; int wave;
    volatile LAS unsigned* st;
};

__device__ __forceinline__ XcdBarrier xcd_barrier_post(unsigned* bar, volatile LAS unsigned* st, int wave) {
    XcdBarrier b; b.bar = bar; b.x = xb_xcc_id(); b.st = st; b.wave = wave;
    if (wave == 0 && pg8::lane_now() == 0) (void)xb_add(&bar[XB_XCNT(b.x)], 1u);
    return b;
}
__device__ __forceinline__ void xcd_barrier_complete(unsigned* bar, unsigned x, unsigned& nloc, unsigned& nx) {
    const unsigned G = gridDim.x * gridDim.y * gridDim.z;
    unsigned sum, cnt, mine, sp = 0u;
    for (;;) {
        sum = 0u; cnt = 0u; mine = 0u;
#pragma unroll
        for (unsigned j = 0; j < 16; ++j) { const unsigned c = xb_ld(&bar[XB_XCNT(j)]); sum += c; cnt += (c > 0u) ? 1u : 0u; mine = (j == x) ? c : mine; }
        if (sum == G) break;
        __builtin_amdgcn_s_sleep(1);
        if ((++sp & 255u) == 0u) { if (xb_ld(&bar[XB_TMO])) break; if (sp > XB_SPIN_CAP) { atomicAdd(&bar[XB_TMO], 1u); break; } }
    }
    nloc = mine > 0u ? mine : 1u; nx = cnt > 0u ? cnt : 1u;
}

__device__ __forceinline__ void xcd_barrier(const XcdBarrier& b) {
    asm volatile("s_waitcnt vmcnt(0)" ::: "memory");
    __syncthreads();
    if (b.wave == 0 && pg8::lane_now() == 0) {
        unsigned* bar = b.bar;
        __builtin_amdgcn_s_waitcnt(0);
        unsigned nloc = b.st[0], nx = b.st[1];
        if (nloc == 0u) { xcd_barrier_complete(bar, b.x, nloc, nx); b.st[0] = nloc; b.st[1] = nx; }
        const unsigned old = xb_add(&bar[XB_XSUB(b.x)], 1u);
        const unsigned gen = old / nloc;
        if (old + 1u == (gen + 1u) * nloc) {
            __builtin_amdgcn_fence(__ATOMIC_RELEASE, "agent");
            asm volatile("s_waitcnt vmcnt(0)" ::: "memory");
            const unsigned og = xb_add(&bar[XB_TOP], 1u);
            const unsigned tg = og / nx;
            if (og + 1u == (tg + 1u) * nx) xb_add(&bar[XB_TOPGEN], 1u);
            else XB_SPIN(xb_ld(&bar[XB_TOPGEN]) == tg, bar);
            __builtin_amdgcn_fence(__ATOMIC_ACQUIRE, "agent");
            xb_add(&bar[XB_XGEN(b.x)], 1u);
            asm volatile("s_waitcnt vmcnt(0)" ::: "memory");
        } else {
            XB_SPIN(xb_ld(&bar[XB_XGEN(b.x)]) == gen, bar);
            __builtin_amdgcn_fence(__ATOMIC_ACQUIRE, "agent");
            asm volatile("s_waitcnt vmcnt(0)" ::: "memory");
        }
    }
    __syncthreads();
}

__device__ __forceinline__ float dpp_add(float v, const int ctrl_sel) {
    int r;
    if (ctrl_sel == 0) r = __builtin_amdgcn_mov_dpp(__builtin_bit_cast(int, v), 0xB1, 0xF, 0xF, false);
    else if (ctrl_sel == 1) r = __builtin_amdgcn_mov_dpp(__builtin_bit_cast(int, v), 0x4E, 0xF, 0xF, false);
    else if (ctrl_sel == 2) r = __builtin_amdgcn_mov_dpp(__builtin_bit_cast(int, v), 0x124, 0xF, 0xF, false);
    else r = __builtin_amdgcn_mov_dpp(__builtin_bit_cast(int, v), 0x128, 0xF, 0xF, false);
    return v + __builtin_bit_cast(float, r);
}
__device__ __forceinline__ float row16_sum(float v) { v = dpp_add(v, 0); v = dpp_add(v, 1); v = dpp_add(v, 2); v = dpp_add(v, 3); return v; }
__device__ __forceinline__ float wave_sum(float v) {
    v = row16_sum(v);
    v += __shfl_xor(v, 16);
    v += __shfl_xor(v, 32);
    return v;
}
__device__ __forceinline__ void p0_transpose_item(const float* W, int K, int N, bf16* WT, int row_off, LAS float* scr, int item, int lane) {
    const int nblk = N / 32, kb = item / nblk, nb = item % nblk, k0 = 64 * kb, n0 = 32 * nb;
#pragma unroll 8
    for (int i = 0; i < 32; ++i) { const int kk = 2 * i + (lane >> 5); scr[kk * 33 + (lane & 31)] = W[(size_t)(k0 + kk) * N + n0 + (lane & 31)]; }
    LDS_WAIT(); asm volatile("" ::: "memory");
    const int c = lane & 7;
#pragma unroll
    for (int j = 0; j < 4; ++j) { const int n = (lane >> 3) + 8 * j; const LAS float* s = scr + (8 * c) * 33 + n;
        v4u o; o.x = pk2(s[0 * 33], s[1 * 33]); o.y = pk2(s[2 * 33], s[3 * 33]); o.z = pk2(s[4 * 33], s[5 * 33]); o.w = pk2(s[6 * 33], s[7 * 33]);
        *(GAS v4u*)(WT + (size_t)(row_off + n0 + n) * K + k0 + 8 * c) = o; }
    LDS_WAIT(); asm volatile("" ::: "memory");
}

__device__ __forceinline__ float bf2f(bf16 v) { return __uint_as_float((unsigned)v << 16); }
__device__ __forceinline__ float siluf(float x) { return x / (1.f + __expf(-x)); }
__device__ __forceinline__ float sigmoidf(float x) { return 1.f / (1.f + __expf(-x)); }

struct Args { const float* in[20]; float* out; unsigned char* ws; int ph_lo, ph_hi, li, pad; };

struct Frame {
    LAS unsigned char* lds; volatile LAS unsigned* MISC; gu32* ctl;
    int wave, vcu, G;
};

__device__ __forceinline__ void transpose_item(const float* W, int K, int pitch, int ncols, bf16* WT, int row_off, LAS float* scr, int item, int lane) {
    const int nblk = ncols / 32, kb = item / nblk, nb = item % nblk, k0 = 64 * kb, n0 = 32 * nb;
#pragma unroll 8
    for (int i = 0; i < 32; ++i) { const int kk = 2 * i + (lane >> 5); scr[kk * 33 + (lane & 31)] = W[(size_t)(k0 + kk) * pitch + n0 + (lane & 31)]; }
    LDS_WAIT(); asm volatile("" ::: "memory");
    const int c = lane & 7;
#pragma unroll
    for (int j = 0; j < 4; ++j) { const int n = (lane >> 3) + 8 * j; const LAS float* s = scr + (8 * c) * 33 + n;
        v4u o; o.x = pk2(s[0 * 33], s[1 * 33]); o.y = pk2(s[2 * 33], s[3 * 33]); o.z = pk2(s[4 * 33], s[5 * 33]); o.w = pk2(s[6 * 33], s[7 * 33]);
        *(GAS v4u*)(WT + (size_t)(row_off + n0 + n) * K + k0 + 8 * c) = o; }
    LDS_WAIT(); asm volatile("" ::: "memory");
}

__device__ __forceinline__ void p0_phase(Frame& F, unsigned char* ws, const float* c, const float* w_ada, const float* b_ada, const float* w_in, const float* w_out, const float* w_gate, const float* w_up, const float* w_down, const float* w_rg, const float* w_re) {
    const int lane_ = pg8::lane_now(), tid_ = F.wave * 64 + lane_;
    float* mod = (float*)(ws + WS_MOD);
    if ((int)blockIdx.x < 192) {
        LAS float* cs = (LAS float*)(F.lds + RING_OFF);
        LAS float* red = cs + 8192;
        float wa[32], wb[32];
        { const int col = tid_ & 31, kq = tid_ >> 5, n = (int)blockIdx.x * 32 + col;
#pragma unroll
          for (int k = 0; k < 32; ++k) wa[k] = w_ada[(size_t)(kq * 64 + k) * 6144 + n];
#pragma unroll
          for (int k = 0; k < 32; ++k) wb[k] = w_ada[(size_t)(kq * 64 + 32 + k) * 6144 + n]; }
        for (int i = tid_; i < 8192; i += NWAVES * 64) cs[i] = c[i];
        __syncthreads();
        for (int item = blockIdx.x; item < 192; item += F.G) {
            const int col = tid_ & 31, kq = tid_ >> 5, n = item * 32 + col;
            float acc[8];
#pragma unroll
            for (int b = 0; b < 8; ++b) acc[b] = 0.f;
            if (item != (int)blockIdx.x) {
#pragma unroll
                for (int k = 0; k < 32; ++k) wa[k] = w_ada[(size_t)(kq * 64 + k) * 6144 + n];
#pragma unroll
                for (int k = 0; k < 32; ++k) wb[k] = w_ada[(size_t)(kq * 64 + 32 + k) * 6144 + n]; }
#pragma unroll
            for (int k = 0; k < 32; ++k) {
#pragma unroll
                for (int b = 0; b < 8; ++b) acc[b] += cs[b * D + kq * 64 + k] * wa[k]; }
#pragma unroll
            for (int k = 0; k < 32; ++k) {
#pragma unroll
                for (int b = 0; b < 8; ++b) acc[b] += cs[b * D + kq * 64 + 32 + k] * wb[k]; }
#pragma unroll
            for (int b = 0; b < 8; ++b) red[(kq * 8 + b) * 32 + col] = acc[b];
            __syncthreads();
            if (tid_ < 256) { const int b = tid_ >> 5; float s = 0.f;
#pragma unroll
              for (int q = 0; q < 16; ++q) s += red[(q * 8 + b) * 32 + col];
              mod[b * 6144 + n] = s + b_ada[n]; }
            __syncthreads();
        }
    }
    { bf16* wrt = (bf16*)(ws + WS_WRT);
      for (int i = blockIdx.x * (NWAVES * 64) + tid_; i < 48 * 1024; i += F.G * NWAVES * 64) { const int e = i >> 10, k = i & 1023;
          const float v = e < 4 ? w_rg[k * 4 + e] : (e < 36 ? w_re[k * 32 + e - 4] : 0.f); wrt[i] = (bf16)f2bf(v); } }
}
__device__ __forceinline__ void p0b_phase(Frame& F, unsigned char* ws, const float* w_in, const float* w_out, const float* w_gate, const float* w_up, const float* w_down) {
    const int lane_ = pg8::lane_now();
    LAS float* scr = (LAS float*)(F.lds + RING_OFF + F.wave * 16384);
    const int gw = F.vcu * NWAVES + F.wave, NGW = F.G * NWAVES;
    bf16* win_t = (bf16*)(ws + WS_WIN); bf16* wout_t = (bf16*)(ws + WS_WOUT); bf16* wgu_t = (bf16*)(ws + WS_WGU); bf16* wdn_t = (bf16*)(ws + WS_WDN);
    constexpr int I_A = 16 * 64, I_B = 16 * 48, I_C = 16 * 32, I_D = 32 * 256, I_E = 32 * 128, I_ALL = I_A + I_B + I_C + I_D + I_E;
#define P0_DECODE(it_, W_, K_, pitch_, ncols_, WT_, roff_, li_) do { int r = (it_); \
        if (r < I_A) { W_ = w_in; K_ = D; pitch_ = IN_COLS; ncols_ = 2048; WT_ = win_t; roff_ = 0; li_ = r; } \
        else if ((r -= I_A) < I_B) { W_ = w_in + 2056; K_ = D; pitch_ = IN_COLS; ncols_ = 1536; WT_ = win_t; roff_ = 2048; li_ = r; } \
        else if ((r -= I_B) < I_C) { W_ = w_out; K_ = D; pitch_ = D; ncols_ = D; WT_ = wout_t; roff_ = 0; li_ = r; } \
        else if ((r -= I_C) < I_D) { const int e = r >> 8, q = r & 255, piece = q >> 6; \
            W_ = (piece < 2 ? w_gate : w_up) + (size_t)e * D * DEXP + (piece & 1) * 128; K_ = D; pitch_ = DEXP; ncols_ = 128; WT_ = wgu_t + (size_t)e * 512 * D; roff_ = (piece & 1) * 256 + (piece >> 1) * 128; li_ = q & 63; } \
        else { r -= I_D; const int e = r >> 7; W_ = w_down + (size_t)e * DEXP * D; K_ = DEXP; pitch_ = D; ncols_ = D; WT_ = wdn_t + (size_t)e * D * DEXP; roff_ = 0; li_ = r & 127; } } while (0)
#define P0_LOAD(dst, W_, pitch_, ncols_, li_) do { const int nblk_ = (ncols_) / 32, k0_ = 64 * ((li_) / nblk_), n0_ = 32 * ((li_) % nblk_); \
        _Pragma("unroll") for (int i = 0; i < 32; ++i) dst[i] = (W_)[(size_t)(k0_ + 2 * i + (lane_ >> 5)) * (pitch_) + n0_ + (lane_ & 31)]; } while (0)
    float tv[32];
    const float* cW = nullptr; int cK = 0, cP = 0, cN = 32, cR = 0, cL = 0; bf16* cT = nullptr;
    if (gw < I_ALL) { P0_DECODE(gw, cW, cK, cP, cN, cT, cR, cL); P0_LOAD(tv, cW, cP, cN, cL); }
    for (int it = gw; it < I_ALL; it += NGW) {
#pragma unroll
        for (int i = 0; i < 32; ++i) scr[(2 * i + (lane_ >> 5)) * 33 + (lane_ & 31)] = tv[i];
        const int K = cK, roff = cR; bf16* WT = cT; const int nblk = cN / 32, k0 = 64 * (cL / nblk), n0 = 32 * (cL % nblk);
        if (it + NGW < I_ALL) { P0_DECODE(it + NGW, cW, cK, cP, cN, cT, cR, cL); P0_LOAD(tv, cW, cP, cN, cL); }
        LDS_WAIT(); asm volatile("" ::: "memory");
        const int c = lane_ & 7;
#pragma unroll
        for (int j = 0; j < 4; ++j) { const int n = (lane_ >> 3) + 8 * j; const LAS float* s = scr + (8 * c) * 33 + n;
            v4u o; o.x = pk2(s[0 * 33], s[1 * 33]); o.y = pk2(s[2 * 33], s[3 * 33]); o.z = pk2(s[4 * 33], s[5 * 33]); o.w = pk2(s[6 * 33], s[7 * 33]);
            *(GAS v4u*)(WT + (size_t)(roff + n0 + n) * K + k0 + 8 * c) = o; }
        LDS_WAIT(); asm volatile("" ::: "memory");
    }
#undef P0_DECODE
#undef P0_LOAD
}

__device__ __forceinline__ void p1_rows(f32x4 (&v)[2][4], int mb, int lane_, const f32x4 (&gm)[4], const f32x4 (&sh)[4], bf16* H, const LAS float* w8, float* bg, const float* a_log, const float* dt_bias) {
            float ss[2];
#pragma unroll
            for (int r = 0; r < 2; ++r) { float s = 0.f;
#pragma unroll
                for (int j = 0; j < 4; ++j) s += (v[r][j].x * v[r][j].x + v[r][j].y * v[r][j].y) + (v[r][j].z * v[r][j].z + v[r][j].w * v[r][j].w);
                ss[r] = s; }
#pragma unroll
    for (int r = 0; r < 2; ++r) ss[r] = wave_sum(ss[r]);
            typedef float f32x2 __attribute__((ext_vector_type(2)));
            f32x2 dots2[2][8];
#pragma unroll
            for (int r = 0; r < 2; ++r)
#pragma unroll
                for (int q = 0; q < 8; ++q) dots2[r][q] = (f32x2){0.f, 0.f};
#pragma unroll
            for (int r = 0; r < 2; ++r) { const float rs = __builtin_amdgcn_rsqf(ss[r] * (1.f / D) + EPS);
                GAS unsigned long long* o8 = (GAS unsigned long long*)(H + (size_t)(mb + r) * D) + lane_;
#pragma unroll
                for (int j = 0; j < 4; ++j) { v[r][j] = v[r][j] * rs * gm[j] + sh[j];
                    o8[64 * j] = (unsigned long long)pk2(v[r][j].x, v[r][j].y) | ((unsigned long long)pk2(v[r][j].z, v[r][j].w) << 32); } }
            asm volatile("" ::: "memory");
#pragma unroll
            for (int j = 0; j < 4; ++j)
#pragma unroll
                for (int q = 0; q < 8; ++q) { const f32x4 w = *(const LAS f32x4*)(w8 + q * 1024 + 4 * lane_ + 256 * j);
#pragma unroll
                    for (int r = 0; r < 2; ++r) { dots2[r][q] = __builtin_elementwise_fma((f32x2){v[r][j].x, v[r][j].y}, (f32x2){w.x, w.y}, dots2[r][q]);
                                                  dots2[r][q] = __builtin_elementwise_fma((f32x2){v[r][j].z, v[r][j].w}, (f32x2){w.z, w.w}, dots2[r][q]); } }
            float dots[2][8];
#pragma unroll
            for (int r = 0; r < 2; ++r)
#pragma unroll
                for (int q = 0; q < 8; ++q) dots[r][q] = dots2[r][q].x + dots2[r][q].y;
#pragma unroll
            for (int r = 0; r < 2; ++r)
#pragma unroll
                for (int q = 0; q < 8; ++q) dots[r][q] = wave_sum(dots[r][q]);
            if (lane_ < 16) {
                const int r = lane_ >> 3, q = lane_ & 7;
                float raw = 0.f;
#pragma unroll
                for (int rr = 0; rr < 2; ++rr)
#pragma unroll
                    for (int qq = 0; qq < 8; ++qq) raw = (r == rr && q == qq) ? dots[rr][qq] : raw;
                const int hh = q & 3; const float xr2 = raw + (q < 4 ? 0.f : dt_bias[hh]);
                const float e2 = __builtin_amdgcn_exp2f((q < 4 ? -xr2 : xr2) * 1.4426950408889634f);
                const float sg = __builtin_amdgcn_rcpf(1.f + e2);
                const float sp = xr2 > 20.f ? xr2 : 0.6931471805599453f * __builtin_amdgcn_logf(1.f + e2);
                const float o = q < 4 ? sg : -__builtin_amdgcn_exp2f(a_log[hh] * 1.4426950408889634f) * sp;
                bg[(size_t)(mb + r) * 8 + q] = o;
            }
}
__device__ __forceinline__ void p1_phase(Frame& F, unsigned char* ws, const float* x, const float* norm_mix, const float* w_in, const float* a_log, const float* dt_bias) {
    const int lane_ = pg8::lane_now(), tid_ = F.wave * 64 + lane_;
    const float* mod = (const float*)(ws + WS_MOD); float* bg = (float*)(ws + WS_BG); bf16* H = (bf16*)(ws + WS_H);
    LAS float* w8 = (LAS float*)(F.lds + RING_OFF);
    for (int i = tid_; i < 8 * 1024; i += NWAVES * 64) { const int j = i & 7, k = i >> 3; w8[j * 1024 + k] = w_in[(size_t)k * IN_COLS + 2048 + j]; }
    __syncthreads();
    for (int tl = F.vcu * NWAVES + F.wave; tl < T / 16; tl += F.G * NWAVES) {
        const int m0 = tl * 16, bb = m0 >> 12;
        f32x4 gm[4], sh[4];
#pragma unroll
        for (int j = 0; j < 4; ++j) { const f32x4 g = ((const GAS f32x4*)norm_mix)[lane_ + 64 * j]; const f32x4 sc = ((const GAS f32x4*)(mod + bb * 6144 + 1024))[lane_ + 64 * j];
            sh[j] = ((const GAS f32x4*)(mod + bb * 6144))[lane_ + 64 * j]; gm[j] = g * (sc + 1.f); }
        f32x4 vA[2][4], vB[2][4], vC[2][4];
#define P1_LOAD(dst, mb_) do { _Pragma("unroll") for (int r = 0; r < 2; ++r) { const GAS f32x4* xr = (const GAS f32x4*)(x + (size_t)((mb_) + r) * D) + lane_; \
            _Pragma("unroll") for (int j = 0; j < 4; ++j) dst[r][j] = xr[64 * j]; } } while (0)
        P1_LOAD(vA, m0); P1_LOAD(vB, m0 + 2);
        P1_LOAD(vC, m0 + 4);  p1_rows(vA, m0, lane_, gm, sh, H, w8, bg, a_log, dt_bias);
        P1_LOAD(vA, m0 + 6);  p1_rows(vB, m0 + 2, lane_, gm, sh, H, w8, bg, a_log, dt_bias);
        P1_LOAD(vB, m0 + 8);  p1_rows(vC, m0 + 4, lane_, gm, sh, H, w8, bg, a_log, dt_bias);
        P1_LOAD(vC, m0 + 10); p1_rows(vA, m0 + 6, lane_, gm, sh, H, w8, bg, a_log, dt_bias);
        P1_LOAD(vA, m0 + 12); p1_rows(vB, m0 + 8, lane_, gm, sh, H, w8, bg, a_log, dt_bias);
        P1_LOAD(vB, m0 + 14); p1_rows(vC, m0 + 10, lane_, gm, sh, H, w8, bg, a_log, dt_bias);
        p1_rows(vA, m0 + 12, lane_, gm, sh, H, w8, bg, a_log, dt_bias);
        p1_rows(vB, m0 + 14, lane_, gm, sh, H, w8, bg, a_log, dt_bias);
#undef P1_LOAD
    }
}


__device__ __forceinline__ f32x4 bf4_to_f32(unsigned long long a) { f32x4 y; y.x = __uint_as_float((unsigned)(a & 0xFFFFu) << 16); y.y = __uint_as_float((unsigned)(a >> 16) << 16); y.z = __uint_as_float((unsigned)((a >> 32) & 0xFFFFu) << 16); y.w = __uint_as_float((unsigned)(a >> 48) << 16); return y; }
__device__ __forceinline__ void p7_rows(const unsigned long long (&raw)[2][4], int mb, int lane_, const f32x4 (&gm)[4], const f32x4 (&sh)[4], bf16* H) {
    float ss[2]; f32x4 v[2][4];
#pragma unroll
    for (int r = 0; r < 2; ++r)
#pragma unroll
        for (int j = 0; j < 4; ++j) v[r][j] = bf4_to_f32(raw[r][j]);
#pragma unroll
    for (int r = 0; r < 2; ++r) { float s = 0.f;
#pragma unroll
        for (int j = 0; j < 4; ++j) s += (v[r][j].x * v[r][j].x + v[r][j].y * v[r][j].y) + (v[r][j].z * v[r][j].z + v[r][j].w * v[r][j].w);
        ss[r] = s; }
#pragma unroll
    for (int r = 0; r < 2; ++r) ss[r] = wave_sum(ss[r]);
#pragma unroll
    for (int r = 0; r < 2; ++r) { const float rs = __builtin_amdgcn_rsqf(ss[r] * (1.f / D) + EPS);
        GAS unsigned long long* o8 = (GAS unsigned long long*)(H + (size_t)(mb + r) * D) + lane_;
#pragma unroll
        for (int j = 0; j < 4; ++j) { const f32x4 h = v[r][j] * rs * gm[j] + sh[j];
            o8[64 * j] = (unsigned long long)pk2(h.x, h.y) | ((unsigned long long)pk2(h.z, h.w) << 32); } }
}
#if MK_PROF_A >= 110 && MK_PROF_A < 120
#define PROF7(idx) do { if (blockIdx.x == 0 && F.wave == 0 && pg8::lane_now() == 0) { const unsigned long long t_ = __builtin_amdgcn_s_memrealtime(); \
        const unsigned long long p_ = ((unsigned long long)F.MISC[23] << 32) | F.MISC[22]; if ((idx) >= 0) F.MISC[24 + (idx)] = __float_as_uint(__uint_as_float(F.MISC[24 + (idx)]) + (float)(t_ - p_) * 0.01f); \
        F.MISC[22] = (unsigned)t_; F.MISC[23] = (unsigned)(t_ >> 32); } } while (0)
#else
#define PROF7(idx) do {} while (0)
#endif
__device__ __forceinline__ void p5_phase(Frame& F, unsigned char* ws, const bf16* xmid, const float* norm_ffn) {
    const int lane_ = pg8::lane_now(), tid_ = F.wave * 64 + lane_;
    const float* mod = (const float*)(ws + WS_MOD); bf16* H = (bf16*)(ws + WS_H); const bf16* wrt = (const bf16*)(ws + WS_WRT);
    int* ltok = (int*)(ws + WS_LTOK); float* lw = (float*)(ws + WS_LW); int* tokslot = (int*)(ws + WS_TOKSLOT);
    gu32* gcnt = F.ctl + CW_CNT;
    LAS float* lg = (LAS float*)(F.lds + RING_OFF) + F.wave * (16 * 48);
    LAS unsigned* lcnt = (LAS unsigned*)(F.lds + RING_OFF + 32768);
    LAS unsigned* gbase = lcnt + 32;
    constexpr int NT = T / 16;
    LAS unsigned char* wrtL = F.lds + RING_OFF + 40960;
    for (int i = tid_; i < 48 * 128; i += NWAVES * 64) { const int row = i >> 7, p = i & 127;
        *(LAS v4u*)(wrtL + row * 2048 + ((p ^ (row & 7)) << 4)) = *(const GAS v4u*)(wrt + (size_t)row * D + 8 * p); }
    for (int tl0 = F.vcu * NWAVES; tl0 < NT; tl0 += F.G * NWAVES) {
        const int tl = tl0 + F.wave; const bool active = tl < NT; const int m0 = tl * 16;
        if (tid_ < 32) lcnt[tid_] = 0u;
        __syncthreads(); PROF7(-1);
        int e1 = 0, e2 = 0, ls1 = 0, ls2 = 0; float w1 = 0.f, w2 = 0.f;
        if (active) {
            {
                const int bb = m0 >> 12;
                f32x4 gm[4], sh[4];
#pragma unroll
                for (int j = 0; j < 4; ++j) { const f32x4 g = ((const GAS f32x4*)norm_ffn)[lane_ + 64 * j]; const f32x4 sc = ((const GAS f32x4*)(mod + bb * 6144 + 4096))[lane_ + 64 * j];
                    sh[j] = ((const GAS f32x4*)(mod + bb * 6144 + 3072))[lane_ + 64 * j]; gm[j] = g * (sc + 1.f); }
                unsigned long long vA[2][4], vB[2][4], vC[2][4], vD[2][4];
#define P7_LOAD(dst, mb_) do { _Pragma("unroll") for (int r = 0; r < 2; ++r) { const GAS unsigned long long* xr = (const GAS unsigned long long*)(xmid + (size_t)((mb_) + r) * D) + lane_; \
                    _Pragma("unroll") for (int j = 0; j < 4; ++j) dst[r][j] = xr[64 * j]; } } while (0)
                P7_LOAD(vA, m0); P7_LOAD(vB, m0 + 2); P7_LOAD(vC, m0 + 4);
#pragma unroll 1
                for (int gp = 0; gp < 2; ++gp) {
                    P7_LOAD(vD, m0 + 8 * gp + 6);
                    p7_rows(vA, m0 + 8 * gp, lane_, gm, sh, H);
                    if (gp < 1) P7_LOAD(vA, m0 + 8);
                    p7_rows(vB, m0 + 8 * gp + 2, lane_, gm, sh, H);
                    if (gp < 1) P7_LOAD(vB, m0 + 10);
                    p7_rows(vC, m0 + 8 * gp + 4, lane_, gm, sh, H);
                    if (gp < 1) P7_LOAD(vC, m0 + 12);
                    p7_rows(vD, m0 + 8 * gp + 6, lane_, gm, sh, H);
                }
#undef P7_LOAD
            }
            PROF7(0);
            __threadfence_block();
            asm volatile("s_waitcnt vmcnt(0)" ::: "memory");
            f32x4 acc0 = {0.f, 0.f, 0.f, 0.f}, acc1 = acc0, acc2 = acc0;
            const bf16* ap = H + (size_t)(m0 + (lane_ & 15)) * D + 8 * (lane_ >> 4);
            const LAS unsigned char* bp = wrtL + (lane_ & 15) * 2048; const int bg_ = lane_ >> 4, bx_ = lane_ & 7;
#pragma unroll 16
            for (int sI = 0; sI < 32; ++sI) {
                const bf16x8 av = *(const GAS bf16x8*)(ap + 32 * sI);
                const int po = ((4 * sI + bg_) ^ bx_) << 4;
                const bf16x8 b0 = *(const LAS bf16x8*)(bp + po), b1 = *(const LAS bf16x8*)(bp + 16 * 2048 + po), b2 = *(const LAS bf16x8*)(bp + 32 * 2048 + po);
                acc0 = __builtin_amdgcn_mfma_f32_16x16x32_bf16(av, b0, acc0, 0, 0, 0);
                acc1 = __builtin_amdgcn_mfma_f32_16x16x32_bf16(av, b1, acc1, 0, 0, 0);
                acc2 = __builtin_amdgcn_mfma_f32_16x16x32_bf16(av, b2, acc2, 0, 0, 0);
            }
            PROF7(1);
#pragma unroll
            for (int rg = 0; rg < 4; ++rg) { const int row = 4 * (lane_ >> 4) + rg;
                lg[row * 48 + (lane_ & 15)] = acc0[rg]; lg[row * 48 + 16 + (lane_ & 15)] = acc1[rg]; lg[row * 48 + 32 + (lane_ & 15)] = acc2[rg]; }
            LDS_WAIT(); asm volatile("" ::: "memory");
            if (lane_ < 16) {
                const LAS float* l = lg + lane_ * 48;
                float gmax = l[0]; int gi = 0;
#pragma unroll
                for (int i = 1; i < 4; ++i) { const float v = l[i]; if (v > gmax) { gmax = v; gi = i; } }
                float gs = 0.f;
#pragma unroll
                for (int i = 0; i < 4; ++i) gs += __expf(l[i] - gmax);
                const float gprob = 1.f / gs;
                float a1 = -1e30f, a2 = -1e30f; int i1 = 0, i2 = 0;
#pragma unroll
                for (int i = 0; i < 8; ++i) { const float v = l[4 + gi * 8 + i]; if (v > a1) { a2 = a1; i2 = i1; a1 = v; i1 = i; } else if (v > a2) { a2 = v; i2 = i; } }
                const float p2 = __expf(a2 - a1);
                w1 = gprob / (1.f + p2); w2 = gprob * p2 / (1.f + p2);
                e1 = gi * 8 + i1; e2 = gi * 8 + i2;
                ls1 = (int)atomicAdd((unsigned*)&lcnt[e1], 1u); ls2 = (int)atomicAdd((unsigned*)&lcnt[e2], 1u);
            }
        }
        __syncthreads(); PROF7(2);
        if (tid_ < 32) gbase[tid_] = __hip_atomic_fetch_add(gcnt + tid_, lcnt[tid_], __ATOMIC_RELAXED, __HIP_MEMORY_SCOPE_AGENT);
        __syncthreads(); PROF7(3);
        if (active && lane_ < 16) {
            const int m = m0 + lane_; const int s1 = (int)gbase[e1] + ls1, s2 = (int)gbase[e2] + ls2;
            ltok[(size_t)e1 * CAP + s1] = m; lw[(size_t)e1 * CAP + s1] = w1;
            ltok[(size_t)e2 * CAP + s2] = m; lw[(size_t)e2 * CAP + s2] = w2;
            tokslot[2 * m] = (e1 << 20) | s1; tokslot[2 * m + 1] = (e2 << 20) | s2;
        }
        PROF7(4);
    }
}

__device__ __forceinline__ void moe_setup(Frame& F) {
    const int lane_ = pg8::lane_now();
    LAS int* tpre = (LAS int*)(F.lds + MOE_OFF); LAS int* cn = tpre + 33;
    if (F.wave == 0) {
        const int c = lane_ < 32 ? (int)__hip_atomic_load(F.ctl + CW_CNT + lane_, RLX_AGENT) : 0;
        const int tiles = (c + 255) >> 8;
        int incl = tiles;
#pragma unroll
        for (int o = 1; o < 32; o <<= 1) { const int t = __shfl_up(incl, o); if (lane_ >= o) incl += t; }
        if (lane_ < 32) { cn[lane_] = c; tpre[lane_] = incl - tiles; }
        if (lane_ == 31) tpre[32] = incl;
    }
    __syncthreads();
}

__device__ __forceinline__ void p10_rows(const unsigned long long (&xraw)[2][4], const unsigned long long (&ya)[2][4], const unsigned long long (&yb)[2][4], int mb, int lane_, const f32x4 (&gt)[4], const f32x4 (&nf)[4], float* xo) {
    float ss[2]; f32x4 v[2][4];
#pragma unroll
    for (int r = 0; r < 2; ++r)
#pragma unroll
        for (int j = 0; j < 4; ++j) v[r][j] = bf4_to_f32(xraw[r][j]);
#pragma unroll
    for (int r = 0; r < 2; ++r) { float s = 0.f;
#pragma unroll
        for (int j = 0; j < 4; ++j) { const unsigned long long a = ya[r][j], b = yb[r][j]; f32x4 y;
            y.x = __uint_as_float((unsigned)(a & 0xFFFFu) << 16) + __uint_as_float((unsigned)(b & 0xFFFFu) << 16);
            y.y = __uint_as_float((unsigned)(a >> 16) << 16) + __uint_as_float((unsigned)(b >> 16) << 16);
            y.z = __uint_as_float((unsigned)((a >> 32) & 0xFFFFu) << 16) + __uint_as_float((unsigned)((b >> 32) & 0xFFFFu) << 16);
            y.w = __uint_as_float((unsigned)(a >> 48) << 16) + __uint_as_float((unsigned)(b >> 48) << 16);
            v[r][j] = v[r][j] + gt[j] * y;
            s += (v[r][j].x * v[r][j].x + v[r][j].y * v[r][j].y) + (v[r][j].z * v[r][j].z + v[r][j].w * v[r][j].w); }
        ss[r] = s; }
#pragma unroll
    for (int r = 0; r < 2; ++r) ss[r] = wave_sum(ss[r]);
#pragma unroll
    for (int r = 0; r < 2; ++r) { const float rs = __builtin_amdgcn_rsqf(ss[r] * (1.f / D) + EPS);
        GAS f32x4* xr = (GAS f32x4*)(xo + (size_t)(mb + r) * D) + lane_;
#pragma unroll
        for (int j = 0; j < 4; ++j) xr[64 * j] = v[r][j] * rs * nf[j]; }
}
__device__ __forceinline__ void p8_phase(Frame& F, unsigned char* ws, float* xo, const float* norm_final) {
    const bf16* xm = (const bf16*)(ws + WS_XM);
    const int lane_ = pg8::lane_now();
    const float* mod = (const float*)(ws + WS_MOD); const int* tokslot = (const int*)(ws + WS_TOKSLOT); const bf16* ys = (const bf16*)(ws + WS_YS);
    const LAS int* tpre = (const LAS int*)(F.lds + MOE_OFF);
    f32x4 nf[4];
#pragma unroll
    for (int j = 0; j < 4; ++j) nf[j] = ((const GAS f32x4*)norm_final)[lane_ + 64 * j];
    for (int tl = F.vcu * NWAVES + F.wave; tl < T / 16; tl += F.G * NWAVES) {
        const int m0 = tl * 16, bb = m0 >> 12;
        int myrow = 0;
        if (lane_ < 32) { const int t = tokslot[2 * m0 + lane_]; myrow = tpre[t >> 20] * 256 + (t & 0xFFFFF); }
        f32x4 gt[4];
#pragma unroll
        for (int j = 0; j < 4; ++j) gt[j] = ((const GAS f32x4*)(mod + bb * 6144 + 5120))[lane_ + 64 * j];
        unsigned long long vA[2][4], vB[2][4], yaA[2][4], ybA[2][4], yaB[2][4], ybB[2][4];
#define P10_LOAD(dv, da, db, g_) do { _Pragma("unroll") for (int r = 0; r < 2; ++r) { \
            const size_t r0 = (size_t)__shfl(myrow, 2 * (2 * (g_) + r)), r1 = (size_t)__shfl(myrow, 2 * (2 * (g_) + r) + 1); \
            const GAS unsigned long long* xr = (const GAS unsigned long long*)(xm + (size_t)(m0 + 2 * (g_) + r) * D) + lane_; \
            const GAS unsigned long long* y0 = (const GAS unsigned long long*)(ys + r0 * D) + lane_; const GAS unsigned long long* y1 = (const GAS unsigned long long*)(ys + r1 * D) + lane_; \
            _Pragma("unroll") for (int j = 0; j < 4; ++j) { dv[r][j] = xr[64 * j]; da[r][j] = y0[64 * j]; db[r][j] = y1[64 * j]; } } } while (0)
        P10_LOAD(vA, yaA, ybA, 0);
#pragma unroll 1
        for (int gp = 0; gp < 4; ++gp) {
            P10_LOAD(vB, yaB, ybB, 2 * gp + 1);
            p10_rows(vA, yaA, ybA, m0 + 4 * gp, lane_, gt, nf, xo);
            if (gp < 3) P10_LOAD(vA, yaA, ybA, 2 * gp + 2);
            p10_rows(vB, yaB, ybB, m0 + 4 * gp + 2, lane_, gt, nf, xo);
        }
#undef P10_LOAD
    }
}

#if MK_PROF_A >= 200
#define PROFA(idx) do { if (blockIdx.x == 32 && wid_ == 0 && lane == 0) { const unsigned long long t_ = __builtin_amdgcn_s_memrealtime(); \
        const unsigned long long p_ = ((unsigned long long)misc_[23] << 32) | misc_[22]; if ((idx) >= 0) misc_[24 + (idx)] = __float_as_uint(__uint_as_float(misc_[24 + (idx)]) + (float)(t_ - p_) * 0.01f); \
        misc_[22] = (unsigned)t_; misc_[23] = (unsigned)(t_ >> 32); } } while (0)
#else
#define PROFA(idx) do {} while (0)
#endif
#ifndef ATT_NPF
#define ATT_NPF 2
#endif
namespace att {
typedef short bf16x8 __attribute__((ext_vector_type(8)));
typedef short s16x4 __attribute__((ext_vector_type(4)));
typedef float f32x16 __attribute__((ext_vector_type(16)));
typedef unsigned u32x4 __attribute__((ext_vector_type(4)));
constexpr int TBL_N = 192;
constexpr int LDS_TBL = 0;
constexpr int LDS_WAVE = 18432;
constexpr int WAVE_BYTES = 8704;
constexpr float LOG2E = 1.4426950408889634f;
__device__ __forceinline__ int crow(int r, int hi) { return (r & 3) + 8 * (r >> 2) + 4 * hi; }
__device__ __forceinline__ unsigned cvtpk(float lo, float hi) { typedef float f32x2_t_ __attribute__((ext_vector_type(2))); typedef __bf16 bf16x2_t_ __attribute__((ext_vector_type(2))); const f32x2_t_ v_ = {lo, hi}; return __builtin_bit_cast(unsigned, __builtin_convertvector(v_, bf16x2_t_)); }
__device__ __forceinline__ s16x4 vtr(const LAS unsigned char* p) { typedef short v4i16_t __attribute__((ext_vector_type(4)));
    return __builtin_bit_cast(s16x4, __builtin_amdgcn_ds_read_tr16_b64_v4i16((LAS v4i16_t*)p)); }

__device__ __forceinline__ void build_tables(LAS float* tbl, const float* rel_bias, int tid) {
    for (int i = tid; i < 24 * TBL_N; i += NWAVES * 64) {
        const int bh = i / TBL_N, u = i % TBL_N, br = bh >> 3, h = bh & 7, delta = 159 - u, dil = br == 0 ? 1 : (br == 1 ? 4 : 16);
        float v = -1e30f;
        if (delta >= 0 && delta <= 128) { const int dist = delta * dil; int bucket;
            if (dist < 16) bucket = dist; else { const float vv = __builtin_amdgcn_logf((float)dist * 0.0625f) * (16.f / 7.f);
                const int l = 16 + (int)vv; bucket = l < 31 ? l : 31; }
            v = rel_bias[bucket * 8 + h] * LOG2E; }
        tbl[i] = v;
    }
}
__device__ __forceinline__ void build_tables_max(LAS float* tbl, int tid) {
    if (tid < 24) { float mx = -1e30f; for (int u = 31; u <= 159; ++u) mx = fmaxf(mx, tbl[tid * TBL_N + u]); tbl[tid * TBL_N + TBL_N - 1] = mx; }
}

struct TileP { int rowbase, h, dil, r, I0; };
__device__ __forceinline__ unsigned lane_kofs(int dil, int lane) { return (unsigned)((lane & 31) * dil * 128 + (lane >> 5) * 16); }
__device__ __forceinline__ unsigned lane_vofs(int dil, int lane) { return (unsigned)((lane >> 3) * dil * 128 + (lane & 7) * 16); }
__device__ __forceinline__ const GAS unsigned char* tile_row(const void* B, const TileP& t, int J) {
    const long tok = (long)(t.rowbase * 8 + t.h * 4096) + t.r + (long)t.dil * J; return (const GAS unsigned char*)B + tok * 128; }
__device__ __forceinline__ unsigned lane_pofs(int dil, int lane) { return (unsigned)((lane >> 3) * dil * 1024 + (lane & 7) * 16); }
__device__ __forceinline__ void load_q(const bf16* QB, const TileP& t, unsigned kofs, bf16x8 (&qf)[4]) {
    const GAS unsigned char* b = tile_row(QB, t, t.I0);
#pragma unroll
    for (int s = 0; s < 4; ++s) qf[s] = *(const GAS bf16x8*)(b + kofs + 32 * s);
}
__device__ __forceinline__ void load_k(const bf16* KB, const TileP& t, unsigned vofs, int kt, u32x4 (&kr)[4]) {
#pragma unroll
    for (int ii = 0; ii < 4; ++ii) kr[ii] = *(const GAS u32x4*)(tile_row(KB, t, t.I0 - 128 + 32 * kt + 8 * ii) + vofs);
}
__device__ __forceinline__ void load_v(const bf16* VB, const TileP& t, unsigned vofs, int kt, u32x4 (&vv)[4]) {
#pragma unroll
    for (int ii = 0; ii < 4; ++ii) vv[ii] = *(const GAS u32x4*)(tile_row(VB, t, t.I0 - 128 + 32 * kt + 8 * ii) + vofs);
}
__device__ __forceinline__ void wave_tile(const bf16* QB, const bf16* KB, const bf16* VB, bf16* part, float* lse, const LAS float* tb, LAS unsigned char* wl,
                                          const TileP& tc, bool has_next, const TileP& tn, int lane, volatile LAS unsigned* misc_, int wid_,
                                          bf16x8 (&qf)[4], bf16x8 (&qn)[4], u32x4 (&ks0)[4], u32x4 (&vx)[4], u32x4 (&vy)[4]) {
    const int h = tc.h, I0 = tc.I0;
    const int i = lane & 31, h2 = lane >> 5;
    PROFA(-1);
    LAS unsigned char* vt = wl; LAS unsigned char* ost = wl + 4096;
    const bool needmask = I0 < 128;
    const LAS float* tbase = tb + (31 - i + 4 * h2);
    const int vrow_l = lane >> 3, vch = lane & 7;
    const LAS unsigned char* vrd = vt + ((lane >> 4) & 1) * 32 + (lane & 3) * 8 + (4 * h2 + ((lane & 15) >> 2)) * 64;
    const unsigned kofs = lane_kofs(tc.dil, lane), vofs = lane_vofs(tc.dil, lane);
    LAS unsigned char* kwr = ost + vrow_l * 144 + vch * 16; const LAS unsigned char* krd = ost + i * 144 + h2 * 16;
    u32x4 ks1[4], ks2[4], ks3[4], ks4[4];
    load_k(KB, tc, vofs, 3, ks1);
    float m = 0.f, l = 0.f;
    f32x16 o0 = {0.f, 0.f, 0.f, 0.f, 0.f, 0.f, 0.f, 0.f, 0.f, 0.f, 0.f, 0.f, 0.f, 0.f, 0.f, 0.f}, o1 = o0;
#define ATT_STEP(j_, KF_, VV_, PRE_) do { constexpr int kt = 4 - (j_); \
        _Pragma("unroll") for (int ii = 0; ii < 4; ++ii) *(LAS u32x4*)(vt + (vch >> 2) * 2048 + (vrow_l + 8 * ii) * 64 + (vch & 3) * 16) = VV_[ii]; \
        if ((j_) < 3) load_v(VB, tc, vofs, kt - 2, VV_); else if (has_next) load_v(VB, tn, lane_vofs(tn.dil, lane), 7 - (j_), VV_);     \
        f32x16 acc; \
        if ((j_) == 0) { _Pragma("unroll") for (int rr = 0; rr < 16; ++rr) acc[rr] = 0.f; } else { _Pragma("unroll") for (int rr = 0; rr < 16; ++rr) acc[rr] = -m; } \
        _Pragma("unroll") for (int ii = 0; ii < 4; ++ii) *(LAS u32x4*)(kwr + ii * (8 * 144)) = KF_[ii];     \
        asm volatile("" ::: "memory"); \
        _Pragma("unroll") for (int s = 0; s < 4; ++s) { const bf16x8 kf_ = *(const LAS bf16x8*)(krd + 32 * s); \
            acc = __builtin_amdgcn_mfma_f32_32x32x16_bf16(kf_, qf[s], acc, 0, 0, 0); } \
        asm volatile("" ::: "memory"); \
        PRE_; \
        if ((j_) == 0) { float mx = acc[0]; _Pragma("unroll") for (int rr = 1; rr < 16; ++rr) mx = fmaxf(mx, acc[rr]); \
            { float w_ = mx; asm volatile("" : "+v"(w_)); auto rx = __builtin_amdgcn_permlane32_swap(__float_as_uint(mx), __float_as_uint(w_), false, false); mx = fmaxf(__uint_as_float(rx[0]), __uint_as_float(rx[1])); } \
            m = mx + tb[att::TBL_N - 1]; _Pragma("unroll") for (int rr = 0; rr < 16; ++rr) acc[rr] -= m; } \
        if (needmask) {                                       \
            const int jlim = 128 - 32 * kt - I0 - 4 * h2; asm volatile("" ::: "memory"); \
            _Pragma("unroll") for (int rr = 0; rr < 16; ++rr) { const int kk = (rr & 3) + 8 * (rr >> 2); if (kk < jlim) acc[rr] = -1e30f; } } \
        float p[16]; \
        _Pragma("unroll") for (int rr = 0; rr < 16; ++rr) { const int kk = (rr & 3) + 8 * (rr >> 2); \
            p[rr] = __builtin_amdgcn_exp2f(acc[rr] + tbase[32 * kt + kk]); l += p[rr]; } \
        u32x4 pw0, pw1; \
        pw0.x = cvtpk(p[0], p[1]); pw0.y = cvtpk(p[2], p[3]); pw0.z = cvtpk(p[4], p[5]); pw0.w = cvtpk(p[6], p[7]); \
        pw1.x = cvtpk(p[8], p[9]); pw1.y = cvtpk(p[10], p[11]); pw1.z = cvtpk(p[12], p[13]); pw1.w = cvtpk(p[14], p[15]); \
        const bf16x8 pa0 = __builtin_bit_cast(bf16x8, pw0), pa1 = __builtin_bit_cast(bf16x8, pw1); \
        asm volatile("s_waitcnt lgkmcnt(0)" ::: "memory"); \
        _Pragma("unroll") for (int db = 0; db < 2; ++db) { \
            const s16x4 a0 = vtr(vrd + db * 2048), a1 = vtr(vrd + db * 2048 + 512), b0 = vtr(vrd + db * 2048 + 1024), b1 = vtr(vrd + db * 2048 + 1536); \
            const bf16x8 v0 = (bf16x8){a0[0], a0[1], a0[2], a0[3], a1[0], a1[1], a1[2], a1[3]}, v1 = (bf16x8){b0[0], b0[1], b0[2], b0[3], b1[0], b1[1], b1[2], b1[3]}; \
            if (db == 0) { o0 = __builtin_amdgcn_mfma_f32_32x32x16_bf16(v0, pa0, o0, 0, 0, 0); o0 = __builtin_amdgcn_mfma_f32_32x32x16_bf16(v1, pa1, o0, 0, 0, 0); } \
            else         { o1 = __builtin_amdgcn_mfma_f32_32x32x16_bf16(v0, pa0, o1, 0, 0, 0); o1 = __builtin_amdgcn_mfma_f32_32x32x16_bf16(v1, pa1, o1, 0, 0, 0); } } \
        asm volatile("s_waitcnt lgkmcnt(0)" ::: "memory"); } while (0)
    ATT_STEP(0, ks0, vx, load_k(KB, tc, vofs, 2, ks2));
    PROFA(0);
    ATT_STEP(1, ks1, vy, load_k(KB, tc, vofs, 1, ks3));
    ATT_STEP(2, ks2, vx, { load_k(KB, tc, vofs, 0, ks4); if (has_next) load_q(QB, tn, lane_kofs(tn.dil, lane), qn); });
    ATT_STEP(3, ks3, vy, if (has_next) load_k(KB, tn, lane_vofs(tn.dil, lane), 4, ks0));
    ATT_STEP(4, ks4, vx, (void)0);
#undef ATT_STEP
    PROFA(1);
    { float w_ = l; asm volatile("" : "+v"(w_)); auto rr = __builtin_amdgcn_permlane32_swap(__float_as_uint(l), __float_as_uint(w_), false, false); l = __uint_as_float(rr[0]) + __uint_as_float(rr[1]); }
    const float il = 1.f / l;
    if (h2 == 0) *(GAS float*)((GAS unsigned char*)lse + ((long)tc.rowbase + tc.r + (long)tc.dil * I0) * 32 + h * 4 + (size_t)(i * tc.dil * 32)) = m + __log2f(l);
#pragma unroll
    for (int qd = 0; qd < 4; ++qd) { typedef unsigned u32x2_ __attribute__((ext_vector_type(2)));
        LAS unsigned char* wp = ost + i * 128 + h2 * 8;
        *(LAS u32x2_*)(wp + ((qd ^ (i & 7)) << 4)) = (u32x2_){cvtpk(o0[4 * qd] * il, o0[4 * qd + 1] * il), cvtpk(o0[4 * qd + 2] * il, o0[4 * qd + 3] * il)};
        *(LAS u32x2_*)(wp + (((qd + 4) ^ (i & 7)) << 4)) = (u32x2_){cvtpk(o1[4 * qd] * il, o1[4 * qd + 1] * il), cvtpk(o1[4 * qd + 2] * il, o1[4 * qd + 3] * il)}; }
    asm volatile("s_waitcnt lgkmcnt(0)" ::: "memory");
    { GAS unsigned char* pb = (GAS unsigned char*)part + ((long)tc.rowbase + tc.r + (long)tc.dil * I0) * 1024 + h * 128; const unsigned pofs = lane_pofs(tc.dil, lane);
#pragma unroll
      for (int ii = 0; ii < 4; ++ii) { const int row = ii * 8 + vrow_l;
        const u32x4 v = *(const LAS u32x4*)(ost + row * 128 + ((vch ^ (row & 7)) << 4));
        __builtin_nontemporal_store(v, (GAS u32x4*)(pb + (size_t)(ii * 8 * tc.dil) * 1024 + pofs)); } }
    asm volatile("s_waitcnt lgkmcnt(0)" ::: "memory");
    PROFA(2);
}
}

struct AttTile { int br, h, b, dil, r, I0; };
__device__ __forceinline__ AttTile att_tile(int u, int wt) {
    AttTile t; t.h = u / 192; const int nu = u % 192; t.br = nu % 3; const int bb = nu / 3; t.b = bb >> 3; const int blk = bb & 7;
    t.dil = t.br == 0 ? 1 : (t.br == 1 ? 4 : 16);
    if (t.br == 0) { t.r = 0; t.I0 = blk * 512 + 32 * wt; } else if (t.br == 1) { t.r = wt & 3; t.I0 = blk * 128 + 32 * (wt >> 2); } else { t.r = wt; t.I0 = blk * 32; }
    return t;
}
__device__ __forceinline__ unsigned att_draw_unit(gu32* qctr, volatile LAS unsigned* Q, unsigned x) {
    unsigned k = Q[1];
    while (k < 8u) { const unsigned y = (x + k) & 7u; const unsigned nu = __hip_atomic_fetch_add(qctr + 32 * y, 1u, __ATOMIC_RELAXED, __HIP_MEMORY_SCOPE_AGENT);
        if (nu < 192u) return y * 192u + nu;
        ++k; Q[1] = k; }
    return 1536u;
}
__device__ __forceinline__ void att_prefetch(const bf16* QB, const bf16* KB, const bf16* VB, const AttTile& t, int lane, unsigned (&pf)[6]) {
#pragma unroll
    for (int q = 0; q < 6; ++q) { const int xidx = lane + 64 * q; const bf16* base; int J;
        if (xidx < 32) { base = QB; J = t.I0 + xidx; } else if (xidx < 192) { base = KB; J = t.I0 - 128 + (xidx - 32); } else { base = VB; J = t.I0 - 128 + (xidx - 192); }
        if (J < 0) J = 0; if (xidx >= 352) J = t.I0;
        pf[q] = *(const GAS unsigned*)(base + ((size_t)t.b * SEQ + t.r + (size_t)t.dil * J) * 512 + 64 * t.h); }
}
__device__ __forceinline__ void attn_phase(Frame& F, unsigned char* ws, const float* rel_bias) {
    const int lane_ = pg8::lane_now(), tid_ = F.wave * 64 + lane_;
    LAS float* tbl = (LAS float*)(F.lds + RING_OFF + att::LDS_TBL);
    volatile LAS unsigned* Q = (volatile LAS unsigned*)(F.lds + LDSCTL_OFF);
    gu32* qctr = F.ctl + CW_ATTQ; const unsigned xq_ = xb_xcc_id() & 7u;
    if (tid_ < 32) Q[tid_] = 0u;
    att::build_tables(tbl, rel_bias, tid_);
    __syncthreads();
    att::build_tables_max(tbl, tid_);
    if (tid_ == 0) { Q[8] = att_draw_unit(qctr, Q, xq_); Q[9] = att_draw_unit(qctr, Q, xq_); Q[16] = 1u; Q[17] = 2u; }
    __syncthreads();
    const bf16* QB = (const bf16*)(ws + WS_QB); const bf16* KB = (const bf16*)(ws + WS_KB); const bf16* VB = (const bf16*)(ws + WS_VB);
    LAS unsigned char* wl = F.lds + RING_OFF + att::LDS_WAVE + F.wave * att::WAVE_BYTES;
#define ATT_DRAW(u_, wt_) do { unsigned g_ = 0u; if (pg8::lane_now() == 0) g_ = atomicAdd((unsigned*)&Q[0], 1u); g_ = (unsigned)__builtin_amdgcn_readfirstlane((int)g_); \
        const unsigned s_ = g_ >> 4; wt_ = (int)(g_ & 15u); \
        if (wt_ == 0 && pg8::lane_now() == 0) { const unsigned nu_ = att_draw_unit(qctr, Q, xq_); Q[8 + ((s_ + 2u) & 7u)] = nu_; \
            asm volatile("s_waitcnt lgkmcnt(0)" ::: "memory"); Q[16 + ((s_ + 2u) & 7u)] = s_ + 3u; } \
        while (Q[16 + (s_ & 7u)] != s_ + 1u) __builtin_amdgcn_s_sleep(1); \
        u_ = __builtin_amdgcn_readfirstlane((int)Q[8 + (s_ & 7u)]); } while (0)
#if MK_PROF_A >= 200
    const unsigned long long tph0_ = __builtin_amdgcn_s_memrealtime(); unsigned long long tdraw_ = 0; int ntile_ = 0;
#endif
    int u_cur, wt_cur, u_nxt, wt_nxt;
    ATT_DRAW(u_cur, wt_cur);
    att::bf16x8 qA[4], qB[4]; att::u32x4 ks0[4], vA[4], vB[4];
    if (u_cur < 1536) { const AttTile t0 = att_tile(u_cur, wt_cur); const att::TileP p0{t0.b * SEQ, t0.h, t0.dil, t0.r, t0.I0}; const int ln = pg8::lane_now();
        const unsigned ko = att::lane_kofs(p0.dil, ln), vo = att::lane_vofs(p0.dil, ln);
        att::load_q(QB, p0, ko, qA); att::load_k(KB, p0, vo, 4, ks0); att::load_v(VB, p0, vo, 4, vA); att::load_v(VB, p0, vo, 3, vB); }
#if MK_PROF_A >= 200
#define ATT_PROF_DRAW0() const unsigned long long td0_ = __builtin_amdgcn_s_memrealtime()
#define ATT_PROF_DRAW1() do { tdraw_ += __builtin_amdgcn_s_memrealtime() - td0_; ++ntile_; } while (0)
#else
#define ATT_PROF_DRAW0() do {} while (0)
#define ATT_PROF_DRAW1() do {} while (0)
#endif
#define ATT_ONE_TILE(QC_, QN_, VX_, VY_) do { \
        ATT_PROF_DRAW0(); \
        ATT_DRAW(u_nxt, wt_nxt);                               \
        ATT_PROF_DRAW1(); \
        const int ln = pg8::lane_now();                        \
        const AttTile t = att_tile(u_cur, wt_cur); \
        const bool has_next = u_nxt < 1536; \
        const AttTile tn = att_tile(has_next ? u_nxt : u_cur, has_next ? wt_nxt : wt_cur); \
        const att::TileP pc{t.b * SEQ, t.h, t.dil, t.r, t.I0}, pn{tn.b * SEQ, tn.h, tn.dil, tn.r, tn.I0}; \
        bf16* part = (bf16*)(ws + (t.br == 0 ? WS_PART0 : (t.br == 1 ? WS_PART1 : WS_PART2))); \
        float* lse = (float*)(ws + WS_LSE) + (size_t)t.br * T * 8; \
        att::wave_tile(QB, KB, VB, part, lse, tbl + (t.br * 8 + t.h) * att::TBL_N, wl, pc, has_next, pn, ln, F.MISC, F.wave, QC_, QN_, ks0, VX_, VY_); \
        u_cur = u_nxt; wt_cur = wt_nxt; } while (0)
    while (u_cur < 1536) {
        ATT_ONE_TILE(qA, qB, vA, vB);
        if (u_cur >= 1536) break;
        ATT_ONE_TILE(qB, qA, vB, vA);
    }
#undef ATT_ONE_TILE
#undef ATT_DRAW
#if MK_PROF_A >= 200
    if (pg8::lane_now() == 0) atomicMax((unsigned*)(F.ctl + CW_CNT + 70), (unsigned)(__builtin_amdgcn_s_memrealtime() - tph0_));
    if (blockIdx.x == MK_PROF_BLK && tid_ == MK_PROF_WV * 64) { F.MISC[27] = __float_as_uint((float)(__builtin_amdgcn_s_memrealtime() - tph0_) * 0.01f); F.MISC[26] = __float_as_uint((float)ntile_ * 5.f); F.MISC[25] = __float_as_uint((float)tdraw_ * 0.01f); }
#endif
    __syncthreads();
}

__device__ __forceinline__ void attn_combine_phase(Frame& F, unsigned char* ws, const float* attn_norm) {
    const int lane_ = pg8::lane_now();
    const int gw = F.vcu * NWAVES + F.wave, NGW = F.G * NWAVES;
    const float* lse = (const float*)(ws + WS_LSE); bf16* Y = (bf16*)(ws + WS_Y);
    const bf16* p0 = (const bf16*)(ws + WS_PART0); const bf16* p1 = (const bf16*)(ws + WS_PART1); const bf16* p2 = (const bf16*)(ws + WS_PART2);
    const int h = lane_ >> 3;
    f32x4 an0 = ((const GAS f32x4*)attn_norm)[2 * lane_], an1 = ((const GAS f32x4*)attn_norm)[2 * lane_ + 1];
    for (int tl = gw; tl < T / 16; tl += NGW) {
#pragma unroll 1
        for (int g4 = 0; g4 < 4; ++g4) {
            const int mb = tl * 16 + 4 * g4;
            float l0[4], l1[4], l2[4]; v4u pa[4], pb[4], pc[4];
#pragma unroll
            for (int r = 0; r < 4; ++r) { const size_t m = (size_t)(mb + r);
                l0[r] = lse[m * 8 + h]; l1[r] = lse[(size_t)T * 8 + m * 8 + h]; l2[r] = lse[(size_t)2 * T * 8 + m * 8 + h];
                pa[r] = *(const GAS v4u*)(p0 + m * 512 + 8 * lane_); pb[r] = *(const GAS v4u*)(p1 + m * 512 + 8 * lane_); pc[r] = *(const GAS v4u*)(p2 + m * 512 + 8 * lane_); }
            float o[4][8], ss[4];
#pragma unroll
            for (int r = 0; r < 4; ++r) {
                const float mx = fmaxf(l0[r], fmaxf(l1[r], l2[r]));
                float w0 = __builtin_amdgcn_exp2f(l0[r] - mx), w1 = __builtin_amdgcn_exp2f(l1[r] - mx), w2 = __builtin_amdgcn_exp2f(l2[r] - mx);
                const float inv = 1.f / (w0 + w1 + w2); w0 *= inv; w1 *= inv; w2 *= inv;
                float s = 0.f;
#pragma unroll
                for (int q = 0; q < 4; ++q) { const unsigned ua = pa[r][q], ub = pb[r][q], uc = pc[r][q];
                    o[r][2 * q] = w0 * __uint_as_float(ua << 16) + w1 * __uint_as_float(ub << 16) + w2 * __uint_as_float(uc << 16);
                    o[r][2 * q + 1] = w0 * __uint_as_float(ua & 0xFFFF0000u) + w1 * __uint_as_float(ub & 0xFFFF0000u) + w2 * __uint_as_float(uc & 0xFFFF0000u);
                    s += o[r][2 * q] * o[r][2 * q] + o[r][2 * q + 1] * o[r][2 * q + 1]; }
                ss[r] = s; }
#pragma unroll
            for (int r = 0; r < 4; ++r) ss[r] = wave_sum(ss[r]);
#pragma unroll
            for (int r = 0; r < 4; ++r) { const float ra = __builtin_amdgcn_rsqf(ss[r] * (1.f / 512.f) + EPS);
                v4u w;
                w.x = pk2(o[r][0] * ra * an0.x, o[r][1] * ra * an0.y); w.y = pk2(o[r][2] * ra * an0.z, o[r][3] * ra * an0.w);
                w.z = pk2(o[r][4] * ra * an1.x, o[r][5] * ra * an1.y); w.w = pk2(o[r][6] * ra * an1.z, o[r][7] * ra * an1.w);
                *(GAS v4u*)(Y + (size_t)(mb + r) * 1024 + 512 + 8 * lane_) = w; }
        }
    }
}
namespace gdn {
__device__ __forceinline__ float fsilu(float x) { return x * __builtin_amdgcn_rcpf(1.f + __builtin_amdgcn_exp2f(-1.4426950408889634f * x)); }
typedef short bf16x8 __attribute__((ext_vector_type(8)));
typedef short s16x4 __attribute__((ext_vector_type(4)));
typedef float f32x4 __attribute__((ext_vector_type(4)));
typedef float f32x16 __attribute__((ext_vector_type(16)));
typedef unsigned u32x4 __attribute__((ext_vector_type(4)));
typedef __bf16 bf16x2_t __attribute__((ext_vector_type(2)));
constexpr int NCH = 2048;
constexpr int SCAN_BYTES = 49152;
__device__ __forceinline__ int sigma_inv(int x) { return (x & ~31) | (((x >> 2) & 3) << 3) | (((x >> 4) & 1) << 2) | (x & 3); }
__device__ __forceinline__ int crow(int r, int hi) { return (r & 3) + 8 * (r >> 2) + 4 * hi; }
__device__ __forceinline__ unsigned cvtpk(float lo, float hi) { typedef float f32x2_t_ __attribute__((ext_vector_type(2))); typedef __bf16 bf16x2_t_ __attribute__((ext_vector_type(2))); const f32x2_t_ v_ = {lo, hi}; return __builtin_bit_cast(unsigned, __builtin_convertvector(v_, bf16x2_t_)); }
__device__ __forceinline__ float bflo(unsigned w) { return __uint_as_float(w << 16); }
__device__ __forceinline__ float bfhi(unsigned w) { return __uint_as_float(w & 0xFFFF0000u); }
__device__ __forceinline__ s16x4 vtr(const LAS unsigned char* p) { typedef short v4i16_t __attribute__((ext_vector_type(4)));
    return __builtin_bit_cast(s16x4, __builtin_amdgcn_ds_read_tr16_b64_v4i16((LAS v4i16_t*)p)); }
__device__ __forceinline__ int sw256(int row, int col) { return row * 256 + ((((col >> 3) ^ (row & 15)) << 4) | ((col & 7) << 1)); }
__device__ __forceinline__ int sw128(int row, int col) { return row * 128 + ((((col >> 3) ^ ((row >> 1) & 7)) << 4) | ((col & 7) << 1)); }

constexpr int L_QN = 0, L_KN = 16384, L_KGT = 32768, L_AQK = 49152, L_G = 57344  , L_A = 59392  , L_G8 = 124928  ;

#if MK_PROF_A >= 100 && MK_PROF_A < 110
#define PROFX(idx) do { if (blockIdx.x == 0 && F.wave == 0 && pg8::lane_now() == 0) { const unsigned long long t_ = __builtin_amdgcn_s_memrealtime(); \
        const unsigned long long p_ = ((unsigned long long)F.MISC[23] << 32) | F.MISC[22]; if ((idx) >= 0) F.MISC[24 + (idx)] = __float_as_uint(__uint_as_float(F.MISC[24 + (idx)]) + (float)(t_ - p_) * 0.01f); \
        F.MISC[22] = (unsigned)t_; F.MISC[23] = (unsigned)(t_ >> 32); } } while (0)
#else
#define PROFX(idx) do {} while (0)
#endif
__device__ __forceinline__ void a1_phase(Frame& F, unsigned char* ws, unsigned char* dout, const float* wconv) {
    const int w = F.wave;
    PROFX(-1);
    const bf16* qkva = (const bf16*)(ws + WS_QKVA); const float* bg = (const float*)(ws + WS_BG);
    unsigned char* scanops = dout; bf16* QGb = (bf16*)(dout + 96 * MiB); bf16* AQKb = (bf16*)(ws + WS_GAQK); float* GLb = (float*)(ws + WS_GGL);
    bf16* RS = (bf16*)(ws + WS_H);
    LAS unsigned char* L = F.lds + RING_OFF;
    for (int grp = F.vcu; grp < NCH / 8; grp += F.G) {
        {
            const int lane = pg8::lane_now(), ch = grp * 8 + w, n = ch & 63, bh = ch >> 6, h = bh & 3, b = bh >> 2;
            const size_t m0 = (size_t)b * SEQ + n * 64;
            LAS float* Gs = (LAS float*)(L + L_G8 + w * 1024);
            float gq = bg[(m0 + lane) * 8 + 4 + h]; const float be = bg[(m0 + lane) * 8 + h];
#pragma unroll
            for (int o = 1; o < 64; o <<= 1) { const float t = __shfl_up(gq, o); if (lane >= o) gq += t; }
            const float glast = __shfl(gq, 63);
            Gs[lane] = gq; Gs[64 + lane] = __expf(gq); Gs[128 + lane] = be; Gs[192 + lane] = __expf(glast - gq);
            if (lane == 0) GLb[ch] = __expf(glast);
        }
        unsigned rq[11], rk[11], rv[11];
#define A1_LOADRAW(ci_) do { const int ch_ = grp * 8 + (ci_), n_ = ch_ & 63, bh_ = ch_ >> 6, h_ = bh_ & 3, b_ = bh_ >> 2; const int ln_ = pg8::lane_now(); \
            _Pragma("unroll") for (int t = 0; t < 11; ++t) { const int tt = n_ * 64 + 8 * w - 3 + t; \
                if (tt >= 0) { const size_t m = ((size_t)(b_ * 4 + h_) * SEQ + tt) * 384 + 2 * ln_; rq[t] = *(const GAS unsigned*)(qkva + m); rk[t] = *(const GAS unsigned*)(qkva + m + 128); rv[t] = *(const GAS unsigned*)(qkva + m + 256); } \
                else { rq[t] = 0u; rk[t] = 0u; rv[t] = 0u; } } } while (0)
        A1_LOADRAW(0);
        float wq[4][2], wk[4][2], wv[4][2];
        { const int ln_ = pg8::lane_now(), cq = ((grp >> 3) & 3) * 128 + 2 * ln_, ck = 512 + cq, cv = 1024 + cq;
#pragma unroll
          for (int t = 0; t < 4; ++t) { wq[t][0] = wconv[t * 1536 + cq]; wq[t][1] = wconv[t * 1536 + cq + 1]; wk[t][0] = wconv[t * 1536 + ck]; wk[t][1] = wconv[t * 1536 + ck + 1];
              wv[t][0] = wconv[t * 1536 + cv]; wv[t][1] = wconv[t * 1536 + cv + 1]; } }
        for (int ci = 0; ci < 8; ++ci) {
            const int ch = grp * 8 + ci, n = ch & 63, bh = ch >> 6, h = bh & 3, b = bh >> 2;
            const int t0 = n * 64; const size_t m0 = (size_t)b * SEQ + t0;
            const int lane = pg8::lane_now(), tid = w * 64 + lane, i32 = lane & 31, h2 = lane >> 5;
            __syncthreads(); PROFX(0);
            LAS float* Gs = (LAS float*)(L + L_G8 + ci * 1024); LAS float* eG = Gs + 64; LAS float* bet = Gs + 128; LAS float* eGl = Gs + 192;
            {
                float kg0[8], kg1[8];
#pragma unroll
                for (int rr = 0; rr < 8; ++rr) {
                    const int c = 8 * w + rr;
                    unsigned xq[4], xk[4], xv[4];
#pragma unroll
                    for (int t = 0; t < 4; ++t) { xq[t] = rq[rr + t]; xk[t] = rk[rr + t]; xv[t] = rv[rr + t]; }
                    float q0 = 0.f, q1 = 0.f, k0 = 0.f, k1 = 0.f, v0 = 0.f, v1 = 0.f;
#pragma unroll
                    for (int t = 0; t < 4; ++t) { q0 += wq[t][0] * bflo(xq[t]); q1 += wq[t][1] * bfhi(xq[t]); k0 += wk[t][0] * bflo(xk[t]); k1 += wk[t][1] * bfhi(xk[t]);
                        v0 += wv[t][0] * bflo(xv[t]); v1 += wv[t][1] * bfhi(xv[t]); }
                    q0 = fsilu(q0); q1 = fsilu(q1); k0 = fsilu(k0); k1 = fsilu(k1); v0 = fsilu(v0); v1 = fsilu(v1);
                    const float sq = wave_sum(q0 * q0 + q1 * q1), sk = wave_sum(k0 * k0 + k1 * k1);
                    const float rq = __builtin_amdgcn_rsqf(sq + EPS) * 0.08838834764831845f, rk = __builtin_amdgcn_rsqf(sk + EPS);
                    q0 *= rq; q1 *= rq; k0 *= rk; k1 *= rk;
                    const float be = bet[c], eg = eG[c], egl = eGl[c];
                    const int kc = 2 * lane;
                    *(LAS unsigned*)(L + L_QN + sw256(c, kc)) = cvtpk(q0, q1);
                    *(LAS unsigned*)(L + L_KN + sw256(c, kc)) = cvtpk(k0, k1);
                    kg0[rr] = k0 * egl; kg1[rr] = k1 * egl;
                    *(GAS unsigned*)(QGb + (size_t)ch * 8192 + c * 128 + sigma_inv(kc)) = cvtpk(q0 * eg, q1 * eg);
                    *(GAS unsigned*)(RS + (size_t)ch * 16384 + c * 256 + kc) = cvtpk(k0 * be * eg, k1 * be * eg);
                    *(GAS unsigned*)(RS + (size_t)ch * 16384 + c * 256 + 128 + kc) = cvtpk(v0 * be, v1 * be);
                }
                { const int kc = 2 * lane, c0 = 8 * w, p0 = (c0 & ~31) | (((c0 >> 2) & 3) << 3) | (((c0 >> 4) & 1) << 2);
                  typedef unsigned u32x2 __attribute__((ext_vector_type(2)));
                  *(LAS u32x2*)(L + L_KGT + sw128(kc, p0)) = (u32x2){cvtpk(kg0[0], kg0[1]), cvtpk(kg0[2], kg0[3])};
                  *(LAS u32x2*)(L + L_KGT + sw128(kc, p0 + 8)) = (u32x2){cvtpk(kg0[4], kg0[5]), cvtpk(kg0[6], kg0[7])};
                  *(LAS u32x2*)(L + L_KGT + sw128(kc + 1, p0)) = (u32x2){cvtpk(kg1[0], kg1[1]), cvtpk(kg1[2], kg1[3])};
                  *(LAS u32x2*)(L + L_KGT + sw128(kc + 1, p0 + 8)) = (u32x2){cvtpk(kg1[4], kg1[5]), cvtpk(kg1[6], kg1[7])}; }
            }
            if (ci < 7) A1_LOADRAW(ci + 1);
            __syncthreads(); PROFX(1);
            {
                const int pw = w >> 2, ti = (w >> 1) & 1, tj = w & 1;
                f32x16 acc = {0.f, 0.f, 0.f, 0.f, 0.f, 0.f, 0.f, 0.f, 0.f, 0.f, 0.f, 0.f, 0.f, 0.f, 0.f, 0.f};
                const LAS unsigned char* Ab = L + (pw ? L_QN : L_KN);
#pragma unroll
                for (int s = 0; s < 8; ++s) {
                    const bf16x8 af = *(const LAS bf16x8*)(Ab + sw256(32 * ti + i32, 16 * s + 8 * h2));
                    const bf16x8 bf = *(const LAS bf16x8*)(L + L_KN + sw256(32 * tj + i32, 16 * s + 8 * h2));
                    acc = __builtin_amdgcn_mfma_f32_32x32x16_bf16(af, bf, acc, 0, 0, 0);
                }
                const int j = 32 * tj + i32; const float Gj = Gs[j];
                if (pw == 0) {
                    LAS unsigned char* As = L + L_A + ci * 8192;
#pragma unroll
                    for (int rg = 0; rg < 16; ++rg) { const int i = 32 * ti + crow(rg, h2);
                        const float v = (j < i) ? bet[i] * acc[rg] * __expf(Gs[i] - Gj) : 0.f;
                        *(LAS bf16*)(As + i * 128 + j * 2) = (bf16)f2bf(v); }
                } else {
                    const int pj = sigma_inv(j);
#pragma unroll
                    for (int rg = 0; rg < 16; ++rg) { const int i = 32 * ti + crow(rg, h2);
                        const float v = (j <= i) ? acc[rg] * __expf(Gs[i] - Gj) : 0.f;
                        *(LAS bf16*)(L + L_AQK + i * 128 + pj * 2) = (bf16)f2bf(v); }
                }
            }
            __syncthreads(); PROFX(2);
            {
#pragma unroll
                for (int q = 0; q < 2; ++q) { const int off = (tid + 512 * q) * 16; *(GAS u32x4*)(scanops + (size_t)ch * SCAN_BYTES + 16384 + off) = *(const LAS u32x4*)(L + L_KGT + off); }
                { const int off = tid * 16; *(GAS u32x4*)((unsigned char*)AQKb + (size_t)ch * 8192 + off) = *(const LAS u32x4*)(L + L_AQK + off); }
            }
        }
        __syncthreads(); PROFX(3);
#if MK_A1 == 1
        {
            const int lane = pg8::lane_now(), tid = w * 64 + lane;
#pragma unroll
            for (int q = 0; q < 8; ++q) { const int off = (tid + 512 * q) * 16; *(GAS u32x4*)(ws + WS_PART2 + (size_t)grp * 65536 + off) = *(const LAS u32x4*)(L + L_A + off); }
        }
#else
        {
            const int lane = pg8::lane_now();
            LAS unsigned char* As = L + L_A + w * 8192;
            unsigned tp[32];
            float tprev = 0.f;
#pragma unroll
            for (int i = 0; i < 64; ++i) {
                float acc = 0.f;
#pragma unroll
                for (int p = 0; p < i / 2; ++p) { const unsigned lwp = *(const LAS unsigned*)(As + i * 128 + p * 4);
                    acc = __builtin_amdgcn_fdot2_f32_bf16(__builtin_bit_cast(bf16x2_t, lwp), __builtin_bit_cast(bf16x2_t, tp[p]), acc, false); }
                if (i & 1) { const unsigned lw1 = *(const LAS unsigned*)(As + i * 128 + (i - 1) * 2); acc += bflo(lw1) * tprev; }
                const float ti = ((lane == i) ? 1.f : 0.f) - acc;
                if (i & 1) tp[i >> 1] = cvtpk(tprev, ti);
                tprev = ti;
            }
#pragma unroll
            for (int p = 0; p < 32; ++p) { *(LAS bf16*)(As + (2 * p) * 128 + lane * 2) = (bf16)(tp[p] & 0xFFFFu); *(LAS bf16*)(As + (2 * p + 1) * 128 + lane * 2) = (bf16)(tp[p] >> 16); }
        }
        __syncthreads(); PROFX(4);
        u32x4 rpre[4];
        for (int ci = 0; ci < 8; ++ci) {
            const int ch = grp * 8 + ci;
            const int lane = pg8::lane_now(), tid = w * 64 + lane, i32 = lane & 31, h2 = lane >> 5;
            __syncthreads();
            if (ci == 0) {
#pragma unroll
                for (int q = 0; q < 4; ++q) rpre[q] = *(const GAS u32x4*)((const unsigned char*)RS + (size_t)ch * 32768 + (tid + 512 * q) * 16); }
#pragma unroll
            for (int q = 0; q < 4; ++q) *(LAS u32x4*)(L + (tid + 512 * q) * 16) = rpre[q];
            if (ci < 7) {
#pragma unroll
                for (int q = 0; q < 4; ++q) rpre[q] = *(const GAS u32x4*)((const unsigned char*)RS + (size_t)(ch + 1) * 32768 + (tid + 512 * q) * 16); }
            __syncthreads();
            const LAS unsigned char* Ts = L + L_A + ci * 8192;
            f32x16 x0 = {0.f, 0.f, 0.f, 0.f, 0.f, 0.f, 0.f, 0.f, 0.f, 0.f, 0.f, 0.f, 0.f, 0.f, 0.f, 0.f}, x1 = x0;
            const LAS unsigned char* rb = L + (8 * h2 + ((lane & 15) >> 2)) * 512 + (32 * w + 16 * ((lane >> 4) & 1) + 4 * (lane & 3)) * 2;
#pragma unroll
            for (int s = 0; s < 4; ++s) {
                const s16x4 lo = vtr(rb + (16 * s) * 512), hi = vtr(rb + (16 * s + 4) * 512);
                const bf16x8 bf = (bf16x8){lo[0], lo[1], lo[2], lo[3], hi[0], hi[1], hi[2], hi[3]};
                const bf16x8 a0 = *(const LAS bf16x8*)(Ts + i32 * 128 + (16 * s + 8 * h2) * 2), a1 = *(const LAS bf16x8*)(Ts + (32 + i32) * 128 + (16 * s + 8 * h2) * 2);
                x0 = __builtin_amdgcn_mfma_f32_32x32x16_bf16(a0, bf, x0, 0, 0, 0);
                x1 = __builtin_amdgcn_mfma_f32_32x32x16_bf16(a1, bf, x1, 0, 0, 0);
            }
            __syncthreads();
            {
                const int x = 32 * w + i32;
#pragma unroll
                for (int rg = 0; rg < 16; ++rg) {
#pragma unroll
                    for (int mt = 0; mt < 2; ++mt) { const int c = 32 * mt + crow(rg, h2); const float v = mt ? x1[rg] : x0[rg];
                        if (x < 128) *(LAS bf16*)(L + sw256(c, sigma_inv(x))) = (bf16)f2bf(-v);
                        else { const int vv = x - 128; const int idx = (((vv >> 4) * 64 + (vv & 15) + 16 * ((c >> 2) & 3)) * 16 + (c >> 4) * 4 + (c & 3));
                               *(LAS bf16*)(L + 16384 + idx * 2) = (bf16)f2bf(v); } }
                }
            }
            __syncthreads();
#pragma unroll
            for (int q = 0; q < 2; ++q) { const int off = (tid + 512 * q) * 16;
                *(GAS u32x4*)(scanops + (size_t)ch * SCAN_BYTES + off) = *(const LAS u32x4*)(L + off);
                *(GAS u32x4*)(scanops + (size_t)ch * SCAN_BYTES + 32768 + off) = *(const LAS u32x4*)(L + 16384 + off); }
        }
#endif
        __syncthreads(); PROFX(5);
    }
}

__device__ __forceinline__ void glds16(const void* gsrc, unsigned lds_dst) { unsigned keep;
    asm volatile("s_mov_b32 %0, m0\n\ts_mov_b32 m0, %2\n\ts_nop 0\n\tglobal_load_lds_dwordx4 %1, off\n\ts_mov_b32 m0, %0" : "=&s"(keep) : "v"(gsrc), "s"(lds_dst) : "memory"); }

__device__ __forceinline__ void scan_phase(Frame& F, unsigned char* ws, const unsigned char* dout, int bh) {
    const int lane = pg8::lane_now(), w = F.wave;
    const unsigned char* scanops = dout; const float* GLb = (const float*)(ws + WS_GGL);
    bf16* ST = (bf16*)(ws + WS_QKVA); bf16* UT = (bf16*)(ws + WS_QKVA + 64 * MiB);
    LAS unsigned char* L = F.lds + RING_OFF;
    const unsigned lds0 = (unsigned)(uintptr_t)(F.lds + RING_OFF);
    const int v16 = lane & 15, kg = lane >> 4;
    f32x4 Sf[8];
#pragma unroll
    for (int mt = 0; mt < 8; ++mt) Sf[mt] = (f32x4){0.f, 0.f, 0.f, 0.f};
    float glv = GLb[bh * 64 + lane];
    asm volatile("s_waitcnt vmcnt(0)" : "+v"(glv));
#define GDN_STAGE3(n, sl_) do { const unsigned char* src_ = scanops + (size_t)(bh * 64 + (n)) * SCAN_BYTES + lane * 16; \
        _Pragma("unroll") for (int q_ = 0; q_ < 6; ++q_) { const int piece_ = w * 6 + q_; \
            glds16(src_ + piece_ * 1024, (unsigned)__builtin_amdgcn_readfirstlane(lds0 + (sl_) * SCAN_BYTES + piece_ * 1024)); } } while (0)
#define GDN_STAGE(n) GDN_STAGE3(n, n)
    GDN_STAGE(0); GDN_STAGE(1);
    asm volatile("s_waitcnt vmcnt(6)" ::: "memory");
    int slot = 0, slot2 = 2;
    u32x4 Sb[4], Ub[2];
    for (int n = 0; n < 64; ++n) {
#if MK_PROF_A == 138
        const unsigned long long tb0_ = __builtin_amdgcn_s_memrealtime();
#endif
        __builtin_amdgcn_s_barrier();
#if MK_PROF_A == 138
        if (blockIdx.x == 0 && w == 0 && lane == 0) F.MISC[30] = __float_as_uint(__uint_as_float(F.MISC[30]) + (float)(__builtin_amdgcn_s_memrealtime() - tb0_) * 0.01f);
#endif
        asm volatile("" ::: "memory");
        if (n + 2 < 64) GDN_STAGE3(n + 2, slot2);
        const LAS unsigned char* sl = L + slot * SCAN_BYTES;
        const float gl = __shfl(glv, n);
#pragma unroll
        for (int s = 0; s < 4; ++s) { Sb[s].x = cvtpk(Sf[2 * s][0], Sf[2 * s][1]); Sb[s].y = cvtpk(Sf[2 * s][2], Sf[2 * s][3]); Sb[s].z = cvtpk(Sf[2 * s + 1][0], Sf[2 * s + 1][1]); Sb[s].w = cvtpk(Sf[2 * s + 1][2], Sf[2 * s + 1][3]); }
        f32x4 Uf[4];
        { const u32x4 u0 = *(const LAS u32x4*)(sl + 32768 + (w * 64 + lane) * 32), u1 = *(const LAS u32x4*)(sl + 32768 + (w * 64 + lane) * 32 + 16);
          Uf[0] = (f32x4){bflo(u0.x), bfhi(u0.x), bflo(u0.y), bfhi(u0.y)}; Uf[1] = (f32x4){bflo(u0.z), bfhi(u0.z), bflo(u0.w), bfhi(u0.w)};
          Uf[2] = (f32x4){bflo(u1.x), bfhi(u1.x), bflo(u1.y), bfhi(u1.y)}; Uf[3] = (f32x4){bflo(u1.z), bfhi(u1.z), bflo(u1.w), bfhi(u1.w)}; }
        bf16x8 ak[16];
        {
            bf16x8 aw[16];
#pragma unroll
            for (int mt = 0; mt < 4; ++mt)
#pragma unroll
                for (int s = 0; s < 4; ++s) aw[mt * 4 + s] = *(const LAS bf16x8*)(sl + sw256(16 * mt + v16, 32 * s + 8 * kg));
#pragma unroll
            for (int s = 0; s < 4; ++s)
#pragma unroll
                for (int mt = 0; mt < 4; ++mt) Uf[mt] = __builtin_amdgcn_mfma_f32_16x16x32_bf16(aw[mt * 4 + s], __builtin_bit_cast(bf16x8, Sb[s]), Uf[mt], 0, 0, 0);
#pragma unroll
            for (int mt = 0; mt < 8; ++mt)
#pragma unroll
                for (int s = 0; s < 2; ++s) ak[mt * 2 + s] = *(const LAS bf16x8*)(sl + 16384 + sw128(16 * mt + v16, 32 * s + 8 * kg));
            __builtin_amdgcn_sched_group_barrier(0x100, 34, 0);
            __builtin_amdgcn_sched_group_barrier(0x008, 16, 0);
        }
#pragma unroll
        for (int s = 0; s < 2; ++s) { Ub[s].x = cvtpk(Uf[2 * s][0], Uf[2 * s][1]); Ub[s].y = cvtpk(Uf[2 * s][2], Uf[2 * s][3]); Ub[s].z = cvtpk(Uf[2 * s + 1][0], Uf[2 * s + 1][1]); Ub[s].w = cvtpk(Uf[2 * s + 1][2], Uf[2 * s + 1][3]); }
        {
#pragma unroll
            for (int mt = 0; mt < 8; ++mt) Sf[mt] = Sf[mt] * gl;
#pragma unroll
            for (int s = 0; s < 2; ++s)
#pragma unroll
                for (int mt = 0; mt < 8; ++mt) Sf[mt] = __builtin_amdgcn_mfma_f32_16x16x32_bf16(ak[mt * 2 + s], __builtin_bit_cast(bf16x8, Ub[s]), Sf[mt], 0, 0, 0);
        }
#if MK_PROF_A == 136 || MK_PROF_A == 137
        const unsigned long long tw0_ = __builtin_amdgcn_s_memrealtime();
#endif
        if (n + 2 < 64) asm volatile("s_waitcnt vmcnt(6) lgkmcnt(0)" ::: "memory"); else asm volatile("s_waitcnt vmcnt(0) lgkmcnt(0)" ::: "memory");
#if MK_PROF_A == 136 || MK_PROF_A == 137
        if (blockIdx.x == 0 && w == (MK_PROF_A == 136 ? 0 : 5) && lane == 0) F.MISC[30] = __float_as_uint(__uint_as_float(F.MISC[30]) + (float)(__builtin_amdgcn_s_memrealtime() - tw0_) * 0.01f);
#endif
        { bf16* dst = ST + (size_t)(bh * 64 + n) * 16384 + (w * 4 * 64 + lane) * 8;
#pragma unroll
          for (int s = 0; s < 4; ++s) __builtin_nontemporal_store(Sb[s], (GAS u32x4*)(dst + s * 512)); }
        { bf16* dst = UT + (size_t)(bh * 64 + n) * 8192 + (w * 2 * 64 + lane) * 8;
#pragma unroll
          for (int s = 0; s < 2; ++s) __builtin_nontemporal_store(Ub[s], (GAS u32x4*)(dst + s * 512)); }
        slot = (slot == 2) ? 0 : slot + 1; slot2 = (slot2 == 2) ? 0 : slot2 + 1;
    }
    asm volatile("s_waitcnt vmcnt(0) lgkmcnt(0)" ::: "memory");
    __builtin_amdgcn_s_barrier();
#undef GDN_STAGE
#undef GDN_STAGE3
}

__device__ __forceinline__ void a3_phase(Frame& F, unsigned char* ws, const unsigned char* dout, const float* gdn_norm) {
    const int lane = pg8::lane_now(), w = F.wave, tid = w * 64 + lane;
    const bf16* QGb = (const bf16*)(dout + 96 * MiB); const bf16* AQKb = (const bf16*)(ws + WS_GAQK);
    const bf16* ST = (const bf16*)(ws + WS_QKVA); const bf16* UT = (const bf16*)(ws + WS_QKVA + 64 * MiB);
    const bf16* Z = (const bf16*)(ws + WS_Z); bf16* Y = (bf16*)(ws + WS_Y);
    LAS float* Ot = (LAS float*)(F.lds + RING_OFF);
    const int v16 = lane & 15, kg = lane >> 4;
    const int c = tid >> 3, v0 = 16 * (tid & 7);
    f32x4 gn[4];
#pragma unroll
    for (int q = 0; q < 4; ++q) gn[q] = *(const GAS f32x4*)(gdn_norm + v0 + 4 * q);
    LAS unsigned char* LQ = F.lds + RING_OFF + 34816; LAS unsigned char* LA = LQ + 16384;
    bf16x8 fb[6]; u32x4 gq[3];
#define A3_LOADB(ch_) do { const int ch__ = (ch_); \
        const bf16* sp_ = ST + (size_t)ch__ * 16384 + (w * 4 * 64 + lane) * 8; const bf16* up_ = UT + (size_t)ch__ * 8192 + (w * 2 * 64 + lane) * 8; \
        _Pragma("unroll") for (int s = 0; s < 4; ++s) fb[s] = *(const GAS bf16x8*)(sp_ + 512 * s); \
        _Pragma("unroll") for (int s = 0; s < 2; ++s) fb[4 + s] = *(const GAS bf16x8*)(up_ + 512 * s); } while (0)
#define A3_LOADA(ch_) do { const int ch__ = (ch_); \
        gq[0] = *(const GAS u32x4*)((const unsigned char*)QGb + (size_t)ch__ * 16384 + tid * 16); gq[1] = *(const GAS u32x4*)((const unsigned char*)QGb + (size_t)ch__ * 16384 + (tid + 512) * 16); \
        gq[2] = *(const GAS u32x4*)((const unsigned char*)AQKb + (size_t)ch__ * 8192 + tid * 16); } while (0)
    if (F.vcu < NCH) { A3_LOADA(F.vcu); A3_LOADB(F.vcu); }
    for (int ch = F.vcu; ch < NCH; ch += F.G) {
        const int n = ch & 63, bh = ch >> 6, h = bh & 3, b = bh >> 2;
        const size_t m = (size_t)b * SEQ + n * 64 + c;
        const size_t zo = ((size_t)(b * 4 + h) * SEQ + n * 64 + c) * 128 + v0;
        const u32x4 z0 = *(const GAS u32x4*)(Z + zo), z1 = *(const GAS u32x4*)(Z + zo + 8);
        { const int r0 = tid >> 4, r1 = (tid + 512) >> 4, r2 = tid >> 3;
          *(LAS u32x4*)(LQ + r0 * 256 + (((tid & 15) ^ (r0 & 15)) << 4)) = gq[0]; *(LAS u32x4*)(LQ + r1 * 256 + (((tid & 15) ^ (r1 & 15)) << 4)) = gq[1];
          *(LAS u32x4*)(LA + r2 * 128 + (((tid & 7) ^ (r2 & 7)) << 4)) = gq[2]; }
        __syncthreads();
        if (ch + F.G < NCH) A3_LOADA(ch + F.G);
        f32x4 acc[4];
#pragma unroll
        for (int mt = 0; mt < 4; ++mt) acc[mt] = (f32x4){0.f, 0.f, 0.f, 0.f};
#pragma unroll
        for (int s = 0; s < 4; ++s) {
            bf16x8 fa[4];
#pragma unroll
            for (int mt = 0; mt < 4; ++mt) fa[mt] = *(const LAS bf16x8*)(LQ + (16 * mt + v16) * 256 + (((4 * s + kg) ^ v16) << 4));
#pragma unroll
            for (int mt = 0; mt < 4; ++mt) acc[mt] = __builtin_amdgcn_mfma_f32_16x16x32_bf16(fa[mt], fb[s], acc[mt], 0, 0, 0); }
#pragma unroll
        for (int s = 0; s < 2; ++s) {
            bf16x8 fa[4];
#pragma unroll
            for (int mt = 0; mt < 4; ++mt) fa[mt] = *(const LAS bf16x8*)(LA + (16 * mt + v16) * 128 + (((4 * s + kg) ^ (v16 & 7)) << 4));
#pragma unroll
            for (int mt = 0; mt < 4; ++mt) acc[mt] = __builtin_amdgcn_mfma_f32_16x16x32_bf16(fa[mt], fb[4 + s], acc[mt], 0, 0, 0); }
        if (ch + F.G < NCH) A3_LOADB(ch + F.G);
        __syncthreads();
#pragma unroll
        for (int mt = 0; mt < 4; ++mt)
#pragma unroll
            for (int rg = 0; rg < 4; ++rg) Ot[(16 * mt + 4 * kg + rg) * 132 + 16 * w + v16] = acc[mt][rg];
        __syncthreads();
        {
            f32x4 o[4]; float ss = 0.f;
#pragma unroll
            for (int q = 0; q < 4; ++q) { o[q] = *(const LAS f32x4*)(Ot + c * 132 + v0 + 4 * q); ss += (o[q].x * o[q].x + o[q].y * o[q].y) + (o[q].z * o[q].z + o[q].w * o[q].w); }
            ss = dpp_add(ss, 0); ss = dpp_add(ss, 1);
            ss += __builtin_bit_cast(float, __builtin_amdgcn_mov_dpp(__builtin_bit_cast(int, ss), 0x141, 0xF, 0xF, false));
            const float rg = __builtin_amdgcn_rsqf(ss * (1.f / 128.f) + EPS);
            u32x4 y0, y1;
#pragma unroll
            for (int q = 0; q < 2; ++q) {
                const f32x4 a = o[q] * rg * gn[q], bq = o[2 + q] * rg * gn[2 + q];
                y0[2 * q] = cvtpk(a.x * fsilu(bflo(z0[2 * q])), a.y * fsilu(bfhi(z0[2 * q]))); y0[2 * q + 1] = cvtpk(a.z * fsilu(bflo(z0[2 * q + 1])), a.w * fsilu(bfhi(z0[2 * q + 1])));
                y1[2 * q] = cvtpk(bq.x * fsilu(bflo(z1[2 * q])), bq.y * fsilu(bfhi(z1[2 * q]))); y1[2 * q + 1] = cvtpk(bq.z * fsilu(bflo(z1[2 * q + 1])), bq.w * fsilu(bfhi(z1[2 * q + 1]))); }
            *(GAS u32x4*)(Y + m * 1024 + h * 128 + v0) = y0; *(GAS u32x4*)(Y + m * 1024 + h * 128 + v0 + 8) = y1;
        }
    }
#undef A3_LOADA
#undef A3_LOADB
}
}

__global__ void __launch_bounds__(NWAVES * 64, 2) mega_fwd(Args args) {
    extern __shared__ __attribute__((aligned(16))) unsigned char lds[];
    Frame F;
    F.lds = (LAS unsigned char*)lds;
    F.MISC = (volatile LAS unsigned*)(F.lds + MISC_OFF);
    F.wave = __builtin_amdgcn_readfirstlane(threadIdx.x >> 6);
    F.G = gridDim.x; { const int bx = blockIdx.x; F.vcu = (F.G % 8 == 0) ? (bx % 8) * (F.G / 8) + bx / 8 : bx; }
    unsigned char* ws = args.ws;
    F.ctl = (gu32*)(ws + WS_CTL);
    for (int u = threadIdx.x; u < (LDS_BYTES - LDSCTL_OFF) / 4; u += NWAVES * 64) ((LAS unsigned*)(F.lds + LDSCTL_OFF))[u] = 0u;
    __syncthreads();
    const int lo = args.ph_lo, hi = args.ph_hi;
    const bool multi = (hi - lo) > 1;
    XcdBarrier bar; bar.bar = (unsigned*)(F.ctl + CW_BAR) + args.li * XCD_BAR_WORDS; bar.x = 0; bar.st = nullptr; bar.wave = F.wave;
    if (multi) bar = xcd_barrier_post((unsigned*)(F.ctl + CW_BAR) + args.li * XCD_BAR_WORDS, F.MISC + 8, F.wave);
#ifndef MK_REP
#define MK_REP -1
#endif
#define REPS(k) (((k) == MK_REP) ? 2 : 1)
#define IN(k) (lo <= (k) && (k) < hi)
#define BOTH(k) (IN(k) && IN((k) + 1))
#if MK_PROF_A >= 140 && MK_PROF_A < 180
#define GRID_BAR() do { if (F.wave == 0 && pg8::lane_now() == 0) { const unsigned long long t_ = __builtin_amdgcn_s_memrealtime(); const unsigned long long p_ = ((unsigned long long)F.MISC[17] << 32) | F.MISC[16]; \
        if ((int)F.MISC[18] == (MK_PROF_A % 20)) { const unsigned d_ = (unsigned)(t_ - p_); atomicMax((unsigned*)(F.ctl + CW_CNT + 72), MK_PROF_A < 160 ? d_ : 0x7FFFFFFFu - d_); } } \
        xcd_barrier(bar); if (F.wave == 0 && pg8::lane_now() == 0) { const unsigned long long t2_ = __builtin_amdgcn_s_memrealtime(); F.MISC[16] = (unsigned)t2_; F.MISC[17] = (unsigned)(t2_ >> 32); F.MISC[18] = F.MISC[18] + 1u; } } while (0)
#else
#define GRID_BAR() do { xcd_barrier(bar); PROF_STAMP(); } while (0)
#endif
#if MK_PROF_A >= 0
    if (F.wave == 0 && pg8::lane_now() == 0) { const unsigned long long t_ = __builtin_amdgcn_s_memrealtime(); F.MISC[16] = (unsigned)t_; F.MISC[17] = (unsigned)(t_ >> 32); F.MISC[18] = (unsigned)lo; F.MISC[19] = 0u; F.MISC[20] = 0u; }
#define PROF_STAMP() do { if (F.wave == 0 && pg8::lane_now() == 0) { const unsigned long long t_ = __builtin_amdgcn_s_memrealtime(); \
        const unsigned long long p_ = ((unsigned long long)F.MISC[17] << 32) | F.MISC[16]; const float d_ = (float)(t_ - p_) * 0.01f; const int k_ = (int)F.MISC[18]; \
        if (k_ == MK_PROF_A) F.MISC[19] = __float_as_uint(d_); if (k_ == MK_PROF_B) F.MISC[20] = __float_as_uint(d_); F.MISC[16] = (unsigned)t_; F.MISC[17] = (unsigned)(t_ >> 32); F.MISC[18] = (unsigned)(k_ + 1); } } while (0)
#else
#define PROF_STAMP() do {} while (0)
#endif

#if MK_PROF_A >= 120 && MK_PROF_A < 130
#define PROFM(idx) do { if (blockIdx.x == 0 && F.wave == 0 && pg8::lane_now() == 0) { const unsigned long long t_ = __builtin_amdgcn_s_memrealtime(); \
        const unsigned long long p_ = ((unsigned long long)F.MISC[23] << 32) | F.MISC[22]; if ((idx) >= 0) F.MISC[24 + (idx)] = __float_as_uint(__uint_as_float(F.MISC[24 + (idx)]) + (float)(t_ - p_) * 0.01f); \
        F.MISC[22] = (unsigned)t_; F.MISC[23] = (unsigned)(t_ >> 32); } } while (0)
#else
#define PROFM(idx) do {} while (0)
#endif
    if (IN(0)) { p0_phase(F, ws, args.in[1], args.in[2], args.in[3], args.in[5], args.in[11], args.in[16], args.in[17], args.in[18], args.in[14], args.in[15]);
        asm volatile("s_waitcnt vmcnt(0)" ::: "memory"); __syncthreads();
        if ((int)blockIdx.x < 192 && F.wave == 0 && pg8::lane_now() == 0) { __builtin_amdgcn_fence(__ATOMIC_RELEASE, "agent"); asm volatile("s_waitcnt vmcnt(0)" ::: "memory"); (void)xb_add((unsigned*)(F.ctl + CW_MODF), 1u); }
        PROF_STAMP(); }
    if (IN(1)) { PROFM(-1); p0b_phase(F, ws, args.in[5], args.in[11], args.in[16], args.in[17], args.in[18]); PROFM(2);
        if (F.wave == 0 && pg8::lane_now() == 0) { unsigned* bw_ = (unsigned*)(F.ctl + CW_BAR) + args.li * XCD_BAR_WORDS; const unsigned need_ = (unsigned)(F.G < 192 ? F.G : 192);
            XB_SPIN(xb_ld((unsigned*)(F.ctl + CW_MODF)) < need_, bw_);
            __builtin_amdgcn_fence(__ATOMIC_ACQUIRE, "agent"); asm volatile("s_waitcnt vmcnt(0)" ::: "memory"); }
        __syncthreads(); PROFM(3);
        p1_phase(F, ws, args.in[0], args.in[4], args.in[5], args.in[7], args.in[8]); PROFM(4);
        if (BOTH(1)) GRID_BAR(); }
    if (IN(2)) { for (int rep_ = 0; rep_ < REPS(2); ++rep_) {
        pg8::Gemm g{(const pg8::bf16_t*)(ws + WS_H), (const pg8::bf16_t*)(ws + WS_WIN), T, NPROJ, D};
        pg8::StaticOrder S; S.init(T, NPROJ, F.G, (int)blockIdx.x);
#if MK_STAGGER > 0
        if (((int)blockIdx.x >> 3) & 1) { if (F.wave == 0 && pg8::lane_now() == 0) { const unsigned long long t0_ = __builtin_amdgcn_s_memrealtime(); while (__builtin_amdgcn_s_memrealtime() - t0_ < (unsigned long long)MK_STAGGER) __builtin_amdgcn_s_sleep(8); } __syncthreads(); }
#endif
        pg8::EpiProj E{ws, 0.125f * 1.4426950408889634f};
        pg8::gemm_phase<pg8::EpiProj, pg8::StaticOrder, true, true>(F.lds + RING_OFF, g, S, E, F.wave); }
        if (BOTH(2)) GRID_BAR();
    }
    if (IN(3)) { for (int rep_ = 0; rep_ < REPS(3); ++rep_) gdn::a1_phase(F, ws, (unsigned char*)args.out, args.in[6]); if (BOTH(3)) GRID_BAR(); }
    if (IN(4)) { for (int rep_ = 0; rep_ < REPS(4); ++rep_) {
        if ((int)blockIdx.x < 32) {
#if MK_PROF_A >= 200
            unsigned long long ts0_ = __builtin_amdgcn_s_memrealtime();
#endif
            for (int r2_ = 0; r2_ < 1 + MK_REPSCAN; ++r2_) gdn::scan_phase(F, ws, (const unsigned char*)args.out, (int)blockIdx.x);
#if MK_PROF_A >= 200
            if (pg8::lane_now() == 0) atomicMax((unsigned*)(F.ctl + CW_CNT + 71), (unsigned)(__builtin_amdgcn_s_memrealtime() - ts0_));
#endif
        }
#if MK_SERIAL_SCAN
        if ((int)blockIdx.x < 32) { __syncthreads(); if (F.wave == 0 && pg8::lane_now() == 0) (void)xb_add((unsigned*)(F.ctl + CW_MODF + 32), 1u); }
        else { if (F.wave == 0 && pg8::lane_now() == 0) { unsigned* bw_ = (unsigned*)(F.ctl + CW_BAR) + args.li * XCD_BAR_WORDS; XB_SPIN(xb_ld((unsigned*)(F.ctl + CW_MODF + 32)) < 32u, bw_); } __syncthreads(); }
#endif
        attn_phase(F, ws, args.in[12]);
        }
        if (BOTH(4)) GRID_BAR(); }
#if MK_PROF_A >= 200
    if (blockIdx.x == MK_PROF_BLK && F.wave == 0 && pg8::lane_now() == 0) { for (int q_ = 0; q_ < 4; ++q_) F.ctl[CW_CNT + 64 + q_] = F.MISC[24 + q_]; }
#endif
    if (IN(5)) { for (int rep_ = 0; rep_ < REPS(5); ++rep_) {
        PROFM(-1);
#if MK_MODE != 2 && MK_MODE != 3
        gdn::a3_phase(F, ws, (const unsigned char*)args.out, args.in[9]);
#endif
        PROFM(0);
        attn_combine_phase(F, ws, args.in[10]); PROFM(1); }
        if (BOTH(5)) GRID_BAR(); }

    if (IN(6)) { for (int rep_ = 0; rep_ < REPS(6); ++rep_) {
        pg8::Gemm g{(const pg8::bf16_t*)(ws + WS_Y), (const pg8::bf16_t*)(ws + WS_WOUT), T, D, D};
        pg8::StaticOrder S; S.init(T, D, F.G, (int)blockIdx.x);
        pg8::EpiRes E{args.in[0], (const float*)(ws + WS_MOD), (pg8::bf16_t*)(ws + WS_XM), 2048};
        pg8::gemm_phase<pg8::EpiRes, pg8::StaticOrder, true, true>(F.lds + RING_OFF, g, S, E, F.wave); }
        if (BOTH(6)) GRID_BAR();
    }
    if (IN(7)) { p5_phase(F, ws, (const bf16*)(ws + WS_XM), args.in[13]); if (BOTH(7)) GRID_BAR(); }
    if (IN(8) || IN(9) || IN(10)) moe_setup(F);
    if (IN(8)) { for (int rep_ = 0; rep_ < REPS(8); ++rep_) {
        pg8::Gemm g{(const pg8::bf16_t*)(ws + WS_H), (const pg8::bf16_t*)(ws + WS_WGU), PROWS, 256, D};
        pg8::MoeOrder<true, 2> S{(const LAS int*)(F.lds + MOE_OFF), (const LAS int*)(F.lds + MOE_OFF) + 33, (const int*)(ws + WS_LTOK), CAP, F.G, F.vcu, (unsigned*)(F.ctl + CW_TCNT), F.wave};
        pg8::EpiHid E{(pg8::bf16_t*)(ws + WS_HID), PROWS * 256 * 2};
        pg8::gemm_phase<pg8::EpiHid, pg8::MoeOrder<true, 2>, true, true>(F.lds + RING_OFF, g, S, E, F.wave); }
        if (BOTH(8)) { __syncthreads(); PROF_STAMP(); }
    }
    if (IN(9)) { for (int rep_ = 0; rep_ < REPS(9); ++rep_) {
        pg8::Gemm g{(const pg8::bf16_t*)(ws + WS_HID), (const pg8::bf16_t*)(ws + WS_WDN), PROWS, D, DEXP};
        pg8::MoeOrder<false, 4> S{(const LAS int*)(F.lds + MOE_OFF), (const LAS int*)(F.lds + MOE_OFF) + 33, (const int*)(ws + WS_LTOK), CAP, F.G, F.vcu, (unsigned*)(F.ctl + CW_TCNT), F.wave};
        pg8::EpiYs E{(pg8::bf16_t*)(ws + WS_YS), (const float*)(ws + WS_LW), (const LAS int*)(F.lds + MOE_OFF) + 33, CAP};
        pg8::gemm_phase<pg8::EpiYs, pg8::MoeOrder<false, 4>, true, true>(F.lds + RING_OFF, g, S, E, F.wave); }
        if (BOTH(9)) GRID_BAR();
    }
    if (IN(10)) { p8_phase(F, ws, args.out, args.in[19]); }
#if MK_PROF_A >= 0
    GRID_BAR();
    if (blockIdx.x == 0) { const int t_ = F.wave * 64 + pg8::lane_now(); if (MK_PROF_A >= 136 && MK_PROF_A <= 138 && t_ == 0) F.MISC[24 + (MK_PROF_A % 10)] = F.MISC[30];
        if (MK_PROF_A >= 140 && MK_PROF_A < 180 && t_ == 0) { const unsigned v_ = F.ctl[CW_CNT + 72]; F.MISC[24 + (MK_PROF_A % 10)] = __float_as_uint((float)(MK_PROF_A < 160 ? v_ : 0x7FFFFFFFu - v_) * 0.01f); }
        if (MK_PROF_A >= 200 && t_ == 0) { for (int q_ = 0; q_ < 4; ++q_) F.MISC[24 + q_] = F.ctl[CW_CNT + 64 + q_]; F.MISC[30] = __float_as_uint((float)F.ctl[CW_CNT + 70] * 0.01f); F.MISC[31] = __float_as_uint((float)F.ctl[CW_CNT + 71] * 0.01f); } __syncthreads();
        const float prof_a = (MK_PROF_A >= 100) ? __uint_as_float(F.MISC[24 + (MK_PROF_A % 10)]) : __uint_as_float(F.MISC[19]), prof_b = (MK_PROF_B >= 100) ? __uint_as_float(F.MISC[24 + (MK_PROF_B % 10)]) : __uint_as_float(F.MISC[20]);
        for (int r = t_; r < T; r += NWAVES * 64) args.out[(size_t)r * D + 1] += prof_b * (1.f / (float)MK_PROF_SB);
        if (t_ == 0) args.out[0] += 10.f + prof_a * (0.01f * (float)MK_PROF_SA); }
#endif
#undef IN
#undef BOTH
}


static int g_grid = 0;
static void launch_mega(Args a, int lo, int hi, int li, hipStream_t stream) {
    a.ph_lo = lo; a.ph_hi = hi; a.li = li;
    void* params[] = {&a};
    hipError_t e = hipLaunchCooperativeKernel((const void*)mega_fwd, dim3(g_grid), dim3(NWAVES * 64), params, LDS_BYTES, stream);
    if (e != hipSuccess) fprintf(stderr, "kernel_launch: cooperative launch [%d,%d) failed: %s (grid %d)\n", lo, hi, hipGetErrorString(e), g_grid);
}

extern "C" void kernel_launch(void* const* d_in, const int* in_sizes, int n_in, void* d_out, int out_size, void* d_ws, size_t ws_size, hipStream_t stream) {
    if (g_grid == 0) {
        if (n_in != 20 || ws_size < WS_NEED || out_size != T * D) { fprintf(stderr, "kernel_launch: unexpected shapes (n_in %d, ws %zu, out %d)\n", n_in, ws_size, out_size); g_grid = -1; return; }
        int dev = 0, cus = 0, per_cu = 0;
        (void)hipGetDevice(&dev); (void)hipDeviceGetAttribute(&cus, hipDeviceAttributeMultiprocessorCount, dev);
        if (hipFuncSetAttribute((const void*)mega_fwd, hipFuncAttributeMaxDynamicSharedMemorySize, LDS_BYTES) != hipSuccess) { fprintf(stderr, "kernel_launch: hipFuncSetAttribute failed\n"); g_grid = -1; return; }
        if (hipOccupancyMaxActiveBlocksPerMultiprocessor(&per_cu, (const void*)mega_fwd, NWAVES * 64, LDS_BYTES) != hipSuccess || per_cu < 1) { fprintf(stderr, "kernel_launch: occupancy query says %d\n", per_cu); per_cu = 1; }
        (void)hipGetLastError();
        g_grid = cus;
        fprintf(stderr, "kernel_launch: cus %d per_cu %d grid %d\n", cus, per_cu, g_grid);
    }
    if (g_grid < 0) return;
    (void)hipMemsetAsync((char*)d_ws + WS_CTL, 0, CTL_ZERO_BYTES, stream);
    Args a{};
    for (int i = 0; i < 20; ++i) a.in[i] = (const float*)d_in[i];
    a.out = (float*)d_out; a.ws = (unsigned char*)d_ws;
#if MK_DEV
#if MK_SPLIT
    launch_mega(a, 0, 1, 0, stream); launch_mega(a, 1, 2, 0, stream); launch_mega(a, 2, 3, 0, stream);
#else
    launch_mega(a, 0, 3, 0, stream);
#endif
#if MK_MODE == 2
    naive_gdn(a, stream); launch_mega(a, 4, 6, 1, stream); naive_yfin_gdn(a, stream); launch_mega(a, 6, 11, 2, stream);
#elif MK_MODE == 5
    launch_mega(a, 3, 4, 1, stream); naive_solve(a, stream); launch_mega(a, 4, 11, 2, stream);
#elif MK_MODE == 4
    launch_mega(a, 3, 4, 1, stream); naive_scan(a, stream); launch_mega(a, 4, 11, 2, stream);
#elif MK_MODE == 3
    launch_mega(a, 3, 6, 1, stream); naive_a3(a, stream); launch_mega(a, 6, 11, 2, stream);
#else
    launch_mega(a, 3, 11, 1, stream);
#endif
#else
    launch_mega(a, 0, 11, 0, stream);
#endif
}
```
